# Optimizing an MI355X kernel written in HIP

```python
import jax
import jax.numpy as jnp
from jax import lax
import numpy as np

D_MODEL = 1024
BATCH = 8
SEQ = 8192
DEPTH = 4

GRID_W = 64
CTX_LEN = 256
HEAD_DIM = 64
MIX_WIDTH = D_MODEL
POOL_WIDTH = MIX_WIDTH // 4
N_POOL = 4
POOL_DIM = POOL_WIDTH // N_POOL
POOL_WINDOWS = (2, 4, 8, 16)
NA_WIDTH = 3 * MIX_WIDTH // 8
NA_HEADS = NA_WIDTH // HEAD_DIM
NA_ROWS = 8
NA_COLS = 16
GQA_WIDTH = MIX_WIDTH - POOL_WIDTH - NA_WIDTH
GQA_Q_HEADS = GQA_WIDTH // HEAD_DIM
GQA_KV_HEADS = 2
GQA_KV_WIDTH = GQA_KV_HEADS * HEAD_DIM
IN_SIZES = (POOL_WIDTH, NA_WIDTH, NA_WIDTH, NA_WIDTH, GQA_WIDTH, GQA_KV_WIDTH, GQA_KV_WIDTH)
IN_WIDTH = POOL_WIDTH + 3 * NA_WIDTH + GQA_WIDTH + 2 * GQA_KV_WIDTH
Q_BLOCK = 128
ROPE_THETA = 10000.0
ROPE_AXIS_DIM = HEAD_DIM // 2
D_FF = 2816
CONV_WIDTH = 3
DEEPNORM_ALPHA = (2 * DEPTH) ** 0.25
DEEPNORM_BETA = (8 * DEPTH) ** -0.25
LN_EPS = 1e-6

kernel_name = 'hybrid_pool_natten_gqa_dit'


def layer_norm(x, g, b):
    xf = x.astype(jnp.float32)
    mu = jnp.mean(xf, -1, keepdims=True)
    var = jnp.mean(jnp.square(xf - mu), -1, keepdims=True)
    y = (xf - mu) * lax.rsqrt(var + LN_EPS) * g.astype(jnp.float32) + b.astype(jnp.float32)
    return y.astype(x.dtype)


def rms_norm(x, g):
    xf = x.astype(jnp.float32)
    y = xf * lax.rsqrt(jnp.mean(xf * xf, -1, keepdims=True) + LN_EPS) * g.astype(jnp.float32)
    return y.astype(x.dtype)


def axial_rope_tables(L):
    t = jnp.arange(L, dtype=jnp.int32)
    inv = ROPE_THETA ** (-jnp.arange(0, ROPE_AXIS_DIM, 2, dtype=jnp.float32) / ROPE_AXIS_DIM)
    ang_r = (t // GRID_W).astype(jnp.float32)[:, None] * inv
    ang_c = (t % GRID_W).astype(jnp.float32)[:, None] * inv
    return (jnp.cos(ang_r), jnp.sin(ang_r), jnp.cos(ang_c), jnp.sin(ang_c))


def _rotate(x, cos, sin):
    x1, x2 = jnp.split(x, 2, axis=-1)
    cos = cos[:, None, :].astype(x.dtype)
    sin = sin[:, None, :].astype(x.dtype)
    return jnp.concatenate([x1 * cos - x2 * sin, x1 * sin + x2 * cos], axis=-1)


def apply_axial_rope(x, tabs):
    cos_r, sin_r, cos_c, sin_c = tabs
    x_row, x_col = jnp.split(x, 2, axis=-1)
    return jnp.concatenate([_rotate(x_row, cos_r, sin_r), _rotate(x_col, cos_c, sin_c)], axis=-1)


def project(h, w):
    z = h @ w
    B, L, _ = z.shape
    points, acc = [], 0
    for s in IN_SIZES[:-1]:
        acc += s
        points.append(acc)
    parts = jnp.split(z, points, axis=-1)
    pool_in = parts[0]
    q_na, k_na, v_na = [t.reshape(B, L, NA_HEADS, HEAD_DIM) for t in parts[1:4]]
    q_g = parts[4].reshape(B, L, GQA_Q_HEADS, HEAD_DIM)
    k_g, v_g = [t.reshape(B, L, GQA_KV_HEADS, HEAD_DIM) for t in parts[5:7]]
    return pool_in, q_na, k_na, v_na, q_g, k_g, v_g


def multiscale_pool(u, w_grp, scale):
    B, L, _ = u.shape
    ug = u.reshape(B, L, N_POOL, POOL_DIM)
    csum = jnp.concatenate([jnp.zeros((B, 1, N_POOL, POOL_DIM), jnp.float32),
                            jnp.cumsum(ug.astype(jnp.float32), axis=1)], axis=1)
    t = jnp.arange(L)
    means = []
    for g, w in enumerate(POOL_WINDOWS):
        lo = jnp.clip(t - w // 2, 0, L - 1)
        hi = jnp.clip(t + w // 2 - 1, 0, L - 1)
        cnt = (hi - lo + 1).astype(jnp.float32)[None, :, None]
        means.append((csum[:, hi + 1, g] - csum[:, lo, g]) / cnt)
    pooled = jnp.stack(means, axis=2).astype(u.dtype) - ug
    y = jnp.einsum('blgc,gcd->blgd', pooled, w_grp)
    return y.reshape(B, L, N_POOL * POOL_DIM) * scale


def attend(q, k, v):
    B, Lq, H, dh = q.shape
    hkv = k.shape[2]
    qg = q.reshape(B, Lq, hkv, H // hkv, dh)
    s = jnp.einsum('bqkgd,bskd->bkgqs', qg, k, preferred_element_type=jnp.float32) * (dh ** -0.5)
    p = jax.nn.softmax(s, axis=-1).astype(v.dtype)
    return jnp.einsum('bkgqs,bskd->bqkgd', p, v).reshape(B, Lq, H * dh)


def blocked_gqa(q, k, v, k_ctx, v_ctx):
    B, L, H, dh = q.shape
    k_all = jnp.concatenate([k_ctx, k], axis=1)
    v_all = jnp.concatenate([v_ctx, v], axis=1)
    qb = q.reshape(B, L // Q_BLOCK, Q_BLOCK, H, dh).swapaxes(0, 1)
    out = lax.map(lambda q_blk: attend(q_blk, k_all, v_all), qb)
    return out.swapaxes(0, 1).reshape(B, L, H * dh)


def neighbourhood_attention(q, k, v, k_ctx, v_ctx, rpb):
    B, L, H, dh = q.shape
    rows = L // GRID_W
    kh = min(NA_ROWS, rows)
    n_nb = kh * NA_COLS
    qg = q.reshape(B, rows, GRID_W, H, dh) * (dh ** -0.5)
    kg = k.reshape(B, rows, GRID_W, H, dh)
    vg = v.reshape(B, rows, GRID_W, H, dh)
    col = jnp.arange(GRID_W)
    c_start = jnp.clip(col - NA_COLS // 2, 0, GRID_W - NA_COLS)
    c_idx = c_start[:, None] + jnp.arange(NA_COLS)
    dc = c_idx - col[:, None] + (NA_COLS - 1)
    rpb_c = rpb[:, :, dc].astype(jnp.float32)

    def one_row(r):
        r_start = jnp.clip(r - kh // 2, 0, rows - kh)
        k_band = lax.dynamic_slice_in_dim(kg, r_start, kh, axis=1)
        v_band = lax.dynamic_slice_in_dim(vg, r_start, kh, axis=1)
        k_nb = k_band[:, :, c_idx]
        v_nb = v_band[:, :, c_idx]
        q_row = lax.dynamic_index_in_dim(qg, r, axis=1, keepdims=False)
        dr = r_start + jnp.arange(kh) - r + (NA_ROWS - 1)
        bias = rpb_c[:, dr].transpose(0, 2, 1, 3)
        s_nb = jnp.einsum('bqhd,bkqjhd->bhqkj', q_row, k_nb,
                          preferred_element_type=jnp.float32) + bias[None]
        s_ctx = jnp.einsum('bqhd,bchd->bhqc', q_row, k_ctx, preferred_element_type=jnp.float32)
        s = jnp.concatenate([s_nb.reshape(B, H, GRID_W, n_nb), s_ctx], axis=-1)
        p = jax.nn.softmax(s, axis=-1).astype(v.dtype)
        p_nb = p[..., :n_nb].reshape(B, H, GRID_W, kh, NA_COLS)
        p_ctx = p[..., n_nb:]
        return (jnp.einsum('bhqkj,bkqjhd->bqhd', p_nb, v_nb)
                + jnp.einsum('bhqc,bchd->bqhd', p_ctx, v_ctx))

    out = lax.map(one_row, jnp.arange(rows))
    return out.transpose(1, 0, 2, 3, 4).reshape(B, L, H * dh)


def conv_ffn(h, w_up, conv_w, conv_b, w_down):
    u = h @ w_up
    L = u.shape[1]
    half = CONV_WIDTH // 2
    up = jnp.pad(u, ((0, 0), (half, half), (0, 0)))
    acc = up[:, 0:L] * conv_w[0] + conv_b
    for j in range(1, CONV_WIDTH):
        acc = acc + up[:, j:j + L] * conv_w[j]
    a, g = jnp.split(acc, 2, axis=-1)
    return (a * jax.nn.silu(g)) @ w_down


def setup_inputs(seed: int = 0) -> dict:
    key = jax.random.key(seed)
    ks = jax.random.split(key, 22)

    def nrm(k, shape, s):
        return jax.random.normal(k, shape, jnp.float32) * s

    return {
        'x': nrm(ks[0], (BATCH, SEQ, D_MODEL), 1.0),
        'c': nrm(ks[1], (BATCH, D_MODEL), 1.0),
        'ctx': nrm(ks[2], (BATCH, CTX_LEN, D_MODEL), 1.0),
        'c_ctx': nrm(ks[3], (D_MODEL,), 1.0),
        'w_mod': nrm(ks[4], (DEPTH, D_MODEL, 6 * D_MODEL), 0.5 * D_MODEL ** -0.5),
        'b_mod': nrm(ks[5], (DEPTH, 6 * D_MODEL), 0.02),
        'w_in': nrm(ks[6], (DEPTH, D_MODEL, IN_WIDTH), D_MODEL ** -0.5),
        'pool_w': nrm(ks[7], (DEPTH, N_POOL, POOL_DIM, POOL_DIM), POOL_DIM ** -0.5),
        'pool_scale': 1.0 + nrm(ks[8], (DEPTH, POOL_WIDTH), 0.1),
        'na_rpb': nrm(ks[9], (DEPTH, NA_HEADS, 2 * NA_ROWS - 1, 2 * NA_COLS - 1), 0.1),
        'q_norm': 1.0 + nrm(ks[10], (DEPTH, HEAD_DIM), 0.1),
        'k_norm': 1.0 + nrm(ks[11], (DEPTH, HEAD_DIM), 0.1),
        'w_out': nrm(ks[12], (DEPTH, MIX_WIDTH, D_MODEL), MIX_WIDTH ** -0.5 * DEEPNORM_BETA),
        'ln1_g': 1.0 + nrm(ks[13], (DEPTH, D_MODEL), 0.1),
        'ln1_b': nrm(ks[14], (DEPTH, D_MODEL), 0.02),
        'w_up': nrm(ks[15], (DEPTH, D_MODEL, 2 * D_FF), D_MODEL ** -0.5),
        'conv_w': nrm(ks[16], (DEPTH, CONV_WIDTH, 2 * D_FF), CONV_WIDTH ** -0.5),
        'conv_b': nrm(ks[17], (DEPTH, 2 * D_FF), 0.02),
        'w_down': nrm(ks[18], (DEPTH, D_FF, D_MODEL), D_FF ** -0.5 * DEEPNORM_BETA),
        'ln2_g': 1.0 + nrm(ks[19], (DEPTH, D_MODEL), 0.1),
        'ln2_b': nrm(ks[20], (DEPTH, D_MODEL), 0.02),
    }


def reference(x, c, ctx, c_ctx, w_mod, b_mod, w_in, pool_w, pool_scale, na_rpb, q_norm, k_norm,
              w_out, ln1_g, ln1_b, w_up, conv_w, conv_b, w_down, ln2_g, ln2_b):
    rope = axial_rope_tables(x.shape[1])
    xc = ctx
    act_lat = jax.nn.silu(c)
    act_ctx = jax.nn.silu(c_ctx)
    for l in range(DEPTH):
        mod = act_lat @ w_mod[l] + b_mod[l]
        mod_c = act_ctx @ w_mod[l] + b_mod[l]
        sh1, s1, g1, sh2, s2, g2 = [m[:, None, :] for m in jnp.split(mod, 6, axis=-1)]
        sh1c, s1c, g1c, sh2c, s2c, g2c = jnp.split(mod_c, 6, axis=-1)

        p_c, qn_c, kn_c, vn_c, qg_c, kg_c, vg_c = project(xc * (1 + s1c) + sh1c, w_in[l])
        kg_c = rms_norm(kg_c, k_norm[l])

        p, qn, kn, vn, qg, kg, vg = project(x * (1 + s1) + sh1, w_in[l])
        y_pool = multiscale_pool(p, pool_w[l], pool_scale[l])
        y_na = neighbourhood_attention(qn, kn, vn, kn_c, vn_c, na_rpb[l])
        qg = apply_axial_rope(rms_norm(qg, q_norm[l]), rope)
        kg = apply_axial_rope(rms_norm(kg, k_norm[l]), rope)
        y_gqa = blocked_gqa(qg, kg, vg, kg_c, vg_c)
        mix = jnp.concatenate([y_pool, y_na, y_gqa], axis=-1) @ w_out[l]
        x = layer_norm(DEEPNORM_ALPHA * x + g1 * mix, ln1_g[l], ln1_b[l])
        ffn = conv_ffn(x * (1 + s2) + sh2, w_up[l], conv_w[l], conv_b[l], w_down[l])
        x = layer_norm(DEEPNORM_ALPHA * x + g2 * ffn, ln2_g[l], ln2_b[l])

        if l < DEPTH - 1:
            mix_c = jnp.concatenate([
                multiscale_pool(p_c, pool_w[l], pool_scale[l]),
                attend(qn_c, kn_c, vn_c),
                attend(rms_norm(qg_c, q_norm[l]), kg_c, vg_c)], axis=-1) @ w_out[l]
            xc = layer_norm(DEEPNORM_ALPHA * xc + g1c * mix_c, ln1_g[l], ln1_b[l])
            ffn_c = conv_ffn(xc * (1 + s2c) + sh2c, w_up[l], conv_w[l], conv_b[l], w_down[l])
            xc = layer_norm(DEEPNORM_ALPHA * xc + g2c * ffn_c, ln2_g[l], ln2_b[l])
    return x
```

```cpp
#include <hip/hip_runtime.h>
#include <hip/hip_cooperative_groups.h>
#include <cstdio>
#include <cstdint>
constexpr int P_D = 1024, P_B = 8, P_SEQ = 8192, P_CTX = 256, P_RPB = P_SEQ + P_CTX  , P_M = P_B * P_RPB  ;
constexpr int P_DEPTH = 4, P_INW = 2048, P_DFF = 2816, P_UPW = 2 * P_DFF, P_MODW = 6 * P_D;
constexpr float P_C2 = 0.125f * 1.4426950408889634f;
constexpr float P_LOG2E = 1.4426950408889634f;
constexpr float P_ALPHA = 1.681792830507429f;
constexpr float P_EPS = 1e-6f;
__device__ __forceinline__ int ltid() { int t = threadIdx.x; asm volatile("" : "+v"(t)); return t; }
namespace pg8 {
#define PG8_LAS __attribute__((address_space(3)))
typedef unsigned short bf16_t;
typedef short bf16x8 __attribute__((ext_vector_type(8)));
typedef float f32x4 __attribute__((ext_vector_type(4)));
typedef unsigned u32x4 __attribute__((ext_vector_type(4)));
constexpr int BM = 256, BK = 64, HALF = 128, HTB = HALF * BK * 2  , STAGE_BYTES = 8 * HTB, NXCD = 8, WGM = 8;

__host__ __device__ __forceinline__ int lds_byte(int r, int c) { const int st = (r >> 4) * 2 + (c >> 5), rr = r & 15, cc = c & 31, ob = rr * 64 + cc * 2; return st * 1024 + (ob ^ (((ob >> 9) & 1) << 5)); }
__host__ __device__ __forceinline__ void stage_rc(int b, int& R, int& C) { const int st = b / 1024, sb = b % 1024, swz = sb ^ (((sb >> 9) & 1) << 5); R = (st >> 1) * 16 + swz / 64; C = (st & 1) * 32 + (swz % 64) / 2; }
__host__ __device__ __forceinline__ int perm32(int rho) { const int n = rho >> 4, i = rho & 15; return 8 * (i >> 2) + 4 * n + (i & 3); }

struct Unit { int pm, pn; };
struct Gemm { const bf16_t* A; const bf16_t* Bt; int M, N, K; };

struct StaticOrder {
    int nM, nN, nwg, G, c;
    __host__ __device__ void init(int nM_, int nN_, int G_, int c_) { nM = nM_; nN = nN_; nwg = nM * nN; G = G_; c = c_; }
    __host__ __device__ bool next(int i, Unit& u) const {
        const long L = (long)i * G + c; if (L >= nwg) return false;
        int wgid = (int)L; { const int q = nwg / NXCD, r = nwg % NXCD, xcd = wgid % NXCD, off = wgid / NXCD; wgid = (xcd < r ? xcd * (q + 1) : r * (q + 1) + (xcd - r) * q) + off; }
        const int nig = WGM * nN, gid = wgid / nig, fm = gid * WGM, gsz = (nM - fm) < WGM ? (nM - fm) : WGM;
        u.pm = fm + ((wgid % nig) % gsz); u.pn = (wgid % nig) / gsz; return true;
    }
    __device__ __forceinline__ void a_ready(const Unit&) const {}
    __device__ __forceinline__ void done(const Unit&) const {}
};

__device__ __forceinline__ unsigned cvt_pk_bf16(float lo, float hi) { unsigned r; asm volatile("v_cvt_pk_bf16_f32 %0, %1, %2" : "=v"(r) : "v"(lo), "v"(hi)); return r; }
#ifndef EPI_SHFL
#define EPI_SHFL 1
#endif
__device__ __forceinline__ f32x4 dppror(const f32x4 v, const bool up) {
    f32x4 r;
#if EPI_SHFL
    const int lane = threadIdx.x & 63; const int src = (lane & ~15) | ((lane + (up ? 15 : 1)) & 15);
#pragma unroll
    for (int j = 0; j < 4; ++j) r[j] = __shfl(v[j], src);
#else
#pragma unroll
    for (int j = 0; j < 4; ++j) { const int iv = __builtin_bit_cast(int, v[j]);
        r[j] = __builtin_bit_cast(float, up ? __builtin_amdgcn_mov_dpp(iv, 0x121, 0xf, 0xf, true) : __builtin_amdgcn_mov_dpp(iv, 0x12F, 0xf, 0xf, true)); }
#endif
    return r;
}
struct EpiIn {
    static constexpr bool PERM = false, AFTER_DRAIN = false;
    bf16_t* Z; const float* qn; const float* kn; const float* rc; const float* rs;
    __device__ __forceinline__ void operator()(const f32x4 (&acc)[2][2][4][2], const Unit& u, int wr, int wc, int fr, int fq) const {
        asm volatile("" : "+v"(fr), "+v"(fq));
        const int hs = u.pn * 4 + wc;
        const bool isq = (hs >= 22 && hs < 28), isk = (hs == 28 || hs == 29);
        const float sc = ((hs >= 4 && hs < 10) || isq) ? P_C2 : 1.f;
        const int tb = u.pm % 33; const bool is_ctx = (tb == 0);
#pragma unroll
        for (int ai = 0; ai < 2; ++ai)
#pragma unroll
            for (int m = 0; m < 4; ++m) {
                const int rt = ai * HALF + wr * 64 + m * 16 + fr;
                const size_t row = (size_t)u.pm * BM + rt;
                f32x4 v[2][2];
#pragma unroll
                for (int bj = 0; bj < 2; ++bj)
#pragma unroll
                    for (int n = 0; n < 2; ++n) v[bj][n] = acc[ai][bj][m][n];
                if (isq || isk) {
                    float ss = 0.f;
#pragma unroll
                    for (int bj = 0; bj < 2; ++bj)
#pragma unroll
                        for (int n = 0; n < 2; ++n) { const f32x4 x = v[bj][n]; ss += (x[0] * x[0] + x[1] * x[1]) + (x[2] * x[2] + x[3] * x[3]); }
                    ss += __shfl_xor(ss, 16); ss += __shfl_xor(ss, 32);
                    const float rstd = 1.0f / sqrtf(ss * (1.0f / 64.0f) + P_EPS);
                    const float* gp = (isq ? qn : kn) + 4 * fq;
                    const int pos = (tb - 1) * BM + rt; const int gr = pos >> 6, gc = pos & 63;
#pragma unroll
                    for (int bj = 0; bj < 2; ++bj) {
                        const f32x4 g0 = *(const f32x4*)(gp + 32 * bj), g1 = *(const f32x4*)(gp + 32 * bj + 16);
                        f32x4 x1 = v[bj][0] * rstd * g0, x2 = v[bj][1] * rstd * g1;
                        if (!is_ctx) { const int idx = bj ? gc : gr;
                            const f32x4 cs = *(const f32x4*)(rc + idx * 16 + 4 * fq), sn = *(const f32x4*)(rs + idx * 16 + 4 * fq);
                            const f32x4 y1 = x1 * cs - x2 * sn, y2 = x1 * sn + x2 * cs; x1 = y1; x2 = y2; }
                        v[bj][0] = x1; v[bj][1] = x2;
                    }
                }
                bf16_t* zp = Z + row * P_INW + hs * 64 + 4 * fq;
#pragma unroll
                for (int bj = 0; bj < 2; ++bj)
#pragma unroll
                    for (int n = 0; n < 2; ++n) { const f32x4 x = v[bj][n] * sc; unsigned long long w = (unsigned long long)cvt_pk_bf16(x[0], x[1]) | ((unsigned long long)cvt_pk_bf16(x[2], x[3]) << 32);
                        *(unsigned long long*)(zp + 32 * bj + 16 * n) = w; }
                asm volatile("" ::: "memory");
            }
    }
};
struct EpiRes {
    static constexpr bool PERM = false, AFTER_DRAIN = false;
    float* X; const float* gate;
    __device__ __forceinline__ void operator()(const f32x4 (&acc)[2][2][4][2], const Unit& u, int wr, int wc, int fr, int fq) const {
        asm volatile("" : "+v"(fr), "+v"(fq));
        const int b = u.pm / 33, tb = u.pm % 33; const int mrow = tb == 0 ? 8 : b;
        const int col0 = u.pn * BM + wc * 32 + 4 * fq;
        const float* gp = gate + mrow * P_MODW + col0;
        f32x4 gv[2][2];
#pragma unroll
        for (int bj = 0; bj < 2; ++bj)
#pragma unroll
            for (int n = 0; n < 2; ++n) gv[bj][n] = *(const f32x4*)(gp + bj * HALF + n * 16);
#pragma unroll
        for (int ai = 0; ai < 2; ++ai)
#pragma unroll
            for (int m = 0; m < 4; ++m) { float* xr = X + ((size_t)u.pm * BM + ai * HALF + wr * 64 + m * 16 + fr) * P_D + col0;
#pragma unroll
                for (int bj = 0; bj < 2; ++bj)
#pragma unroll
                    for (int n = 0; n < 2; ++n) { f32x4 xo = *(const f32x4*)(xr + bj * HALF + n * 16); xo = xo * P_ALPHA + gv[bj][n] * acc[ai][bj][m][n]; *(f32x4*)(xr + bj * HALF + n * 16) = xo; }
                if (m & 1) asm volatile("" ::: "memory"); }
    }
};
struct EpiUp {
    static constexpr bool PERM = true, AFTER_DRAIN = false;
    bf16_t* ACT; const float* cw; const float* cb;
    __device__ __forceinline__ void operator()(const f32x4 (&acc)[2][2][4][2], const Unit& u, int wr, int wc, int fr, int fq) const {
        asm volatile("" : "+v"(fr), "+v"(fq));
#pragma unroll
        for (int n = 0; n < 2; ++n) {
            const int ch = u.pn * 128 + wc * 32 + 8 * fq + 4 * n;
            const f32x4 wa0 = *(const f32x4*)(cw + ch), wa1 = *(const f32x4*)(cw + P_UPW + ch), wa2 = *(const f32x4*)(cw + 2 * P_UPW + ch), ba = *(const f32x4*)(cb + ch);
            const f32x4 wg0 = *(const f32x4*)(cw + P_DFF + ch), wg1 = *(const f32x4*)(cw + P_UPW + P_DFF + ch), wg2 = *(const f32x4*)(cw + 2 * P_UPW + P_DFF + ch), bg = *(const f32x4*)(cb + P_DFF + ch);
#pragma unroll
            for (int ai = 0; ai < 2; ++ai) {
                const int Rb = u.pm * 248 - 1 + (2 * ai + wr) * 62;
                f32x4 ra_prev = (f32x4){0.f, 0.f, 0.f, 0.f}, rg_prev = ra_prev;
                f32x4 la_cur = dppror(acc[ai][0][0][n], false), lg_cur = dppror(acc[ai][1][0][n], false);
#pragma unroll
                for (int m = 0; m < 4; ++m) {
                    const f32x4 va = acc[ai][0][m][n], vg = acc[ai][1][m][n];
                    const f32x4 ra_cur = dppror(va, true), rg_cur = dppror(vg, true);
                    f32x4 la_next = la_cur, lg_next = lg_cur;
                    if (m < 3) { la_next = dppror(acc[ai][0][m < 3 ? m + 1 : 3][n], false); lg_next = dppror(acc[ai][1][m < 3 ? m + 1 : 3][n], false); }
                    const int i = 16 * m + fr; const int R = Rb + i;
                    const int rbm = R - (R / P_RPB) * P_RPB;
                    const bool first = (rbm == 0) || (rbm == P_CTX), last = (rbm == P_CTX - 1) || (rbm == P_RPB - 1);
                    f32x4 upa = (fr == 0) ? ra_prev : ra_cur, upg = (fr == 0) ? rg_prev : rg_cur;
                    f32x4 dna = (fr == 15) ? la_next : la_cur, dng = (fr == 15) ? lg_next : lg_cur;
                    const f32x4 z4 = (f32x4){0.f, 0.f, 0.f, 0.f};
                    if (first) { upa = z4; upg = z4; }
                    if (last) { dna = z4; dng = z4; }
                    const f32x4 av = wa0 * upa + wa1 * va + wa2 * dna + ba;
                    const f32x4 gv = wg0 * upg + wg1 * vg + wg2 * dng + bg;
                    f32x4 o;
#pragma unroll
                    for (int j = 0; j < 4; ++j) o[j] = av[j] * gv[j] * __builtin_amdgcn_rcpf(1.0f + __expf(-gv[j]));
                    if (i >= 1 && i <= 62 && R < P_M) {
                        unsigned long long w = (unsigned long long)cvt_pk_bf16(o[0], o[1]) | ((unsigned long long)cvt_pk_bf16(o[2], o[3]) << 32);
                        *(unsigned long long*)(ACT + (size_t)R * P_DFF + ch) = w; }
                    ra_prev = ra_cur; rg_prev = rg_cur; la_cur = la_next; lg_cur = lg_next;
                }
            }
        }
    }
};

template <class Epi, class Sched, bool ALIGN_EPI = false, bool SP2 = false, int AMODE = 0>
__device__ __forceinline__ void gemm_phase(PG8_LAS unsigned char* lds, const Gemm g, const Sched& S, const Epi& E) {
    const int tid = ltid(), wid = __builtin_amdgcn_readfirstlane(tid >> 6), lane = tid & 63, wr = wid >> 2, wc = wid & 3, fr = lane & 15, fq = lane >> 4;
    const int K = g.K, nt = K / BK;
    unsigned voffA[2], voffB[2];
#pragma unroll
    for (int i = 0; i < 2; ++i) { int R, C; stage_rc(tid * 16 + i * 8192, R, C); const int Rb = Epi::PERM ? ((R & ~31) + perm32(R & 31)) : R;
        voffA[i] = (unsigned)((AMODE ? ((R >> 6) * 62 + (R & 63)) : R) * K + C) * 2u; voffB[i] = (unsigned)(Rb * K + C) * 2u; }
    const size_t kstep = (size_t)(BK * 2);
    const size_t hstepB = (size_t)HALF * K * 2; const size_t hstepA = (size_t)(AMODE ? 124 : HALF) * K * 2;
    const size_t tstepB = 2 * hstepB; const size_t tstepA = 2 * hstepA;
    const unsigned ldsw = (unsigned)wid * 1024u;
    const int aoff = lds_byte(wr * 64 + fr, fq * 8), boff = lds_byte(wc * 32 + fr, fq * 8);
#define PG8_SA(b, h) (((b) * 2 + (h)) * HTB)
#define PG8_SB(b, h) ((4 + (b) * 2 + (h)) * HTB)
#define PG8_STAGE(bufoff, gbase, voff) do { _Pragma("unroll") for (int _i = 0; _i < 2; ++_i) \
        __builtin_amdgcn_global_load_lds((const unsigned*)((const char*)(gbase) + (voff)[_i]), (PG8_LAS unsigned*)(lds + (bufoff) + ldsw + _i * 8192), 16, 0, 0); } while (0)
#define PG8_LDA(dst, b, h) do { _Pragma("unroll") for (int m = 0; m < 4; ++m) _Pragma("unroll") for (int k = 0; k < 2; ++k) dst[m][k] = *(const PG8_LAS bf16x8*)(lds + PG8_SA(b, h) + aoff + m * 2048 + k * 1024); } while (0)
#define PG8_LDB(dst, b, h) do { _Pragma("unroll") for (int n = 0; n < 2; ++n) _Pragma("unroll") for (int k = 0; k < 2; ++k) dst[n][k] = *(const PG8_LAS bf16x8*)(lds + PG8_SB(b, h) + boff + n * 2048 + k * 1024); } while (0)
#define PG8_MMA(ai, bj, At, Bt) do { __builtin_amdgcn_s_setprio(1); _Pragma("unroll") for (int m = 0; m < 4; ++m) _Pragma("unroll") for (int n = 0; n < 2; ++n) _Pragma("unroll") for (int k = 0; k < 2; ++k) \
        acc[ai][bj][m][n] = __builtin_amdgcn_mfma_f32_16x16x32_bf16(Bt[n][k], At[m][k], acc[ai][bj][m][n], 0, 0, 0); __builtin_amdgcn_s_setprio(0); } while (0)
#define PG8_WAIT_V(n) asm volatile("s_waitcnt vmcnt(" #n ")" ::: "memory")
#define PG8_WAIT_L(n) asm volatile("s_waitcnt lgkmcnt(" #n ")" ::: "memory")
#define PG8_BAR __builtin_amdgcn_s_barrier()
#define PG8_SCHED __builtin_amdgcn_sched_barrier(0)
    Unit cur, nxt; int ui = 0;
    if (!S.next(0, cur)) return;
    f32x4 acc[2][2][4][2];
#pragma unroll
    for (int a = 0; a < 2; ++a)
#pragma unroll
        for (int b = 0; b < 2; ++b)
#pragma unroll
            for (int m = 0; m < 4; ++m)
#pragma unroll
                for (int n = 0; n < 2; ++n) acc[a][b][m][n] = (f32x4){0.f, 0.f, 0.f, 0.f};
    bf16x8 At[4][2], B0[2][2], B1[2][2];
    const char* cA = (const char*)g.A + (size_t)cur.pm * tstepA; const char* cB = (const char*)g.Bt + (size_t)cur.pn * tstepB;
    S.a_ready(cur);
    if constexpr (SP2) {
        PG8_STAGE(PG8_SB(0, 0), cB, voffB); PG8_STAGE(PG8_SB(0, 1), cB + hstepB, voffB); PG8_STAGE(PG8_SA(0, 0), cA, voffA); PG8_STAGE(PG8_SA(0, 1), cA + hstepA, voffA);
        if (wr == 1) PG8_BAR;
        PG8_WAIT_V(2); PG8_BAR;
        PG8_STAGE(PG8_SB(1, 0), cB + kstep, voffB); PG8_STAGE(PG8_SA(1, 0), cA + kstep, voffA); PG8_STAGE(PG8_SB(1, 1), cB + hstepB + kstep, voffB);
        PG8_WAIT_V(6); PG8_BAR;
    } else {
        PG8_STAGE(PG8_SB(0, 0), cB, voffB); PG8_STAGE(PG8_SA(0, 0), cA, voffA); PG8_STAGE(PG8_SB(0, 1), cB + hstepB, voffB); PG8_STAGE(PG8_SA(0, 1), cA + hstepA, voffA);
        if (wr == 1) PG8_BAR;
        PG8_WAIT_V(4); PG8_BAR;
        PG8_STAGE(PG8_SB(1, 0), cB + kstep, voffB); PG8_STAGE(PG8_SA(1, 0), cA + kstep, voffA); PG8_STAGE(PG8_SB(1, 1), cB + hstepB + kstep, voffB);
        PG8_WAIT_V(6); PG8_BAR;
    }
    for (;;) {
        const bool has_next = S.next(ui + 1, nxt);
        const char* nA = has_next ? (const char*)g.A + (size_t)nxt.pm * tstepA : cA; const char* nB = has_next ? (const char*)g.Bt + (size_t)nxt.pn * tstepB : cB;
        for (int t = 0; t < nt; t += 2) {
            const bool last = (t == nt - 2);
            const char* a1 = cA + (size_t)(t + 1) * kstep;
            const char* a2 = last ? nA : cA + (size_t)(t + 2) * kstep; const char* b2 = last ? nB : cB + (size_t)(t + 2) * kstep;
            const char* a3 = a2 + kstep; const char* b3 = b2 + kstep;
            if (last && has_next) S.a_ready(nxt);
            if constexpr (SP2) {
            PG8_LDB(B0, 0, 0); PG8_LDB(B1, 0, 1); PG8_SCHED; PG8_LDA(At, 0, 0); PG8_STAGE(PG8_SA(1, 1), a1 + hstepA, voffA);
            PG8_WAIT_V(8); PG8_WAIT_L(0); PG8_BAR; PG8_MMA(0, 0, At, B0); PG8_MMA(0, 1, At, B1); PG8_BAR; PG8_SCHED;
            PG8_LDA(At, 0, 1); PG8_STAGE(PG8_SB(0, 0), b2, voffB); PG8_STAGE(PG8_SB(0, 1), b2 + hstepB, voffB); PG8_STAGE(PG8_SA(0, 0), a2, voffA);
            PG8_WAIT_V(8); PG8_WAIT_L(0); PG8_BAR; PG8_MMA(1, 0, At, B0); PG8_MMA(1, 1, At, B1); PG8_BAR; PG8_SCHED;
            PG8_LDB(B0, 1, 0); PG8_LDB(B1, 1, 1); PG8_SCHED; PG8_LDA(At, 1, 0); PG8_STAGE(PG8_SA(0, 1), a2 + hstepA, voffA);
            PG8_WAIT_V(8); PG8_WAIT_L(0); PG8_BAR; PG8_MMA(0, 0, At, B0); PG8_MMA(0, 1, At, B1); PG8_BAR; PG8_SCHED;
            PG8_LDA(At, 1, 1); PG8_STAGE(PG8_SB(1, 0), b3, voffB); PG8_STAGE(PG8_SB(1, 1), b3 + hstepB, voffB); PG8_STAGE(PG8_SA(1, 0), a3, voffA);
            PG8_WAIT_V(8); PG8_WAIT_L(0); PG8_BAR; PG8_MMA(1, 0, At, B0); PG8_MMA(1, 1, At, B1); PG8_BAR; PG8_SCHED;
            } else {
            PG8_LDB(B0, 0, 0); PG8_SCHED; PG8_LDA(At, 0, 0); PG8_STAGE(PG8_SA(1, 1), a1 + hstepA, voffA);
            PG8_WAIT_L(8); PG8_BAR; PG8_WAIT_L(0); PG8_MMA(0, 0, At, B0); PG8_BAR; PG8_SCHED;
            PG8_LDB(B1, 0, 1); PG8_STAGE(PG8_SB(0, 0), b2, voffB);
            PG8_BAR; PG8_WAIT_L(0); PG8_MMA(0, 1, At, B1); PG8_BAR;
            PG8_LDA(At, 0, 1); PG8_STAGE(PG8_SA(0, 0), a2, voffA);
            PG8_BAR; PG8_WAIT_L(0); PG8_MMA(1, 0, At, B0); PG8_BAR; PG8_SCHED;
            PG8_STAGE(PG8_SB(0, 1), b2 + hstepB, voffB);
            PG8_WAIT_V(6); PG8_BAR; PG8_MMA(1, 1, At, B1); PG8_BAR;
            PG8_LDB(B0, 1, 0); PG8_SCHED; PG8_LDA(At, 1, 0); PG8_STAGE(PG8_SA(0, 1), a2 + hstepA, voffA);
            PG8_WAIT_L(8); PG8_BAR; PG8_WAIT_L(0); PG8_MMA(0, 0, At, B0); PG8_BAR; PG8_SCHED;
            PG8_LDB(B1, 1, 1); PG8_STAGE(PG8_SB(1, 0), b3, voffB);
            PG8_BAR; PG8_WAIT_L(0); PG8_MMA(0, 1, At, B1); PG8_BAR;
            PG8_LDA(At, 1, 1); PG8_STAGE(PG8_SA(1, 0), a3, voffA);
            PG8_BAR; PG8_WAIT_L(0); PG8_MMA(1, 0, At, B0); PG8_BAR; PG8_SCHED;
            PG8_STAGE(PG8_SB(1, 1), b3 + hstepB, voffB);
            PG8_WAIT_V(6); PG8_BAR; PG8_MMA(1, 1, At, B1); PG8_BAR;
            }
        }
        if constexpr (ALIGN_EPI) { if (wr == 0) PG8_BAR; }
        if constexpr (!Epi::AFTER_DRAIN) { E(acc, cur, wr, wc, fr, fq); S.done(cur); }
        if (!has_next) break;
#pragma unroll
        for (int a = 0; a < 2; ++a)
#pragma unroll
            for (int b = 0; b < 2; ++b)
#pragma unroll
                for (int m = 0; m < 4; ++m)
#pragma unroll
                    for (int n = 0; n < 2; ++n) acc[a][b][m][n] = (f32x4){0.f, 0.f, 0.f, 0.f};
        cur = nxt; cA = nA; cB = nB; ++ui;
        if constexpr (ALIGN_EPI) { if (wr == 1) PG8_BAR; }
    }
    PG8_WAIT_V(0);
    if constexpr (!ALIGN_EPI) { if (wr == 0) PG8_BAR; }
    PG8_BAR;
    if constexpr (Epi::AFTER_DRAIN) { E.fused(acc, cur, wr, wc, fr, fq, lds, wid, lane); S.done(cur); }
#undef PG8_SA
#undef PG8_SB
#undef PG8_STAGE
#undef PG8_LDA
#undef PG8_LDB
#undef PG8_MMA
#undef PG8_WAIT_V
#undef PG8_WAIT_L
#undef PG8_BAR
#undef PG8_SCHED
}
}
#include <hip/hip_bf16.h>
#include <cmath>
namespace attn_body {
using bf16=__hip_bfloat16;
using bf16x8=__attribute__((ext_vector_type(8)))short;
using s16x4=__attribute__((ext_vector_type(4)))short;
using f32x16=__attribute__((ext_vector_type(16)))float;
using u32x4=__attribute__((ext_vector_type(4)))unsigned;
constexpr int D=64,DM=2048,ODM=1024;
constexpr int NW=8,QBLK=32,QB=QBLK*NW,KVBLK=64;
constexpr int ATTN_PITCH=DM, ATTN_UNIT_ROWS=QB;
__device__ __forceinline__ int crow(int r,int hi){return (r&3)+8*(r>>2)+4*hi;}
#define SBAR() __builtin_amdgcn_sched_barrier(0)
__device__ __forceinline__ void cmask(f32x16&p0,f32x16&p1,int jb,int qrel,int hi){
  const float NEG=-INFINITY; int kb=64*jb+4*hi;
  #pragma unroll
  for(int r=0;r<16;++r){int kv=kb+(r&3)+8*(r>>2); if(kv>qrel)p0[r]=NEG; if(kv+32>qrel)p1[r]=NEG;}
}

typedef const __attribute__((address_space(3))) float* lds_fptr;
__device__ __forceinline__ void nabias(f32x16&p0,f32x16&p1,int kr,int qr_,int r32,int wid,int hi,lds_fptr rp){
  const float NEG=-INFINITY;
  asm volatile("":"+v"(r32),"+v"(hi));
  const int qc=32*(wid&1)+r32;
  const int rs=min(max(qr_-4,0),120), cs=min(max(qc-8,0),48);
  if(kr<rs||kr>=rs+8){
    #pragma unroll
    for(int r=0;r<16;++r){p0[r]=NEG;p1[r]=NEG;}
  } else {
    lds_fptr tb=rp+(kr-qr_+7)*31+(15-qc);
    #pragma unroll
    for(int r=0;r<16;++r){
      const int kc=(r&3)+8*(r>>2)+4*hi;
      const bool ok0=(unsigned)(kc-cs)<16u, ok1=(unsigned)(kc+32-cs)<16u;
      const float b0=tb[ok0?kc:cs], b1=tb[ok1?kc+32:cs];
      p0[r]=ok0?p0[r]+b0:NEG; p1[r]=ok1?p1[r]+b1:NEG;
    }
  }
}
constexpr int NSLOT=3, SLOTB=8192;
constexpr int LDS_K=0, LDS_V=NSLOT*SLOTB, LDS_WS=2*NSLOT*SLOTB, LDS_OST=LDS_WS+NW*64*4, LDS_BYTES=LDS_OST+NW*4096;
constexpr float C2=0.125f*1.4426950408889634f;
__device__ __forceinline__ void glds16(const void*gsrc,unsigned lds_dst){unsigned keep;
  asm volatile("s_mov_b32 %0, m0\n\ts_mov_b32 m0, %2\n\ts_nop 0\n\tglobal_load_lds_dwordx4 %1, off\n\ts_mov_b32 m0, %0":"=&s"(keep):"v"(gsrc),"s"(lds_dst):"memory");}
__device__ __forceinline__ float max3f(float a,float b,float c){float r;asm("v_max3_f32 %0, %1, %2, %3":"=v"(r):"v"(a),"v"(b),"v"(c));return r;}
__device__ __forceinline__ float max2f(float a,float b){float r;asm("v_max_f32_e32 %0, %1, %2":"=v"(r):"v"(a),"v"(b));return r;}
__device__ __forceinline__ float fadd_s(float a,float b){float r;asm("v_add_f32_e32 %0, %1, %2":"=v"(r):"v"(a),"v"(b));return r;}
__device__ __forceinline__ float fsub_s(float a,float b){float r;asm("v_sub_f32_e32 %0, %1, %2":"=v"(r):"v"(a),"v"(b));return r;}
typedef float f32x2_t __attribute__((ext_vector_type(2))); typedef __bf16 bf16x2_t __attribute__((ext_vector_type(2)));
__device__ __forceinline__ unsigned cvtpk_s(float lo,float hi){f32x2_t v={lo,hi};bf16x2_t b=__builtin_convertvector(v,bf16x2_t);return __builtin_bit_cast(unsigned,b);}
#define WAIT_BAR(N) asm volatile("s_waitcnt vmcnt(" #N ") lgkmcnt(0)\n\ts_barrier":::"memory")

__device__ __forceinline__ void qkt(f32x16&p0,f32x16&p1,const char*Kslot,const bf16x8*qr,const f32x16&negm,int r32,int hi){
  const char*kb=Kslot+hi*1024+r32*16;
  #pragma unroll
  for(int d0=0;d0<4;++d0){
    const bf16x8 b0=*reinterpret_cast<const bf16x8*>(kb+d0*2048);
    const bf16x8 b1=*reinterpret_cast<const bf16x8*>(kb+d0*2048+512);
    if(d0==0){p0=__builtin_amdgcn_mfma_f32_32x32x16_bf16(b0,qr[0],negm,0,0,0);p1=__builtin_amdgcn_mfma_f32_32x32x16_bf16(b1,qr[0],negm,0,0,0);}
    else{p0=__builtin_amdgcn_mfma_f32_32x32x16_bf16(b0,qr[d0],p0,0,0,0);p1=__builtin_amdgcn_mfma_f32_32x32x16_bf16(b1,qr[d0],p1,0,0,0);}}
}
typedef __attribute__((address_space(3))) const char* lds_cptr;
typedef short v4i16_t __attribute__((ext_vector_type(4)));
__device__ __forceinline__ void kload8(bf16x8*kf,lds_cptr kp){
  kf[0]=*(const __attribute__((address_space(3))) bf16x8*)(kp);      kf[1]=*(const __attribute__((address_space(3))) bf16x8*)(kp+512);
  kf[2]=*(const __attribute__((address_space(3))) bf16x8*)(kp+2048); kf[3]=*(const __attribute__((address_space(3))) bf16x8*)(kp+2560);
  kf[4]=*(const __attribute__((address_space(3))) bf16x8*)(kp+4096); kf[5]=*(const __attribute__((address_space(3))) bf16x8*)(kp+4608);
  kf[6]=*(const __attribute__((address_space(3))) bf16x8*)(kp+6144); kf[7]=*(const __attribute__((address_space(3))) bf16x8*)(kp+6656);
}
__device__ __forceinline__ void kload2(bf16x8*kf,lds_cptr kp,int j){ kf[2*j]=*(const __attribute__((address_space(3))) bf16x8*)(kp+j*2048); kf[2*j+1]=*(const __attribute__((address_space(3))) bf16x8*)(kp+j*2048+512); }
__device__ __forceinline__ s16x4 vtr(lds_cptr p){ return __builtin_bit_cast(s16x4,__builtin_amdgcn_ds_read_tr16_b64_v4i16((__attribute__((address_space(3))) v4i16_t*)p)); }
__device__ __forceinline__ float rowmax(const f32x16&p0,const f32x16&p1){
  float a=max3f(p0[0],p0[1],p1[0]),b=max3f(p0[2],p0[3],p1[1]);a=max3f(a,p1[2],p1[3]);
  #pragma unroll
  for(int r=4;r<16;r+=4){a=max3f(a,p0[r],p0[r+1]);b=max3f(b,p0[r+2],p0[r+3]);a=max3f(a,p1[r],p1[r+1]);b=max3f(b,p1[r+2],p1[r+3]);}
  const float m=max2f(a,b);
  auto rr=__builtin_amdgcn_permlane32_swap(__float_as_uint(m),__float_as_uint(m),false,false);
  return max2f(__uint_as_float(rr[0]),__uint_as_float(rr[1]));
}
__device__ __forceinline__ void pv(f32x16*o,int vb,bf16x8 pa0,bf16x8 pa1,bf16x8 pa2,bf16x8 pa3){
  #pragma unroll
  for(int d0=0;d0<2;++d0){s16x4 lo[4],hi[4];
    #pragma unroll
    for(int ks=0;ks<4;++ks){
      asm volatile("ds_read_b64_tr_b16 %0,%1 offset:%c2":"=&v"(lo[ks]):"v"(vb),"i"(d0*4096+ks*1024):"memory");
      asm volatile("ds_read_b64_tr_b16 %0,%1 offset:%c2":"=&v"(hi[ks]):"v"(vb),"i"(d0*4096+ks*1024+512):"memory");}
    asm volatile("s_waitcnt lgkmcnt(0)":::"memory");SBAR();
    #define PK(k) (bf16x8){lo[k][0],lo[k][1],lo[k][2],lo[k][3],hi[k][0],hi[k][1],hi[k][2],hi[k][3]}
    o[d0]=__builtin_amdgcn_mfma_f32_32x32x16_bf16(pa0,PK(0),o[d0],0,0,0);
    o[d0]=__builtin_amdgcn_mfma_f32_32x32x16_bf16(pa1,PK(1),o[d0],0,0,0);
    o[d0]=__builtin_amdgcn_mfma_f32_32x32x16_bf16(pa2,PK(2),o[d0],0,0,0);
    o[d0]=__builtin_amdgcn_mfma_f32_32x32x16_bf16(pa3,PK(3),o[d0],0,0,0);
    #undef PK
  }
}

#ifndef ATTN_STORE16
#define ATTN_STORE16(p,v) (*(u32x4*)(p)=(v))
#endif
template<int THRL,int MODE> __device__ __forceinline__ void attn_unit(const bf16*Qw0,const bf16*__restrict__ Kh,const bf16*__restrict__ Vh,bf16*Ow0,const int NT,const int lat_off,const int na_r0,const int na_rsmin,const int rpb_off,char*shm){
  const int tid=ltid(),lane=tid&63,r32=lane&31,hi=lane>>5; const int wid=__builtin_amdgcn_readfirstlane(tid>>6);
  const bf16*Qw=Qw0+(long)(wid*QBLK)*DM;
  const unsigned lds0=(unsigned)(uintptr_t)shm;
  float*wsf=(float*)(shm+LDS_WS)+wid*64;
  const bf16*ksrc=Kh+(long)lane*DM+wid*8;
  const bf16*vsrc=Vh+(long)(16*(wid&3)+(lane>>2))*DM+(wid>>2)*32+(lane&3)*8;
  const unsigned kdst=lds0+LDS_K+wid*1024, vdst=lds0+LDS_V+wid*1024;
  #define TROW(t) (((t)<4)?(t)*64:lat_off+((t)-4)*64)
  #define DMA_K(t,slot) glds16(ksrc+(long)TROW(t)*DM,(unsigned)__builtin_amdgcn_readfirstlane(kdst+(slot)))
  #define DMA_V(t,slot) glds16(vsrc+(long)TROW(t)*DM,(unsigned)__builtin_amdgcn_readfirstlane(vdst+(slot)))
  const int vb0=(int)(lds0+LDS_V)+((lane>>4)&1)*32+(lane&3)*8+(4*hi+((lane&15)>>2))*64;
  const char*Kbase=shm+LDS_K; bf16x8 kf[8];
  const lds_cptr shm3=(lds_cptr)shm; const lds_cptr kp0=shm3+LDS_K+hi*1024+r32*16; const lds_cptr vp0=shm3+LDS_V+((lane>>4)&1)*32+(lane&3)*8+(4*hi+((lane&15)>>2))*64;
  DMA_K(0,0);DMA_V(0,0);DMA_K(1,SLOTB);
  bf16x8 qr[4];
  #pragma unroll
  for(int d0=0;d0<4;++d0)qr[d0]=*reinterpret_cast<const bf16x8*>(&Qw[(long)r32*DM+d0*16+hi*8]);
  float mhat=0.f,l_reg=0.f;f32x16 o[2];o[0]=f32x16{};o[1]=f32x16{};f32x16 negm=f32x16{};asm volatile("":"+v"(negm));
  const lds_fptr rp_=(lds_fptr)(shm3+rpb_off); const int na_qr=na_r0+(wid>>1);
  #define CMASK(P0,P1,t) do{ if(MODE==1 && (t)>=4) nabias(P0,P1,na_rsmin+(t)-4,na_qr,r32,wid,hi,rp_); }while(0)
  bool resc=false;
  #define START(P0,P1) do{ const float rm=rowmax(P0,P1); resc=false; \
    { const float dl=rm; mhat=fadd_s(mhat,dl); \
      _Pragma("unroll") for(int r=0;r<16;++r){P0[r]=fsub_s(P0[r],dl);P1[r]=fsub_s(P1[r],dl);} \
      _Pragma("unroll") for(int r=0;r<16;++r)negm[r]=-mhat; asm volatile("":"+v"(negm)); } \
    _Pragma("unroll") for(int r=0;r<16;++r)P0[r]=__builtin_amdgcn_exp2f(P0[r]); }while(0)
  #define RESC() do{ if(resc){ asm volatile("s_waitcnt lgkmcnt(0)":::"memory"); \
      _Pragma("unroll") for(int d_=0;d_<2;++d_) _Pragma("unroll") for(int r=0;r<16;++r)o[d_][r]*=wsf[crow(r,hi)]; } }while(0)
  f32x16 pA0,pA1,pB0,pB1;
  int sl_prev=0,sl_cur=0,sl_next=SLOTB;
  #define ROT() do{sl_prev=sl_cur;sl_cur=sl_next;sl_next=(sl_next==(NSLOT-1)*SLOTB)?0:sl_next+SLOTB;}while(0)
  DMA_K(2,2*SLOTB);
  WAIT_BAR(3);
  qkt(pA0,pA1,Kbase,qr,negm,r32,hi);asm volatile("s_nop 15\n\ts_nop 7":"+v"(pA0),"+v"(pA1));CMASK(pA0,pA1,0);
  START(pA0,pA1);
  _Pragma("unroll") for(int r=0;r<16;++r)pA1[r]=__builtin_amdgcn_exp2f(pA1[r]);
  WAIT_BAR(0);
  DMA_K(3,0);DMA_V(1,SLOTB);
  ROT();
  kload8(kf,kp0+sl_cur);
  WAIT_BAR(2);
  s16x4 vlo[8],vhi[8]; u32x4 pw0,pw1,pw2,pw3;
  #define PKW(P,B) cvtpk_s(P[B],P[B+1])
  #define PAF(k) __builtin_bit_cast(bf16x8,pw##k)
  #define VFR(i) (bf16x8){vlo[i][0],vlo[i][1],vlo[i][2],vlo[i][3],vhi[i][0],vhi[i][1],vhi[i][2],vhi[i][3]}
  #define PIN(x) asm volatile("":"+v"(x))
  #define MX3(a,b,c) __builtin_fmaxf(__builtin_fmaxf((a),(b)),(c))
  #define GAPA(MF,A0,A1,A2,A3,W0,W1,PW) do{ MF; sacc+=A0; sacc+=A1; sacc+=A2; sacc+=A3; PIN(sacc); W0; W1; PIN(PW); SBAR(); }while(0)
  #define EX(v) __builtin_amdgcn_exp2f(v)
  #define GAPB(MF,X,B) do{ MF; X[B]=EX(X[B]); X[B+1]=EX(X[B+1]); X[B+2]=EX(X[B+2]); X[B+3]=EX(X[B+3]); PIN(X); SBAR(); }while(0)
  #define VRD(i) do{ vlo[i]=vtr(vp_+(((i)>>2)*4096+((i)&3)*1024)); vhi[i]=vtr(vp_+(((i)>>2)*4096+((i)&3)*1024+512)); }while(0)
  #define KRD(G,j) do{ if(G){ kload2(kf,kp0+sl_next,j); SBAR(); } }while(0)
  #define STEP(C0,C1,P0,P1,t,GK,GV,GL) do{ SBAR(); \
    const lds_cptr vp_=vp0+sl_prev; \
    VRD(0); SBAR(); float sacc=(P0[0]+P0[1]); \
    GAPA(C0=__builtin_amdgcn_mfma_f32_32x32x16_bf16(kf[0],qr[0],negm,0,0,0), P0[2],P0[3],P0[4],P0[5],     pw0[0]=PKW(P0,0), pw0[1]=PKW(P0,2), pw0); \
    VRD(4); SBAR(); GAPA(C1=__builtin_amdgcn_mfma_f32_32x32x16_bf16(kf[1],qr[0],negm,0,0,0), P0[6],P0[7],P0[8],P0[9],     pw0[2]=PKW(P0,4), pw0[3]=PKW(P0,6), pw0); \
    VRD(1); SBAR(); GAPA(C0=__builtin_amdgcn_mfma_f32_32x32x16_bf16(kf[2],qr[1],C0,0,0,0),   P0[10],P0[11],P0[12],P0[13], pw1[0]=PKW(P0,8), pw1[1]=PKW(P0,10), pw1); \
    VRD(5); SBAR(); GAPA(C1=__builtin_amdgcn_mfma_f32_32x32x16_bf16(kf[3],qr[1],C1,0,0,0),   P0[14],P0[15],P1[0],P1[1],   pw1[2]=PKW(P0,12),pw1[3]=PKW(P0,14), pw1); \
    VRD(2); SBAR(); GAPA(C0=__builtin_amdgcn_mfma_f32_32x32x16_bf16(kf[4],qr[2],C0,0,0,0),   P1[2],P1[3],P1[4],P1[5],     pw2[0]=PKW(P1,0), pw2[1]=PKW(P1,2), pw2); \
    VRD(6); SBAR(); GAPA(C1=__builtin_amdgcn_mfma_f32_32x32x16_bf16(kf[5],qr[2],C1,0,0,0),   P1[6],P1[7],P1[8],P1[9],     pw2[2]=PKW(P1,4), pw2[3]=PKW(P1,6), pw2); \
    VRD(3); SBAR(); GAPA(C0=__builtin_amdgcn_mfma_f32_32x32x16_bf16(kf[6],qr[3],C0,0,0,0),   P1[10],P1[11],P1[12],P1[13], pw3[0]=PKW(P1,8), pw3[1]=PKW(P1,10), pw3); \
    VRD(7); SBAR(); GAPA(C1=__builtin_amdgcn_mfma_f32_32x32x16_bf16(kf[7],qr[3],C1,0,0,0),   P1[14],P1[15],0.f,0.f,       pw3[2]=PKW(P1,12),pw3[3]=PKW(P1,14), pw3); \
    l_reg+=sacc; \
    if(GK){DMA_K((t)+3,sl_cur);} if(GV){DMA_V((t)+1,sl_next);} \
    CMASK(C0,C1,t); \
    { float a=MX3(C0[0],C0[1],C1[0]),b=MX3(C0[2],C0[3],C1[1]); a=MX3(a,C1[2],C1[3]); \
      _Pragma("unroll") for(int r=4;r<16;r+=4){a=MX3(a,C0[r],C0[r+1]);b=MX3(b,C0[r+2],C0[r+3]);a=MX3(a,C1[r],C1[r+1]);b=MX3(b,C1[r+2],C1[r+3]);} \
      float rm=__builtin_fmaxf(a,b); { auto rr=__builtin_amdgcn_permlane32_swap(__float_as_uint(rm),__float_as_uint(rm),false,false); rm=__builtin_fmaxf(__uint_as_float(rr[0]),__uint_as_float(rr[1])); } \
      resc=false; \
      if(__builtin_expect(__any(rm>(float)THRL),0)){ const float dl=__builtin_fmaxf(rm,0.f); mhat+=dl; \
        _Pragma("unroll") for(int r=0;r<16;++r){C0[r]-=dl;C1[r]-=dl;} \
        _Pragma("unroll") for(int r=0;r<16;++r)negm[r]=-mhat; asm volatile("":"+v"(negm)); \
        const float f=__builtin_amdgcn_exp2f(-dl); l_reg*=f; if(hi==0)wsf[r32]=f; resc=true; } } \
    SBAR(); \
    GAPB(o[0]=__builtin_amdgcn_mfma_f32_32x32x16_bf16(PAF(0),VFR(0),o[0],0,0,0), C0,0); \
    GAPB(o[1]=__builtin_amdgcn_mfma_f32_32x32x16_bf16(PAF(0),VFR(4),o[1],0,0,0), C0,4); \
    KRD(GL,0); GAPB(o[0]=__builtin_amdgcn_mfma_f32_32x32x16_bf16(PAF(1),VFR(1),o[0],0,0,0), C0,8); \
    KRD(GL,1); GAPB(o[1]=__builtin_amdgcn_mfma_f32_32x32x16_bf16(PAF(1),VFR(5),o[1],0,0,0), C0,12); \
    KRD(GL,2); GAPB(o[0]=__builtin_amdgcn_mfma_f32_32x32x16_bf16(PAF(2),VFR(2),o[0],0,0,0), C1,0); \
    KRD(GL,3); GAPB(o[1]=__builtin_amdgcn_mfma_f32_32x32x16_bf16(PAF(2),VFR(6),o[1],0,0,0), C1,4); \
    GAPB(o[0]=__builtin_amdgcn_mfma_f32_32x32x16_bf16(PAF(3),VFR(3),o[0],0,0,0), C1,8); \
    GAPB(o[1]=__builtin_amdgcn_mfma_f32_32x32x16_bf16(PAF(3),VFR(7),o[1],0,0,0), C1,12); \
    }while(0)
  int t=1;
  #undef CMASK
  #define CMASK(P0,P1,t) do{ if(MODE==1 && (t)>=4) nabias(P0,P1,na_rsmin+(t)-4,na_qr,r32,wid,hi,rp_); }while(0)
  for(;t+5<NT;t+=2){
    STEP(pB0,pB1,pA0,pA1,t,true,true,true);     WAIT_BAR(2); RESC(); ROT();
    STEP(pA0,pA1,pB0,pB1,t+1,true,true,true);   WAIT_BAR(2); RESC(); ROT();
  }
  #undef CMASK
  #define CMASK(P0,P1,t) do{ if(MODE==1 && (t)>=4) nabias(P0,P1,na_rsmin+(t)-4,na_qr,r32,wid,hi,rp_); }while(0)
  #define ENDW(tt) do{ if((tt)+3<NT){WAIT_BAR(2);} else if((tt)+2<NT){WAIT_BAR(1);} else {WAIT_BAR(0);} }while(0)
  for(;t+1<NT;t+=2){
    STEP(pB0,pB1,pA0,pA1,t,(t+3<NT),(t+1<NT),(t+1<NT));       ENDW(t);   RESC(); ROT();
    STEP(pA0,pA1,pB0,pB1,t+1,(t+4<NT),(t+2<NT),(t+2<NT));     ENDW(t+1); RESC(); ROT();
  }
  STEP(pB0,pB1,pA0,pA1,NT-1,false,false,false); RESC();
  { float sacc=pB0[0]+pB0[1]; _Pragma("unroll") for(int r=2;r<16;++r)sacc+=pB0[r]; _Pragma("unroll") for(int r=0;r<16;++r)sacc+=pB1[r]; l_reg+=sacc;
    pw0=(u32x4){PKW(pB0,0),PKW(pB0,2),PKW(pB0,4),PKW(pB0,6)};pw1=(u32x4){PKW(pB0,8),PKW(pB0,10),PKW(pB0,12),PKW(pB0,14)};pw2=(u32x4){PKW(pB1,0),PKW(pB1,2),PKW(pB1,4),PKW(pB1,6)};pw3=(u32x4){PKW(pB1,8),PKW(pB1,10),PKW(pB1,12),PKW(pB1,14)};
    SBAR(); pv(o,vb0+sl_cur,PAF(0),PAF(1),PAF(2),PAF(3)); }
  #undef PKW
  #undef PAF
  #undef VFR
  #undef PIN
  #undef MX3
  #undef GAPA
  #undef GAPB
  #undef EX
  #undef VRD
  #undef KRD
  #undef STEP
  #undef ENDW
  {auto rr=__builtin_amdgcn_permlane32_swap(__float_as_uint(l_reg),__float_as_uint(l_reg),false,false);l_reg=__uint_as_float(rr[0])+__uint_as_float(rr[1]);}
  if(hi==0)wsf[32+r32]=l_reg;asm volatile("s_waitcnt lgkmcnt(0)":::"memory");
  float rli[16];
  #pragma unroll
  for(int r=0;r<16;++r)rli[r]=__builtin_amdgcn_rcpf(wsf[32+crow(r,hi)]);
  bf16*Ow=Ow0+(long)(wid*QBLK)*ODM;
  { bf16*stg=(bf16*)(shm+LDS_OST)+wid*2048;
    #pragma unroll
    for(int r=0;r<16;++r){const int orow=crow(r,hi);
      #pragma unroll
      for(int d0=0;d0<2;++d0)stg[orow*64+d0*32+r32]=__float2bfloat16(o[d0][r]*rli[r]);}
    asm volatile("s_waitcnt lgkmcnt(0)":::"memory");
    #pragma unroll
    for(int i=0;i<4;++i){const int row=i*8+(lane>>3),ch=lane&7; const u32x4 v=*(const u32x4*)(stg+row*64+ch*8); ATTN_STORE16(Ow+(long)row*ODM+ch*8,v);} }
  asm volatile("s_waitcnt lgkmcnt(0)\n\ts_barrier":::"memory");
  #undef DMA_K
  #undef TROW
  #undef DMA_V
  #undef CMASK
  #undef START
  #undef RESC
  #undef ROT
}
constexpr int ATTN_LDS_BYTES=LDS_BYTES;
}
#ifndef DBG_MASK
#define DBG_MASK 127
#endif
#ifndef DBG_DIAG
#define DBG_DIAG 0
#endif
#ifndef DBG_NA
#define DBG_NA 1
#endif
#ifndef DBG_CTX
#define DBG_CTX 1
#endif
#ifndef DBG_POOL
#define DBG_POOL 1
#endif
namespace cg = cooperative_groups;
#define GAS __attribute__((address_space(1)))
#define LAS __attribute__((address_space(3)))
typedef unsigned short bf16;
typedef unsigned v4u __attribute__((ext_vector_type(4)));
typedef float f32x4 __attribute__((ext_vector_type(4)));
#define LDS_WAIT() asm volatile("s_waitcnt lgkmcnt(0)" ::: "memory")
__device__ __forceinline__ unsigned f2bf(float f) { unsigned u = __builtin_bit_cast(unsigned, f); return (u + 0x7fffu + ((u >> 16) & 1u)) >> 16; }
__device__ __forceinline__ unsigned pk2(float lo, float hi) { return f2bf(lo) | (f2bf(hi) << 16); }
__device__ __forceinline__ float bf2f(unsigned short h) { return __builtin_bit_cast(float, (unsigned)h << 16); }
__device__ __forceinline__ float wave_sum(float v) {
#pragma unroll
    for (int o = 1; o < 64; o <<= 1) v += __shfl_xor(v, o);
    return v;
}
constexpr size_t MiB = 1u << 20;
constexpr size_t WS_MOD = 0, WS_ROPEC = 1 * MiB, WS_ROPES = 1 * MiB + 8192;
constexpr size_t WS_WIN = 2 * MiB, WS_WOUT = 18 * MiB, WS_WUP = 26 * MiB, WS_WDN = 70 * MiB;
constexpr size_t WS_X = 92 * MiB, WS_H = 357 * MiB, WS_Z = 490 * MiB, WS_Y = 754 * MiB, WS_ACT = WS_Z, WS_END = 886 * MiB;
static_assert(WS_WIN + (size_t)P_DEPTH * P_INW * P_D * 2 <= WS_WOUT && WS_WOUT + (size_t)P_DEPTH * P_D * P_D * 2 <= WS_WUP && WS_WUP + (size_t)P_DEPTH * P_UPW * P_D * 2 <= WS_WDN && WS_WDN + (size_t)P_DEPTH * P_D * P_DFF * 2 <= WS_X, "weights map");
static_assert(WS_X + (size_t)P_M * P_D * 4 <= WS_H - MiB / 2 && WS_H + (size_t)P_M * P_D * 2 + MiB / 2 <= WS_Z && WS_Z + (size_t)P_M * P_INW * 2 <= WS_Y && WS_Y + (size_t)P_M * P_D * 2 <= WS_END && WS_ACT + (size_t)P_M * P_DFF * 2 <= WS_END, "activation map");
constexpr int LDS_BYTES = 147456, RPB_OFF = 98304;
constexpr int N_PHASES = 2 + 7 * P_DEPTH;

struct Args {
    const float *x, *c, *ctx, *c_ctx, *w_mod, *b_mod, *w_in, *pool_w, *pool_scale, *na_rpb, *q_norm, *k_norm, *w_out, *ln1_g, *ln1_b, *w_up, *conv_w, *conv_b, *w_down, *ln2_g, *ln2_b;
    float* out; unsigned char* ws; int ph_lo, ph_hi;
};
static_assert(sizeof(Args) == 23 * 8 + 8, "Args has no padding");

template <int OFF> __device__ __forceinline__ unsigned long long ldarg() {
    unsigned long long v; asm volatile("s_load_dwordx2 %0, %1, %2\n\ts_waitcnt lgkmcnt(0)" : "=s"(v) : "s"(__builtin_amdgcn_kernarg_segment_ptr()), "n"(OFF)); return v; }
#define ARGF(A, f) (A).f = (decltype(Args::f))ldarg<offsetof(Args, f)>()
__device__ __forceinline__ void p0_item(const float* W, int K, int N, bf16* WT, int k0, int n0, int drow, LAS float* scr, int lane) {
#pragma unroll 8
    for (int i = 0; i < 32; ++i) { const int kk = 2 * i + (lane >> 5); scr[kk * 33 + (lane & 31)] = W[(size_t)(k0 + kk) * N + n0 + (lane & 31)]; }
    LDS_WAIT(); asm volatile("" ::: "memory");
    const int c = lane & 7;
#pragma unroll
    for (int j = 0; j < 4; ++j) { const int n = (lane >> 3) + 8 * j; const LAS float* s = scr + (8 * c) * 33 + n;
        v4u o; o.x = pk2(s[0 * 33], s[1 * 33]); o.y = pk2(s[2 * 33], s[3 * 33]); o.z = pk2(s[4 * 33], s[5 * 33]); o.w = pk2(s[6 * 33], s[7 * 33]);
        *(GAS v4u*)(WT + (size_t)(drow + n) * K + k0 + 8 * c) = o; }
    LDS_WAIT(); asm volatile("" ::: "memory");
}

__device__ __forceinline__ void phase0(const Args& a, LAS unsigned char* lds, int vcu, int G, int tid, int lane, int wave) {
    unsigned char* ws = a.ws;
    {
        LAS float* scr = (LAS float*)(lds + wave * 16384);
        const int gw = vcu * 8 + wave, NGW = G * 8;
        constexpr int I_IN = 16 * 64, I_OUT = 16 * 32, I_UP = 16 * 176, I_DN = 44 * 32, I_L = I_IN + I_OUT + I_UP + I_DN;
        for (int it = gw; it < P_DEPTH * I_L; it += NGW) {
            const int l = it / I_L; int r = it - l * I_L;
            if (r < I_IN) { const int kb = r >> 6, nb = r & 63, L0 = 32 * nb; const int drow = (L0 & ~255) + ((L0 >> 5) & 1) * 128 + ((L0 >> 6) & 3) * 32;
                p0_item(a.w_in + (size_t)l * P_D * P_INW, P_D, P_INW, (bf16*)(ws + WS_WIN) + (size_t)l * P_INW * P_D, 64 * kb, 32 * nb, drow, scr, lane); continue; }
            r -= I_IN;
            if (r < I_OUT) { const int kb = r >> 5, nb = r & 31;
                p0_item(a.w_out + (size_t)l * P_D * P_D, P_D, P_D, (bf16*)(ws + WS_WOUT) + (size_t)l * P_D * P_D, 64 * kb, 32 * nb, 32 * nb, scr, lane); continue; }
            r -= I_OUT;
            if (r < I_UP) { const int kb = r / 176, nb = r - kb * 176, L0 = 32 * nb; const int half = L0 >= P_DFF ? 1 : 0, ch0 = L0 - half * P_DFF; const int drow = (ch0 >> 7) * 256 + half * 128 + (ch0 & 127);
                p0_item(a.w_up + (size_t)l * P_D * P_UPW, P_D, P_UPW, (bf16*)(ws + WS_WUP) + (size_t)l * P_UPW * P_D, 64 * kb, 32 * nb, drow, scr, lane); continue; }
            r -= I_UP;
            { const int kb = r >> 5, nb = r & 31;
                p0_item(a.w_down + (size_t)l * P_DFF * P_D, P_DFF, P_D, (bf16*)(ws + WS_WDN) + (size_t)l * P_D * P_DFF, 64 * kb, 32 * nb, 32 * nb, scr, lane); }
        }
    }
    __syncthreads();
    if (vcu < 192) {
        LAS float* act = (LAS float*)lds; LAS float* red = (LAS float*)(lds + 40960);
        for (int e = tid; e < 9 * P_D; e += 512) { const int r = e >> 10, k = e & 1023; const float v = r < 8 ? a.c[r * P_D + k] : a.c_ctx[k]; act[e] = v / (1.0f + expf(-v)); }
        __syncthreads();
        for (int u = vcu; u < 192; u += G) {
            const int l = u / 48, n0 = (u - l * 48) * 128, col = tid & 127, ks = tid >> 7;
            const float* wp = a.w_mod + (size_t)l * P_D * P_MODW + (size_t)(ks * 256) * P_MODW + n0 + col;
            float s[9];
#pragma unroll
            for (int r = 0; r < 9; ++r) s[r] = 0.f;
#pragma unroll 4
            for (int k = 0; k < 256; ++k) { const float w = wp[(size_t)k * P_MODW];
#pragma unroll
                for (int r = 0; r < 9; ++r) s[r] += act[r * P_D + ks * 256 + k] * w; }
#pragma unroll
            for (int r = 0; r < 9; ++r) red[(ks * 9 + r) * 128 + col] = s[r];
            __syncthreads();
            for (int e = tid; e < 9 * 128; e += 512) { const int r = e >> 7, cc = e & 127;
                const float t = (red[(0 * 9 + r) * 128 + cc] + red[(1 * 9 + r) * 128 + cc]) + (red[(2 * 9 + r) * 128 + cc] + red[(3 * 9 + r) * 128 + cc]);
                ((float*)(ws + WS_MOD))[(size_t)(l * 9 + r) * P_MODW + n0 + cc] = t + a.b_mod[l * P_MODW + n0 + cc]; }
            __syncthreads();
        }
    }
    if (vcu == G - 1) {
        for (int e = tid; e < 2048; e += 512) { const int pos = e >> 4, f = e & 15;
            const float inv = exp2f(-(float)f * (13.287712379549449f / 16.0f));
            const float ang = (float)pos * inv;
            ((float*)(ws + WS_ROPEC))[e] = cosf(ang); ((float*)(ws + WS_ROPES))[e] = sinf(ang); }
    }
}

template <int KIND> __device__ __forceinline__ void row_phase(const Args& a, int l, int vcu, int G, int wave, int lane) {
    unsigned char* ws = a.ws; float* X = (float*)(ws + WS_X); bf16* H = (bf16*)(ws + WS_H); const float* mod = (const float*)(ws + WS_MOD);
    const int gw = vcu * 8 + wave, NGW = G * 8;
    const bool lastl = (KIND == 2 && l == P_DEPTH - 1);
    const int ml = (KIND == 2) ? l + 1 : l; const int csh = (KIND == 1) ? 3 : 0, csc = (KIND == 1) ? 4 : 1;
    const float* lg = (KIND == 1 ? a.ln1_g : a.ln2_g) + l * P_D; const float* lb = (KIND == 1 ? a.ln1_b : a.ln2_b) + l * P_D;
    for (int m = gw; m < P_M; m += NGW) {
        const int b = m / P_RPB, rb = m - b * P_RPB; const bool is_ctx = rb < P_CTX; const int mrow = is_ctx ? 8 : b;
        const float* src;
        if (KIND == 0) src = is_ctx ? a.ctx + ((size_t)b * P_CTX + rb) * P_D : a.x + ((size_t)b * P_SEQ + (rb - P_CTX)) * P_D;
        else src = X + (size_t)m * P_D;
        const f32x4* xr = (const f32x4*)src + lane;
        f32x4 v[4];
#pragma unroll
        for (int j = 0; j < 4; ++j) v[j] = xr[64 * j];
        if (KIND != 0) {
            float s = 0.f;
#pragma unroll
            for (int j = 0; j < 4; ++j) s += (v[j].x + v[j].y) + (v[j].z + v[j].w);
            const float mean = wave_sum(s) * (1.f / P_D); float s2 = 0.f;
#pragma unroll
            for (int j = 0; j < 4; ++j) { v[j] = v[j] - mean; s2 += (v[j].x * v[j].x + v[j].y * v[j].y) + (v[j].z * v[j].z + v[j].w * v[j].w); }
            const float rstd = 1.f / sqrtf(wave_sum(s2) * (1.f / P_D) + P_EPS);
#pragma unroll
            for (int j = 0; j < 4; ++j) { const f32x4 g = ((const f32x4*)lg)[lane + 64 * j], bb = ((const f32x4*)lb)[lane + 64 * j]; v[j] = v[j] * rstd * g + bb; }
        }
        if (lastl) {
            if (!is_ctx) { f32x4* o = (f32x4*)(a.out + ((size_t)b * P_SEQ + (rb - P_CTX)) * P_D) + lane;
#pragma unroll
                for (int j = 0; j < 4; ++j) o[64 * j] = v[j]; }
        } else {
            f32x4* xo = (f32x4*)(X + (size_t)m * P_D) + lane;
#pragma unroll
            for (int j = 0; j < 4; ++j) xo[64 * j] = v[j];
            const float* mp = mod + (size_t)(ml * 9 + mrow) * P_MODW;
            unsigned long long* o8 = (unsigned long long*)(H + (size_t)m * P_D) + lane;
#pragma unroll
            for (int j = 0; j < 4; ++j) { const f32x4 sh = ((const f32x4*)(mp + csh * P_D))[lane + 64 * j], sc = ((const f32x4*)(mp + csc * P_D))[lane + 64 * j];
                const f32x4 h = v[j] * (1.0f + sc) + sh;
                o8[64 * j] = (unsigned long long)pk2(h.x, h.y) | ((unsigned long long)pk2(h.z, h.w) << 32); }
        }
    }
}

__device__ __forceinline__ void pool_unit(const Args& a, int l, int u, LAS unsigned char* lds, int tid) {
    const bf16* Z = (const bf16*)(a.ws + WS_Z); bf16* Y = (bf16*)(a.ws + WS_Y);
    const int tk = u >> 2, g = u & 3; const int row0 = tk * 128; const int b = row0 / P_RPB, rb0 = row0 - b * P_RPB;
    const int slo = (rb0 < P_CTX) ? b * P_RPB : b * P_RPB + P_CTX, shi = (rb0 < P_CTX) ? b * P_RPB + P_CTX : (b + 1) * P_RPB;
    LAS float* zt = (LAS float*)lds;
    LAS float* pl = (LAS float*)(lds + 36864);
    LAS float* wl = (LAS float*)(lds + 36864 + 34816);
    for (int e = tid; e < 144 * 8; e += 512) { const int rr = e >> 3, c8 = e & 7; const int R = row0 - 8 + rr;
        v4u w = (v4u){0u, 0u, 0u, 0u};
        if (R >= slo && R < shi) w = *(const v4u*)(Z + (size_t)R * P_INW + g * 64 + c8 * 8);
        LAS float* d = zt + rr * 64 + c8 * 8;
        d[0] = bf2f(w.x & 0xffff); d[1] = bf2f(w.x >> 16); d[2] = bf2f(w.y & 0xffff); d[3] = bf2f(w.y >> 16); d[4] = bf2f(w.z & 0xffff); d[5] = bf2f(w.z >> 16); d[6] = bf2f(w.w & 0xffff); d[7] = bf2f(w.w >> 16); }
    { const f32x4* wsrc = (const f32x4*)(a.pool_w + ((size_t)l * 4 + g) * 4096);
      for (int e = tid; e < 1024; e += 512) ((LAS f32x4*)wl)[e] = wsrc[e]; }
    __syncthreads();
    const int hw = 1 << g;
    for (int e = tid; e < 128 * 64; e += 512) { const int t = e >> 6, c = e & 63; const int T = row0 + t;
        const int lo = max(T - hw, slo), hi = min(T + hw - 1, shi - 1);
        float s = 0.f;
        for (int p = lo; p <= hi; ++p) s += zt[(p - row0 + 8) * 64 + c];
        pl[t * 68 + c] = s / (float)(hi - lo + 1) - zt[(t + 8) * 64 + c]; }
    __syncthreads();
    { const int d = tid & 63, tq = tid >> 6;
      float acc[16];
#pragma unroll
      for (int t = 0; t < 16; ++t) acc[t] = 0.f;
      for (int c4 = 0; c4 < 16; ++c4) {
          const float w0 = wl[(4 * c4 + 0) * 64 + d], w1 = wl[(4 * c4 + 1) * 64 + d], w2 = wl[(4 * c4 + 2) * 64 + d], w3 = wl[(4 * c4 + 3) * 64 + d];
#pragma unroll
          for (int t = 0; t < 16; ++t) { const f32x4 p = *(const LAS f32x4*)(pl + (tq * 16 + t) * 68 + 4 * c4); acc[t] += (p.x * w0 + p.y * w1) + (p.z * w2 + p.w * w3); }
      }
      const float sc = a.pool_scale[l * 256 + g * 64 + d];
#pragma unroll
      for (int t = 0; t < 16; ++t) Y[(size_t)(row0 + tq * 16 + t) * P_D + g * 64 + d] = (bf16)f2bf(acc[t] * sc);
    }
    __syncthreads();
}

__device__ __forceinline__ void mix_phase(const Args& a, int l, unsigned char* ldsg, LAS unsigned char* lds, int vcu, int G, int tid) {
    using abf = attn_body::bf16;
    const abf* Z = (const abf*)(a.ws + WS_Z); abf* Y = (abf*)(a.ws + WS_Y);
    { LAS float* rp = (LAS float*)(lds + RPB_OFF); const float* src = a.na_rpb + (size_t)l * 6 * 465;
      for (int e = tid; e < 6 * 465; e += 512) rp[e] = src[e] * P_LOG2E; }
    __syncthreads();
    for (int u = vcu; u < 1536; u += G) { const int h = u >> 8, b = (u >> 5) & 7, qb = u & 31, kv = h / 3;
        const size_t brow = (size_t)b * P_RPB, qrow = brow + P_CTX + (size_t)qb * 256;
        attn_body::attn_unit<8, 0>(Z + qrow * P_INW + 1408 + 64 * h, Z + brow * P_INW + 1792 + 64 * kv, Z + brow * P_INW + 1920 + 64 * kv, Y + qrow * P_D + 640 + 64 * h, 132, 256, 0, 0, RPB_OFF, (char*)ldsg); }
    if (DBG_NA) for (int u = vcu; u < 1536; u += G) { const int h = u >> 8, b = (u >> 5) & 7, qb = u & 31;
        const size_t brow = (size_t)b * P_RPB, qrow = brow + P_CTX + (size_t)qb * 256;
        const int rsmin = min(max(4 * qb - 4, 0), 116);
        attn_body::attn_unit<8, 1>(Z + qrow * P_INW + 256 + 64 * h, Z + brow * P_INW + 640 + 64 * h, Z + brow * P_INW + 1024 + 64 * h, Y + qrow * P_D + 256 + 64 * h, 16, 256 + 64 * rsmin, 4 * qb, rsmin, RPB_OFF + h * 465 * 4, (char*)ldsg); }
    if (DBG_CTX && l < P_DEPTH - 1)
        for (int u = vcu; u < 96; u += G) { const int b = u / 12, hh = u - b * 12; const size_t brow = (size_t)b * P_RPB;
            int qc, kc, vc, oc;
            if (hh < 6) { qc = 256 + 64 * hh; kc = 640 + 64 * hh; vc = 1024 + 64 * hh; oc = 256 + 64 * hh; }
            else { const int h = hh - 6; qc = 1408 + 64 * h; kc = 1792 + 64 * (h / 3); vc = 1920 + 64 * (h / 3); oc = 640 + 64 * h; }
            attn_body::attn_unit<8, 0>(Z + brow * P_INW + qc, Z + brow * P_INW + kc, Z + brow * P_INW + vc, Y + brow * P_D + oc, 4, 256, 0, 0, RPB_OFF, (char*)ldsg); }
    if (DBG_POOL) for (int u = vcu; u < (P_M / 128) * 4; u += G) pool_unit(a, l, u, lds, tid);
}


#if DBG_DIAG
constexpr size_t WS_FLAG = 1 * MiB + 65536;
__device__ __forceinline__ bool dclose(float a, float b, float tol) { return fabsf(a - b) <= tol * (1.0f + fabsf(b)); }
__device__ __forceinline__ void diag_phase(const Args& a, int code, int vcu, int tid, int G) {
    unsigned char* ws = a.ws; unsigned* flag = (unsigned*)(ws + WS_FLAG);
    const float* mod = (const float*)(ws + WS_MOD); const float* X = (const float*)(ws + WS_X); const bf16* H = (const bf16*)(ws + WS_H);
    const bf16* Z = (const bf16*)(ws + WS_Z); const bf16* Y = (const bf16*)(ws + WS_Y); const bf16* ACT = (const bf16*)(ws + WS_ACT);
    const int b = 2, pos = 3000; const size_t Rl = (size_t)b * P_RPB + P_CTX + pos;
    const int lane = tid & 63;
    if (code == 199) {
        const unsigned fl = *flag; int first = 0; for (int i = 0; i < 16; ++i) if ((fl >> i) & 1) { first = i + 1; break; }
        for (size_t i = (size_t)vcu * 512 + tid; i < (size_t)P_B * P_SEQ * P_D; i += (size_t)G * 512) a.out[i] = (float)first;
        return;
    }
    if (vcu != 0 || tid >= 64) return;
    bool bad = false;
    if (code == 100) {
        if (lane == 0) *flag = 0u;
        const int ns[4] = {5, 1030, 3200, 6000};
        for (int q = 0; q < 4; ++q) { const int n = ns[q]; float s = 0.f;
            for (int k = lane; k < P_D; k += 64) { const float v = a.c[b * P_D + k]; s += v / (1.f + expf(-v)) * a.w_mod[(size_t)k * P_MODW + n]; }
            s = wave_sum(s) + a.b_mod[n]; if (!dclose(mod[(size_t)b * P_MODW + n], s, 1e-3f)) bad = true; }
        { const int k = lane * 16 + 3; const float xv = a.x[((size_t)b * P_SEQ + pos) * P_D + k];
          const float h = xv * (1.f + mod[(size_t)b * P_MODW + P_D + k]) + mod[(size_t)b * P_MODW + k];
          if (!dclose(bf2f(H[Rl * P_D + k]), h, 1e-2f)) bad = true; if (X[Rl * P_D + k] != xv) bad = true; }
        if (__any(bad) && lane == 0) atomicOr(flag, 1u);
    } else if (code == 101) {
        const int cs[5] = {100, 700, 1100, 2000, 300};
        for (int q = 0; q < 5; ++q) { const int col = cs[q]; float s = 0.f;
            for (int k = lane; k < P_D; k += 64) s += bf2f(H[Rl * P_D + k]) * a.w_in[(size_t)k * P_INW + col];
            s = wave_sum(s); if (q == 4) s *= P_C2; if (!dclose(bf2f(Z[Rl * P_INW + col]), s, 3e-2f)) bad = true; }
        if (__any(bad) && lane == 0) atomicOr(flag, 2u);
        bad = false;
        { float s = 0.f; for (int k = 0; k < P_D; ++k) s += bf2f(H[Rl * P_D + k]) * a.w_in[(size_t)k * P_INW + 1792 + lane];
          const float ss = wave_sum(s * s); float xn = s / sqrtf(ss / 64.f + P_EPS) * a.k_norm[lane];
          const int gr = pos >> 6, gc = pos & 63; const int f = lane & 15; const float inv = exp2f(-(float)f * (13.287712379549449f / 16.0f));
          const float ang = (float)((lane < 32) ? gr : gc) * inv; const float cs_ = cosf(ang), sn_ = sinf(ang);
          const float pr = __shfl_xor(xn, 16); const float o = ((lane & 16) == 0) ? xn * cs_ - pr * sn_ : pr * sn_ + xn * cs_;
          if (!dclose(bf2f(Z[Rl * P_INW + 1792 + lane]), o, 3e-2f)) bad = true; }
        if (__any(bad) && lane == 0) atomicOr(flag, 4u);
    } else if (code == 102) {
        { const int g = 3, hw = 8; float s = 0.f; for (int p = -hw; p < hw; ++p) s += bf2f(Z[(Rl + p) * P_INW + g * 64 + lane]);
          const float pooled = s / 16.f - bf2f(Z[Rl * P_INW + g * 64 + lane]); float y = 0.f;
          for (int c = 0; c < 64; ++c) y += __shfl(pooled, c) * a.pool_w[(size_t)g * 4096 + c * 64 + lane];
          y *= a.pool_scale[g * 64 + lane]; if (!dclose(bf2f(Y[Rl * P_D + g * 64 + lane]), y, 3e-2f)) bad = true; }
        if (__any(bad) && lane == 0) atomicOr(flag, 8u);
        bad = false;
        { const int h = 2; const int gr = pos >> 6, gc = pos & 63; const int rs = min(max(gr - 4, 0), 120), cs = min(max(gc - 8, 0), 48);
          float mx = -1e30f, sc[6];
          for (int i = 0; i < 6; ++i) { const int key = lane + 64 * i; size_t kr_; float bias = 0.f;
              if (key < 128) { const int kr = rs + key / 16, kc = cs + key % 16; kr_ = (size_t)b * P_RPB + P_CTX + kr * 64 + kc; bias = a.na_rpb[(size_t)h * 465 + (kr - gr + 7) * 31 + (kc - gc + 15)] * P_LOG2E; }
              else kr_ = (size_t)b * P_RPB + (key - 128);
              float s = 0.f; for (int d = 0; d < 64; ++d) s += bf2f(Z[Rl * P_INW + 256 + 64 * h + d]) * bf2f(Z[kr_ * P_INW + 640 + 64 * h + d]);
              sc[i] = s + bias; mx = fmaxf(mx, sc[i]); }
          for (int o = 1; o < 64; o <<= 1) mx = fmaxf(mx, __shfl_xor(mx, o));
          float den = 0.f; for (int i = 0; i < 6; ++i) { sc[i] = exp2f(sc[i] - mx); den += sc[i]; } den = wave_sum(den);
          float o_ = 0.f;
          for (int i = 0; i < 6; ++i) for (int l2 = 0; l2 < 64; ++l2) { const int key = l2 + 64 * i; size_t kr_;
              if (key < 128) { const int kr = rs + key / 16, kc = cs + key % 16; kr_ = (size_t)b * P_RPB + P_CTX + kr * 64 + kc; } else kr_ = (size_t)b * P_RPB + (key - 128);
              o_ += __shfl(sc[i], l2) * bf2f(Z[kr_ * P_INW + 1024 + 64 * h + lane]); }
          o_ /= den; if (!dclose(bf2f(Y[Rl * P_D + 256 + 64 * h + lane]), o_, 3e-2f)) bad = true; }
        if (__any(bad) && lane == 0) atomicOr(flag, 16u);
        bad = false;
        { const int h = 4, kv = 1; float mx = -1e30f; float den = 0.f, o_ = 0.f;
          for (int i = 0; i < 132; ++i) { const size_t kr_ = (size_t)b * P_RPB + lane + 64 * i; float s = 0.f;
              for (int d = 0; d < 64; ++d) s += bf2f(Z[Rl * P_INW + 1408 + 64 * h + d]) * bf2f(Z[kr_ * P_INW + 1792 + 64 * kv + d]); mx = fmaxf(mx, s); }
          for (int o = 1; o < 64; o <<= 1) mx = fmaxf(mx, __shfl_xor(mx, o));
          for (int i = 0; i < 132; ++i) { const size_t kr_ = (size_t)b * P_RPB + lane + 64 * i; float s = 0.f;
              for (int d = 0; d < 64; ++d) s += bf2f(Z[Rl * P_INW + 1408 + 64 * h + d]) * bf2f(Z[kr_ * P_INW + 1792 + 64 * kv + d]);
              const float p = exp2f(s - mx); den += p;
              for (int l2 = 0; l2 < 64; ++l2) o_ += __shfl(p, l2) * bf2f(Z[((size_t)b * P_RPB + l2 + 64 * i) * P_INW + 1920 + 64 * kv + lane]); }
          den = wave_sum(den); o_ /= den; if (!dclose(bf2f(Y[Rl * P_D + 640 + 64 * h + lane]), o_, 3e-2f)) bad = true; }
        if (__any(bad) && lane == 0) atomicOr(flag, 32u);
    } else if (code == 103) {
        { const int c = lane * 16 + 5; float s = 0.f; for (int k = 0; k < P_D; ++k) s += bf2f(Y[Rl * P_D + k]) * a.w_out[(size_t)k * P_D + c];
          const float e = P_ALPHA * a.x[((size_t)b * P_SEQ + pos) * P_D + c] + mod[(size_t)b * P_MODW + 2 * P_D + c] * s;
          if (!dclose(X[Rl * P_D + c], e, 3e-3f)) bad = true; }
        if (__any(bad) && lane == 0) atomicOr(flag, 64u);
    } else if (code == 104) {
        { float m = 0.f, q = 0.f; for (int k = lane; k < P_D; k += 64) { const float y = (X[Rl * P_D + k] - a.ln1_b[k]) / a.ln1_g[k]; m += y; q += y * y; }
          m = wave_sum(m) / P_D; q = wave_sum(q) / P_D; if (fabsf(m) > 1e-3f || fabsf(q - 1.f) > 2e-3f) bad = true;
          const int k = lane * 16 + 7; const float h = X[Rl * P_D + k] * (1.f + mod[(size_t)b * P_MODW + 4 * P_D + k]) + mod[(size_t)b * P_MODW + 3 * P_D + k];
          if (!dclose(bf2f(H[Rl * P_D + k]), h, 1e-2f)) bad = true; }
        if (__any(bad) && lane == 0) atomicOr(flag, 128u);
    } else if (code == 105) {
        { const int ch = 37 + lane * 43; float ua[3] = {0.f, 0.f, 0.f}, ug[3] = {0.f, 0.f, 0.f};
          for (int k = 0; k < P_D; ++k) { const float wa = a.w_up[(size_t)k * P_UPW + ch], wg = a.w_up[(size_t)k * P_UPW + P_DFF + ch];
              for (int j = 0; j < 3; ++j) { const float hv = bf2f(H[(Rl + j - 1) * P_D + k]); ua[j] += hv * wa; ug[j] += hv * wg; } }
          const float av = a.conv_w[ch] * ua[0] + a.conv_w[P_UPW + ch] * ua[1] + a.conv_w[2 * P_UPW + ch] * ua[2] + a.conv_b[ch];
          const float gv = a.conv_w[P_DFF + ch] * ug[0] + a.conv_w[P_UPW + P_DFF + ch] * ug[1] + a.conv_w[2 * P_UPW + P_DFF + ch] * ug[2] + a.conv_b[P_DFF + ch];
          const float e = av * gv / (1.f + expf(-gv)); if (!dclose(bf2f(ACT[Rl * P_DFF + ch]), e, 4e-2f)) bad = true; }
        if (__any(bad) && lane == 0) atomicOr(flag, 256u);
    } else if (code == 106) {
        { const int c = lane * 16 + 9; float s = 0.f; for (int k = 0; k < P_DFF; ++k) s += bf2f(ACT[Rl * P_DFF + k]) * a.w_down[(size_t)k * P_D + c];
          const float x1 = (bf2f(H[Rl * P_D + c]) - mod[(size_t)b * P_MODW + 3 * P_D + c]) / (1.f + mod[(size_t)b * P_MODW + 4 * P_D + c]);
          const float e = P_ALPHA * x1 + mod[(size_t)b * P_MODW + 5 * P_D + c] * s;
          if (fabsf(X[Rl * P_D + c] - e) > 0.03f) bad = true; }
        if (__any(bad) && lane == 0) atomicOr(flag, 512u);
    }
}
#endif

__global__ void __launch_bounds__(512, 2) mega(Args a) {
    extern __shared__ __attribute__((aligned(16))) unsigned char ldsraw[];
    LAS unsigned char* lds = (LAS unsigned char*)ldsraw;
    cg::grid_group grid = cg::this_grid();
    const int G = gridDim.x; const int bx = blockIdx.x; const int vcu = (G % 8 == 0) ? (bx % 8) * (G / 8) + bx / 8 : bx;
    const int ph_lo = a.ph_lo, ph_hi = a.ph_hi;
    for (int ph = ph_lo; ph < ph_hi; ++ph) {
        if (ph > ph_lo) grid.sync();
        const int tid = ltid(), lane = tid & 63, wave = __builtin_amdgcn_readfirstlane(tid >> 6);
        Args q;
        ARGF(q, ws); unsigned char* ws = q.ws;
#if DBG_DIAG
        if (ph >= 100) { q = a; diag_phase(q, ph, vcu, tid, G); continue; }
#endif
        if (ph == 0) { ARGF(q, c); ARGF(q, c_ctx); ARGF(q, w_mod); ARGF(q, b_mod); ARGF(q, w_in); ARGF(q, w_out); ARGF(q, w_up); ARGF(q, w_down); phase0(q, lds, vcu, G, tid, lane, wave); continue; }
        if (ph == 1) { ARGF(q, x); ARGF(q, ctx); row_phase<0>(q, 0, vcu, G, wave, lane); continue; }
        const int l = (ph - 2) / 7, sp = (ph - 2) % 7;
        if (sp == 0 && (DBG_MASK & 1)) {
            ARGF(q, q_norm); ARGF(q, k_norm);
            pg8::Gemm g{(const pg8::bf16_t*)(ws + WS_H), (const pg8::bf16_t*)(ws + WS_WIN) + (size_t)l * P_INW * P_D, P_M, P_INW, P_D};
            pg8::StaticOrder S; S.init(P_M / 256, P_INW / 256, G, bx);
            pg8::EpiIn E{(pg8::bf16_t*)(ws + WS_Z), q.q_norm + l * 64, q.k_norm + l * 64, (const float*)(ws + WS_ROPEC), (const float*)(ws + WS_ROPES)};
            pg8::gemm_phase<pg8::EpiIn, pg8::StaticOrder, true, true, 0>(lds, g, S, E);
        } else if (sp == 1 && (DBG_MASK & 2)) {
            ARGF(q, na_rpb); ARGF(q, pool_w); ARGF(q, pool_scale);
            mix_phase(q, l, ldsraw, lds, vcu, G, tid);
        } else if (sp == 2 && (DBG_MASK & 4)) {
            pg8::Gemm g{(const pg8::bf16_t*)(ws + WS_Y), (const pg8::bf16_t*)(ws + WS_WOUT) + (size_t)l * P_D * P_D, P_M, P_D, P_D};
            pg8::StaticOrder S; S.init(P_M / 256, P_D / 256, G, bx);
            pg8::EpiRes E{(float*)(ws + WS_X), (const float*)(ws + WS_MOD) + (size_t)l * 9 * P_MODW + 2 * P_D};
            pg8::gemm_phase<pg8::EpiRes, pg8::StaticOrder, true, true, 0>(lds, g, S, E);
        } else if (sp == 3 && (DBG_MASK & 8)) {
            ARGF(q, ln1_g); ARGF(q, ln1_b);
            row_phase<1>(q, l, vcu, G, wave, lane);
        } else if (sp == 4 && (DBG_MASK & 16)) {
            ARGF(q, conv_w); ARGF(q, conv_b);
            pg8::Gemm g{(const pg8::bf16_t*)(ws + WS_H) - P_D, (const pg8::bf16_t*)(ws + WS_WUP) + (size_t)l * P_UPW * P_D, P_M, P_UPW, P_D};
            pg8::StaticOrder S; S.init((P_M + 247) / 248, P_UPW / 256, G, bx);
            pg8::EpiUp E{(pg8::bf16_t*)(ws + WS_ACT), q.conv_w + (size_t)l * 3 * P_UPW, q.conv_b + (size_t)l * P_UPW};
            pg8::gemm_phase<pg8::EpiUp, pg8::StaticOrder, true, true, 1>(lds, g, S, E);
        } else if (sp == 5 && (DBG_MASK & 32)) {
            pg8::Gemm g{(const pg8::bf16_t*)(ws + WS_ACT), (const pg8::bf16_t*)(ws + WS_WDN) + (size_t)l * P_D * P_DFF, P_M, P_D, P_DFF};
            pg8::StaticOrder S; S.init(P_M / 256, P_D / 256, G, bx);
            pg8::EpiRes E{(float*)(ws + WS_X), (const float*)(ws + WS_MOD) + (size_t)l * 9 * P_MODW + 5 * P_D};
            pg8::gemm_phase<pg8::EpiRes, pg8::StaticOrder, true, true, 0>(lds, g, S, E);
        } else if (DBG_MASK & 64) {
            ARGF(q, ln2_g); ARGF(q, ln2_b); ARGF(q, out);
            row_phase<2>(q, l, vcu, G, wave, lane);
        }
    }
}

#ifndef MK_MULTI
#define MK_MULTI 0
#endif
extern "C" void kernel_launch(void* const* d_in, const int* in_sizes, int n_in, void* d_out, int out_size, void* d_ws, size_t ws_size, hipStream_t stream) {
    static int grid = 0;
    if (grid == 0) {
        if (n_in != 21 || ws_size < WS_END) { fprintf(stderr, "kernel_launch: unexpected n_in %d / ws_size %zu\n", n_in, ws_size); grid = -1; return; }
        int dev = 0, cus = 0, per_cu = 0;
        if (hipGetDevice(&dev) != hipSuccess || hipDeviceGetAttribute(&cus, hipDeviceAttributeMultiprocessorCount, dev) != hipSuccess) { grid = -1; return; }
        if (hipFuncSetAttribute((const void*)mega, hipFuncAttributeMaxDynamicSharedMemorySize, LDS_BYTES) != hipSuccess) { fprintf(stderr, "kernel_launch: hipFuncSetAttribute failed\n"); grid = -1; return; }
        if (hipOccupancyMaxActiveBlocksPerMultiprocessor(&per_cu, (const void*)mega, 512, LDS_BYTES) != hipSuccess || per_cu < 1) { fprintf(stderr, "kernel_launch: occupancy query says %d\n", per_cu); per_cu = 1; }
        (void)hipGetLastError();
        grid = cus * 1;
        fprintf(stderr, "kernel_launch: cus %d per_cu %d grid %d\n", cus, per_cu, grid);
    }
    if (grid < 0) return;
    Args a{};
    const float** f = (const float**)&a;
    for (int i = 0; i < 21; ++i) f[i] = (const float*)d_in[i];
    a.out = (float*)d_out; a.ws = (unsigned char*)d_ws;
#if MK_MULTI
#if DBG_DIAG
    { const int seq[] = {0, 1, 100, 2, 101, 3, 102, 4, 103, 5, 104, 6, 105, 7, 106, 199};
      for (int i = 0; i < 16; ++i) { a.ph_lo = seq[i]; a.ph_hi = seq[i] + 1; hipLaunchKernelGGL(mega, dim3(grid), dim3(512), LDS_BYTES, stream, a); } }
#else
    for (int ph = 0; ph < N_PHASES; ++ph) { a.ph_lo = ph; a.ph_hi = ph + 1; hipLaunchKernelGGL(mega, dim3(grid), dim3(512), LDS_BYTES, stream, a); }
#endif
#else
    a.ph_lo = 0; a.ph_hi = N_PHASES;
    void* args[] = {&a};
    hipError_t e = hipLaunchCooperativeKernel((const void*)mega, dim3(grid), dim3(512), args, LDS_BYTES, stream);
    if (e != hipSuccess) fprintf(stderr, "cooperative launch failed: %s (grid %d)\n", hipGetErrorString(e), grid);
#endif
}
```

```cpp
#include <hip/hip_runtime.h>
#include <hip/hip_cooperative_groups.h>
#include <cstdio>
#include <cstdint>
constexpr int P_D = 1024, P_B = 8, P_SEQ = 8192, P_CTX = 256, P_RPB = P_SEQ + P_CTX  , P_M = P_B * P_RPB  ;
constexpr int P_DEPTH = 4, P_INW = 2048, P_DFF = 2816, P_UPW = 2 * P_DFF, P_MODW = 6 * P_D;
constexpr float P_C2 = 0.125f * 1.4426950408889634f;
constexpr float P_LOG2E = 1.4426950408889634f;
constexpr float P_ALPHA = 1.681792830507429f;
constexpr float P_EPS = 1e-6f;
__device__ __forceinline__ int ltid() { int t = threadIdx.x; asm volatile("" : "+v"(t)); return t; }
namespace pg8 {
#define PG8_LAS __attribute__((address_space(3)))
typedef unsigned short bf16_t;
typedef short bf16x8 __attribute__((ext_vector_type(8)));
typedef float f32x4 __attribute__((ext_vector_type(4)));
typedef unsigned u32x4 __attribute__((ext_vector_type(4)));
constexpr int BM = 256, BK = 64, HALF = 128, HTB = HALF * BK * 2  , STAGE_BYTES = 8 * HTB, NXCD = 8, WGM = 8;

__host__ __device__ __forceinline__ int lds_byte(int r, int c) { const int st = (r >> 4) * 2 + (c >> 5), rr = r & 15, cc = c & 31, ob = rr * 64 + cc * 2; return st * 1024 + (ob ^ (((ob >> 9) & 1) << 5)); }
__host__ __device__ __forceinline__ void stage_rc(int b, int& R, int& C) { const int st = b / 1024, sb = b % 1024, swz = sb ^ (((sb >> 9) & 1) << 5); R = (st >> 1) * 16 + swz / 64; C = (st & 1) * 32 + (swz % 64) / 2; }
__host__ __device__ __forceinline__ int perm32(int rho) { const int n = rho >> 4, i = rho & 15; return 8 * (i >> 2) + 4 * n + (i & 3); }

struct Unit { int pm, pn; };
struct Gemm { const bf16_t* A; const bf16_t* Bt; int M, N, K; };

struct StaticOrder {
    int nM, nN, nwg, G, c;
    __host__ __device__ void init(int nM_, int nN_, int G_, int c_) { nM = nM_; nN = nN_; nwg = nM * nN; G = G_; c = c_; }
    __host__ __device__ bool next(int i, Unit& u) const {
        const long L = (long)i * G + c; if (L >= nwg) return false;
        int wgid = (int)L; { const int q = nwg / NXCD, r = nwg % NXCD, xcd = wgid % NXCD, off = wgid / NXCD; wgid = (xcd < r ? xcd * (q + 1) : r * (q + 1) + (xcd - r) * q) + off; }
        const int nig = WGM * nN, gid = wgid / nig, fm = gid * WGM, gsz = (nM - fm) < WGM ? (nM - fm) : WGM;
        u.pm = fm + ((wgid % nig) % gsz); u.pn = (wgid % nig) / gsz; return true;
    }
    __device__ __forceinline__ void a_ready(const Unit&) const {}
    __device__ __forceinline__ void done(const Unit&) const {}
};

__device__ __forceinline__ unsigned cvt_pk_bf16(float lo, float hi) { unsigned r; asm volatile("v_cvt_pk_bf16_f32 %0, %1, %2" : "=v"(r) : "v"(lo), "v"(hi)); return r; }
#ifndef EPI_SHFL
#define EPI_SHFL 0
#endif
__device__ __forceinline__ f32x4 dppror(const f32x4 v, const bool up) {
    f32x4 r;
#if EPI_SHFL
    const int lane = threadIdx.x & 63; const int src = (lane & ~15) | ((lane + (up ? 15 : 1)) & 15);
#pragma unroll
    for (int j = 0; j < 4; ++j) r[j] = __shfl(v[j], src);
#else
#pragma unroll
    for (int j = 0; j < 4; ++j) { const float xs = v[j]; const int iv = __float_as_int(xs);
        r[j] = __int_as_float(up ? __builtin_amdgcn_mov_dpp(iv, 0x121, 0xf, 0xf, true) : __builtin_amdgcn_mov_dpp(iv, 0x12F, 0xf, 0xf, true)); }
#endif
    return r;
}
struct EpiIn {
    static constexpr bool PERM = false, AFTER_DRAIN = false;
    bf16_t* Z; const float* qn; const float* kn; const float* rc; const float* rs;
    __device__ __forceinline__ void operator()(const f32x4 (&acc)[2][2][4][2], const Unit& u, int wr, int wc, int fr, int fq) const {
        asm volatile("" : "+v"(fr), "+v"(fq));
        const int hs = u.pn * 4 + wc;
        const bool isq = (hs >= 22 && hs < 28), isk = (hs == 28 || hs == 29);
        const float sc = ((hs >= 4 && hs < 10) || isq) ? P_C2 : 1.f;
        const int tb = u.pm % 33; const bool is_ctx = (tb == 0);
#pragma unroll
        for (int ai = 0; ai < 2; ++ai)
#pragma unroll
            for (int m = 0; m < 4; ++m) {
                const int rt = ai * HALF + wr * 64 + m * 16 + fr;
                const size_t row = (size_t)u.pm * BM + rt;
                f32x4 v[2][2];
#pragma unroll
                for (int bj = 0; bj < 2; ++bj)
#pragma unroll
                    for (int n = 0; n < 2; ++n) v[bj][n] = acc[ai][bj][m][n];
                if (isq || isk) {
                    float ss = 0.f;
#pragma unroll
                    for (int bj = 0; bj < 2; ++bj)
#pragma unroll
                        for (int n = 0; n < 2; ++n) { const f32x4 x = v[bj][n]; ss += (x[0] * x[0] + x[1] * x[1]) + (x[2] * x[2] + x[3] * x[3]); }
                    ss += __shfl_xor(ss, 16); ss += __shfl_xor(ss, 32);
                    const float rstd = 1.0f / sqrtf(ss * (1.0f / 64.0f) + P_EPS);
                    const float* gp = (isq ? qn : kn) + 4 * fq;
                    const int pos = (tb - 1) * BM + rt; const int gr = pos >> 6, gc = pos & 63;
#pragma unroll
                    for (int bj = 0; bj < 2; ++bj) {
                        const f32x4 g0 = *(const f32x4*)(gp + 32 * bj), g1 = *(const f32x4*)(gp + 32 * bj + 16);
                        f32x4 x1 = v[bj][0] * rstd * g0, x2 = v[bj][1] * rstd * g1;
                        if (!is_ctx) { const int idx = bj ? gc : gr;
                            const f32x4 cs = *(const f32x4*)(rc + idx * 16 + 4 * fq), sn = *(const f32x4*)(rs + idx * 16 + 4 * fq);
                            const f32x4 y1 = x1 * cs - x2 * sn, y2 = x1 * sn + x2 * cs; x1 = y1; x2 = y2; }
                        v[bj][0] = x1; v[bj][1] = x2;
                    }
                }
                bf16_t* zp = Z + row * P_INW + hs * 64 + 4 * fq;
#pragma unroll
                for (int bj = 0; bj < 2; ++bj)
#pragma unroll
                    for (int n = 0; n < 2; ++n) { const f32x4 x = v[bj][n] * sc; unsigned long long w = (unsigned long long)cvt_pk_bf16(x[0], x[1]) | ((unsigned long long)cvt_pk_bf16(x[2], x[3]) << 32);
                        *(unsigned long long*)(zp + 32 * bj + 16 * n) = w; }
                asm volatile("" ::: "memory");
            }
    }
};
struct EpiRes {
    static constexpr bool PERM = false, AFTER_DRAIN = false;
    float* X; const float* gate;
    __device__ __forceinline__ void operator()(const f32x4 (&acc)[2][2][4][2], const Unit& u, int wr, int wc, int fr, int fq) const {
        asm volatile("" : "+v"(fr), "+v"(fq));
        const int b = u.pm / 33, tb = u.pm % 33; const int mrow = tb == 0 ? 8 : b;
        const int col0 = u.pn * BM + wc * 32 + 4 * fq;
        const float* gp = gate + mrow * P_MODW + col0;
        f32x4 gv[2][2];
#pragma unroll
        for (int bj = 0; bj < 2; ++bj)
#pragma unroll
            for (int n = 0; n < 2; ++n) gv[bj][n] = *(const f32x4*)(gp + bj * HALF + n * 16);
#pragma unroll
        for (int ai = 0; ai < 2; ++ai)
#pragma unroll
            for (int m = 0; m < 4; ++m) { float* xr = X + ((size_t)u.pm * BM + ai * HALF + wr * 64 + m * 16 + fr) * P_D + col0;
#pragma unroll
                for (int bj = 0; bj < 2; ++bj)
#pragma unroll
                    for (int n = 0; n < 2; ++n) { f32x4 xo = *(const f32x4*)(xr + bj * HALF + n * 16); xo = xo * P_ALPHA + gv[bj][n] * acc[ai][bj][m][n]; *(f32x4*)(xr + bj * HALF + n * 16) = xo; }
                if (m & 1) asm volatile("" ::: "memory"); }
    }
};
struct EpiUp {
    static constexpr bool PERM = true, AFTER_DRAIN = false;
    bf16_t* ACT; const float* cw; const float* cb;
    __device__ __forceinline__ void operator()(const f32x4 (&acc)[2][2][4][2], const Unit& u, int wr, int wc, int fr, int fq) const {
        asm volatile("" : "+v"(fr), "+v"(fq));
#pragma unroll
        for (int n = 0; n < 2; ++n) {
            const int ch = u.pn * 128 + wc * 32 + 8 * fq + 4 * n;
            const f32x4 wa0 = *(const f32x4*)(cw + ch), wa1 = *(const f32x4*)(cw + P_UPW + ch), wa2 = *(const f32x4*)(cw + 2 * P_UPW + ch), ba = *(const f32x4*)(cb + ch);
            const f32x4 wg0 = *(const f32x4*)(cw + P_DFF + ch), wg1 = *(const f32x4*)(cw + P_UPW + P_DFF + ch), wg2 = *(const f32x4*)(cw + 2 * P_UPW + P_DFF + ch), bg = *(const f32x4*)(cb + P_DFF + ch);
#pragma unroll
            for (int ai = 0; ai < 2; ++ai) {
                const int Rb = u.pm * 248 - 1 + (2 * ai + wr) * 62;
                f32x4 ra_prev = (f32x4){0.f, 0.f, 0.f, 0.f}, rg_prev = ra_prev;
                f32x4 la_cur = dppror(acc[ai][0][0][n], false), lg_cur = dppror(acc[ai][1][0][n], false);
#pragma unroll
                for (int m = 0; m < 4; ++m) {
                    const f32x4 va = acc[ai][0][m][n], vg = acc[ai][1][m][n];
                    const f32x4 ra_cur = dppror(va, true), rg_cur = dppror(vg, true);
                    f32x4 la_next = la_cur, lg_next = lg_cur;
                    if (m < 3) { la_next = dppror(acc[ai][0][m < 3 ? m + 1 : 3][n], false); lg_next = dppror(acc[ai][1][m < 3 ? m + 1 : 3][n], false); }
                    const int i = 16 * m + fr; const int R = Rb + i;
                    const int rbm = R - (R / P_RPB) * P_RPB;
                    const bool first = (rbm == 0) || (rbm == P_CTX), last = (rbm == P_CTX - 1) || (rbm == P_RPB - 1);
                    f32x4 upa = (fr == 0) ? ra_prev : ra_cur, upg = (fr == 0) ? rg_prev : rg_cur;
                    f32x4 dna = (fr == 15) ? la_next : la_cur, dng = (fr == 15) ? lg_next : lg_cur;
                    const f32x4 z4 = (f32x4){0.f, 0.f, 0.f, 0.f};
                    if (first) { upa = z4; upg = z4; }
                    if (last) { dna = z4; dng = z4; }
                    const f32x4 av = wa0 * upa + wa1 * va + wa2 * dna + ba;
                    const f32x4 gv = wg0 * upg + wg1 * vg + wg2 * dng + bg;
                    f32x4 o;
#pragma unroll
                    for (int j = 0; j < 4; ++j) o[j] = av[j] * gv[j] * __builtin_amdgcn_rcpf(1.0f + __expf(-gv[j]));
                    unsigned long long w = (unsigned long long)cvt_pk_bf16(o[0], o[1]) | ((unsigned long long)cvt_pk_bf16(o[2], o[3]) << 32);
                    asm volatile("" : "+v"(w));
                    if (i >= 1 && i <= 62 && R < P_M) *(unsigned long long*)(ACT + (size_t)R * P_DFF + ch) = w;
                    ra_prev = ra_cur; rg_prev = rg_cur; la_cur = la_next; lg_cur = lg_next;
                }
            }
        }
    }
};

template <class Epi, class Sched, bool ALIGN_EPI = false, bool SP2 = false, int AMODE = 0>
__device__ __forceinline__ void gemm_phase(PG8_LAS unsigned char* lds, const Gemm g, const Sched& S, const Epi& E) {
    const int tid = ltid(), wid = __builtin_amdgcn_readfirstlane(tid >> 6), lane = tid & 63, wr = wid >> 2, wc = wid & 3, fr = lane & 15, fq = lane >> 4;
    const int K = g.K, nt = K / BK;
    unsigned voffA[2], voffB[2];
#pragma unroll
    for (int i = 0; i < 2; ++i) { int R, C; stage_rc(tid * 16 + i * 8192, R, C); const int Rb = Epi::PERM ? ((R & ~31) + perm32(R & 31)) : R;
        voffA[i] = (unsigned)((AMODE ? ((R >> 6) * 62 + (R & 63)) : R) * K + C) * 2u; voffB[i] = (unsigned)(Rb * K + C) * 2u; }
    const size_t kstep = (size_t)(BK * 2);
    const size_t hstepB = (size_t)HALF * K * 2; const size_t hstepA = (size_t)(AMODE ? 124 : HALF) * K * 2;
    const size_t tstepB = 2 * hstepB; const size_t tstepA = 2 * hstepA;
    const unsigned ldsw = (unsigned)wid * 1024u;
    const int aoff = lds_byte(wr * 64 + fr, fq * 8), boff = lds_byte(wc * 32 + fr, fq * 8);
#define PG8_SA(b, h) (((b) * 2 + (h)) * HTB)
#define PG8_SB(b, h) ((4 + (b) * 2 + (h)) * HTB)
#define PG8_STAGE(bufoff, gbase, voff) do { _Pragma("unroll") for (int _i = 0; _i < 2; ++_i) \
        __builtin_amdgcn_global_load_lds((const unsigned*)((const char*)(gbase) + (voff)[_i]), (PG8_LAS unsigned*)(lds + (bufoff) + ldsw + _i * 8192), 16, 0, 0); } while (0)
#define PG8_LDA(dst, b, h) do { _Pragma("unroll") for (int m = 0; m < 4; ++m) _Pragma("unroll") for (int k = 0; k < 2; ++k) dst[m][k] = *(const PG8_LAS bf16x8*)(lds + PG8_SA(b, h) + aoff + m * 2048 + k * 1024); } while (0)
#define PG8_LDB(dst, b, h) do { _Pragma("unroll") for (int n = 0; n < 2; ++n) _Pragma("unroll") for (int k = 0; k < 2; ++k) dst[n][k] = *(const PG8_LAS bf16x8*)(lds + PG8_SB(b, h) + boff + n * 2048 + k * 1024); } while (0)
#define PG8_MMA(ai, bj, At, Bt) do { __builtin_amdgcn_s_setprio(1); _Pragma("unroll") for (int m = 0; m < 4; ++m) _Pragma("unroll") for (int n = 0; n < 2; ++n) _Pragma("unroll") for (int k = 0; k < 2; ++k) \
        acc[ai][bj][m][n] = __builtin_amdgcn_mfma_f32_16x16x32_bf16(Bt[n][k], At[m][k], acc[ai][bj][m][n], 0, 0, 0); __builtin_amdgcn_s_setprio(0); } while (0)
#define PG8_WAIT_V(n) asm volatile("s_waitcnt vmcnt(" #n ")" ::: "memory")
#define PG8_WAIT_L(n) asm volatile("s_waitcnt lgkmcnt(" #n ")" ::: "memory")
#define PG8_BAR __builtin_amdgcn_s_barrier()
#define PG8_SCHED __builtin_amdgcn_sched_barrier(0)
    Unit cur, nxt; int ui = 0;
    if (!S.next(0, cur)) return;
    f32x4 acc[2][2][4][2];
#pragma unroll
    for (int a = 0; a < 2; ++a)
#pragma unroll
        for (int b = 0; b < 2; ++b)
#pragma unroll
            for (int m = 0; m < 4; ++m)
#pragma unroll
                for (int n = 0; n < 2; ++n) acc[a][b][m][n] = (f32x4){0.f, 0.f, 0.f, 0.f};
    bf16x8 At[4][2], B0[2][2], B1[2][2];
    const char* cA = (const char*)g.A + (size_t)cur.pm * tstepA; const char* cB = (const char*)g.Bt + (size_t)cur.pn * tstepB;
    S.a_ready(cur);
    if constexpr (SP2) {
        PG8_STAGE(PG8_SB(0, 0), cB, voffB); PG8_STAGE(PG8_SB(0, 1), cB + hstepB, voffB); PG8_STAGE(PG8_SA(0, 0), cA, voffA); PG8_STAGE(PG8_SA(0, 1), cA + hstepA, voffA);
        if (wr == 1) PG8_BAR;
        PG8_WAIT_V(2); PG8_BAR;
        PG8_STAGE(PG8_SB(1, 0), cB + kstep, voffB); PG8_STAGE(PG8_SA(1, 0), cA + kstep, voffA); PG8_STAGE(PG8_SB(1, 1), cB + hstepB + kstep, voffB);
        PG8_WAIT_V(6); PG8_BAR;
    } else {
        PG8_STAGE(PG8_SB(0, 0), cB, voffB); PG8_STAGE(PG8_SA(0, 0), cA, voffA); PG8_STAGE(PG8_SB(0, 1), cB + hstepB, voffB); PG8_STAGE(PG8_SA(0, 1), cA + hstepA, voffA);
        if (wr == 1) PG8_BAR;
        PG8_WAIT_V(4); PG8_BAR;
        PG8_STAGE(PG8_SB(1, 0), cB + kstep, voffB); PG8_STAGE(PG8_SA(1, 0), cA + kstep, voffA); PG8_STAGE(PG8_SB(1, 1), cB + hstepB + kstep, voffB);
        PG8_WAIT_V(6); PG8_BAR;
    }
    for (;;) {
        const bool has_next = S.next(ui + 1, nxt);
        const char* nA = has_next ? (const char*)g.A + (size_t)nxt.pm * tstepA : cA; const char* nB = has_next ? (const char*)g.Bt + (size_t)nxt.pn * tstepB : cB;
        for (int t = 0; t < nt; t += 2) {
            const bool last = (t == nt - 2);
            const char* a1 = cA + (size_t)(t + 1) * kstep;
            const char* a2 = last ? nA : cA + (size_t)(t + 2) * kstep; const char* b2 = last ? nB : cB + (size_t)(t + 2) * kstep;
            const char* a3 = a2 + kstep; const char* b3 = b2 + kstep;
            if (last && has_next) S.a_ready(nxt);
            if constexpr (SP2) {
            PG8_LDB(B0, 0, 0); PG8_LDB(B1, 0, 1); PG8_SCHED; PG8_LDA(At, 0, 0); PG8_STAGE(PG8_SA(1, 1), a1 + hstepA, voffA);
            PG8_WAIT_V(8); PG8_WAIT_L(0); PG8_BAR; PG8_MMA(0, 0, At, B0); PG8_MMA(0, 1, At, B1); PG8_BAR; PG8_SCHED;
            PG8_LDA(At, 0, 1); PG8_STAGE(PG8_SB(0, 0), b2, voffB); PG8_STAGE(PG8_SB(0, 1), b2 + hstepB, voffB); PG8_STAGE(PG8_SA(0, 0), a2, voffA);
            PG8_WAIT_V(8); PG8_WAIT_L(0); PG8_BAR; PG8_MMA(1, 0, At, B0); PG8_MMA(1, 1, At, B1); PG8_BAR; PG8_SCHED;
            PG8_LDB(B0, 1, 0); PG8_LDB(B1, 1, 1); PG8_SCHED; PG8_LDA(At, 1, 0); PG8_STAGE(PG8_SA(0, 1), a2 + hstepA, voffA);
            PG8_WAIT_V(8); PG8_WAIT_L(0); PG8_BAR; PG8_MMA(0, 0, At, B0); PG8_MMA(0, 1, At, B1); PG8_BAR; PG8_SCHED;
            PG8_LDA(At, 1, 1); PG8_STAGE(PG8_SB(1, 0), b3, voffB); PG8_STAGE(PG8_SB(1, 1), b3 + hstepB, voffB); PG8_STAGE(PG8_SA(1, 0), a3, voffA);
            PG8_WAIT_V(8); PG8_WAIT_L(0); PG8_BAR; PG8_MMA(1, 0, At, B0); PG8_MMA(1, 1, At, B1); PG8_BAR; PG8_SCHED;
            } else {
            PG8_LDB(B0, 0, 0); PG8_SCHED; PG8_LDA(At, 0, 0); PG8_STAGE(PG8_SA(1, 1), a1 + hstepA, voffA);
            PG8_WAIT_L(8); PG8_BAR; PG8_WAIT_L(0); PG8_MMA(0, 0, At, B0); PG8_BAR; PG8_SCHED;
            PG8_LDB(B1, 0, 1); PG8_STAGE(PG8_SB(0, 0), b2, voffB);
            PG8_BAR; PG8_WAIT_L(0); PG8_MMA(0, 1, At, B1); PG8_BAR;
            PG8_LDA(At, 0, 1); PG8_STAGE(PG8_SA(0, 0), a2, voffA);
            PG8_BAR; PG8_WAIT_L(0); PG8_MMA(1, 0, At, B0); PG8_BAR; PG8_SCHED;
            PG8_STAGE(PG8_SB(0, 1), b2 + hstepB, voffB);
            PG8_WAIT_V(6); PG8_BAR; PG8_MMA(1, 1, At, B1); PG8_BAR;
            PG8_LDB(B0, 1, 0); PG8_SCHED; PG8_LDA(At, 1, 0); PG8_STAGE(PG8_SA(0, 1), a2 + hstepA, voffA);
            PG8_WAIT_L(8); PG8_BAR; PG8_WAIT_L(0); PG8_MMA(0, 0, At, B0); PG8_BAR; PG8_SCHED;
            PG8_LDB(B1, 1, 1); PG8_STAGE(PG8_SB(1, 0), b3, voffB);
            PG8_BAR; PG8_WAIT_L(0); PG8_MMA(0, 1, At, B1); PG8_BAR;
            PG8_LDA(At, 1, 1); PG8_STAGE(PG8_SA(1, 0), a3, voffA);
            PG8_BAR; PG8_WAIT_L(0); PG8_MMA(1, 0, At, B0); PG8_BAR; PG8_SCHED;
            PG8_STAGE(PG8_SB(1, 1), b3 + hstepB, voffB);
            PG8_WAIT_V(6); PG8_BAR; PG8_MMA(1, 1, At, B1); PG8_BAR;
            }
        }
        if constexpr (ALIGN_EPI) { if (wr == 0) PG8_BAR; }
        if constexpr (!Epi::AFTER_DRAIN) { E(acc, cur, wr, wc, fr, fq); S.done(cur); }
        if (!has_next) break;
#pragma unroll
        for (int a = 0; a < 2; ++a)
#pragma unroll
            for (int b = 0; b < 2; ++b)
#pragma unroll
                for (int m = 0; m < 4; ++m)
#pragma unroll
                    for (int n = 0; n < 2; ++n) acc[a][b][m][n] = (f32x4){0.f, 0.f, 0.f, 0.f};
        cur = nxt; cA = nA; cB = nB; ++ui;
        if constexpr (ALIGN_EPI) { if (wr == 1) PG8_BAR; }
    }
    PG8_WAIT_V(0);
    if constexpr (!ALIGN_EPI) { if (wr == 0) PG8_BAR; }
    PG8_BAR;
    if constexpr (Epi::AFTER_DRAIN) { E.fused(acc, cur, wr, wc, fr, fq, lds, wid, lane); S.done(cur); }
#undef PG8_SA
#undef PG8_SB
#undef PG8_STAGE
#undef PG8_LDA
#undef PG8_LDB
#undef PG8_MMA
#undef PG8_WAIT_V
#undef PG8_WAIT_L
#undef PG8_BAR
#undef PG8_SCHED
}
}
#include <hip/hip_bf16.h>
#include <cmath>
namespace attn_body {
using bf16=__hip_bfloat16;
using bf16x8=__attribute__((ext_vector_type(8)))short;
using s16x4=__attribute__((ext_vector_type(4)))short;
using f32x16=__attribute__((ext_vector_type(16)))float;
using u32x4=__attribute__((ext_vector_type(4)))unsigned;
constexpr int D=64,DM=2048,ODM=1024;
constexpr int NW=8,QBLK=32,QB=QBLK*NW,KVBLK=64;
constexpr int ATTN_PITCH=DM, ATTN_UNIT_ROWS=QB;
__device__ __forceinline__ int crow(int r,int hi){return (r&3)+8*(r>>2)+4*hi;}
#define SBAR() __builtin_amdgcn_sched_barrier(0)
__device__ __forceinline__ void cmask(f32x16&p0,f32x16&p1,int jb,int qrel,int hi){
  const float NEG=-INFINITY; int kb=64*jb+4*hi;
  #pragma unroll
  for(int r=0;r<16;++r){int kv=kb+(r&3)+8*(r>>2); if(kv>qrel)p0[r]=NEG; if(kv+32>qrel)p1[r]=NEG;}
}

typedef const __attribute__((address_space(3))) float* lds_fptr;
__device__ __forceinline__ void nabias(f32x16&p0,f32x16&p1,int kr,int qr_,int r32,int wid,int hi,lds_fptr rp){
  const float NEG=-INFINITY;
  asm volatile("":"+v"(r32),"+v"(hi));
  const int qc=32*(wid&1)+r32;
  const int rs=min(max(qr_-4,0),120), cs=min(max(qc-8,0),48);
  if(kr<rs||kr>=rs+8){
    #pragma unroll
    for(int r=0;r<16;++r){p0[r]=NEG;p1[r]=NEG;}
  } else {
    lds_fptr tb=rp+(kr-qr_+7)*31+(15-qc);
    #pragma unroll
    for(int r=0;r<16;++r){
      const int kc=(r&3)+8*(r>>2)+4*hi;
      const bool ok0=(unsigned)(kc-cs)<16u, ok1=(unsigned)(kc+32-cs)<16u;
      const float b0=tb[ok0?kc:cs], b1=tb[ok1?kc+32:cs];
      p0[r]=ok0?p0[r]+b0:NEG; p1[r]=ok1?p1[r]+b1:NEG;
    }
  }
}
constexpr int NSLOT=3, SLOTB=8192;
constexpr int LDS_K=0, LDS_V=NSLOT*SLOTB, LDS_WS=2*NSLOT*SLOTB, LDS_OST=LDS_WS+NW*64*4, LDS_BYTES=LDS_OST+NW*4096;
constexpr float C2=0.125f*1.4426950408889634f;
__device__ __forceinline__ void glds16(const void*gsrc,unsigned lds_dst){unsigned keep;
  asm volatile("s_mov_b32 %0, m0\n\ts_mov_b32 m0, %2\n\ts_nop 0\n\tglobal_load_lds_dwordx4 %1, off\n\ts_mov_b32 m0, %0":"=&s"(keep):"v"(gsrc),"s"(lds_dst):"memory");}
__device__ __forceinline__ float max3f(float a,float b,float c){float r;asm("v_max3_f32 %0, %1, %2, %3":"=v"(r):"v"(a),"v"(b),"v"(c));return r;}
__device__ __forceinline__ float max2f(float a,float b){float r;asm("v_max_f32_e32 %0, %1, %2":"=v"(r):"v"(a),"v"(b));return r;}
__device__ __forceinline__ float fadd_s(float a,float b){float r;asm("v_add_f32_e32 %0, %1, %2":"=v"(r):"v"(a),"v"(b));return r;}
__device__ __forceinline__ float fsub_s(float a,float b){float r;asm("v_sub_f32_e32 %0, %1, %2":"=v"(r):"v"(a),"v"(b));return r;}
typedef float f32x2_t __attribute__((ext_vector_type(2))); typedef __bf16 bf16x2_t __attribute__((ext_vector_type(2)));
__device__ __forceinline__ unsigned cvtpk_s(float lo,float hi){f32x2_t v={lo,hi};bf16x2_t b=__builtin_convertvector(v,bf16x2_t);return __builtin_bit_cast(unsigned,b);}
#define WAIT_BAR(N) asm volatile("s_waitcnt vmcnt(" #N ") lgkmcnt(0)\n\ts_barrier":::"memory")

__device__ __forceinline__ void qkt(f32x16&p0,f32x16&p1,const char*Kslot,const bf16x8*qr,const f32x16&negm,int r32,int hi){
  const char*kb=Kslot+hi*1024+r32*16;
  #pragma unroll
  for(int d0=0;d0<4;++d0){
    const bf16x8 b0=*reinterpret_cast<const bf16x8*>(kb+d0*2048);
    const bf16x8 b1=*reinterpret_cast<const bf16x8*>(kb+d0*2048+512);
    if(d0==0){p0=__builtin_amdgcn_mfma_f32_32x32x16_bf16(b0,qr[0],negm,0,0,0);p1=__builtin_amdgcn_mfma_f32_32x32x16_bf16(b1,qr[0],negm,0,0,0);}
    else{p0=__builtin_amdgcn_mfma_f32_32x32x16_bf16(b0,qr[d0],p0,0,0,0);p1=__builtin_amdgcn_mfma_f32_32x32x16_bf16(b1,qr[d0],p1,0,0,0);}}
}
typedef __attribute__((address_space(3))) const char* lds_cptr;
typedef short v4i16_t __attribute__((ext_vector_type(4)));
__device__ __forceinline__ void kload8(bf16x8*kf,lds_cptr kp){
  kf[0]=*(const __attribute__((address_space(3))) bf16x8*)(kp);      kf[1]=*(const __attribute__((address_space(3))) bf16x8*)(kp+512);
  kf[2]=*(const __attribute__((address_space(3))) bf16x8*)(kp+2048); kf[3]=*(const __attribute__((address_space(3))) bf16x8*)(kp+2560);
  kf[4]=*(const __attribute__((address_space(3))) bf16x8*)(kp+4096); kf[5]=*(const __attribute__((address_space(3))) bf16x8*)(kp+4608);
  kf[6]=*(const __attribute__((address_space(3))) bf16x8*)(kp+6144); kf[7]=*(const __attribute__((address_space(3))) bf16x8*)(kp+6656);
}
__device__ __forceinline__ void kload2(bf16x8*kf,lds_cptr kp,int j){ kf[2*j]=*(const __attribute__((address_space(3))) bf16x8*)(kp+j*2048); kf[2*j+1]=*(const __attribute__((address_space(3))) bf16x8*)(kp+j*2048+512); }
__device__ __forceinline__ s16x4 vtr(lds_cptr p){ return __builtin_bit_cast(s16x4,__builtin_amdgcn_ds_read_tr16_b64_v4i16((__attribute__((address_space(3))) v4i16_t*)p)); }
__device__ __forceinline__ float rowmax(const f32x16&p0,const f32x16&p1){
  float a=max3f(p0[0],p0[1],p1[0]),b=max3f(p0[2],p0[3],p1[1]);a=max3f(a,p1[2],p1[3]);
  #pragma unroll
  for(int r=4;r<16;r+=4){a=max3f(a,p0[r],p0[r+1]);b=max3f(b,p0[r+2],p0[r+3]);a=max3f(a,p1[r],p1[r+1]);b=max3f(b,p1[r+2],p1[r+3]);}
  const float m=max2f(a,b);
  auto rr=__builtin_amdgcn_permlane32_swap(__float_as_uint(m),__float_as_uint(m),false,false);
  return max2f(__uint_as_float(rr[0]),__uint_as_float(rr[1]));
}
__device__ __forceinline__ void pv(f32x16*o,int vb,bf16x8 pa0,bf16x8 pa1,bf16x8 pa2,bf16x8 pa3){
  #pragma unroll
  for(int d0=0;d0<2;++d0){s16x4 lo[4],hi[4];
    #pragma unroll
    for(int ks=0;ks<4;++ks){
      asm volatile("ds_read_b64_tr_b16 %0,%1 offset:%c2":"=&v"(lo[ks]):"v"(vb),"i"(d0*4096+ks*1024):"memory");
      asm volatile("ds_read_b64_tr_b16 %0,%1 offset:%c2":"=&v"(hi[ks]):"v"(vb),"i"(d0*4096+ks*1024+512):"memory");}
    asm volatile("s_waitcnt lgkmcnt(0)":::"memory");SBAR();
    #define PK(k) (bf16x8){lo[k][0],lo[k][1],lo[k][2],lo[k][3],hi[k][0],hi[k][1],hi[k][2],hi[k][3]}
    o[d0]=__builtin_amdgcn_mfma_f32_32x32x16_bf16(pa0,PK(0),o[d0],0,0,0);
    o[d0]=__builtin_amdgcn_mfma_f32_32x32x16_bf16(pa1,PK(1),o[d0],0,0,0);
    o[d0]=__builtin_amdgcn_mfma_f32_32x32x16_bf16(pa2,PK(2),o[d0],0,0,0);
    o[d0]=__builtin_amdgcn_mfma_f32_32x32x16_bf16(pa3,PK(3),o[d0],0,0,0);
    #undef PK
  }
}

#ifndef ATTN_STORE16
#define ATTN_STORE16(p,v) (*(u32x4*)(p)=(v))
#endif
template<int THRL,int MODE> __device__ __forceinline__ void attn_unit(const bf16*Qw0,const bf16*__restrict__ Kh,const bf16*__restrict__ Vh,bf16*Ow0,const int NT,const int lat_off,const int na_r0,const int na_rsmin,const int rpb_off,char*shm){
  const int tid=ltid(),lane=tid&63,r32=lane&31,hi=lane>>5; const int wid=__builtin_amdgcn_readfirstlane(tid>>6);
  const bf16*Qw=Qw0+(long)(wid*QBLK)*DM;
  const unsigned lds0=(unsigned)(uintptr_t)shm;
  float*wsf=(float*)(shm+LDS_WS)+wid*64;
  const bf16*ksrc=Kh+(long)lane*DM+wid*8;
  const bf16*vsrc=Vh+(long)(16*(wid&3)+(lane>>2))*DM+(wid>>2)*32+(lane&3)*8;
  const unsigned kdst=lds0+LDS_K+wid*1024, vdst=lds0+LDS_V+wid*1024;
  #define TROW(t) (((t)<4)?(t)*64:lat_off+((t)-4)*64)
  #define DMA_K(t,slot) glds16(ksrc+(long)TROW(t)*DM,(unsigned)__builtin_amdgcn_readfirstlane(kdst+(slot)))
  #define DMA_V(t,slot) glds16(vsrc+(long)TROW(t)*DM,(unsigned)__builtin_amdgcn_readfirstlane(vdst+(slot)))
  const int vb0=(int)(lds0+LDS_V)+((lane>>4)&1)*32+(lane&3)*8+(4*hi+((lane&15)>>2))*64;
  const char*Kbase=shm+LDS_K; bf16x8 kf[8];
  const lds_cptr shm3=(lds_cptr)shm; const lds_cptr kp0=shm3+LDS_K+hi*1024+r32*16; const lds_cptr vp0=shm3+LDS_V+((lane>>4)&1)*32+(lane&3)*8+(4*hi+((lane&15)>>2))*64;
  DMA_K(0,0);DMA_V(0,0);DMA_K(1,SLOTB);
  bf16x8 qr[4];
  #pragma unroll
  for(int d0=0;d0<4;++d0)qr[d0]=*reinterpret_cast<const bf16x8*>(&Qw[(long)r32*DM+d0*16+hi*8]);
  float mhat=0.f,l_reg=0.f;f32x16 o[2];o[0]=f32x16{};o[1]=f32x16{};f32x16 negm=f32x16{};asm volatile("":"+v"(negm));
  const lds_fptr rp_=(lds_fptr)(shm3+rpb_off); const int na_qr=na_r0+(wid>>1);
  #define CMASK(P0,P1,t) do{ if(MODE==1 && (t)>=4) nabias(P0,P1,na_rsmin+(t)-4,na_qr,r32,wid,hi,rp_); }while(0)
  bool resc=false;
  #define START(P0,P1) do{ const float rm=rowmax(P0,P1); resc=false; \
    { const float dl=rm; mhat=fadd_s(mhat,dl); \
      _Pragma("unroll") for(int r=0;r<16;++r){P0[r]=fsub_s(P0[r],dl);P1[r]=fsub_s(P1[r],dl);} \
      _Pragma("unroll") for(int r=0;r<16;++r)negm[r]=-mhat; asm volatile("":"+v"(negm)); } \
    _Pragma("unroll") for(int r=0;r<16;++r)P0[r]=__builtin_amdgcn_exp2f(P0[r]); }while(0)
  #define RESC() do{ if(resc){ asm volatile("s_waitcnt lgkmcnt(0)":::"memory"); \
      _Pragma("unroll") for(int d_=0;d_<2;++d_) _Pragma("unroll") for(int r=0;r<16;++r)o[d_][r]*=wsf[crow(r,hi)]; } }while(0)
  f32x16 pA0,pA1,pB0,pB1;
  int sl_prev=0,sl_cur=0,sl_next=SLOTB;
  #define ROT() do{sl_prev=sl_cur;sl_cur=sl_next;sl_next=(sl_next==(NSLOT-1)*SLOTB)?0:sl_next+SLOTB;}while(0)
  DMA_K(2,2*SLOTB);
  WAIT_BAR(3);
  qkt(pA0,pA1,Kbase,qr,negm,r32,hi);asm volatile("s_nop 15\n\ts_nop 7":"+v"(pA0),"+v"(pA1));CMASK(pA0,pA1,0);
  START(pA0,pA1);
  _Pragma("unroll") for(int r=0;r<16;++r)pA1[r]=__builtin_amdgcn_exp2f(pA1[r]);
  WAIT_BAR(0);
  DMA_K(3,0);DMA_V(1,SLOTB);
  ROT();
  kload8(kf,kp0+sl_cur);
  WAIT_BAR(2);
  s16x4 vlo[8],vhi[8]; u32x4 pw0,pw1,pw2,pw3;
  #define PKW(P,B) cvtpk_s(P[B],P[B+1])
  #define PAF(k) __builtin_bit_cast(bf16x8,pw##k)
  #define VFR(i) (bf16x8){vlo[i][0],vlo[i][1],vlo[i][2],vlo[i][3],vhi[i][0],vhi[i][1],vhi[i][2],vhi[i][3]}
  #define PIN(x) asm volatile("":"+v"(x))
  #define MX3(a,b,c) __builtin_fmaxf(__builtin_fmaxf((a),(b)),(c))
  #define GAPA(MF,A0,A1,A2,A3,W0,W1,PW) do{ MF; sacc+=A0; sacc+=A1; sacc+=A2; sacc+=A3; PIN(sacc); W0; W1; PIN(PW); SBAR(); }while(0)
  #define EX(v) __builtin_amdgcn_exp2f(v)
  #define GAPB(MF,X,B) do{ MF; X[B]=EX(X[B]); X[B+1]=EX(X[B+1]); X[B+2]=EX(X[B+2]); X[B+3]=EX(X[B+3]); PIN(X); SBAR(); }while(0)
  #define VRD(i) do{ vlo[i]=vtr(vp_+(((i)>>2)*4096+((i)&3)*1024)); vhi[i]=vtr(vp_+(((i)>>2)*4096+((i)&3)*1024+512)); }while(0)
  #define KRD(G,j) do{ if(G){ kload2(kf,kp0+sl_next,j); SBAR(); } }while(0)
  #define STEP(C0,C1,P0,P1,t,GK,GV,GL) do{ SBAR(); \
    const lds_cptr vp_=vp0+sl_prev; \
    VRD(0); SBAR(); float sacc=(P0[0]+P0[1]); \
    GAPA(C0=__builtin_amdgcn_mfma_f32_32x32x16_bf16(kf[0],qr[0],negm,0,0,0), P0[2],P0[3],P0[4],P0[5],     pw0[0]=PKW(P0,0), pw0[1]=PKW(P0,2), pw0); \
    VRD(4); SBAR(); GAPA(C1=__builtin_amdgcn_mfma_f32_32x32x16_bf16(kf[1],qr[0],negm,0,0,0), P0[6],P0[7],P0[8],P0[9],     pw0[2]=PKW(P0,4), pw0[3]=PKW(P0,6), pw0); \
    VRD(1); SBAR(); GAPA(C0=__builtin_amdgcn_mfma_f32_32x32x16_bf16(kf[2],qr[1],C0,0,0,0),   P0[10],P0[11],P0[12],P0[13], pw1[0]=PKW(P0,8), pw1[1]=PKW(P0,10), pw1); \
    VRD(5); SBAR(); GAPA(C1=__builtin_amdgcn_mfma_f32_32x32x16_bf16(kf[3],qr[1],C1,0,0,0),   P0[14],P0[15],P1[0],P1[1],   pw1[2]=PKW(P0,12),pw1[3]=PKW(P0,14), pw1); \
    VRD(2); SBAR(); GAPA(C0=__builtin_amdgcn_mfma_f32_32x32x16_bf16(kf[4],qr[2],C0,0,0,0),   P1[2],P1[3],P1[4],P1[5],     pw2[0]=PKW(P1,0), pw2[1]=PKW(P1,2), pw2); \
    VRD(6); SBAR(); GAPA(C1=__builtin_amdgcn_mfma_f32_32x32x16_bf16(kf[5],qr[2],C1,0,0,0),   P1[6],P1[7],P1[8],P1[9],     pw2[2]=PKW(P1,4), pw2[3]=PKW(P1,6), pw2); \
    VRD(3); SBAR(); GAPA(C0=__builtin_amdgcn_mfma_f32_32x32x16_bf16(kf[6],qr[3],C0,0,0,0),   P1[10],P1[11],P1[12],P1[13], pw3[0]=PKW(P1,8), pw3[1]=PKW(P1,10), pw3); \
    VRD(7); SBAR(); GAPA(C1=__builtin_amdgcn_mfma_f32_32x32x16_bf16(kf[7],qr[3],C1,0,0,0),   P1[14],P1[15],0.f,0.f,       pw3[2]=PKW(P1,12),pw3[3]=PKW(P1,14), pw3); \
    l_reg+=sacc; \
    if(GK){DMA_K((t)+3,sl_cur);} if(GV){DMA_V((t)+1,sl_next);} \
    CMASK(C0,C1,t); \
    { float a=MX3(C0[0],C0[1],C1[0]),b=MX3(C0[2],C0[3],C1[1]); a=MX3(a,C1[2],C1[3]); \
      _Pragma("unroll") for(int r=4;r<16;r+=4){a=MX3(a,C0[r],C0[r+1]);b=MX3(b,C0[r+2],C0[r+3]);a=MX3(a,C1[r],C1[r+1]);b=MX3(b,C1[r+2],C1[r+3]);} \
      float rm=__builtin_fmaxf(a,b); { auto rr=__builtin_amdgcn_permlane32_swap(__float_as_uint(rm),__float_as_uint(rm),false,false); rm=__builtin_fmaxf(__uint_as_float(rr[0]),__uint_as_float(rr[1])); } \
      resc=false; \
      if(__builtin_expect(__any(rm>(float)THRL),0)){ const float dl=__builtin_fmaxf(rm,0.f); mhat+=dl; \
        _Pragma("unroll") for(int r=0;r<16;++r){C0[r]-=dl;C1[r]-=dl;} \
        _Pragma("unroll") for(int r=0;r<16;++r)negm[r]=-mhat; asm volatile("":"+v"(negm)); \
        const float f=__builtin_amdgcn_exp2f(-dl); l_reg*=f; if(hi==0)wsf[r32]=f; resc=true; } } \
    SBAR(); \
    GAPB(o[0]=__builtin_amdgcn_mfma_f32_32x32x16_bf16(PAF(0),VFR(0),o[0],0,0,0), C0,0); \
    GAPB(o[1]=__builtin_amdgcn_mfma_f32_32x32x16_bf16(PAF(0),VFR(4),o[1],0,0,0), C0,4); \
    KRD(GL,0); GAPB(o[0]=__builtin_amdgcn_mfma_f32_32x32x16_bf16(PAF(1),VFR(1),o[0],0,0,0), C0,8); \
    KRD(GL,1); GAPB(o[1]=__builtin_amdgcn_mfma_f32_32x32x16_bf16(PAF(1),VFR(5),o[1],0,0,0), C0,12); \
    KRD(GL,2); GAPB(o[0]=__builtin_amdgcn_mfma_f32_32x32x16_bf16(PAF(2),VFR(2),o[0],0,0,0), C1,0); \
    KRD(GL,3); GAPB(o[1]=__builtin_amdgcn_mfma_f32_32x32x16_bf16(PAF(2),VFR(6),o[1],0,0,0), C1,4); \
    GAPB(o[0]=__builtin_amdgcn_mfma_f32_32x32x16_bf16(PAF(3),VFR(3),o[0],0,0,0), C1,8); \
    GAPB(o[1]=__builtin_amdgcn_mfma_f32_32x32x16_bf16(PAF(3),VFR(7),o[1],0,0,0), C1,12); \
    }while(0)
  int t=1;
  #undef CMASK
  #define CMASK(P0,P1,t) do{ if(MODE==1 && (t)>=4) nabias(P0,P1,na_rsmin+(t)-4,na_qr,r32,wid,hi,rp_); }while(0)
  for(;t+5<NT;t+=2){
    STEP(pB0,pB1,pA0,pA1,t,true,true,true);     WAIT_BAR(2); RESC(); ROT();
    STEP(pA0,pA1,pB0,pB1,t+1,true,true,true);   WAIT_BAR(2); RESC(); ROT();
  }
  #undef CMASK
  #define CMASK(P0,P1,t) do{ if(MODE==1 && (t)>=4) nabias(P0,P1,na_rsmin+(t)-4,na_qr,r32,wid,hi,rp_); }while(0)
  #define ENDW(tt) do{ if((tt)+3<NT){WAIT_BAR(2);} else if((tt)+2<NT){WAIT_BAR(1);} else {WAIT_BAR(0);} }while(0)
  for(;t+1<NT;t+=2){
    STEP(pB0,pB1,pA0,pA1,t,(t+3<NT),(t+1<NT),(t+1<NT));       ENDW(t);   RESC(); ROT();
    STEP(pA0,pA1,pB0,pB1,t+1,(t+4<NT),(t+2<NT),(t+2<NT));     ENDW(t+1); RESC(); ROT();
  }
  STEP(pB0,pB1,pA0,pA1,NT-1,false,false,false); RESC();
  { float sacc=pB0[0]+pB0[1]; _Pragma("unroll") for(int r=2;r<16;++r)sacc+=pB0[r]; _Pragma("unroll") for(int r=0;r<16;++r)sacc+=pB1[r]; l_reg+=sacc;
    pw0=(u32x4){PKW(pB0,0),PKW(pB0,2),PKW(pB0,4),PKW(pB0,6)};pw1=(u32x4){PKW(pB0,8),PKW(pB0,10),PKW(pB0,12),PKW(pB0,14)};pw2=(u32x4){PKW(pB1,0),PKW(pB1,2),PKW(pB1,4),PKW(pB1,6)};pw3=(u32x4){PKW(pB1,8),PKW(pB1,10),PKW(pB1,12),PKW(pB1,14)};
    SBAR(); pv(o,vb0+sl_cur,PAF(0),PAF(1),PAF(2),PAF(3)); }
  #undef PKW
  #undef PAF
  #undef VFR
  #undef PIN
  #undef MX3
  #undef GAPA
  #undef GAPB
  #undef EX
  #undef VRD
  #undef KRD
  #undef STEP
  #undef ENDW
  {auto rr=__builtin_amdgcn_permlane32_swap(__float_as_uint(l_reg),__float_as_uint(l_reg),false,false);l_reg=__uint_as_float(rr[0])+__uint_as_float(rr[1]);}
  if(hi==0)wsf[32+r32]=l_reg;asm volatile("s_waitcnt lgkmcnt(0)":::"memory");
  float rli[16];
  #pragma unroll
  for(int r=0;r<16;++r)rli[r]=__builtin_amdgcn_rcpf(wsf[32+crow(r,hi)]);
  bf16*Ow=Ow0+(long)(wid*QBLK)*ODM;
  { bf16*stg=(bf16*)(shm+LDS_OST)+wid*2048;
    #pragma unroll
    for(int r=0;r<16;++r){const int orow=crow(r,hi);
      #pragma unroll
      for(int d0=0;d0<2;++d0)stg[orow*64+d0*32+r32]=__float2bfloat16(o[d0][r]*rli[r]);}
    asm volatile("s_waitcnt lgkmcnt(0)":::"memory");
    #pragma unroll
    for(int i=0;i<4;++i){const int row=i*8+(lane>>3),ch=lane&7; const u32x4 v=*(const u32x4*)(stg+row*64+ch*8); ATTN_STORE16(Ow+(long)row*ODM+ch*8,v);} }
  asm volatile("s_waitcnt lgkmcnt(0)\n\ts_barrier":::"memory");
  #undef DMA_K
  #undef TROW
  #undef DMA_V
  #undef CMASK
  #undef START
  #undef RESC
  #undef ROT
}
constexpr int ATTN_LDS_BYTES=LDS_BYTES;
}
#ifndef DBG_MASK
#define DBG_MASK 127
#endif
#ifndef DBG_DIAG
#define DBG_DIAG 0
#endif
#ifndef DBG_NA
#define DBG_NA 1
#endif
#ifndef DBG_CTX
#define DBG_CTX 1
#endif
#ifndef DBG_POOL
#define DBG_POOL 1
#endif
namespace cg = cooperative_groups;
#define GAS __attribute__((address_space(1)))
#define LAS __attribute__((address_space(3)))
typedef unsigned short bf16;
typedef unsigned v4u __attribute__((ext_vector_type(4)));
typedef float f32x4 __attribute__((ext_vector_type(4)));
#define LDS_WAIT() asm volatile("s_waitcnt lgkmcnt(0)" ::: "memory")
__device__ __forceinline__ unsigned f2bf(float f) { unsigned u = __builtin_bit_cast(unsigned, f); return (u + 0x7fffu + ((u >> 16) & 1u)) >> 16; }
__device__ __forceinline__ unsigned pk2(float lo, float hi) { return f2bf(lo) | (f2bf(hi) << 16); }
__device__ __forceinline__ float bf2f(unsigned short h) { return __builtin_bit_cast(float, (unsigned)h << 16); }
__device__ __forceinline__ float wave_sum(float v) {
#pragma unroll
    for (int o = 1; o < 64; o <<= 1) v += __shfl_xor(v, o);
    return v;
}
#define RLX_AGENT __ATOMIC_RELAXED, __HIP_MEMORY_SCOPE_AGENT
#define XB_TMO      128
#define XB_XCNT(j)  (256  + 64 * (j))
#define XB_XSUB(j)  (1280 + 64 * (j))
#define XB_XGEN(j)  (2304 + 64 * (j))
#define XB_TOP      3328
#define XB_TOPGEN   3392
#define XCD_BAR_WORDS 3456
#define XB_SPIN_CAP (1u << 18)

__device__ __forceinline__ unsigned xb_ld(unsigned* p)              { return __hip_atomic_load(p, __ATOMIC_RELAXED, __HIP_MEMORY_SCOPE_AGENT); }
__device__ __forceinline__ unsigned xb_add(unsigned* p, unsigned v) { return __hip_atomic_fetch_add(p, v, __ATOMIC_RELAXED, __HIP_MEMORY_SCOPE_AGENT); }
__device__ __forceinline__ unsigned xb_xcc_id() { return (unsigned)__builtin_amdgcn_s_getreg((3 << 11) | 20) & 0xFu; }
#define XB_SPIN(cond, bar) do { unsigned _sp = 0; while (cond) { __builtin_amdgcn_s_sleep(1); \
    if ((++_sp & 255u) == 0u) { if (xb_ld(&(bar)[XB_TMO])) break; if (_sp > XB_SPIN_CAP) { atomicAdd(&(bar)[XB_TMO], 1u); break; } } } } while (0)

struct XcdBarrier {
    unsigned* bar; unsigned x;
    volatile LAS unsigned* st;
};

__device__ __forceinline__ XcdBarrier xcd_barrier_post(unsigned* bar, volatile LAS unsigned* st) {
    XcdBarrier b; b.bar = bar; b.x = xb_xcc_id(); b.st = st;
    if (threadIdx.x == 0) (void)xb_add(&bar[XB_XCNT(b.x)], 1u);
    return b;
}
__device__ __forceinline__ void xcd_barrier_complete(unsigned* bar, unsigned x, unsigned& nloc, unsigned& nx) {
    const unsigned G = gridDim.x * gridDim.y * gridDim.z;
    unsigned sum, cnt, mine, sp = 0u;
    for (;;) {
        sum = 0u; cnt = 0u; mine = 0u;
#pragma unroll
        for (unsigned j = 0; j < 16; ++j) { const unsigned c = xb_ld(&bar[XB_XCNT(j)]); sum += c; cnt += (c > 0u) ? 1u : 0u; mine = (j == x) ? c : mine; }
        if (sum == G) break;
        __builtin_amdgcn_s_sleep(1);
        if ((++sp & 255u) == 0u) { if (xb_ld(&bar[XB_TMO])) break; if (sp > XB_SPIN_CAP) { atomicAdd(&bar[XB_TMO], 1u); break; } }
    }
    nloc = mine > 0u ? mine : 1u; nx = cnt > 0u ? cnt : 1u;
}

__device__ __forceinline__ void xcd_barrier(const XcdBarrier& b) {
    asm volatile("s_waitcnt vmcnt(0)" ::: "memory");
    __syncthreads();
    if (threadIdx.x == 0) {
        unsigned* bar = b.bar;
        __builtin_amdgcn_s_waitcnt(0);
        unsigned nloc = b.st[0], nx = b.st[1];
        if (nloc == 0u) { xcd_barrier_complete(bar, b.x, nloc, nx); b.st[0] = nloc; b.st[1] = nx; }
        const unsigned old = xb_add(&bar[XB_XSUB(b.x)], 1u);
        const unsigned gen = old / nloc;
        if (old + 1u == (gen + 1u) * nloc) {
            __builtin_amdgcn_fence(__ATOMIC_RELEASE, "agent");
            asm volatile("s_waitcnt vmcnt(0)" ::: "memory");
            const unsigned og = xb_add(&bar[XB_TOP], 1u);
            const unsigned tg = og / nx;
            if (og + 1u == (tg + 1u) * nx) xb_add(&bar[XB_TOPGEN], 1u);
            else XB_SPIN(xb_ld(&bar[XB_TOPGEN]) == tg, bar);
            __builtin_amdgcn_fence(__ATOMIC_ACQUIRE, "agent");
            xb_add(&bar[XB_XGEN(b.x)], 1u);
            asm volatile("s_waitcnt vmcnt(0)" ::: "memory");
        } else {
            XB_SPIN(xb_ld(&bar[XB_XGEN(b.x)]) == gen, bar);
            __builtin_amdgcn_fence(__ATOMIC_ACQUIRE, "agent");
            asm volatile("s_waitcnt vmcnt(0)" ::: "memory");
        }
    }
    __syncthreads();
}
constexpr size_t MiB = 1u << 20;
constexpr size_t WS_MOD = 0, WS_ROPEC = 1 * MiB, WS_ROPES = 1 * MiB + 8192, WS_BAR = 1 * MiB + 131072;
constexpr size_t WS_WIN = 2 * MiB, WS_WOUT = 18 * MiB, WS_WUP = 26 * MiB, WS_WDN = 70 * MiB;
constexpr size_t WS_X = 92 * MiB, WS_H = 357 * MiB, WS_Z = 490 * MiB, WS_Y = 754 * MiB, WS_ACT = WS_Z, WS_END = 886 * MiB;
static_assert(WS_WIN + (size_t)P_DEPTH * P_INW * P_D * 2 <= WS_WOUT && WS_WOUT + (size_t)P_DEPTH * P_D * P_D * 2 <= WS_WUP && WS_WUP + (size_t)P_DEPTH * P_UPW * P_D * 2 <= WS_WDN && WS_WDN + (size_t)P_DEPTH * P_D * P_DFF * 2 <= WS_X, "weights map");
static_assert(WS_X + (size_t)P_M * P_D * 4 <= WS_H - MiB / 2 && WS_H + (size_t)P_M * P_D * 2 + MiB / 2 <= WS_Z && WS_Z + (size_t)P_M * P_INW * 2 <= WS_Y && WS_Y + (size_t)P_M * P_D * 2 <= WS_END && WS_ACT + (size_t)P_M * P_DFF * 2 <= WS_END, "activation map");
constexpr int LDS_BYTES = 147456, RPB_OFF = 98304, BARST_OFF = 131072 + 64;
#ifndef DBG_REP
#define DBG_REP -1
#endif
constexpr int PH_PER_L = (DBG_REP >= 0) ? 8 : 7;
constexpr int N_PHASES = 2 + PH_PER_L * P_DEPTH;

struct Args {
    const float *x, *c, *ctx, *c_ctx, *w_mod, *b_mod, *w_in, *pool_w, *pool_scale, *na_rpb, *q_norm, *k_norm, *w_out, *ln1_g, *ln1_b, *w_up, *conv_w, *conv_b, *w_down, *ln2_g, *ln2_b;
    float* out; unsigned char* ws; int ph_lo, ph_hi;
};
static_assert(sizeof(Args) == 23 * 8 + 8, "Args has no padding");

template <int OFF> __device__ __forceinline__ unsigned long long ldarg() {
    unsigned long long v; asm volatile("s_load_dwordx2 %0, %1, %2\n\ts_waitcnt lgkmcnt(0)" : "=s"(v) : "s"(__builtin_amdgcn_kernarg_segment_ptr()), "n"(OFF)); return v; }
#define ARGF(A, f) (A).f = (decltype(Args::f))ldarg<offsetof(Args, f)>()
__device__ __forceinline__ void p0_item(const float* W, int K, int N, bf16* WT, int k0, int n0, int drow, LAS float* scr, int lane) {
#pragma unroll 8
    for (int i = 0; i < 32; ++i) { const int kk = 2 * i + (lane >> 5); scr[kk * 33 + (lane & 31)] = W[(size_t)(k0 + kk) * N + n0 + (lane & 31)]; }
    LDS_WAIT(); asm volatile("" ::: "memory");
    const int c = lane & 7;
#pragma unroll
    for (int j = 0; j < 4; ++j) { const int n = (lane >> 3) + 8 * j; const LAS float* s = scr + (8 * c) * 33 + n;
        v4u o; o.x = pk2(s[0 * 33], s[1 * 33]); o.y = pk2(s[2 * 33], s[3 * 33]); o.z = pk2(s[4 * 33], s[5 * 33]); o.w = pk2(s[6 * 33], s[7 * 33]);
        *(GAS v4u*)(WT + (size_t)(drow + n) * K + k0 + 8 * c) = o; }
    LDS_WAIT(); asm volatile("" ::: "memory");
}

__device__ __forceinline__ void phase0(const Args& a, LAS unsigned char* lds, int vcu, int G, int tid, int lane, int wave) {
    unsigned char* ws = a.ws;
    {
        LAS float* scr = (LAS float*)(lds + wave * 16384);
        const int gw = vcu * 8 + wave, NGW = G * 8;
        constexpr int I_IN = 16 * 64, I_OUT = 16 * 32, I_UP = 16 * 176, I_DN = 44 * 32, I_L = I_IN + I_OUT + I_UP + I_DN;
        for (int it = gw; it < P_DEPTH * I_L; it += NGW) {
            const int l = it / I_L; int r = it - l * I_L;
            if (r < I_IN) { const int kb = r >> 6, nb = r & 63, L0 = 32 * nb; const int drow = (L0 & ~255) + ((L0 >> 5) & 1) * 128 + ((L0 >> 6) & 3) * 32;
                p0_item(a.w_in + (size_t)l * P_D * P_INW, P_D, P_INW, (bf16*)(ws + WS_WIN) + (size_t)l * P_INW * P_D, 64 * kb, 32 * nb, drow, scr, lane); continue; }
            r -= I_IN;
            if (r < I_OUT) { const int kb = r >> 5, nb = r & 31;
                p0_item(a.w_out + (size_t)l * P_D * P_D, P_D, P_D, (bf16*)(ws + WS_WOUT) + (size_t)l * P_D * P_D, 64 * kb, 32 * nb, 32 * nb, scr, lane); continue; }
            r -= I_OUT;
            if (r < I_UP) { const int kb = r / 176, nb = r - kb * 176, L0 = 32 * nb; const int half = L0 >= P_DFF ? 1 : 0, ch0 = L0 - half * P_DFF; const int drow = (ch0 >> 7) * 256 + half * 128 + (ch0 & 127);
                p0_item(a.w_up + (size_t)l * P_D * P_UPW, P_D, P_UPW, (bf16*)(ws + WS_WUP) + (size_t)l * P_UPW * P_D, 64 * kb, 32 * nb, drow, scr, lane); continue; }
            r -= I_UP;
            { const int kb = r >> 5, nb = r & 31;
                p0_item(a.w_down + (size_t)l * P_DFF * P_D, P_DFF, P_D, (bf16*)(ws + WS_WDN) + (size_t)l * P_D * P_DFF, 64 * kb, 32 * nb, 32 * nb, scr, lane); }
        }
    }
    __syncthreads();
    if (vcu < 192) {
        LAS float* act = (LAS float*)lds; LAS float* red = (LAS float*)(lds + 40960);
        for (int e = tid; e < 9 * P_D; e += 512) { const int r = e >> 10, k = e & 1023; const float v = r < 8 ? a.c[r * P_D + k] : a.c_ctx[k]; act[e] = v / (1.0f + expf(-v)); }
        __syncthreads();
        for (int u = vcu; u < 192; u += G) {
            const int l = u / 48, n0 = (u - l * 48) * 128, col = tid & 127, ks = tid >> 7;
            const float* wp = a.w_mod + (size_t)l * P_D * P_MODW + (size_t)(ks * 256) * P_MODW + n0 + col;
            float s[9];
#pragma unroll
            for (int r = 0; r < 9; ++r) s[r] = 0.f;
#pragma unroll 4
            for (int k = 0; k < 256; ++k) { const float w = wp[(size_t)k * P_MODW];
#pragma unroll
                for (int r = 0; r < 9; ++r) s[r] += act[r * P_D + ks * 256 + k] * w; }
#pragma unroll
            for (int r = 0; r < 9; ++r) red[(ks * 9 + r) * 128 + col] = s[r];
            __syncthreads();
            for (int e = tid; e < 9 * 128; e += 512) { const int r = e >> 7, cc = e & 127;
                const float t = (red[(0 * 9 + r) * 128 + cc] + red[(1 * 9 + r) * 128 + cc]) + (red[(2 * 9 + r) * 128 + cc] + red[(3 * 9 + r) * 128 + cc]);
                ((float*)(ws + WS_MOD))[(size_t)(l * 9 + r) * P_MODW + n0 + cc] = t + a.b_mod[l * P_MODW + n0 + cc]; }
            __syncthreads();
        }
    }
    if (vcu == G - 1) {
        for (int e = tid; e < 2048; e += 512) { const int pos = e >> 4, f = e & 15;
            const float inv = exp2f(-(float)f * (13.287712379549449f / 16.0f));
            const float ang = (float)pos * inv;
            ((float*)(ws + WS_ROPEC))[e] = cosf(ang); ((float*)(ws + WS_ROPES))[e] = sinf(ang); }
    }
}

template <int KIND> __device__ __forceinline__ void row_phase(const Args& a, int l, int vcu, int G, int wave, int lane) {
    unsigned char* ws = a.ws; float* X = (float*)(ws + WS_X); bf16* H = (bf16*)(ws + WS_H); const float* mod = (const float*)(ws + WS_MOD);
    const int gw = vcu * 8 + wave, NGW = G * 8;
    const bool lastl = (KIND == 2 && l == P_DEPTH - 1);
    const int ml = (KIND == 2) ? l + 1 : l; const int csh = (KIND == 1) ? 3 : 0, csc = (KIND == 1) ? 4 : 1;
    const float* lg = (KIND == 1 ? a.ln1_g : a.ln2_g) + l * P_D; const float* lb = (KIND == 1 ? a.ln1_b : a.ln2_b) + l * P_D;
    for (int m = gw; m < P_M; m += NGW) {
        const int b = m / P_RPB, rb = m - b * P_RPB; const bool is_ctx = rb < P_CTX; const int mrow = is_ctx ? 8 : b;
        const float* src;
        if (KIND == 0) src = is_ctx ? a.ctx + ((size_t)b * P_CTX + rb) * P_D : a.x + ((size_t)b * P_SEQ + (rb - P_CTX)) * P_D;
        else src = X + (size_t)m * P_D;
        const f32x4* xr = (const f32x4*)src + lane;
        f32x4 v[4];
#pragma unroll
        for (int j = 0; j < 4; ++j) v[j] = xr[64 * j];
        if (KIND != 0) {
            float s = 0.f;
#pragma unroll
            for (int j = 0; j < 4; ++j) s += (v[j].x + v[j].y) + (v[j].z + v[j].w);
            const float mean = wave_sum(s) * (1.f / P_D); float s2 = 0.f;
#pragma unroll
            for (int j = 0; j < 4; ++j) { v[j] = v[j] - mean; s2 += (v[j].x * v[j].x + v[j].y * v[j].y) + (v[j].z * v[j].z + v[j].w * v[j].w); }
            const float rstd = 1.f / sqrtf(wave_sum(s2) * (1.f / P_D) + P_EPS);
#pragma unroll
            for (int j = 0; j < 4; ++j) { const f32x4 g = ((const f32x4*)lg)[lane + 64 * j], bb = ((const f32x4*)lb)[lane + 64 * j]; v[j] = v[j] * rstd * g + bb; }
        }
        if (lastl) {
            if (!is_ctx) { f32x4* o = (f32x4*)(a.out + ((size_t)b * P_SEQ + (rb - P_CTX)) * P_D) + lane;
#pragma unroll
                for (int j = 0; j < 4; ++j) o[64 * j] = v[j]; }
        } else {
            f32x4* xo = (f32x4*)(X + (size_t)m * P_D) + lane;
#pragma unroll
            for (int j = 0; j < 4; ++j) xo[64 * j] = v[j];
            const float* mp = mod + (size_t)(ml * 9 + mrow) * P_MODW;
            unsigned long long* o8 = (unsigned long long*)(H + (size_t)m * P_D) + lane;
#pragma unroll
            for (int j = 0; j < 4; ++j) { const f32x4 sh = ((const f32x4*)(mp + csh * P_D))[lane + 64 * j], sc = ((const f32x4*)(mp + csc * P_D))[lane + 64 * j];
                const f32x4 h = v[j] * (1.0f + sc) + sh;
                o8[64 * j] = (unsigned long long)pk2(h.x, h.y) | ((unsigned long long)pk2(h.z, h.w) << 32); }
        }
    }
}

__device__ __forceinline__ void pool_unit(const Args& a, int l, int u, LAS unsigned char* lds, int tid) {
    const bf16* Z = (const bf16*)(a.ws + WS_Z); bf16* Y = (bf16*)(a.ws + WS_Y);
    const int tk = u >> 2, g = u & 3; const int row0 = tk * 128; const int b = row0 / P_RPB, rb0 = row0 - b * P_RPB;
    const int slo = (rb0 < P_CTX) ? b * P_RPB : b * P_RPB + P_CTX, shi = (rb0 < P_CTX) ? b * P_RPB + P_CTX : (b + 1) * P_RPB;
    LAS float* zt = (LAS float*)lds;
    LAS float* pl = (LAS float*)(lds + 36864);
    LAS float* wl = (LAS float*)(lds + 36864 + 34816);
    for (int e = tid; e < 144 * 8; e += 512) { const int rr = e >> 3, c8 = e & 7; const int R = row0 - 8 + rr;
        v4u w = (v4u){0u, 0u, 0u, 0u};
        if (R >= slo && R < shi) w = *(const v4u*)(Z + (size_t)R * P_INW + g * 64 + c8 * 8);
        LAS float* d = zt + rr * 64 + c8 * 8;
        d[0] = bf2f(w.x & 0xffff); d[1] = bf2f(w.x >> 16); d[2] = bf2f(w.y & 0xffff); d[3] = bf2f(w.y >> 16); d[4] = bf2f(w.z & 0xffff); d[5] = bf2f(w.z >> 16); d[6] = bf2f(w.w & 0xffff); d[7] = bf2f(w.w >> 16); }
    { const f32x4* wsrc = (const f32x4*)(a.pool_w + ((size_t)l * 4 + g) * 4096);
      for (int e = tid; e < 1024; e += 512) ((LAS f32x4*)wl)[e] = wsrc[e]; }
    __syncthreads();
    const int hw = 1 << g;
    for (int e = tid; e < 128 * 64; e += 512) { const int t = e >> 6, c = e & 63; const int T = row0 + t;
        const int lo = max(T - hw, slo), hi = min(T + hw - 1, shi - 1);
        float s = 0.f;
        for (int p = lo; p <= hi; ++p) s += zt[(p - row0 + 8) * 64 + c];
        pl[t * 68 + c] = s / (float)(hi - lo + 1) - zt[(t + 8) * 64 + c]; }
    __syncthreads();
    { const int d = tid & 63, tq = tid >> 6;
      float acc[16];
#pragma unroll
      for (int t = 0; t < 16; ++t) acc[t] = 0.f;
      for (int c4 = 0; c4 < 16; ++c4) {
          const float w0 = wl[(4 * c4 + 0) * 64 + d], w1 = wl[(4 * c4 + 1) * 64 + d], w2 = wl[(4 * c4 + 2) * 64 + d], w3 = wl[(4 * c4 + 3) * 64 + d];
#pragma unroll
          for (int t = 0; t < 16; ++t) { const f32x4 p = *(const LAS f32x4*)(pl + (tq * 16 + t) * 68 + 4 * c4); acc[t] += (p.x * w0 + p.y * w1) + (p.z * w2 + p.w * w3); }
      }
      const float sc = a.pool_scale[l * 256 + g * 64 + d];
#pragma unroll
      for (int t = 0; t < 16; ++t) Y[(size_t)(row0 + tq * 16 + t) * P_D + g * 64 + d] = (bf16)f2bf(acc[t] * sc);
    }
    __syncthreads();
}

__device__ __forceinline__ void mix_phase(const Args& a, int l, unsigned char* ldsg, LAS unsigned char* lds, int vcu, int G, int tid) {
    using abf = attn_body::bf16;
    const abf* Z = (const abf*)(a.ws + WS_Z); abf* Y = (abf*)(a.ws + WS_Y);
    { LAS float* rp = (LAS float*)(lds + RPB_OFF); const float* src = a.na_rpb + (size_t)l * 6 * 465;
      for (int e = tid; e < 6 * 465; e += 512) rp[e] = src[e] * P_LOG2E; }
    __syncthreads();
    for (int u = vcu; u < 1536; u += G) { const int h = u >> 8, b = (u >> 5) & 7, qb = u & 31, kv = h / 3;
        const size_t brow = (size_t)b * P_RPB, qrow = brow + P_CTX + (size_t)qb * 256;
        attn_body::attn_unit<8, 0>(Z + qrow * P_INW + 1408 + 64 * h, Z + brow * P_INW + 1792 + 64 * kv, Z + brow * P_INW + 1920 + 64 * kv, Y + qrow * P_D + 640 + 64 * h, 132, 256, 0, 0, RPB_OFF, (char*)ldsg); }
    if (DBG_NA) for (int u = vcu; u < 1536; u += G) { const int h = u >> 8, b = (u >> 5) & 7, qb = u & 31;
        const size_t brow = (size_t)b * P_RPB, qrow = brow + P_CTX + (size_t)qb * 256;
        const int rsmin = min(max(4 * qb - 4, 0), 116);
        attn_body::attn_unit<8, 1>(Z + qrow * P_INW + 256 + 64 * h, Z + brow * P_INW + 640 + 64 * h, Z + brow * P_INW + 1024 + 64 * h, Y + qrow * P_D + 256 + 64 * h, 16, 256 + 64 * rsmin, 4 * qb, rsmin, RPB_OFF + h * 465 * 4, (char*)ldsg); }
    if (DBG_CTX && l < P_DEPTH - 1)
        for (int u = vcu; u < 96; u += G) { const int b = u / 12, hh = u - b * 12; const size_t brow = (size_t)b * P_RPB;
            int qc, kc, vc, oc;
            if (hh < 6) { qc = 256 + 64 * hh; kc = 640 + 64 * hh; vc = 1024 + 64 * hh; oc = 256 + 64 * hh; }
            else { const int h = hh - 6; qc = 1408 + 64 * h; kc = 1792 + 64 * (h / 3); vc = 1920 + 64 * (h / 3); oc = 640 + 64 * h; }
            attn_body::attn_unit<8, 0>(Z + brow * P_INW + qc, Z + brow * P_INW + kc, Z + brow * P_INW + vc, Y + brow * P_D + oc, 4, 256, 0, 0, RPB_OFF, (char*)ldsg); }
    if (DBG_POOL) for (int u = vcu; u < (P_M / 128) * 4; u += G) pool_unit(a, l, u, lds, tid);
}


#if DBG_DIAG
constexpr size_t WS_FLAG = 1 * MiB + 65536;
__device__ __forceinline__ bool dclose(float a, float b, float tol) { return fabsf(a - b) <= tol * (1.0f + fabsf(b)); }
__device__ __forceinline__ void diag_phase(const Args& a, int code, int vcu, int tid, int G) {
    unsigned char* ws = a.ws; unsigned* flag = (unsigned*)(ws + WS_FLAG);
    const float* mod = (const float*)(ws + WS_MOD); const float* X = (const float*)(ws + WS_X); const bf16* H = (const bf16*)(ws + WS_H);
    const bf16* Z = (const bf16*)(ws + WS_Z); const bf16* Y = (const bf16*)(ws + WS_Y); const bf16* ACT = (const bf16*)(ws + WS_ACT);
    const int b = 2, pos = 3000; const size_t Rl = (size_t)b * P_RPB + P_CTX + pos;
    const int lane = tid & 63;
    if (code == 199) {
        const unsigned fl = *flag; int first = 0; for (int i = 0; i < 16; ++i) if ((fl >> i) & 1) { first = i + 1; break; }
        if ((fl >> 20) & 1) first += 16;
        for (size_t i = (size_t)vcu * 512 + tid; i < (size_t)P_B * P_SEQ * P_D; i += (size_t)G * 512) a.out[i] = (float)first;
        return;
    }
    if (vcu != 0 || tid >= 64) return;
    bool bad = false;
    if (code == 100) {
        if (lane == 0) *flag = 0u;
        { const int got = __builtin_amdgcn_mov_dpp(lane, 0x121, 0xf, 0xf, true); const int want = (lane & ~15) | ((lane + 15) & 15);
          if (__any(got != want) && lane == 0) atomicOr(flag, 1u << 20); }
        const int ns[4] = {5, 1030, 3200, 6000};
        for (int q = 0; q < 4; ++q) { const int n = ns[q]; float s = 0.f;
            for (int k = lane; k < P_D; k += 64) { const float v = a.c[b * P_D + k]; s += v / (1.f + expf(-v)) * a.w_mod[(size_t)k * P_MODW + n]; }
            s = wave_sum(s) + a.b_mod[n]; if (!dclose(mod[(size_t)b * P_MODW + n], s, 1e-3f)) bad = true; }
        { const int k = lane * 16 + 3; const float xv = a.x[((size_t)b * P_SEQ + pos) * P_D + k];
          const float h = xv * (1.f + mod[(size_t)b * P_MODW + P_D + k]) + mod[(size_t)b * P_MODW + k];
          if (!dclose(bf2f(H[Rl * P_D + k]), h, 1e-2f)) bad = true; if (X[Rl * P_D + k] != xv) bad = true; }
        if (__any(bad) && lane == 0) atomicOr(flag, 1u);
    } else if (code == 101) {
        const int cs[5] = {100, 700, 1100, 2000, 300};
        for (int q = 0; q < 5; ++q) { const int col = cs[q]; float s = 0.f;
            for (int k = lane; k < P_D; k += 64) s += bf2f(H[Rl * P_D + k]) * a.w_in[(size_t)k * P_INW + col];
            s = wave_sum(s); if (q == 4) s *= P_C2; if (!dclose(bf2f(Z[Rl * P_INW + col]), s, 3e-2f)) bad = true; }
        if (__any(bad) && lane == 0) atomicOr(flag, 2u);
        bad = false;
        { float s = 0.f; for (int k = 0; k < P_D; ++k) s += bf2f(H[Rl * P_D + k]) * a.w_in[(size_t)k * P_INW + 1792 + lane];
          const float ss = wave_sum(s * s); float xn = s / sqrtf(ss / 64.f + P_EPS) * a.k_norm[lane];
          const int gr = pos >> 6, gc = pos & 63; const int f = lane & 15; const float inv = exp2f(-(float)f * (13.287712379549449f / 16.0f));
          const float ang = (float)((lane < 32) ? gr : gc) * inv; const float cs_ = cosf(ang), sn_ = sinf(ang);
          const float pr = __shfl_xor(xn, 16); const float o = ((lane & 16) == 0) ? xn * cs_ - pr * sn_ : pr * sn_ + xn * cs_;
          if (!dclose(bf2f(Z[Rl * P_INW + 1792 + lane]), o, 3e-2f)) bad = true; }
        if (__any(bad) && lane == 0) atomicOr(flag, 4u);
    } else if (code == 102) {
        { const int g = 3, hw = 8; float s = 0.f; for (int p = -hw; p < hw; ++p) s += bf2f(Z[(Rl + p) * P_INW + g * 64 + lane]);
          const float pooled = s / 16.f - bf2f(Z[Rl * P_INW + g * 64 + lane]); float y = 0.f;
          for (int c = 0; c < 64; ++c) y += __shfl(pooled, c) * a.pool_w[(size_t)g * 4096 + c * 64 + lane];
          y *= a.pool_scale[g * 64 + lane]; if (!dclose(bf2f(Y[Rl * P_D + g * 64 + lane]), y, 3e-2f)) bad = true; }
        if (__any(bad) && lane == 0) atomicOr(flag, 8u);
        bad = false;
        { const int h = 2; const int gr = pos >> 6, gc = pos & 63; const int rs = min(max(gr - 4, 0), 120), cs = min(max(gc - 8, 0), 48);
          float mx = -1e30f, sc[6];
          for (int i = 0; i < 6; ++i) { const int key = lane + 64 * i; size_t kr_; float bias = 0.f;
              if (key < 128) { const int kr = rs + key / 16, kc = cs + key % 16; kr_ = (size_t)b * P_RPB + P_CTX + kr * 64 + kc; bias = a.na_rpb[(size_t)h * 465 + (kr - gr + 7) * 31 + (kc - gc + 15)] * P_LOG2E; }
              else kr_ = (size_t)b * P_RPB + (key - 128);
              float s = 0.f; for (int d = 0; d < 64; ++d) s += bf2f(Z[Rl * P_INW + 256 + 64 * h + d]) * bf2f(Z[kr_ * P_INW + 640 + 64 * h + d]);
              sc[i] = s + bias; mx = fmaxf(mx, sc[i]); }
          for (int o = 1; o < 64; o <<= 1) mx = fmaxf(mx, __shfl_xor(mx, o));
          float den = 0.f; for (int i = 0; i < 6; ++i) { sc[i] = exp2f(sc[i] - mx); den += sc[i]; } den = wave_sum(den);
          float o_ = 0.f;
          for (int i = 0; i < 6; ++i) for (int l2 = 0; l2 < 64; ++l2) { const int key = l2 + 64 * i; size_t kr_;
              if (key < 128) { const int kr = rs + key / 16, kc = cs + key % 16; kr_ = (size_t)b * P_RPB + P_CTX + kr * 64 + kc; } else kr_ = (size_t)b * P_RPB + (key - 128);
              o_ += __shfl(sc[i], l2) * bf2f(Z[kr_ * P_INW + 1024 + 64 * h + lane]); }
          o_ /= den; if (!dclose(bf2f(Y[Rl * P_D + 256 + 64 * h + lane]), o_, 3e-2f)) bad = true; }
        if (__any(bad) && lane == 0) atomicOr(flag, 16u);
        bad = false;
        { const int h = 4, kv = 1; float mx = -1e30f; float den = 0.f, o_ = 0.f;
          for (int i = 0; i < 132; ++i) { const size_t kr_ = (size_t)b * P_RPB + lane + 64 * i; float s = 0.f;
              for (int d = 0; d < 64; ++d) s += bf2f(Z[Rl * P_INW + 1408 + 64 * h + d]) * bf2f(Z[kr_ * P_INW + 1792 + 64 * kv + d]); mx = fmaxf(mx, s); }
          for (int o = 1; o < 64; o <<= 1) mx = fmaxf(mx, __shfl_xor(mx, o));
          for (int i = 0; i < 132; ++i) { const size_t kr_ = (size_t)b * P_RPB + lane + 64 * i; float s = 0.f;
              for (int d = 0; d < 64; ++d) s += bf2f(Z[Rl * P_INW + 1408 + 64 * h + d]) * bf2f(Z[kr_ * P_INW + 1792 + 64 * kv + d]);
              const float p = exp2f(s - mx); den += p;
              for (int l2 = 0; l2 < 64; ++l2) o_ += __shfl(p, l2) * bf2f(Z[((size_t)b * P_RPB + l2 + 64 * i) * P_INW + 1920 + 64 * kv + lane]); }
          den = wave_sum(den); o_ /= den; if (!dclose(bf2f(Y[Rl * P_D + 640 + 64 * h + lane]), o_, 3e-2f)) bad = true; }
        if (__any(bad) && lane == 0) atomicOr(flag, 32u);
    } else if (code == 103) {
        { const int c = lane * 16 + 5; float s = 0.f; for (int k = 0; k < P_D; ++k) s += bf2f(Y[Rl * P_D + k]) * a.w_out[(size_t)k * P_D + c];
          const float e = P_ALPHA * a.x[((size_t)b * P_SEQ + pos) * P_D + c] + mod[(size_t)b * P_MODW + 2 * P_D + c] * s;
          if (!dclose(X[Rl * P_D + c], e, 3e-3f)) bad = true; }
        if (__any(bad) && lane == 0) atomicOr(flag, 64u);
    } else if (code == 104) {
        { float m = 0.f, q = 0.f; for (int k = lane; k < P_D; k += 64) { const float y = (X[Rl * P_D + k] - a.ln1_b[k]) / a.ln1_g[k]; m += y; q += y * y; }
          m = wave_sum(m) / P_D; q = wave_sum(q) / P_D; if (fabsf(m) > 1e-3f || fabsf(q - 1.f) > 2e-3f) bad = true;
          const int k = lane * 16 + 7; const float h = X[Rl * P_D + k] * (1.f + mod[(size_t)b * P_MODW + 4 * P_D + k]) + mod[(size_t)b * P_MODW + 3 * P_D + k];
          if (!dclose(bf2f(H[Rl * P_D + k]), h, 1e-2f)) bad = true; }
        if (__any(bad) && lane == 0) atomicOr(flag, 128u);
    } else if (code == 105) {
        { const int ch = 37 + lane * 43; float ua[3] = {0.f, 0.f, 0.f}, ug[3] = {0.f, 0.f, 0.f};
          for (int k = 0; k < P_D; ++k) { const float wa = a.w_up[(size_t)k * P_UPW + ch], wg = a.w_up[(size_t)k * P_UPW + P_DFF + ch];
              for (int j = 0; j < 3; ++j) { const float hv = bf2f(H[(Rl + j - 1) * P_D + k]); ua[j] += hv * wa; ug[j] += hv * wg; } }
          const float av = a.conv_w[ch] * ua[0] + a.conv_w[P_UPW + ch] * ua[1] + a.conv_w[2 * P_UPW + ch] * ua[2] + a.conv_b[ch];
          const float gv = a.conv_w[P_DFF + ch] * ug[0] + a.conv_w[P_UPW + P_DFF + ch] * ug[1] + a.conv_w[2 * P_UPW + P_DFF + ch] * ug[2] + a.conv_b[P_DFF + ch];
          const float e = av * gv / (1.f + expf(-gv)); if (!dclose(bf2f(ACT[Rl * P_DFF + ch]), e, 4e-2f)) bad = true; }
        if (__any(bad) && lane == 0) atomicOr(flag, 256u);
    } else if (code == 106) {
        { const int c = lane * 16 + 9; float s = 0.f; for (int k = 0; k < P_DFF; ++k) s += bf2f(ACT[Rl * P_DFF + k]) * a.w_down[(size_t)k * P_D + c];
          const float x1 = (bf2f(H[Rl * P_D + c]) - mod[(size_t)b * P_MODW + 3 * P_D + c]) / (1.f + mod[(size_t)b * P_MODW + 4 * P_D + c]);
          const float e = P_ALPHA * x1 + mod[(size_t)b * P_MODW + 5 * P_D + c] * s;
          if (fabsf(X[Rl * P_D + c] - e) > 0.03f) bad = true; }
        if (__any(bad) && lane == 0) atomicOr(flag, 512u);
    }
}
#endif

__global__ void __launch_bounds__(512, 2) mega(Args a) {
    extern __shared__ __attribute__((aligned(16))) unsigned char ldsraw[];
    LAS unsigned char* lds = (LAS unsigned char*)ldsraw;
    cg::grid_group grid = cg::this_grid();
    const int G = gridDim.x; const int bx = blockIdx.x; const int vcu = (G % 8 == 0) ? (bx % 8) * (G / 8) + bx / 8 : bx;
    const int ph_lo = a.ph_lo, ph_hi = a.ph_hi;
    volatile LAS unsigned* barst = (volatile LAS unsigned*)(lds + BARST_OFF);
    if (threadIdx.x < 2) barst[threadIdx.x] = 0u;
    if (ph_lo == 0 && blockIdx.x == 0) { unsigned* bw = (unsigned*)(a.ws + WS_BAR); for (int i = threadIdx.x; i < XCD_BAR_WORDS; i += 512) bw[i] = 0u; }
    __syncthreads();
    XcdBarrier xbar; xbar.bar = (unsigned*)(a.ws + WS_BAR); xbar.x = 0; xbar.st = barst;
    for (int ph = ph_lo; ph < ph_hi; ++ph) {
        if (ph > ph_lo) {
            if (ph == ph_lo + 1) { grid.sync(); xbar = xcd_barrier_post((unsigned*)(a.ws + WS_BAR), barst); }
            else xcd_barrier(xbar);
        }
        const int tid = ltid(), lane = tid & 63, wave = __builtin_amdgcn_readfirstlane(tid >> 6);
        Args q;
        ARGF(q, ws); unsigned char* ws = q.ws;
#if DBG_DIAG
        if (ph >= 100) { q = a; diag_phase(q, ph, vcu, tid, G); continue; }
#endif
        if (ph == 0) { ARGF(q, c); ARGF(q, c_ctx); ARGF(q, w_mod); ARGF(q, b_mod); ARGF(q, w_in); ARGF(q, w_out); ARGF(q, w_up); ARGF(q, w_down); phase0(q, lds, vcu, G, tid, lane, wave); continue; }
        if (ph == 1) { ARGF(q, x); ARGF(q, ctx); row_phase<0>(q, 0, vcu, G, wave, lane); continue; }
        const int l = (ph - 2) / PH_PER_L; int sp = (ph - 2) % PH_PER_L; if (DBG_REP >= 0 && sp > DBG_REP) --sp;
        if (sp == 0 && (DBG_MASK & 1)) {
            ARGF(q, q_norm); ARGF(q, k_norm);
            pg8::Gemm g{(const pg8::bf16_t*)(ws + WS_H), (const pg8::bf16_t*)(ws + WS_WIN) + (size_t)l * P_INW * P_D, P_M, P_INW, P_D};
            pg8::StaticOrder S; S.init(P_M / 256, P_INW / 256, G, bx);
            pg8::EpiIn E{(pg8::bf16_t*)(ws + WS_Z), q.q_norm + l * 64, q.k_norm + l * 64, (const float*)(ws + WS_ROPEC), (const float*)(ws + WS_ROPES)};
            pg8::gemm_phase<pg8::EpiIn, pg8::StaticOrder, true, true, 0>(lds, g, S, E);
        } else if (sp == 1 && (DBG_MASK & 2)) {
            ARGF(q, na_rpb); ARGF(q, pool_w); ARGF(q, pool_scale);
            mix_phase(q, l, ldsraw, lds, vcu, G, tid);
        } else if (sp == 2 && (DBG_MASK & 4)) {
            pg8::Gemm g{(const pg8::bf16_t*)(ws + WS_Y), (const pg8::bf16_t*)(ws + WS_WOUT) + (size_t)l * P_D * P_D, P_M, P_D, P_D};
            pg8::StaticOrder S; S.init(P_M / 256, P_D / 256, G, bx);
            pg8::EpiRes E{(float*)(ws + WS_X), (const float*)(ws + WS_MOD) + (size_t)l * 9 * P_MODW + 2 * P_D};
            pg8::gemm_phase<pg8::EpiRes, pg8::StaticOrder, true, true, 0>(lds, g, S, E);
        } else if (sp == 3 && (DBG_MASK & 8)) {
            ARGF(q, ln1_g); ARGF(q, ln1_b);
            row_phase<1>(q, l, vcu, G, wave, lane);
        } else if (sp == 4 && (DBG_MASK & 16)) {
            ARGF(q, conv_w); ARGF(q, conv_b);
            pg8::Gemm g{(const pg8::bf16_t*)(ws + WS_H) - P_D, (const pg8::bf16_t*)(ws + WS_WUP) + (size_t)l * P_UPW * P_D, P_M, P_UPW, P_D};
            pg8::StaticOrder S; S.init((P_M + 247) / 248, P_UPW / 256, G, bx);
            pg8::EpiUp E{(pg8::bf16_t*)(ws + WS_ACT), q.conv_w + (size_t)l * 3 * P_UPW, q.conv_b + (size_t)l * P_UPW};
            pg8::gemm_phase<pg8::EpiUp, pg8::StaticOrder, true, true, 1>(lds, g, S, E);
        } else if (sp == 5 && (DBG_MASK & 32)) {
            pg8::Gemm g{(const pg8::bf16_t*)(ws + WS_ACT), (const pg8::bf16_t*)(ws + WS_WDN) + (size_t)l * P_D * P_DFF, P_M, P_D, P_DFF};
            pg8::StaticOrder S; S.init(P_M / 256, P_D / 256, G, bx);
            pg8::EpiRes E{(float*)(ws + WS_X), (const float*)(ws + WS_MOD) + (size_t)l * 9 * P_MODW + 5 * P_D};
            pg8::gemm_phase<pg8::EpiRes, pg8::StaticOrder, true, true, 0>(lds, g, S, E);
        } else if (DBG_MASK & 64) {
            ARGF(q, ln2_g); ARGF(q, ln2_b); ARGF(q, out);
            row_phase<2>(q, l, vcu, G, wave, lane);
        }
    }
}

#ifndef MK_MULTI
#define MK_MULTI 0
#endif
extern "C" void kernel_launch(void* const* d_in, const int* in_sizes, int n_in, void* d_out, int out_size, void* d_ws, size_t ws_size, hipStream_t stream) {
    static int grid = 0;
    if (grid == 0) {
        if (n_in != 21 || ws_size < WS_END) { fprintf(stderr, "kernel_launch: unexpected n_in %d / ws_size %zu\n", n_in, ws_size); grid = -1; return; }
        int dev = 0, cus = 0, per_cu = 0;
        if (hipGetDevice(&dev) != hipSuccess || hipDeviceGetAttribute(&cus, hipDeviceAttributeMultiprocessorCount, dev) != hipSuccess) { grid = -1; return; }
        if (hipFuncSetAttribute((const void*)mega, hipFuncAttributeMaxDynamicSharedMemorySize, LDS_BYTES) != hipSuccess) { fprintf(stderr, "kernel_launch: hipFuncSetAttribute failed\n"); grid = -1; return; }
        if (hipOccupancyMaxActiveBlocksPerMultiprocessor(&per_cu, (const void*)mega, 512, LDS_BYTES) != hipSuccess || per_cu < 1) { fprintf(stderr, "kernel_launch: occupancy query says %d\n", per_cu); per_cu = 1; }
        (void)hipGetLastError();
        grid = cus * 1;
        fprintf(stderr, "kernel_launch: cus %d per_cu %d grid %d\n", cus, per_cu, grid);
    }
    if (grid < 0) return;
    Args a{};
    const float** f = (const float**)&a;
    for (int i = 0; i < 21; ++i) f[i] = (const float*)d_in[i];
    a.out = (float*)d_out; a.ws = (unsigned char*)d_ws;
#if MK_MULTI
#if DBG_DIAG
    { const int seq[] = {0, 1, 100, 2, 101, 3, 102, 4, 103, 5, 104, 6, 105, 7, 106, 199};
      for (int i = 0; i < 16; ++i) { a.ph_lo = seq[i]; a.ph_hi = seq[i] + 1; hipLaunchKernelGGL(mega, dim3(grid), dim3(512), LDS_BYTES, stream, a); } }
#else
    for (int ph = 0; ph < N_PHASES; ++ph) { a.ph_lo = ph; a.ph_hi = ph + 1; hipLaunchKernelGGL(mega, dim3(grid), dim3(512), LDS_BYTES, stream, a); }
#endif
#else
    a.ph_lo = 0; a.ph_hi = N_PHASES;
    void* args[] = {&a};
    hipError_t e = hipLaunchCooperativeKernel((const void*)mega, dim3(grid), dim3(512), args, LDS_BYTES, stream);
    if (e != hipSuccess) fprintf(stderr, "cooperative launch failed: %s (grid %d)\n", hipGetErrorString(e), grid);
#endif
}
```

```cpp
#include <hip/hip_runtime.h>
#include <hip/hip_cooperative_groups.h>
#include <cstdio>
#include <cstdint>
constexpr int P_D = 1024, P_B = 8, P_SEQ = 8192, P_CTX = 256, P_RPB = P_SEQ + P_CTX  , P_M = P_B * P_RPB  ;
constexpr int P_DEPTH = 4, P_INW = 2048, P_DFF = 2816, P_UPW = 2 * P_DFF, P_MODW = 6 * P_D;
constexpr float P_C2 = 0.125f * 1.4426950408889634f;
constexpr float P_LOG2E = 1.4426950408889634f;
constexpr float P_ALPHA = 1.681792830507429f;
constexpr float P_EPS = 1e-6f;
__device__ __forceinline__ int ltid() { int t = threadIdx.x; asm volatile("" : "+v"(t)); return t; }
namespace pg8 {
#define PG8_LAS __attribute__((address_space(3)))
typedef unsigned short bf16_t;
typedef short bf16x8 __attribute__((ext_vector_type(8)));
typedef float f32x4 __attribute__((ext_vector_type(4)));
typedef unsigned u32x4 __attribute__((ext_vector_type(4)));
constexpr int BM = 256, BK = 64, HALF = 128, HTB = HALF * BK * 2  , STAGE_BYTES = 8 * HTB, NXCD = 8, WGM = 8;

__host__ __device__ __forceinline__ int lds_byte(int r, int c) { const int st = (r >> 4) * 2 + (c >> 5), rr = r & 15, cc = c & 31, ob = rr * 64 + cc * 2; return st * 1024 + (ob ^ (((ob >> 9) & 1) << 5)); }
__host__ __device__ __forceinline__ void stage_rc(int b, int& R, int& C) { const int st = b / 1024, sb = b % 1024, swz = sb ^ (((sb >> 9) & 1) << 5); R = (st >> 1) * 16 + swz / 64; C = (st & 1) * 32 + (swz % 64) / 2; }
__host__ __device__ __forceinline__ int perm32(int rho) { const int n = rho >> 4, i = rho & 15; return 8 * (i >> 2) + 4 * n + (i & 3); }

struct Unit { int pm, pn; };
struct Gemm { const bf16_t* A; const bf16_t* Bt; int M, N, K; };

struct StaticOrder {
    int nM, nN, nwg, G, c, skipctx = 0;
    __host__ __device__ void init(int nM_, int nN_, int G_, int c_) { nM = nM_; nN = nN_; nwg = nM * nN; G = G_; c = c_; }
    __host__ __device__ bool next(int i, Unit& u) const {
        const long L = (long)i * G + c; if (L >= nwg) return false;
        int wgid = (int)L; { const int q = nwg / NXCD, r = nwg % NXCD, xcd = wgid % NXCD, off = wgid / NXCD; wgid = (xcd < r ? xcd * (q + 1) : r * (q + 1) + (xcd - r) * q) + off; }
        const int nig = WGM * nN, gid = wgid / nig, fm = gid * WGM, gsz = (nM - fm) < WGM ? (nM - fm) : WGM;
        u.pm = fm + ((wgid % nig) % gsz); u.pn = (wgid % nig) / gsz; if (skipctx) u.pm += (u.pm >> 5) + 1; return true;
    }
    __device__ __forceinline__ void a_ready(const Unit&) const {}
    __device__ __forceinline__ void done(const Unit&) const {}
};

__device__ __forceinline__ unsigned cvt_pk_bf16(float lo, float hi) { unsigned r; asm volatile("v_cvt_pk_bf16_f32 %0, %1, %2" : "=v"(r) : "v"(lo), "v"(hi)); return r; }
#ifndef EPI_SHFL
#define EPI_SHFL 0
#endif
typedef float f32x2 __attribute__((ext_vector_type(2)));
__device__ __forceinline__ f32x4 dppror(const f32x4 v, const bool up) {
    f32x4 r;
#if EPI_SHFL
    const int lane = threadIdx.x & 63; const int src = (lane & ~15) | ((lane + (up ? 15 : 1)) & 15);
#pragma unroll
    for (int j = 0; j < 4; ++j) r[j] = __shfl(v[j], src);
#else
#pragma unroll
    for (int j = 0; j < 4; ++j) { const float xs = v[j]; const int iv = __float_as_int(xs);
        r[j] = __int_as_float(up ? __builtin_amdgcn_mov_dpp(iv, 0x121, 0xf, 0xf, true) : __builtin_amdgcn_mov_dpp(iv, 0x12F, 0xf, 0xf, true)); }
#endif
    return r;
}
struct EpiIn {
    static constexpr bool PERM = false, AFTER_DRAIN = false;
    bf16_t* Z; const float* qn; const float* kn; const float* rc; const float* rs;
    __device__ __forceinline__ void operator()(const f32x4 (&acc)[2][2][4][2], const Unit& u, int wr, int wc, int fr, int fq) const {
        asm volatile("" : "+v"(fr), "+v"(fq));
        const int hs = u.pn * 4 + wc;
        const bool isq = (hs >= 22 && hs < 28), isk = (hs == 28 || hs == 29);
        const float sc = ((hs >= 4 && hs < 10) || isq) ? P_C2 : 1.f;
        const int tb = u.pm % 33; const bool is_ctx = (tb == 0);
#pragma unroll
        for (int ai = 0; ai < 2; ++ai)
#pragma unroll
            for (int m = 0; m < 4; ++m) {
                const int rt = ai * HALF + wr * 64 + m * 16 + fr;
                const size_t row = (size_t)u.pm * BM + rt;
                f32x4 v[2][2];
#pragma unroll
                for (int bj = 0; bj < 2; ++bj)
#pragma unroll
                    for (int n = 0; n < 2; ++n) v[bj][n] = acc[ai][bj][m][n];
                if (isq || isk) {
                    float ss = 0.f;
#pragma unroll
                    for (int bj = 0; bj < 2; ++bj)
#pragma unroll
                        for (int n = 0; n < 2; ++n) { const f32x4 x = v[bj][n]; ss += (x[0] * x[0] + x[1] * x[1]) + (x[2] * x[2] + x[3] * x[3]); }
                    ss += __shfl_xor(ss, 16); ss += __shfl_xor(ss, 32);
                    const float rstd = 1.0f / sqrtf(ss * (1.0f / 64.0f) + P_EPS);
                    const float* gp = (isq ? qn : kn) + 4 * fq;
                    const int pos = (tb - 1) * BM + rt; const int gr = pos >> 6, gc = pos & 63;
#pragma unroll
                    for (int bj = 0; bj < 2; ++bj) {
                        const f32x4 g0 = *(const f32x4*)(gp + 32 * bj), g1 = *(const f32x4*)(gp + 32 * bj + 16);
                        f32x4 x1 = v[bj][0] * rstd * g0, x2 = v[bj][1] * rstd * g1;
                        if (!is_ctx) { const int idx = bj ? gc : gr;
                            const f32x4 cs = *(const f32x4*)(rc + idx * 16 + 4 * fq), sn = *(const f32x4*)(rs + idx * 16 + 4 * fq);
                            const f32x4 y1 = x1 * cs - x2 * sn, y2 = x1 * sn + x2 * cs; x1 = y1; x2 = y2; }
                        v[bj][0] = x1; v[bj][1] = x2;
                    }
                }
                bf16_t* zp = Z + row * P_INW + hs * 64 + 4 * fq;
#pragma unroll
                for (int bj = 0; bj < 2; ++bj)
#pragma unroll
                    for (int n = 0; n < 2; ++n) { const f32x4 x = v[bj][n] * sc; unsigned long long w = (unsigned long long)cvt_pk_bf16(x[0], x[1]) | ((unsigned long long)cvt_pk_bf16(x[2], x[3]) << 32);
                        *(unsigned long long*)(zp + 32 * bj + 16 * n) = w; }
                asm volatile("" ::: "memory");
            }
    }
};
struct EpiRes {
    static constexpr bool PERM = false, AFTER_DRAIN = false;
    float* X; const float* gate;
    const float* st; const float* lg; const float* lb; const float* xin; const float* cin;
    __device__ __forceinline__ void operator()(const f32x4 (&acc)[2][2][4][2], const Unit& u, int wr, int wc, int fr, int fq) const {
        asm volatile("" : "+v"(fr), "+v"(fq));
        const int b = u.pm / 33, tb = u.pm % 33; const int mrow = tb == 0 ? 8 : b;
        const int col0 = u.pn * BM + wc * 32 + 4 * fq;
        const float* gp = gate + mrow * P_MODW + col0;
        const bool ident = (lg == nullptr);
        const float* rbase = ident ? (tb == 0 ? cin + (size_t)b * P_CTX * P_D : xin + ((size_t)b * P_SEQ + (size_t)(tb - 1) * BM) * P_D) : X + (size_t)u.pm * BM * P_D;
#pragma unroll
        for (int ai = 0; ai < 2; ++ai)
#pragma unroll
            for (int m = 0; m < 4; ++m) { const int rt = ai * HALF + wr * 64 + m * 16 + fr;
                float* xw = X + ((size_t)u.pm * BM + rt) * P_D + col0; const float* xr = rbase + (size_t)rt * P_D + col0;
                float mean = 0.f, rstd = 1.f;
                if (!ident) { const f32x2 s2 = *(const f32x2*)(st + ((size_t)u.pm * BM + rt) * 2); mean = s2[0]; rstd = s2[1]; }
#pragma unroll
                for (int bj = 0; bj < 2; ++bj)
#pragma unroll
                    for (int n = 0; n < 2; ++n) { f32x4 xo = *(const f32x4*)(xr + bj * HALF + n * 16);
                        if (!ident) { const f32x4 g4 = *(const f32x4*)(lg + col0 + bj * HALF + n * 16), b4 = *(const f32x4*)(lb + col0 + bj * HALF + n * 16); xo = (xo - mean) * rstd * g4 + b4; }
                        const f32x4 gv = *(const f32x4*)(gp + bj * HALF + n * 16);
                        xo = xo * P_ALPHA + gv * acc[ai][bj][m][n]; *(f32x4*)(xw + bj * HALF + n * 16) = xo; }
                asm volatile("" ::: "memory"); }
    }
};
struct EpiUp {
    static constexpr bool PERM = true, AFTER_DRAIN = false;
    bf16_t* ACT; const float* cw; const float* cb;
    __device__ __forceinline__ void operator()(const f32x4 (&acc)[2][2][4][2], const Unit& u, int wr, int wc, int fr, int fq) const {
        asm volatile("" : "+v"(fr), "+v"(fq));
#pragma unroll
        for (int n = 0; n < 2; ++n) {
            const int ch = u.pn * 128 + wc * 32 + 8 * fq + 4 * n;
            const f32x4 wa0 = *(const f32x4*)(cw + ch), wa1 = *(const f32x4*)(cw + P_UPW + ch), wa2 = *(const f32x4*)(cw + 2 * P_UPW + ch), ba = *(const f32x4*)(cb + ch);
            const f32x4 wg0 = *(const f32x4*)(cw + P_DFF + ch), wg1 = *(const f32x4*)(cw + P_UPW + P_DFF + ch), wg2 = *(const f32x4*)(cw + 2 * P_UPW + P_DFF + ch), bg = *(const f32x4*)(cb + P_DFF + ch);
#pragma unroll
            for (int ai = 0; ai < 2; ++ai) {
                const int Rb = u.pm * 248 - 1 + (2 * ai + wr) * 62;
                f32x4 ra_prev = (f32x4){0.f, 0.f, 0.f, 0.f}, rg_prev = ra_prev;
                f32x4 la_cur = dppror(acc[ai][0][0][n], false), lg_cur = dppror(acc[ai][1][0][n], false);
#pragma unroll
                for (int m = 0; m < 4; ++m) {
                    const f32x4 va = acc[ai][0][m][n], vg = acc[ai][1][m][n];
                    const f32x4 ra_cur = dppror(va, true), rg_cur = dppror(vg, true);
                    f32x4 la_next = la_cur, lg_next = lg_cur;
                    if (m < 3) { la_next = dppror(acc[ai][0][m < 3 ? m + 1 : 3][n], false); lg_next = dppror(acc[ai][1][m < 3 ? m + 1 : 3][n], false); }
                    const int i = 16 * m + fr; const int R = Rb + i;
                    const int rbm = R - (R / P_RPB) * P_RPB;
                    const bool first = (rbm == 0) || (rbm == P_CTX), last = (rbm == P_CTX - 1) || (rbm == P_RPB - 1);
                    f32x4 upa = (fr == 0) ? ra_prev : ra_cur, upg = (fr == 0) ? rg_prev : rg_cur;
                    f32x4 dna = (fr == 15) ? la_next : la_cur, dng = (fr == 15) ? lg_next : lg_cur;
                    const f32x4 z4 = (f32x4){0.f, 0.f, 0.f, 0.f};
                    if (first) { upa = z4; upg = z4; }
                    if (last) { dna = z4; dng = z4; }
                    const f32x4 av = wa0 * upa + wa1 * va + wa2 * dna + ba;
                    const f32x4 gv = wg0 * upg + wg1 * vg + wg2 * dng + bg;
                    f32x4 o;
#pragma unroll
                    for (int j = 0; j < 4; ++j) o[j] = av[j] * gv[j] * __builtin_amdgcn_rcpf(1.0f + __expf(-gv[j]));
                    unsigned long long w = (unsigned long long)cvt_pk_bf16(o[0], o[1]) | ((unsigned long long)cvt_pk_bf16(o[2], o[3]) << 32);
                    asm volatile("" : "+v"(w));
                    if (i >= 1 && i <= 62 && R < P_M) *(unsigned long long*)(ACT + (size_t)R * P_DFF + ch) = w;
                    ra_prev = ra_cur; rg_prev = rg_cur; la_cur = la_next; lg_cur = lg_next;
                }
            }
        }
    }
};

template <class Epi, class Sched, bool ALIGN_EPI = false, bool SP2 = false, int AMODE = 0>
__device__ __forceinline__ void gemm_phase(PG8_LAS unsigned char* lds, const Gemm g, const Sched& S, const Epi& E) {
    const int tid = ltid(), wid = __builtin_amdgcn_readfirstlane(tid >> 6), lane = tid & 63, wr = wid >> 2, wc = wid & 3, fr = lane & 15, fq = lane >> 4;
    const int K = g.K, nt = K / BK;
    unsigned voffA[2], voffB[2];
#pragma unroll
    for (int i = 0; i < 2; ++i) { int R, C; stage_rc(tid * 16 + i * 8192, R, C); const int Rb = Epi::PERM ? ((R & ~31) + perm32(R & 31)) : R;
        voffA[i] = (unsigned)((AMODE ? ((R >> 6) * 62 + (R & 63)) : R) * K + C) * 2u; voffB[i] = (unsigned)(Rb * K + C) * 2u; }
    const size_t kstep = (size_t)(BK * 2);
    const size_t hstepB = (size_t)HALF * K * 2; const size_t hstepA = (size_t)(AMODE ? 124 : HALF) * K * 2;
    const size_t tstepB = 2 * hstepB; const size_t tstepA = 2 * hstepA;
    const unsigned ldsw = (unsigned)wid * 1024u;
    const int aoff = lds_byte(wr * 64 + fr, fq * 8), boff = lds_byte(wc * 32 + fr, fq * 8);
#define PG8_SA(b, h) (((b) * 2 + (h)) * HTB)
#define PG8_SB(b, h) ((4 + (b) * 2 + (h)) * HTB)
#define PG8_STAGE(bufoff, gbase, voff) do { _Pragma("unroll") for (int _i = 0; _i < 2; ++_i) \
        __builtin_amdgcn_global_load_lds((const unsigned*)((const char*)(gbase) + (voff)[_i]), (PG8_LAS unsigned*)(lds + (bufoff) + ldsw + _i * 8192), 16, 0, 0); } while (0)
#define PG8_LDA(dst, b, h) do { _Pragma("unroll") for (int m = 0; m < 4; ++m) _Pragma("unroll") for (int k = 0; k < 2; ++k) dst[m][k] = *(const PG8_LAS bf16x8*)(lds + PG8_SA(b, h) + aoff + m * 2048 + k * 1024); } while (0)
#define PG8_LDB(dst, b, h) do { _Pragma("unroll") for (int n = 0; n < 2; ++n) _Pragma("unroll") for (int k = 0; k < 2; ++k) dst[n][k] = *(const PG8_LAS bf16x8*)(lds + PG8_SB(b, h) + boff + n * 2048 + k * 1024); } while (0)
#define PG8_MMA(ai, bj, At, Bt) do { __builtin_amdgcn_s_setprio(1); _Pragma("unroll") for (int m = 0; m < 4; ++m) _Pragma("unroll") for (int n = 0; n < 2; ++n) _Pragma("unroll") for (int k = 0; k < 2; ++k) \
        acc[ai][bj][m][n] = __builtin_amdgcn_mfma_f32_16x16x32_bf16(Bt[n][k], At[m][k], acc[ai][bj][m][n], 0, 0, 0); __builtin_amdgcn_s_setprio(0); } while (0)
#define PG8_WAIT_V(n) asm volatile("s_waitcnt vmcnt(" #n ")" ::: "memory")
#define PG8_WAIT_L(n) asm volatile("s_waitcnt lgkmcnt(" #n ")" ::: "memory")
#define PG8_BAR __builtin_amdgcn_s_barrier()
#define PG8_SCHED __builtin_amdgcn_sched_barrier(0)
    Unit cur, nxt; int ui = 0;
    if (!S.next(0, cur)) return;
    f32x4 acc[2][2][4][2];
#pragma unroll
    for (int a = 0; a < 2; ++a)
#pragma unroll
        for (int b = 0; b < 2; ++b)
#pragma unroll
            for (int m = 0; m < 4; ++m)
#pragma unroll
                for (int n = 0; n < 2; ++n) acc[a][b][m][n] = (f32x4){0.f, 0.f, 0.f, 0.f};
    bf16x8 At[4][2], B0[2][2], B1[2][2];
    const char* cA = (const char*)g.A + (size_t)cur.pm * tstepA; const char* cB = (const char*)g.Bt + (size_t)cur.pn * tstepB;
    S.a_ready(cur);
    if constexpr (SP2) {
        PG8_STAGE(PG8_SB(0, 0), cB, voffB); PG8_STAGE(PG8_SB(0, 1), cB + hstepB, voffB); PG8_STAGE(PG8_SA(0, 0), cA, voffA); PG8_STAGE(PG8_SA(0, 1), cA + hstepA, voffA);
        if (wr == 1) PG8_BAR;
        PG8_WAIT_V(2); PG8_BAR;
        PG8_STAGE(PG8_SB(1, 0), cB + kstep, voffB); PG8_STAGE(PG8_SA(1, 0), cA + kstep, voffA); PG8_STAGE(PG8_SB(1, 1), cB + hstepB + kstep, voffB);
        PG8_WAIT_V(6); PG8_BAR;
    } else {
        PG8_STAGE(PG8_SB(0, 0), cB, voffB); PG8_STAGE(PG8_SA(0, 0), cA, voffA); PG8_STAGE(PG8_SB(0, 1), cB + hstepB, voffB); PG8_STAGE(PG8_SA(0, 1), cA + hstepA, voffA);
        if (wr == 1) PG8_BAR;
        PG8_WAIT_V(4); PG8_BAR;
        PG8_STAGE(PG8_SB(1, 0), cB + kstep, voffB); PG8_STAGE(PG8_SA(1, 0), cA + kstep, voffA); PG8_STAGE(PG8_SB(1, 1), cB + hstepB + kstep, voffB);
        PG8_WAIT_V(6); PG8_BAR;
    }
    for (;;) {
        const bool has_next = S.next(ui + 1, nxt);
        const char* nA = has_next ? (const char*)g.A + (size_t)nxt.pm * tstepA : cA; const char* nB = has_next ? (const char*)g.Bt + (size_t)nxt.pn * tstepB : cB;
        for (int t = 0; t < nt; t += 2) {
            const bool last = (t == nt - 2);
            const char* a1 = cA + (size_t)(t + 1) * kstep;
            const char* a2 = last ? nA : cA + (size_t)(t + 2) * kstep; const char* b2 = last ? nB : cB + (size_t)(t + 2) * kstep;
            const char* a3 = a2 + kstep; const char* b3 = b2 + kstep;
            if (last && has_next) S.a_ready(nxt);
            if constexpr (SP2) {
            PG8_LDB(B0, 0, 0); PG8_LDB(B1, 0, 1); PG8_SCHED; PG8_LDA(At, 0, 0); PG8_STAGE(PG8_SA(1, 1), a1 + hstepA, voffA);
            PG8_WAIT_V(8); PG8_WAIT_L(0); PG8_BAR; PG8_MMA(0, 0, At, B0); PG8_MMA(0, 1, At, B1); PG8_BAR; PG8_SCHED;
            PG8_LDA(At, 0, 1); PG8_STAGE(PG8_SB(0, 0), b2, voffB); PG8_STAGE(PG8_SB(0, 1), b2 + hstepB, voffB); PG8_STAGE(PG8_SA(0, 0), a2, voffA);
            PG8_WAIT_V(8); PG8_WAIT_L(0); PG8_BAR; PG8_MMA(1, 0, At, B0); PG8_MMA(1, 1, At, B1); PG8_BAR; PG8_SCHED;
            PG8_LDB(B0, 1, 0); PG8_LDB(B1, 1, 1); PG8_SCHED; PG8_LDA(At, 1, 0); PG8_STAGE(PG8_SA(0, 1), a2 + hstepA, voffA);
            PG8_WAIT_V(8); PG8_WAIT_L(0); PG8_BAR; PG8_MMA(0, 0, At, B0); PG8_MMA(0, 1, At, B1); PG8_BAR; PG8_SCHED;
            PG8_LDA(At, 1, 1); PG8_STAGE(PG8_SB(1, 0), b3, voffB); PG8_STAGE(PG8_SB(1, 1), b3 + hstepB, voffB); PG8_STAGE(PG8_SA(1, 0), a3, voffA);
            PG8_WAIT_V(8); PG8_WAIT_L(0); PG8_BAR; PG8_MMA(1, 0, At, B0); PG8_MMA(1, 1, At, B1); PG8_BAR; PG8_SCHED;
            } else {
            PG8_LDB(B0, 0, 0); PG8_SCHED; PG8_LDA(At, 0, 0); PG8_STAGE(PG8_SA(1, 1), a1 + hstepA, voffA);
            PG8_WAIT_L(8); PG8_BAR; PG8_WAIT_L(0); PG8_MMA(0, 0, At, B0); PG8_BAR; PG8_SCHED;
            PG8_LDB(B1, 0, 1); PG8_STAGE(PG8_SB(0, 0), b2, voffB);
            PG8_BAR; PG8_WAIT_L(0); PG8_MMA(0, 1, At, B1); PG8_BAR;
            PG8_LDA(At, 0, 1); PG8_STAGE(PG8_SA(0, 0), a2, voffA);
            PG8_BAR; PG8_WAIT_L(0); PG8_MMA(1, 0, At, B0); PG8_BAR; PG8_SCHED;
            PG8_STAGE(PG8_SB(0, 1), b2 + hstepB, voffB);
            PG8_WAIT_V(6); PG8_BAR; PG8_MMA(1, 1, At, B1); PG8_BAR;
            PG8_LDB(B0, 1, 0); PG8_SCHED; PG8_LDA(At, 1, 0); PG8_STAGE(PG8_SA(0, 1), a2 + hstepA, voffA);
            PG8_WAIT_L(8); PG8_BAR; PG8_WAIT_L(0); PG8_MMA(0, 0, At, B0); PG8_BAR; PG8_SCHED;
            PG8_LDB(B1, 1, 1); PG8_STAGE(PG8_SB(1, 0), b3, voffB);
            PG8_BAR; PG8_WAIT_L(0); PG8_MMA(0, 1, At, B1); PG8_BAR;
            PG8_LDA(At, 1, 1); PG8_STAGE(PG8_SA(1, 0), a3, voffA);
            PG8_BAR; PG8_WAIT_L(0); PG8_MMA(1, 0, At, B0); PG8_BAR; PG8_SCHED;
            PG8_STAGE(PG8_SB(1, 1), b3 + hstepB, voffB);
            PG8_WAIT_V(6); PG8_BAR; PG8_MMA(1, 1, At, B1); PG8_BAR;
            }
        }
        if constexpr (ALIGN_EPI) { if (wr == 0) PG8_BAR; }
        if constexpr (!Epi::AFTER_DRAIN) { E(acc, cur, wr, wc, fr, fq); S.done(cur); }
        if (!has_next) break;
#pragma unroll
        for (int a = 0; a < 2; ++a)
#pragma unroll
            for (int b = 0; b < 2; ++b)
#pragma unroll
                for (int m = 0; m < 4; ++m)
#pragma unroll
                    for (int n = 0; n < 2; ++n) acc[a][b][m][n] = (f32x4){0.f, 0.f, 0.f, 0.f};
        cur = nxt; cA = nA; cB = nB; ++ui;
        if constexpr (ALIGN_EPI) { if (wr == 1) PG8_BAR; }
    }
    PG8_WAIT_V(0);
    if constexpr (!ALIGN_EPI) { if (wr == 0) PG8_BAR; }
    PG8_BAR;
    if constexpr (Epi::AFTER_DRAIN) { E.fused(acc, cur, wr, wc, fr, fq, lds, wid, lane); S.done(cur); }
#undef PG8_SA
#undef PG8_SB
#undef PG8_STAGE
#undef PG8_LDA
#undef PG8_LDB
#undef PG8_MMA
#undef PG8_WAIT_V
#undef PG8_WAIT_L
#undef PG8_BAR
#undef PG8_SCHED
}
}
#include <hip/hip_bf16.h>
#include <cmath>
namespace attn_body {
using bf16=__hip_bfloat16;
using bf16x8=__attribute__((ext_vector_type(8)))short;
using s16x4=__attribute__((ext_vector_type(4)))short;
using f32x16=__attribute__((ext_vector_type(16)))float;
using u32x4=__attribute__((ext_vector_type(4)))unsigned;
constexpr int D=64,DM=2048,ODM=1024;
constexpr int NW=8,QBLK=32,QB=QBLK*NW,KVBLK=64;
constexpr int ATTN_PITCH=DM, ATTN_UNIT_ROWS=QB;
__device__ __forceinline__ int crow(int r,int hi){return (r&3)+8*(r>>2)+4*hi;}
#define SBAR() __builtin_amdgcn_sched_barrier(0)
__device__ __forceinline__ void cmask(f32x16&p0,f32x16&p1,int jb,int qrel,int hi){
  const float NEG=-INFINITY; int kb=64*jb+4*hi;
  #pragma unroll
  for(int r=0;r<16;++r){int kv=kb+(r&3)+8*(r>>2); if(kv>qrel)p0[r]=NEG; if(kv+32>qrel)p1[r]=NEG;}
}

typedef const __attribute__((address_space(3))) float* lds_fptr;
__device__ __forceinline__ void nabias(f32x16&p0,f32x16&p1,int kr,int qr_,int r32,int wid,int hi,lds_fptr rp){
  const float NEG=-INFINITY;
  asm volatile("":"+v"(r32),"+v"(hi));
  const int qc=32*(wid&1)+r32;
  const int rs=min(max(qr_-4,0),120), cs=min(max(qc-8,0),48);
  if(kr<rs||kr>=rs+8){
    #pragma unroll
    for(int r=0;r<16;++r){p0[r]=NEG;p1[r]=NEG;}
  } else {
    lds_fptr tb=rp+(kr-qr_+7)*31+(15-qc);
    #pragma unroll
    for(int r=0;r<16;++r){
      const int kc=(r&3)+8*(r>>2)+4*hi;
      const bool ok0=(unsigned)(kc-cs)<16u, ok1=(unsigned)(kc+32-cs)<16u;
      const float b0=tb[ok0?kc:cs], b1=tb[ok1?kc+32:cs];
      p0[r]=ok0?p0[r]+b0:NEG; p1[r]=ok1?p1[r]+b1:NEG;
    }
  }
}
constexpr int NSLOT=3, SLOTB=8192;
constexpr int LDS_K=0, LDS_V=NSLOT*SLOTB, LDS_WS=2*NSLOT*SLOTB, LDS_OST=LDS_WS+NW*64*4, LDS_BYTES=LDS_OST+NW*4096;
constexpr float C2=0.125f*1.4426950408889634f;
__device__ __forceinline__ void glds16(const void*gsrc,unsigned lds_dst){unsigned keep;
  asm volatile("s_mov_b32 %0, m0\n\ts_mov_b32 m0, %2\n\ts_nop 0\n\tglobal_load_lds_dwordx4 %1, off\n\ts_mov_b32 m0, %0":"=&s"(keep):"v"(gsrc),"s"(lds_dst):"memory");}
__device__ __forceinline__ float max3f(float a,float b,float c){float r;asm("v_max3_f32 %0, %1, %2, %3":"=v"(r):"v"(a),"v"(b),"v"(c));return r;}
__device__ __forceinline__ float max2f(float a,float b){float r;asm("v_max_f32_e32 %0, %1, %2":"=v"(r):"v"(a),"v"(b));return r;}
__device__ __forceinline__ float fadd_s(float a,float b){float r;asm("v_add_f32_e32 %0, %1, %2":"=v"(r):"v"(a),"v"(b));return r;}
__device__ __forceinline__ float fsub_s(float a,float b){float r;asm("v_sub_f32_e32 %0, %1, %2":"=v"(r):"v"(a),"v"(b));return r;}
typedef float f32x2_t __attribute__((ext_vector_type(2))); typedef __bf16 bf16x2_t __attribute__((ext_vector_type(2)));
__device__ __forceinline__ unsigned cvtpk_s(float lo,float hi){f32x2_t v={lo,hi};bf16x2_t b=__builtin_convertvector(v,bf16x2_t);return __builtin_bit_cast(unsigned,b);}
#define WAIT_BAR(N) asm volatile("s_waitcnt vmcnt(" #N ") lgkmcnt(0)\n\ts_barrier":::"memory")

__device__ __forceinline__ void qkt(f32x16&p0,f32x16&p1,const char*Kslot,const bf16x8*qr,const f32x16&negm,int r32,int hi){
  const char*kb=Kslot+hi*1024+r32*16;
  #pragma unroll
  for(int d0=0;d0<4;++d0){
    const bf16x8 b0=*reinterpret_cast<const bf16x8*>(kb+d0*2048);
    const bf16x8 b1=*reinterpret_cast<const bf16x8*>(kb+d0*2048+512);
    if(d0==0){p0=__builtin_amdgcn_mfma_f32_32x32x16_bf16(b0,qr[0],negm,0,0,0);p1=__builtin_amdgcn_mfma_f32_32x32x16_bf16(b1,qr[0],negm,0,0,0);}
    else{p0=__builtin_amdgcn_mfma_f32_32x32x16_bf16(b0,qr[d0],p0,0,0,0);p1=__builtin_amdgcn_mfma_f32_32x32x16_bf16(b1,qr[d0],p1,0,0,0);}}
}
typedef __attribute__((address_space(3))) const char* lds_cptr;
typedef short v4i16_t __attribute__((ext_vector_type(4)));
__device__ __forceinline__ void kload8(bf16x8*kf,lds_cptr kp){
  kf[0]=*(const __attribute__((address_space(3))) bf16x8*)(kp);      kf[1]=*(const __attribute__((address_space(3))) bf16x8*)(kp+512);
  kf[2]=*(const __attribute__((address_space(3))) bf16x8*)(kp+2048); kf[3]=*(const __attribute__((address_space(3))) bf16x8*)(kp+2560);
  kf[4]=*(const __attribute__((address_space(3))) bf16x8*)(kp+4096); kf[5]=*(const __attribute__((address_space(3))) bf16x8*)(kp+4608);
  kf[6]=*(const __attribute__((address_space(3))) bf16x8*)(kp+6144); kf[7]=*(const __attribute__((address_space(3))) bf16x8*)(kp+6656);
}
__device__ __forceinline__ void kload2(bf16x8*kf,lds_cptr kp,int j){ kf[2*j]=*(const __attribute__((address_space(3))) bf16x8*)(kp+j*2048); kf[2*j+1]=*(const __attribute__((address_space(3))) bf16x8*)(kp+j*2048+512); }
__device__ __forceinline__ s16x4 vtr(lds_cptr p){ return __builtin_bit_cast(s16x4,__builtin_amdgcn_ds_read_tr16_b64_v4i16((__attribute__((address_space(3))) v4i16_t*)p)); }
__device__ __forceinline__ float rowmax(const f32x16&p0,const f32x16&p1){
  float a=max3f(p0[0],p0[1],p1[0]),b=max3f(p0[2],p0[3],p1[1]);a=max3f(a,p1[2],p1[3]);
  #pragma unroll
  for(int r=4;r<16;r+=4){a=max3f(a,p0[r],p0[r+1]);b=max3f(b,p0[r+2],p0[r+3]);a=max3f(a,p1[r],p1[r+1]);b=max3f(b,p1[r+2],p1[r+3]);}
  const float m=max2f(a,b);
  auto rr=__builtin_amdgcn_permlane32_swap(__float_as_uint(m),__float_as_uint(m),false,false);
  return max2f(__uint_as_float(rr[0]),__uint_as_float(rr[1]));
}
__device__ __forceinline__ void pv(f32x16*o,int vb,bf16x8 pa0,bf16x8 pa1,bf16x8 pa2,bf16x8 pa3){
  #pragma unroll
  for(int d0=0;d0<2;++d0){s16x4 lo[4],hi[4];
    #pragma unroll
    for(int ks=0;ks<4;++ks){
      asm volatile("ds_read_b64_tr_b16 %0,%1 offset:%c2":"=&v"(lo[ks]):"v"(vb),"i"(d0*4096+ks*1024):"memory");
      asm volatile("ds_read_b64_tr_b16 %0,%1 offset:%c2":"=&v"(hi[ks]):"v"(vb),"i"(d0*4096+ks*1024+512):"memory");}
    asm volatile("s_waitcnt lgkmcnt(0)":::"memory");SBAR();
    #define PK(k) (bf16x8){lo[k][0],lo[k][1],lo[k][2],lo[k][3],hi[k][0],hi[k][1],hi[k][2],hi[k][3]}
    o[d0]=__builtin_amdgcn_mfma_f32_32x32x16_bf16(pa0,PK(0),o[d0],0,0,0);
    o[d0]=__builtin_amdgcn_mfma_f32_32x32x16_bf16(pa1,PK(1),o[d0],0,0,0);
    o[d0]=__builtin_amdgcn_mfma_f32_32x32x16_bf16(pa2,PK(2),o[d0],0,0,0);
    o[d0]=__builtin_amdgcn_mfma_f32_32x32x16_bf16(pa3,PK(3),o[d0],0,0,0);
    #undef PK
  }
}

#ifndef ATTN_STORE16
#define ATTN_STORE16(p,v) (*(u32x4*)(p)=(v))
#endif
template<int THRL,int MODE> __device__ __forceinline__ void attn_unit(const bf16*Qw0,const bf16*__restrict__ Kh,const bf16*__restrict__ Vh,bf16*Ow0,const int NT,const int lat_off,const int na_r0,const int na_rsmin,const int rpb_off,char*shm){
  const int tid=ltid(),lane=tid&63,r32=lane&31,hi=lane>>5; const int wid=__builtin_amdgcn_readfirstlane(tid>>6);
  const bf16*Qw=Qw0+(long)(wid*QBLK)*DM;
  const unsigned lds0=(unsigned)(uintptr_t)shm;
  float*wsf=(float*)(shm+LDS_WS)+wid*64;
  const bf16*ksrc=Kh+(long)lane*DM+wid*8;
  const bf16*vsrc=Vh+(long)(16*(wid&3)+(lane>>2))*DM+(wid>>2)*32+(lane&3)*8;
  const unsigned kdst=lds0+LDS_K+wid*1024, vdst=lds0+LDS_V+wid*1024;
  #define TROW(t) (((t)<4)?(t)*64:lat_off+((t)-4)*64)
  #define DMA_K(t,slot) glds16(ksrc+(long)TROW(t)*DM,(unsigned)__builtin_amdgcn_readfirstlane(kdst+(slot)))
  #define DMA_V(t,slot) glds16(vsrc+(long)TROW(t)*DM,(unsigned)__builtin_amdgcn_readfirstlane(vdst+(slot)))
  const int vb0=(int)(lds0+LDS_V)+((lane>>4)&1)*32+(lane&3)*8+(4*hi+((lane&15)>>2))*64;
  const char*Kbase=shm+LDS_K; bf16x8 kf[8];
  const lds_cptr shm3=(lds_cptr)shm; const lds_cptr kp0=shm3+LDS_K+hi*1024+r32*16; const lds_cptr vp0=shm3+LDS_V+((lane>>4)&1)*32+(lane&3)*8+(4*hi+((lane&15)>>2))*64;
  DMA_K(0,0);DMA_V(0,0);DMA_K(1,SLOTB);
  bf16x8 qr[4];
  #pragma unroll
  for(int d0=0;d0<4;++d0)qr[d0]=*reinterpret_cast<const bf16x8*>(&Qw[(long)r32*DM+d0*16+hi*8]);
  float mhat=0.f,l_reg=0.f;f32x16 o[2];o[0]=f32x16{};o[1]=f32x16{};f32x16 negm=f32x16{};asm volatile("":"+v"(negm));
  const lds_fptr rp_=(lds_fptr)(shm3+rpb_off); const int na_qr=na_r0+(wid>>1);
  #define CMASK(P0,P1,t) do{ if(MODE==1 && (t)>=4) nabias(P0,P1,na_rsmin+(t)-4,na_qr,r32,wid,hi,rp_); }while(0)
  bool resc=false;
  #define START(P0,P1) do{ const float rm=rowmax(P0,P1); resc=false; \
    { const float dl=rm; mhat=fadd_s(mhat,dl); \
      _Pragma("unroll") for(int r=0;r<16;++r){P0[r]=fsub_s(P0[r],dl);P1[r]=fsub_s(P1[r],dl);} \
      _Pragma("unroll") for(int r=0;r<16;++r)negm[r]=-mhat; asm volatile("":"+v"(negm)); } \
    _Pragma("unroll") for(int r=0;r<16;++r)P0[r]=__builtin_amdgcn_exp2f(P0[r]); }while(0)
  #define RESC() do{ if(resc){ asm volatile("s_waitcnt lgkmcnt(0)":::"memory"); \
      _Pragma("unroll") for(int d_=0;d_<2;++d_) _Pragma("unroll") for(int r=0;r<16;++r)o[d_][r]*=wsf[crow(r,hi)]; } }while(0)
  f32x16 pA0,pA1,pB0,pB1;
  int sl_prev=0,sl_cur=0,sl_next=SLOTB;
  #define ROT() do{sl_prev=sl_cur;sl_cur=sl_next;sl_next=(sl_next==(NSLOT-1)*SLOTB)?0:sl_next+SLOTB;}while(0)
  DMA_K(2,2*SLOTB);
  WAIT_BAR(3);
  qkt(pA0,pA1,Kbase,qr,negm,r32,hi);asm volatile("s_nop 15\n\ts_nop 7":"+v"(pA0),"+v"(pA1));CMASK(pA0,pA1,0);
  START(pA0,pA1);
  _Pragma("unroll") for(int r=0;r<16;++r)pA1[r]=__builtin_amdgcn_exp2f(pA1[r]);
  WAIT_BAR(0);
  DMA_K(3,0);DMA_V(1,SLOTB);
  ROT();
  kload8(kf,kp0+sl_cur);
  WAIT_BAR(2);
  s16x4 vlo[8],vhi[8]; u32x4 pw0,pw1,pw2,pw3;
  #define PKW(P,B) cvtpk_s(P[B],P[B+1])
  #define PAF(k) __builtin_bit_cast(bf16x8,pw##k)
  #define VFR(i) (bf16x8){vlo[i][0],vlo[i][1],vlo[i][2],vlo[i][3],vhi[i][0],vhi[i][1],vhi[i][2],vhi[i][3]}
  #define PIN(x) asm volatile("":"+v"(x))
  #define MX3(a,b,c) __builtin_fmaxf(__builtin_fmaxf((a),(b)),(c))
  #define GAPA(MF,A0,A1,A2,A3,W0,W1,PW) do{ MF; sacc+=A0; sacc+=A1; sacc+=A2; sacc+=A3; PIN(sacc); W0; W1; PIN(PW); SBAR(); }while(0)
  #define EX(v) __builtin_amdgcn_exp2f(v)
  #define GAPB(MF,X,B) do{ MF; X[B]=EX(X[B]); X[B+1]=EX(X[B+1]); X[B+2]=EX(X[B+2]); X[B+3]=EX(X[B+3]); PIN(X); SBAR(); }while(0)
  #define VRD(i) do{ vlo[i]=vtr(vp_+(((i)>>2)*4096+((i)&3)*1024)); vhi[i]=vtr(vp_+(((i)>>2)*4096+((i)&3)*1024+512)); }while(0)
  #define KRD(G,j) do{ if(G){ kload2(kf,kp0+sl_next,j); SBAR(); } }while(0)
  #define STEP(C0,C1,P0,P1,t,GK,GV,GL) do{ SBAR(); \
    const lds_cptr vp_=vp0+sl_prev; \
    VRD(0); SBAR(); float sacc=(P0[0]+P0[1]); \
    GAPA(C0=__builtin_amdgcn_mfma_f32_32x32x16_bf16(kf[0],qr[0],negm,0,0,0), P0[2],P0[3],P0[4],P0[5],     pw0[0]=PKW(P0,0), pw0[1]=PKW(P0,2), pw0); \
    VRD(4); SBAR(); GAPA(C1=__builtin_amdgcn_mfma_f32_32x32x16_bf16(kf[1],qr[0],negm,0,0,0), P0[6],P0[7],P0[8],P0[9],     pw0[2]=PKW(P0,4), pw0[3]=PKW(P0,6), pw0); \
    VRD(1); SBAR(); GAPA(C0=__builtin_amdgcn_mfma_f32_32x32x16_bf16(kf[2],qr[1],C0,0,0,0),   P0[10],P0[11],P0[12],P0[13], pw1[0]=PKW(P0,8), pw1[1]=PKW(P0,10), pw1); \
    VRD(5); SBAR(); GAPA(C1=__builtin_amdgcn_mfma_f32_32x32x16_bf16(kf[3],qr[1],C1,0,0,0),   P0[14],P0[15],P1[0],P1[1],   pw1[2]=PKW(P0,12),pw1[3]=PKW(P0,14), pw1); \
    VRD(2); SBAR(); GAPA(C0=__builtin_amdgcn_mfma_f32_32x32x16_bf16(kf[4],qr[2],C0,0,0,0),   P1[2],P1[3],P1[4],P1[5],     pw2[0]=PKW(P1,0), pw2[1]=PKW(P1,2), pw2); \
    VRD(6); SBAR(); GAPA(C1=__builtin_amdgcn_mfma_f32_32x32x16_bf16(kf[5],qr[2],C1,0,0,0),   P1[6],P1[7],P1[8],P1[9],     pw2[2]=PKW(P1,4), pw2[3]=PKW(P1,6), pw2); \
    VRD(3); SBAR(); GAPA(C0=__builtin_amdgcn_mfma_f32_32x32x16_bf16(kf[6],qr[3],C0,0,0,0),   P1[10],P1[11],P1[12],P1[13], pw3[0]=PKW(P1,8), pw3[1]=PKW(P1,10), pw3); \
    VRD(7); SBAR(); GAPA(C1=__builtin_amdgcn_mfma_f32_32x32x16_bf16(kf[7],qr[3],C1,0,0,0),   P1[14],P1[15],0.f,0.f,       pw3[2]=PKW(P1,12),pw3[3]=PKW(P1,14), pw3); \
    l_reg+=sacc; \
    if(GK){DMA_K((t)+3,sl_cur);} if(GV){DMA_V((t)+1,sl_next);} \
    CMASK(C0,C1,t); \
    { float a=MX3(C0[0],C0[1],C1[0]),b=MX3(C0[2],C0[3],C1[1]); a=MX3(a,C1[2],C1[3]); \
      _Pragma("unroll") for(int r=4;r<16;r+=4){a=MX3(a,C0[r],C0[r+1]);b=MX3(b,C0[r+2],C0[r+3]);a=MX3(a,C1[r],C1[r+1]);b=MX3(b,C1[r+2],C1[r+3]);} \
      float rm=__builtin_fmaxf(a,b); { auto rr=__builtin_amdgcn_permlane32_swap(__float_as_uint(rm),__float_as_uint(rm),false,false); rm=__builtin_fmaxf(__uint_as_float(rr[0]),__uint_as_float(rr[1])); } \
      resc=false; \
      if(__builtin_expect(__any(rm>(float)THRL),0)){ const float dl=__builtin_fmaxf(rm,0.f); mhat+=dl; \
        _Pragma("unroll") for(int r=0;r<16;++r){C0[r]-=dl;C1[r]-=dl;} \
        _Pragma("unroll") for(int r=0;r<16;++r)negm[r]=-mhat; asm volatile("":"+v"(negm)); \
        const float f=__builtin_amdgcn_exp2f(-dl); l_reg*=f; if(hi==0)wsf[r32]=f; resc=true; } } \
    SBAR(); \
    GAPB(o[0]=__builtin_amdgcn_mfma_f32_32x32x16_bf16(PAF(0),VFR(0),o[0],0,0,0), C0,0); \
    GAPB(o[1]=__builtin_amdgcn_mfma_f32_32x32x16_bf16(PAF(0),VFR(4),o[1],0,0,0), C0,4); \
    KRD(GL,0); GAPB(o[0]=__builtin_amdgcn_mfma_f32_32x32x16_bf16(PAF(1),VFR(1),o[0],0,0,0), C0,8); \
    KRD(GL,1); GAPB(o[1]=__builtin_amdgcn_mfma_f32_32x32x16_bf16(PAF(1),VFR(5),o[1],0,0,0), C0,12); \
    KRD(GL,2); GAPB(o[0]=__builtin_amdgcn_mfma_f32_32x32x16_bf16(PAF(2),VFR(2),o[0],0,0,0), C1,0); \
    KRD(GL,3); GAPB(o[1]=__builtin_amdgcn_mfma_f32_32x32x16_bf16(PAF(2),VFR(6),o[1],0,0,0), C1,4); \
    GAPB(o[0]=__builtin_amdgcn_mfma_f32_32x32x16_bf16(PAF(3),VFR(3),o[0],0,0,0), C1,8); \
    GAPB(o[1]=__builtin_amdgcn_mfma_f32_32x32x16_bf16(PAF(3),VFR(7),o[1],0,0,0), C1,12); \
    }while(0)
  int t=1;
  #undef CMASK
  #define CMASK(P0,P1,t) do{ if(MODE==1 && (t)>=4) nabias(P0,P1,na_rsmin+(t)-4,na_qr,r32,wid,hi,rp_); }while(0)
  for(;t+5<NT;t+=2){
    STEP(pB0,pB1,pA0,pA1,t,true,true,true);     WAIT_BAR(2); RESC(); ROT();
    STEP(pA0,pA1,pB0,pB1,t+1,true,true,true);   WAIT_BAR(2); RESC(); ROT();
  }
  #undef CMASK
  #define CMASK(P0,P1,t) do{ if(MODE==1 && (t)>=4) nabias(P0,P1,na_rsmin+(t)-4,na_qr,r32,wid,hi,rp_); }while(0)
  #define ENDW(tt) do{ if((tt)+3<NT){WAIT_BAR(2);} else if((tt)+2<NT){WAIT_BAR(1);} else {WAIT_BAR(0);} }while(0)
  for(;t+1<NT;t+=2){
    STEP(pB0,pB1,pA0,pA1,t,(t+3<NT),(t+1<NT),(t+1<NT));       ENDW(t);   RESC(); ROT();
    STEP(pA0,pA1,pB0,pB1,t+1,(t+4<NT),(t+2<NT),(t+2<NT));     ENDW(t+1); RESC(); ROT();
  }
  STEP(pB0,pB1,pA0,pA1,NT-1,false,false,false); RESC();
  { float sacc=pB0[0]+pB0[1]; _Pragma("unroll") for(int r=2;r<16;++r)sacc+=pB0[r]; _Pragma("unroll") for(int r=0;r<16;++r)sacc+=pB1[r]; l_reg+=sacc;
    pw0=(u32x4){PKW(pB0,0),PKW(pB0,2),PKW(pB0,4),PKW(pB0,6)};pw1=(u32x4){PKW(pB0,8),PKW(pB0,10),PKW(pB0,12),PKW(pB0,14)};pw2=(u32x4){PKW(pB1,0),PKW(pB1,2),PKW(pB1,4),PKW(pB1,6)};pw3=(u32x4){PKW(pB1,8),PKW(pB1,10),PKW(pB1,12),PKW(pB1,14)};
    SBAR(); pv(o,vb0+sl_cur,PAF(0),PAF(1),PAF(2),PAF(3)); }
  #undef PKW
  #undef PAF
  #undef VFR
  #undef PIN
  #undef MX3
  #undef GAPA
  #undef GAPB
  #undef EX
  #undef VRD
  #undef KRD
  #undef STEP
  #undef ENDW
  {auto rr=__builtin_amdgcn_permlane32_swap(__float_as_uint(l_reg),__float_as_uint(l_reg),false,false);l_reg=__uint_as_float(rr[0])+__uint_as_float(rr[1]);}
  if(hi==0)wsf[32+r32]=l_reg;asm volatile("s_waitcnt lgkmcnt(0)":::"memory");
  float rli[16];
  #pragma unroll
  for(int r=0;r<16;++r)rli[r]=__builtin_amdgcn_rcpf(wsf[32+crow(r,hi)]);
  bf16*Ow=Ow0+(long)(wid*QBLK)*ODM;
  { bf16*stg=(bf16*)(shm+LDS_OST)+wid*2048;
    #pragma unroll
    for(int r=0;r<16;++r){const int orow=crow(r,hi);
      #pragma unroll
      for(int d0=0;d0<2;++d0)stg[orow*64+d0*32+r32]=__float2bfloat16(o[d0][r]*rli[r]);}
    asm volatile("s_waitcnt lgkmcnt(0)":::"memory");
    #pragma unroll
    for(int i=0;i<4;++i){const int row=i*8+(lane>>3),ch=lane&7; const u32x4 v=*(const u32x4*)(stg+row*64+ch*8); ATTN_STORE16(Ow+(long)row*ODM+ch*8,v);} }
  asm volatile("s_waitcnt lgkmcnt(0)\n\ts_barrier":::"memory");
  #undef DMA_K
  #undef TROW
  #undef DMA_V
  #undef CMASK
  #undef START
  #undef RESC
  #undef ROT
}
constexpr int ATTN_LDS_BYTES=LDS_BYTES;
}
#ifndef DBG_MASK
#define DBG_MASK 127
#endif
#ifndef DBG_DIAG
#define DBG_DIAG 0
#endif
#ifndef DBG_NA
#define DBG_NA 1
#endif
#ifndef DBG_CTX
#define DBG_CTX 1
#endif
#ifndef DBG_POOL
#define DBG_POOL 1
#endif
namespace cg = cooperative_groups;
#define GAS __attribute__((address_space(1)))
#define LAS __attribute__((address_space(3)))
typedef unsigned short bf16;
typedef unsigned v4u __attribute__((ext_vector_type(4)));
typedef float f32x4 __attribute__((ext_vector_type(4)));
#define LDS_WAIT() asm volatile("s_waitcnt lgkmcnt(0)" ::: "memory")
__device__ __forceinline__ unsigned f2bf(float f) { unsigned u = __builtin_bit_cast(unsigned, f); return (u + 0x7fffu + ((u >> 16) & 1u)) >> 16; }
__device__ __forceinline__ unsigned pk2(float lo, float hi) { return f2bf(lo) | (f2bf(hi) << 16); }
__device__ __forceinline__ float bf2f(unsigned short h) { return __builtin_bit_cast(float, (unsigned)h << 16); }
__device__ __forceinline__ float wave_sum(float v) {
#pragma unroll
    for (int o = 1; o < 64; o <<= 1) v += __shfl_xor(v, o);
    return v;
}
#define RLX_AGENT __ATOMIC_RELAXED, __HIP_MEMORY_SCOPE_AGENT
#define XB_TMO      128
#define XB_XCNT(j)  (256  + 64 * (j))
#define XB_XSUB(j)  (1280 + 64 * (j))
#define XB_XGEN(j)  (2304 + 64 * (j))
#define XB_TOP      3328
#define XB_TOPGEN   3392
#define XCD_BAR_WORDS 3456
#define XB_SPIN_CAP (1u << 18)

__device__ __forceinline__ unsigned xb_ld(unsigned* p)              { return __hip_atomic_load(p, __ATOMIC_RELAXED, __HIP_MEMORY_SCOPE_AGENT); }
__device__ __forceinline__ unsigned xb_add(unsigned* p, unsigned v) { return __hip_atomic_fetch_add(p, v, __ATOMIC_RELAXED, __HIP_MEMORY_SCOPE_AGENT); }
__device__ __forceinline__ unsigned xb_xcc_id() { return (unsigned)__builtin_amdgcn_s_getreg((3 << 11) | 20) & 0xFu; }
#define XB_SPIN(cond, bar) do { unsigned _sp = 0; while (cond) { __builtin_amdgcn_s_sleep(1); \
    if ((++_sp & 255u) == 0u) { if (xb_ld(&(bar)[XB_TMO])) break; if (_sp > XB_SPIN_CAP) { atomicAdd(&(bar)[XB_TMO], 1u); break; } } } } while (0)

struct XcdBarrier {
    unsigned* bar; unsigned x;
    volatile LAS unsigned* st;
};

__device__ __forceinline__ XcdBarrier xcd_barrier_post(unsigned* bar, volatile LAS unsigned* st) {
    XcdBarrier b; b.bar = bar; b.x = xb_xcc_id(); b.st = st;
    if (threadIdx.x == 0) (void)xb_add(&bar[XB_XCNT(b.x)], 1u);
    return b;
}
__device__ __forceinline__ void xcd_barrier_complete(unsigned* bar, unsigned x, unsigned& nloc, unsigned& nx) {
    const unsigned G = gridDim.x * gridDim.y * gridDim.z;
    unsigned sum, cnt, mine, sp = 0u;
    for (;;) {
        sum = 0u; cnt = 0u; mine = 0u;
#pragma unroll
        for (unsigned j = 0; j < 16; ++j) { const unsigned c = xb_ld(&bar[XB_XCNT(j)]); sum += c; cnt += (c > 0u) ? 1u : 0u; mine = (j == x) ? c : mine; }
        if (sum == G) break;
        __builtin_amdgcn_s_sleep(1);
        if ((++sp & 255u) == 0u) { if (xb_ld(&bar[XB_TMO])) break; if (sp > XB_SPIN_CAP) { atomicAdd(&bar[XB_TMO], 1u); break; } }
    }
    nloc = mine > 0u ? mine : 1u; nx = cnt > 0u ? cnt : 1u;
}

__device__ __forceinline__ void xcd_barrier(const XcdBarrier& b) {
    asm volatile("s_waitcnt vmcnt(0)" ::: "memory");
    __syncthreads();
    if (threadIdx.x == 0) {
        unsigned* bar = b.bar;
        __builtin_amdgcn_s_waitcnt(0);
        unsigned nloc = b.st[0], nx = b.st[1];
        if (nloc == 0u) { xcd_barrier_complete(bar, b.x, nloc, nx); b.st[0] = nloc; b.st[1] = nx; }
        const unsigned old = xb_add(&bar[XB_XSUB(b.x)], 1u);
        const unsigned gen = old / nloc;
        if (old + 1u == (gen + 1u) * nloc) {
            __builtin_amdgcn_fence(__ATOMIC_RELEASE, "agent");
            asm volatile("s_waitcnt vmcnt(0)" ::: "memory");
            const unsigned og = xb_add(&bar[XB_TOP], 1u);
            const unsigned tg = og / nx;
            if (og + 1u == (tg + 1u) * nx) xb_add(&bar[XB_TOPGEN], 1u);
            else XB_SPIN(xb_ld(&bar[XB_TOPGEN]) == tg, bar);
            __builtin_amdgcn_fence(__ATOMIC_ACQUIRE, "agent");
            xb_add(&bar[XB_XGEN(b.x)], 1u);
            asm volatile("s_waitcnt vmcnt(0)" ::: "memory");
        } else {
            XB_SPIN(xb_ld(&bar[XB_XGEN(b.x)]) == gen, bar);
            __builtin_amdgcn_fence(__ATOMIC_ACQUIRE, "agent");
            asm volatile("s_waitcnt vmcnt(0)" ::: "memory");
        }
    }
    __syncthreads();
}
constexpr size_t MiB = 1u << 20;
constexpr size_t WS_MOD = 0, WS_ROPEC = 1 * MiB, WS_ROPES = 1 * MiB + 8192, WS_BAR = 1 * MiB + 131072;
constexpr size_t WS_WIN = 2 * MiB, WS_WOUT = 18 * MiB, WS_WUP = 26 * MiB, WS_WDN = 70 * MiB;
constexpr size_t WS_ST = 92 * MiB, WS_X = 94 * MiB, WS_H = 359 * MiB, WS_Z = 492 * MiB, WS_Y = 756 * MiB, WS_ACT = WS_Z, WS_END = 888 * MiB;
static_assert(WS_WIN + (size_t)P_DEPTH * P_INW * P_D * 2 <= WS_WOUT && WS_WOUT + (size_t)P_DEPTH * P_D * P_D * 2 <= WS_WUP && WS_WUP + (size_t)P_DEPTH * P_UPW * P_D * 2 <= WS_WDN && WS_WDN + (size_t)P_DEPTH * P_D * P_DFF * 2 <= WS_ST && WS_ST + (size_t)P_M * 8 <= WS_X, "weights map");
static_assert(WS_X + (size_t)P_M * P_D * 4 <= WS_H - MiB / 2 && WS_H + (size_t)P_M * P_D * 2 + MiB / 2 <= WS_Z && WS_Z + (size_t)P_M * P_INW * 2 <= WS_Y && WS_Y + (size_t)P_M * P_D * 2 <= WS_END && WS_ACT + (size_t)P_M * P_DFF * 2 <= WS_END, "activation map");
constexpr int LDS_BYTES = 147456, RPB_OFF = 98304, BARST_OFF = 131072 + 64;
#ifndef DBG_REP
#define DBG_REP -1
#endif
constexpr int PH_PER_L = (DBG_REP >= 0) ? 8 : 7;
#ifndef DBG_P0REP
#define DBG_P0REP 0
#endif
constexpr int N_PHASES = 2 + PH_PER_L * P_DEPTH + 2 * DBG_P0REP;

struct Args {
    const float *x, *c, *ctx, *c_ctx, *w_mod, *b_mod, *w_in, *pool_w, *pool_scale, *na_rpb, *q_norm, *k_norm, *w_out, *ln1_g, *ln1_b, *w_up, *conv_w, *conv_b, *w_down, *ln2_g, *ln2_b;
    float* out; unsigned char* ws; int ph_lo, ph_hi;
};
static_assert(sizeof(Args) == 23 * 8 + 8, "Args has no padding");

template <int OFF> __device__ __forceinline__ unsigned long long ldarg() {
    unsigned long long v; asm volatile("s_load_dwordx2 %0, %1, %2\n\ts_waitcnt lgkmcnt(0)" : "=s"(v) : "s"(__builtin_amdgcn_kernarg_segment_ptr()), "n"(OFF)); return v; }
#define ARGF(A, f) (A).f = (decltype(Args::f))ldarg<offsetof(Args, f)>()
__device__ __forceinline__ void p0_item(const float* W, int K, int N, bf16* WT, int k0, int n0, int drow, LAS float* scr, int lane) {
#pragma unroll 8
    for (int i = 0; i < 32; ++i) { const int kk = 2 * i + (lane >> 5); scr[kk * 33 + (lane & 31)] = W[(size_t)(k0 + kk) * N + n0 + (lane & 31)]; }
    LDS_WAIT(); asm volatile("" ::: "memory");
    const int c = lane & 7;
#pragma unroll
    for (int j = 0; j < 4; ++j) { const int n = (lane >> 3) + 8 * j; const LAS float* s = scr + (8 * c) * 33 + n;
        v4u o; o.x = pk2(s[0 * 33], s[1 * 33]); o.y = pk2(s[2 * 33], s[3 * 33]); o.z = pk2(s[4 * 33], s[5 * 33]); o.w = pk2(s[6 * 33], s[7 * 33]);
        *(GAS v4u*)(WT + (size_t)(drow + n) * K + k0 + 8 * c) = o; }
    LDS_WAIT(); asm volatile("" ::: "memory");
}

__device__ __forceinline__ void phase0(const Args& a, LAS unsigned char* lds, int vcu, int G, int tid, int lane, int wave) {
    unsigned char* ws = a.ws;
    {
        LAS float* scr = (LAS float*)(lds + wave * 16384);
        const int gw = vcu * 8 + wave, NGW = G * 8;
        constexpr int I_IN = 16 * 64, I_OUT = 16 * 32, I_UP = 16 * 176, I_DN = 44 * 32, I_L = I_IN + I_OUT + I_UP + I_DN;
        for (int it = gw; it < P_DEPTH * I_L; it += NGW) {
            const int l = it / I_L; int r = it - l * I_L;
            if (r < I_IN) { const int kb = r >> 6, nb = r & 63, L0 = 32 * nb; const int drow = (L0 & ~255) + ((L0 >> 5) & 1) * 128 + ((L0 >> 6) & 3) * 32;
                p0_item(a.w_in + (size_t)l * P_D * P_INW, P_D, P_INW, (bf16*)(ws + WS_WIN) + (size_t)l * P_INW * P_D, 64 * kb, 32 * nb, drow, scr, lane); continue; }
            r -= I_IN;
            if (r < I_OUT) { const int kb = r >> 5, nb = r & 31;
                p0_item(a.w_out + (size_t)l * P_D * P_D, P_D, P_D, (bf16*)(ws + WS_WOUT) + (size_t)l * P_D * P_D, 64 * kb, 32 * nb, 32 * nb, scr, lane); continue; }
            r -= I_OUT;
            if (r < I_UP) { const int kb = r / 176, nb = r - kb * 176, L0 = 32 * nb; const int half = L0 >= P_DFF ? 1 : 0, ch0 = L0 - half * P_DFF; const int drow = (ch0 >> 7) * 256 + half * 128 + (ch0 & 127);
                p0_item(a.w_up + (size_t)l * P_D * P_UPW, P_D, P_UPW, (bf16*)(ws + WS_WUP) + (size_t)l * P_UPW * P_D, 64 * kb, 32 * nb, drow, scr, lane); continue; }
            r -= I_UP;
            { const int kb = r >> 5, nb = r & 31;
                p0_item(a.w_down + (size_t)l * P_DFF * P_D, P_DFF, P_D, (bf16*)(ws + WS_WDN) + (size_t)l * P_D * P_DFF, 64 * kb, 32 * nb, 32 * nb, scr, lane); }
        }
    }
    __syncthreads();
    if (vcu < 192) {
        LAS float* act = (LAS float*)lds; LAS float* red = (LAS float*)(lds + 40960);
        for (int e = tid; e < 9 * P_D; e += 512) { const int r = e >> 10, k = e & 1023; const float v = r < 8 ? a.c[r * P_D + k] : a.c_ctx[k]; act[e] = v / (1.0f + expf(-v)); }
        __syncthreads();
        for (int u = vcu; u < 192; u += G) {
            const int l = u / 48, n0 = (u - l * 48) * 128, col = tid & 127, ks = tid >> 7;
            const float* wp = a.w_mod + (size_t)l * P_D * P_MODW + (size_t)(ks * 256) * P_MODW + n0 + col;
            float s[9];
#pragma unroll
            for (int r = 0; r < 9; ++r) s[r] = 0.f;
#pragma unroll 4
            for (int k = 0; k < 256; ++k) { const float w = wp[(size_t)k * P_MODW];
#pragma unroll
                for (int r = 0; r < 9; ++r) s[r] += act[r * P_D + ks * 256 + k] * w; }
#pragma unroll
            for (int r = 0; r < 9; ++r) red[(ks * 9 + r) * 128 + col] = s[r];
            __syncthreads();
            for (int e = tid; e < 9 * 128; e += 512) { const int r = e >> 7, cc = e & 127;
                const float t = (red[(0 * 9 + r) * 128 + cc] + red[(1 * 9 + r) * 128 + cc]) + (red[(2 * 9 + r) * 128 + cc] + red[(3 * 9 + r) * 128 + cc]);
                ((float*)(ws + WS_MOD))[(size_t)(l * 9 + r) * P_MODW + n0 + cc] = t + a.b_mod[l * P_MODW + n0 + cc]; }
            __syncthreads();
        }
    }
    if (vcu == G - 1) {
        for (int e = tid; e < 2048; e += 512) { const int pos = e >> 4, f = e & 15;
            const float inv = exp2f(-(float)f * (13.287712379549449f / 16.0f));
            const float ang = (float)pos * inv;
            ((float*)(ws + WS_ROPEC))[e] = cosf(ang); ((float*)(ws + WS_ROPES))[e] = sinf(ang); }
    }
}

template <int KIND> __device__ __forceinline__ void row_phase(const Args& a, int l, int vcu, int G, int wave, int lane) {
    unsigned char* ws = a.ws; const float* X = (const float*)(ws + WS_X); bf16* H = (bf16*)(ws + WS_H); const float* mod = (const float*)(ws + WS_MOD); float* ST = (float*)(ws + WS_ST);
    const int gw = vcu * 8 + wave, NGW = G * 8;
    const bool lastl = (KIND == 2 && l == P_DEPTH - 1);
    const int ml = (KIND == 2) ? l + 1 : l; const int csh = (KIND == 1) ? 3 : 0, csc = (KIND == 1) ? 4 : 1;
    const float* lg = (KIND == 1 ? a.ln1_g : a.ln2_g) + l * P_D; const float* lb = (KIND == 1 ? a.ln1_b : a.ln2_b) + l * P_D;
    const int NR = lastl ? P_B * P_SEQ : P_M;
#define ROW_OF(i) (lastl ? (i) + (((i) >> 13) + 1) * P_CTX : (i))
#define ROW_SRC(m_, b_, rb_) ((KIND == 0) ? ((rb_) < P_CTX ? a.ctx + ((size_t)(b_) * P_CTX + (rb_)) * P_D : a.x + ((size_t)(b_) * P_SEQ + ((rb_) - P_CTX)) * P_D) : X + (size_t)(m_) * P_D)
    f32x4 vn[4];
    if (gw < NR) { const int m0 = ROW_OF(gw); const int b0 = m0 / P_RPB, rb0 = m0 - b0 * P_RPB; const f32x4* xr = (const f32x4*)ROW_SRC(m0, b0, rb0) + lane;
#pragma unroll
        for (int j = 0; j < 4; ++j) vn[j] = xr[64 * j]; }
    for (int i = gw; i < NR; i += NGW) {
        const int m = ROW_OF(i);
        const int b = m / P_RPB, rb = m - b * P_RPB; const bool is_ctx = rb < P_CTX; const int mrow = is_ctx ? 8 : b;
        f32x4 v[4];
#pragma unroll
        for (int j = 0; j < 4; ++j) v[j] = vn[j];
        if (i + NGW < NR) { const int m1 = ROW_OF(i + NGW); const int b1 = m1 / P_RPB, rb1 = m1 - b1 * P_RPB; const f32x4* xr = (const f32x4*)ROW_SRC(m1, b1, rb1) + lane;
#pragma unroll
            for (int j = 0; j < 4; ++j) vn[j] = xr[64 * j]; }
        if (KIND != 0) {
            float s = 0.f;
#pragma unroll
            for (int j = 0; j < 4; ++j) s += (v[j].x + v[j].y) + (v[j].z + v[j].w);
            const float mean = wave_sum(s) * (1.f / P_D); float s2 = 0.f;
#pragma unroll
            for (int j = 0; j < 4; ++j) { v[j] = v[j] - mean; s2 += (v[j].x * v[j].x + v[j].y * v[j].y) + (v[j].z * v[j].z + v[j].w * v[j].w); }
            const float rstd = 1.f / sqrtf(wave_sum(s2) * (1.f / P_D) + P_EPS);
            if (!lastl && lane == 0) { ST[(size_t)m * 2] = mean; ST[(size_t)m * 2 + 1] = rstd; }
#pragma unroll
            for (int j = 0; j < 4; ++j) { const f32x4 g = ((const f32x4*)lg)[lane + 64 * j], bb = ((const f32x4*)lb)[lane + 64 * j]; v[j] = v[j] * rstd * g + bb; }
        }
        if (lastl) {
            f32x4* o = (f32x4*)(a.out + ((size_t)b * P_SEQ + (rb - P_CTX)) * P_D) + lane;
#pragma unroll
            for (int j = 0; j < 4; ++j) o[64 * j] = v[j];
        } else {
            const float* mp = mod + (size_t)(ml * 9 + mrow) * P_MODW;
            unsigned long long* o8 = (unsigned long long*)(H + (size_t)m * P_D) + lane;
#pragma unroll
            for (int j = 0; j < 4; ++j) { const f32x4 sh = ((const f32x4*)(mp + csh * P_D))[lane + 64 * j], sc = ((const f32x4*)(mp + csc * P_D))[lane + 64 * j];
                const f32x4 h = v[j] * (1.0f + sc) + sh;
                o8[64 * j] = (unsigned long long)pk2(h.x, h.y) | ((unsigned long long)pk2(h.z, h.w) << 32); }
        }
    }
#undef ROW_OF
#undef ROW_SRC
}

__device__ __forceinline__ void pool_unit(const Args& a, int l, int u, LAS unsigned char* lds, int tid) {
    const bf16* Z = (const bf16*)(a.ws + WS_Z); bf16* Y = (bf16*)(a.ws + WS_Y);
    const int tk = u >> 2, g = u & 3; const int row0 = tk * 128; const int b = row0 / P_RPB, rb0 = row0 - b * P_RPB;
    const int slo = (rb0 < P_CTX) ? b * P_RPB : b * P_RPB + P_CTX, shi = (rb0 < P_CTX) ? b * P_RPB + P_CTX : (b + 1) * P_RPB;
    LAS float* zt = (LAS float*)lds;
    LAS float* pl = (LAS float*)(lds + 36864);
    LAS float* wl = (LAS float*)(lds + 36864 + 34816);
    for (int e = tid; e < 144 * 8; e += 512) { const int rr = e >> 3, c8 = e & 7; const int R = row0 - 8 + rr;
        v4u w = (v4u){0u, 0u, 0u, 0u};
        if (R >= slo && R < shi) w = *(const v4u*)(Z + (size_t)R * P_INW + g * 64 + c8 * 8);
        LAS float* d = zt + rr * 64 + c8 * 8;
        d[0] = bf2f(w.x & 0xffff); d[1] = bf2f(w.x >> 16); d[2] = bf2f(w.y & 0xffff); d[3] = bf2f(w.y >> 16); d[4] = bf2f(w.z & 0xffff); d[5] = bf2f(w.z >> 16); d[6] = bf2f(w.w & 0xffff); d[7] = bf2f(w.w >> 16); }
    { const f32x4* wsrc = (const f32x4*)(a.pool_w + ((size_t)l * 4 + g) * 4096);
      for (int e = tid; e < 1024; e += 512) ((LAS f32x4*)wl)[e] = wsrc[e]; }
    __syncthreads();
    const int hw = 1 << g;
    for (int e = tid; e < 128 * 64; e += 512) { const int t = e >> 6, c = e & 63; const int T = row0 + t;
        const int lo = max(T - hw, slo), hi = min(T + hw - 1, shi - 1);
        float s = 0.f;
        for (int p = lo; p <= hi; ++p) s += zt[(p - row0 + 8) * 64 + c];
        pl[t * 68 + c] = s / (float)(hi - lo + 1) - zt[(t + 8) * 64 + c]; }
    __syncthreads();
    { const int d = tid & 63, tq = tid >> 6;
      float acc[16];
#pragma unroll
      for (int t = 0; t < 16; ++t) acc[t] = 0.f;
      for (int c4 = 0; c4 < 16; ++c4) {
          const float w0 = wl[(4 * c4 + 0) * 64 + d], w1 = wl[(4 * c4 + 1) * 64 + d], w2 = wl[(4 * c4 + 2) * 64 + d], w3 = wl[(4 * c4 + 3) * 64 + d];
#pragma unroll
          for (int t = 0; t < 16; ++t) { const f32x4 p = *(const LAS f32x4*)(pl + (tq * 16 + t) * 68 + 4 * c4); acc[t] += (p.x * w0 + p.y * w1) + (p.z * w2 + p.w * w3); }
      }
      const float sc = a.pool_scale[l * 256 + g * 64 + d];
#pragma unroll
      for (int t = 0; t < 16; ++t) Y[(size_t)(row0 + tq * 16 + t) * P_D + g * 64 + d] = (bf16)f2bf(acc[t] * sc);
    }
    __syncthreads();
}

__device__ __forceinline__ void mix_phase(const Args& a, int l, unsigned char* ldsg, LAS unsigned char* lds, int vcu, int G, int tid) {
    using abf = attn_body::bf16;
    const abf* Z = (const abf*)(a.ws + WS_Z); abf* Y = (abf*)(a.ws + WS_Y);
    { LAS float* rp = (LAS float*)(lds + RPB_OFF); const float* src = a.na_rpb + (size_t)l * 6 * 465;
      for (int e = tid; e < 6 * 465; e += 512) rp[e] = src[e] * P_LOG2E; }
    __syncthreads();
    for (int u = vcu; u < 1536; u += G) { const int h = u >> 8, b = (u >> 5) & 7, qb = u & 31, kv = h / 3;
        const size_t brow = (size_t)b * P_RPB, qrow = brow + P_CTX + (size_t)qb * 256;
        attn_body::attn_unit<8, 0>(Z + qrow * P_INW + 1408 + 64 * h, Z + brow * P_INW + 1792 + 64 * kv, Z + brow * P_INW + 1920 + 64 * kv, Y + qrow * P_D + 640 + 64 * h, 132, 256, 0, 0, RPB_OFF, (char*)ldsg); }
    if (DBG_NA) for (int u = vcu; u < 1536; u += G) { const int h = u >> 8, b = (u >> 5) & 7, qb = u & 31;
        const size_t brow = (size_t)b * P_RPB, qrow = brow + P_CTX + (size_t)qb * 256;
        const int rsmin = min(max(4 * qb - 4, 0), 116);
        attn_body::attn_unit<8, 1>(Z + qrow * P_INW + 256 + 64 * h, Z + brow * P_INW + 640 + 64 * h, Z + brow * P_INW + 1024 + 64 * h, Y + qrow * P_D + 256 + 64 * h, 16, 256 + 64 * rsmin, 4 * qb, rsmin, RPB_OFF + h * 465 * 4, (char*)ldsg); }
    if (DBG_CTX && l < P_DEPTH - 1)
        for (int u = vcu; u < 96; u += G) { const int b = u / 12, hh = u - b * 12; const size_t brow = (size_t)b * P_RPB;
            int qc, kc, vc, oc;
            if (hh < 6) { qc = 256 + 64 * hh; kc = 640 + 64 * hh; vc = 1024 + 64 * hh; oc = 256 + 64 * hh; }
            else { const int h = hh - 6; qc = 1408 + 64 * h; kc = 1792 + 64 * (h / 3); vc = 1920 + 64 * (h / 3); oc = 640 + 64 * h; }
            attn_body::attn_unit<8, 0>(Z + brow * P_INW + qc, Z + brow * P_INW + kc, Z + brow * P_INW + vc, Y + brow * P_D + oc, 4, 256, 0, 0, RPB_OFF, (char*)ldsg); }
    if (DBG_POOL) for (int u = vcu; u < (P_M / 128) * 4; u += G) pool_unit(a, l, u, lds, tid);
}


#if DBG_DIAG
constexpr size_t WS_FLAG = 1 * MiB + 65536;
__device__ __forceinline__ bool dclose(float a, float b, float tol) { return fabsf(a - b) <= tol * (1.0f + fabsf(b)); }
__device__ __forceinline__ void diag_phase(const Args& a, int code, int vcu, int tid, int G) {
    unsigned char* ws = a.ws; unsigned* flag = (unsigned*)(ws + WS_FLAG);
    const float* mod = (const float*)(ws + WS_MOD); const float* X = (const float*)(ws + WS_X); const bf16* H = (const bf16*)(ws + WS_H);
    const bf16* Z = (const bf16*)(ws + WS_Z); const bf16* Y = (const bf16*)(ws + WS_Y); const bf16* ACT = (const bf16*)(ws + WS_ACT);
    const int b = 2, pos = 3000; const size_t Rl = (size_t)b * P_RPB + P_CTX + pos;
    const int lane = tid & 63;
    if (code == 199) {
        const unsigned fl = *flag; int first = 0; for (int i = 0; i < 16; ++i) if ((fl >> i) & 1) { first = i + 1; break; }
        if ((fl >> 20) & 1) first += 16;
        for (size_t i = (size_t)vcu * 512 + tid; i < (size_t)P_B * P_SEQ * P_D; i += (size_t)G * 512) a.out[i] = (float)first;
        return;
    }
    if (vcu != 0 || tid >= 64) return;
    bool bad = false;
    if (code == 100) {
        if (lane == 0) *flag = 0u;
        { const int got = __builtin_amdgcn_mov_dpp(lane, 0x121, 0xf, 0xf, true); const int want = (lane & ~15) | ((lane + 15) & 15);
          if (__any(got != want) && lane == 0) atomicOr(flag, 1u << 20); }
        const int ns[4] = {5, 1030, 3200, 6000};
        for (int q = 0; q < 4; ++q) { const int n = ns[q]; float s = 0.f;
            for (int k = lane; k < P_D; k += 64) { const float v = a.c[b * P_D + k]; s += v / (1.f + expf(-v)) * a.w_mod[(size_t)k * P_MODW + n]; }
            s = wave_sum(s) + a.b_mod[n]; if (!dclose(mod[(size_t)b * P_MODW + n], s, 1e-3f)) bad = true; }
        { const int k = lane * 16 + 3; const float xv = a.x[((size_t)b * P_SEQ + pos) * P_D + k];
          const float h = xv * (1.f + mod[(size_t)b * P_MODW + P_D + k]) + mod[(size_t)b * P_MODW + k];
          if (!dclose(bf2f(H[Rl * P_D + k]), h, 1e-2f)) bad = true; if (X[Rl * P_D + k] != xv) bad = true; }
        if (__any(bad) && lane == 0) atomicOr(flag, 1u);
    } else if (code == 101) {
        const int cs[5] = {100, 700, 1100, 2000, 300};
        for (int q = 0; q < 5; ++q) { const int col = cs[q]; float s = 0.f;
            for (int k = lane; k < P_D; k += 64) s += bf2f(H[Rl * P_D + k]) * a.w_in[(size_t)k * P_INW + col];
            s = wave_sum(s); if (q == 4) s *= P_C2; if (!dclose(bf2f(Z[Rl * P_INW + col]), s, 3e-2f)) bad = true; }
        if (__any(bad) && lane == 0) atomicOr(flag, 2u);
        bad = false;
        { float s = 0.f; for (int k = 0; k < P_D; ++k) s += bf2f(H[Rl * P_D + k]) * a.w_in[(size_t)k * P_INW + 1792 + lane];
          const float ss = wave_sum(s * s); float xn = s / sqrtf(ss / 64.f + P_EPS) * a.k_norm[lane];
          const int gr = pos >> 6, gc = pos & 63; const int f = lane & 15; const float inv = exp2f(-(float)f * (13.287712379549449f / 16.0f));
          const float ang = (float)((lane < 32) ? gr : gc) * inv; const float cs_ = cosf(ang), sn_ = sinf(ang);
          const float pr = __shfl_xor(xn, 16); const float o = ((lane & 16) == 0) ? xn * cs_ - pr * sn_ : pr * sn_ + xn * cs_;
          if (!dclose(bf2f(Z[Rl * P_INW + 1792 + lane]), o, 3e-2f)) bad = true; }
        if (__any(bad) && lane == 0) atomicOr(flag, 4u);
    } else if (code == 102) {
        { const int g = 3, hw = 8; float s = 0.f; for (int p = -hw; p < hw; ++p) s += bf2f(Z[(Rl + p) * P_INW + g * 64 + lane]);
          const float pooled = s / 16.f - bf2f(Z[Rl * P_INW + g * 64 + lane]); float y = 0.f;
          for (int c = 0; c < 64; ++c) y += __shfl(pooled, c) * a.pool_w[(size_t)g * 4096 + c * 64 + lane];
          y *= a.pool_scale[g * 64 + lane]; if (!dclose(bf2f(Y[Rl * P_D + g * 64 + lane]), y, 3e-2f)) bad = true; }
        if (__any(bad) && lane == 0) atomicOr(flag, 8u);
        bad = false;
        { const int h = 2; const int gr = pos >> 6, gc = pos & 63; const int rs = min(max(gr - 4, 0), 120), cs = min(max(gc - 8, 0), 48);
          float mx = -1e30f, sc[6];
          for (int i = 0; i < 6; ++i) { const int key = lane + 64 * i; size_t kr_; float bias = 0.f;
              if (key < 128) { const int kr = rs + key / 16, kc = cs + key % 16; kr_ = (size_t)b * P_RPB + P_CTX + kr * 64 + kc; bias = a.na_rpb[(size_t)h * 465 + (kr - gr + 7) * 31 + (kc - gc + 15)] * P_LOG2E; }
              else kr_ = (size_t)b * P_RPB + (key - 128);
              float s = 0.f; for (int d = 0; d < 64; ++d) s += bf2f(Z[Rl * P_INW + 256 + 64 * h + d]) * bf2f(Z[kr_ * P_INW + 640 + 64 * h + d]);
              sc[i] = s + bias; mx = fmaxf(mx, sc[i]); }
          for (int o = 1; o < 64; o <<= 1) mx = fmaxf(mx, __shfl_xor(mx, o));
          float den = 0.f; for (int i = 0; i < 6; ++i) { sc[i] = exp2f(sc[i] - mx); den += sc[i]; } den = wave_sum(den);
          float o_ = 0.f;
          for (int i = 0; i < 6; ++i) for (int l2 = 0; l2 < 64; ++l2) { const int key = l2 + 64 * i; size_t kr_;
              if (key < 128) { const int kr = rs + key / 16, kc = cs + key % 16; kr_ = (size_t)b * P_RPB + P_CTX + kr * 64 + kc; } else kr_ = (size_t)b * P_RPB + (key - 128);
              o_ += __shfl(sc[i], l2) * bf2f(Z[kr_ * P_INW + 1024 + 64 * h + lane]); }
          o_ /= den; if (!dclose(bf2f(Y[Rl * P_D + 256 + 64 * h + lane]), o_, 3e-2f)) bad = true; }
        if (__any(bad) && lane == 0) atomicOr(flag, 16u);
        bad = false;
        { const int h = 4, kv = 1; float mx = -1e30f; float den = 0.f, o_ = 0.f;
          for (int i = 0; i < 132; ++i) { const size_t kr_ = (size_t)b * P_RPB + lane + 64 * i; float s = 0.f;
              for (int d = 0; d < 64; ++d) s += bf2f(Z[Rl * P_INW + 1408 + 64 * h + d]) * bf2f(Z[kr_ * P_INW + 1792 + 64 * kv + d]); mx = fmaxf(mx, s); }
          for (int o = 1; o < 64; o <<= 1) mx = fmaxf(mx, __shfl_xor(mx, o));
          for (int i = 0; i < 132; ++i) { const size_t kr_ = (size_t)b * P_RPB + lane + 64 * i; float s = 0.f;
              for (int d = 0; d < 64; ++d) s += bf2f(Z[Rl * P_INW + 1408 + 64 * h + d]) * bf2f(Z[kr_ * P_INW + 1792 + 64 * kv + d]);
              const float p = exp2f(s - mx); den += p;
              for (int l2 = 0; l2 < 64; ++l2) o_ += __shfl(p, l2) * bf2f(Z[((size_t)b * P_RPB + l2 + 64 * i) * P_INW + 1920 + 64 * kv + lane]); }
          den = wave_sum(den); o_ /= den; if (!dclose(bf2f(Y[Rl * P_D + 640 + 64 * h + lane]), o_, 3e-2f)) bad = true; }
        if (__any(bad) && lane == 0) atomicOr(flag, 32u);
    } else if (code == 103) {
        { const int c = lane * 16 + 5; float s = 0.f; for (int k = 0; k < P_D; ++k) s += bf2f(Y[Rl * P_D + k]) * a.w_out[(size_t)k * P_D + c];
          const float e = P_ALPHA * a.x[((size_t)b * P_SEQ + pos) * P_D + c] + mod[(size_t)b * P_MODW + 2 * P_D + c] * s;
          if (!dclose(X[Rl * P_D + c], e, 3e-3f)) bad = true; }
        if (__any(bad) && lane == 0) atomicOr(flag, 64u);
    } else if (code == 104) {
        { float m = 0.f, q = 0.f; for (int k = lane; k < P_D; k += 64) { const float y = (X[Rl * P_D + k] - a.ln1_b[k]) / a.ln1_g[k]; m += y; q += y * y; }
          m = wave_sum(m) / P_D; q = wave_sum(q) / P_D; if (fabsf(m) > 1e-3f || fabsf(q - 1.f) > 2e-3f) bad = true;
          const int k = lane * 16 + 7; const float h = X[Rl * P_D + k] * (1.f + mod[(size_t)b * P_MODW + 4 * P_D + k]) + mod[(size_t)b * P_MODW + 3 * P_D + k];
          if (!dclose(bf2f(H[Rl * P_D + k]), h, 1e-2f)) bad = true; }
        if (__any(bad) && lane == 0) atomicOr(flag, 128u);
    } else if (code == 105) {
        { const int ch = 37 + lane * 43; float ua[3] = {0.f, 0.f, 0.f}, ug[3] = {0.f, 0.f, 0.f};
          for (int k = 0; k < P_D; ++k) { const float wa = a.w_up[(size_t)k * P_UPW + ch], wg = a.w_up[(size_t)k * P_UPW + P_DFF + ch];
              for (int j = 0; j < 3; ++j) { const float hv = bf2f(H[(Rl + j - 1) * P_D + k]); ua[j] += hv * wa; ug[j] += hv * wg; } }
          const float av = a.conv_w[ch] * ua[0] + a.conv_w[P_UPW + ch] * ua[1] + a.conv_w[2 * P_UPW + ch] * ua[2] + a.conv_b[ch];
          const float gv = a.conv_w[P_DFF + ch] * ug[0] + a.conv_w[P_UPW + P_DFF + ch] * ug[1] + a.conv_w[2 * P_UPW + P_DFF + ch] * ug[2] + a.conv_b[P_DFF + ch];
          const float e = av * gv / (1.f + expf(-gv)); if (!dclose(bf2f(ACT[Rl * P_DFF + ch]), e, 4e-2f)) bad = true; }
        if (__any(bad) && lane == 0) atomicOr(flag, 256u);
    } else if (code == 106) {
        { const int c = lane * 16 + 9; float s = 0.f; for (int k = 0; k < P_DFF; ++k) s += bf2f(ACT[Rl * P_DFF + k]) * a.w_down[(size_t)k * P_D + c];
          const float x1 = (bf2f(H[Rl * P_D + c]) - mod[(size_t)b * P_MODW + 3 * P_D + c]) / (1.f + mod[(size_t)b * P_MODW + 4 * P_D + c]);
          const float e = P_ALPHA * x1 + mod[(size_t)b * P_MODW + 5 * P_D + c] * s;
          if (fabsf(X[Rl * P_D + c] - e) > 0.03f) bad = true; }
        if (__any(bad) && lane == 0) atomicOr(flag, 512u);
    }
}
#endif

__global__ void __launch_bounds__(512, 2) mega(Args a) {
    extern __shared__ __attribute__((aligned(16))) unsigned char ldsraw[];
    LAS unsigned char* lds = (LAS unsigned char*)ldsraw;
    cg::grid_group grid = cg::this_grid();
    const int G = gridDim.x; const int bx = blockIdx.x; const int vcu = (G % 8 == 0) ? (bx % 8) * (G / 8) + bx / 8 : bx;
    const int ph_lo = a.ph_lo, ph_hi = a.ph_hi;
    volatile LAS unsigned* barst = (volatile LAS unsigned*)(lds + BARST_OFF);
    if (threadIdx.x < 2) barst[threadIdx.x] = 0u;
    if (ph_lo == 0 && blockIdx.x == 0) { unsigned* bw = (unsigned*)(a.ws + WS_BAR); for (int i = threadIdx.x; i < XCD_BAR_WORDS; i += 512) bw[i] = 0u; }
    __syncthreads();
    XcdBarrier xbar; xbar.bar = (unsigned*)(a.ws + WS_BAR); xbar.x = 0; xbar.st = barst;
    for (int ph_ = ph_lo; ph_ < ph_hi; ++ph_) {
        const int ph = (ph_ < 2 * DBG_P0REP) ? (ph_ & 1) : ph_ - 2 * DBG_P0REP;
        if (ph_ > ph_lo) {
            if (ph_ == ph_lo + 1) { grid.sync(); xbar = xcd_barrier_post((unsigned*)(a.ws + WS_BAR), barst); }
            else xcd_barrier(xbar);
        }
        const int tid = ltid(), lane = tid & 63, wave = __builtin_amdgcn_readfirstlane(tid >> 6);
        Args q;
        ARGF(q, ws); unsigned char* ws = q.ws;
#if DBG_DIAG
        if (ph >= 100) { q = a; diag_phase(q, ph, vcu, tid, G); continue; }
#endif
        if (ph == 0) { ARGF(q, c); ARGF(q, c_ctx); ARGF(q, w_mod); ARGF(q, b_mod); ARGF(q, w_in); ARGF(q, w_out); ARGF(q, w_up); ARGF(q, w_down); phase0(q, lds, vcu, G, tid, lane, wave); continue; }
        if (ph == 1) { ARGF(q, x); ARGF(q, ctx); row_phase<0>(q, 0, vcu, G, wave, lane); continue; }
        const int l = (ph - 2) / PH_PER_L; int sp = (ph - 2) % PH_PER_L; if (DBG_REP >= 0 && sp > DBG_REP) --sp;
        if (sp == 0 && (DBG_MASK & 1)) {
            ARGF(q, q_norm); ARGF(q, k_norm);
            pg8::Gemm g{(const pg8::bf16_t*)(ws + WS_H), (const pg8::bf16_t*)(ws + WS_WIN) + (size_t)l * P_INW * P_D, P_M, P_INW, P_D};
            pg8::StaticOrder S; S.init(P_M / 256, P_INW / 256, G, bx);
            pg8::EpiIn E{(pg8::bf16_t*)(ws + WS_Z), q.q_norm + l * 64, q.k_norm + l * 64, (const float*)(ws + WS_ROPEC), (const float*)(ws + WS_ROPES)};
            pg8::gemm_phase<pg8::EpiIn, pg8::StaticOrder, true, true, 0>(lds, g, S, E);
        } else if (sp == 1 && (DBG_MASK & 2)) {
            ARGF(q, na_rpb); ARGF(q, pool_w); ARGF(q, pool_scale);
            mix_phase(q, l, ldsraw, lds, vcu, G, tid);
        } else if (sp == 2 && (DBG_MASK & 4)) {
            pg8::Gemm g{(const pg8::bf16_t*)(ws + WS_Y), (const pg8::bf16_t*)(ws + WS_WOUT) + (size_t)l * P_D * P_D, P_M, P_D, P_D};
            pg8::StaticOrder S; S.init(l == P_DEPTH - 1 ? 256 : P_M / 256, P_D / 256, G, bx); S.skipctx = (l == P_DEPTH - 1);
            const bool first = (l == 0);
            if (first) { ARGF(q, x); ARGF(q, ctx); } else { ARGF(q, ln2_g); ARGF(q, ln2_b); }
            pg8::EpiRes E{(float*)(ws + WS_X), (const float*)(ws + WS_MOD) + (size_t)l * 9 * P_MODW + 2 * P_D, (const float*)(ws + WS_ST),
                          first ? nullptr : q.ln2_g + (l - 1) * P_D, first ? nullptr : q.ln2_b + (l - 1) * P_D, first ? q.x : nullptr, first ? q.ctx : nullptr};
            pg8::gemm_phase<pg8::EpiRes, pg8::StaticOrder, true, true, 0>(lds, g, S, E);
        } else if (sp == 3 && (DBG_MASK & 8)) {
            ARGF(q, ln1_g); ARGF(q, ln1_b);
            row_phase<1>(q, l, vcu, G, wave, lane);
        } else if (sp == 4 && (DBG_MASK & 16)) {
            ARGF(q, conv_w); ARGF(q, conv_b);
            pg8::Gemm g{(const pg8::bf16_t*)(ws + WS_H) - P_D, (const pg8::bf16_t*)(ws + WS_WUP) + (size_t)l * P_UPW * P_D, P_M, P_UPW, P_D};
            pg8::StaticOrder S; S.init((P_M + 247) / 248, P_UPW / 256, G, bx);
            pg8::EpiUp E{(pg8::bf16_t*)(ws + WS_ACT), q.conv_w + (size_t)l * 3 * P_UPW, q.conv_b + (size_t)l * P_UPW};
            pg8::gemm_phase<pg8::EpiUp, pg8::StaticOrder, true, true, 1>(lds, g, S, E);
        } else if (sp == 5 && (DBG_MASK & 32)) {
            pg8::Gemm g{(const pg8::bf16_t*)(ws + WS_ACT), (const pg8::bf16_t*)(ws + WS_WDN) + (size_t)l * P_D * P_DFF, P_M, P_D, P_DFF};
            pg8::StaticOrder S; S.init(l == P_DEPTH - 1 ? 256 : P_M / 256, P_D / 256, G, bx); S.skipctx = (l == P_DEPTH - 1);
            ARGF(q, ln1_g); ARGF(q, ln1_b);
            pg8::EpiRes E{(float*)(ws + WS_X), (const float*)(ws + WS_MOD) + (size_t)l * 9 * P_MODW + 5 * P_D, (const float*)(ws + WS_ST), q.ln1_g + l * P_D, q.ln1_b + l * P_D, nullptr, nullptr};
            pg8::gemm_phase<pg8::EpiRes, pg8::StaticOrder, true, true, 0>(lds, g, S, E);
        } else if (DBG_MASK & 64) {
            ARGF(q, ln2_g); ARGF(q, ln2_b); ARGF(q, out);
            row_phase<2>(q, l, vcu, G, wave, lane);
        }
    }
}

#ifndef MK_MULTI
#define MK_MULTI 0
#endif
extern "C" void kernel_launch(void* const* d_in, const int* in_sizes, int n_in, void* d_out, int out_size, void* d_ws, size_t ws_size, hipStream_t stream) {
    static int grid = 0;
    if (grid == 0) {
        if (n_in != 21 || ws_size < WS_END) { fprintf(stderr, "kernel_launch: unexpected n_in %d / ws_size %zu\n", n_in, ws_size); grid = -1; return; }
        int dev = 0, cus = 0, per_cu = 0;
        if (hipGetDevice(&dev) != hipSuccess || hipDeviceGetAttribute(&cus, hipDeviceAttributeMultiprocessorCount, dev) != hipSuccess) { grid = -1; return; }
        if (hipFuncSetAttribute((const void*)mega, hipFuncAttributeMaxDynamicSharedMemorySize, LDS_BYTES) != hipSuccess) { fprintf(stderr, "kernel_launch: hipFuncSetAttribute failed\n"); grid = -1; return; }
        if (hipOccupancyMaxActiveBlocksPerMultiprocessor(&per_cu, (const void*)mega, 512, LDS_BYTES) != hipSuccess || per_cu < 1) { fprintf(stderr, "kernel_launch: occupancy query says %d\n", per_cu); per_cu = 1; }
        (void)hipGetLastError();
        grid = cus * 1;
        fprintf(stderr, "kernel_launch: cus %d per_cu %d grid %d\n", cus, per_cu, grid);
    }
    if (grid < 0) return;
    Args a{};
    const float** f = (const float**)&a;
    for (int i = 0; i < 21; ++i) f[i] = (const float*)d_in[i];
    a.out = (float*)d_out; a.ws = (unsigned char*)d_ws;
#if MK_MULTI
#if DBG_DIAG
    { const int seq[] = {0, 1, 100, 2, 101, 3, 102, 4, 103, 5, 104, 6, 105, 7, 106, 199};
      for (int i = 0; i < 16; ++i) { a.ph_lo = seq[i]; a.ph_hi = seq[i] + 1; hipLaunchKernelGGL(mega, dim3(grid), dim3(512), LDS_BYTES, stream, a); } }
#else
    for (int ph = 0; ph < N_PHASES; ++ph) { a.ph_lo = ph; a.ph_hi = ph + 1; hipLaunchKernelGGL(mega, dim3(grid), dim3(512), LDS_BYTES, stream, a); }
#endif
#else
    a.ph_lo = 0; a.ph_hi = N_PHASES;
    void* args[] = {&a};
    hipError_t e = hipLaunchCooperativeKernel((const void*)mega, dim3(grid), dim3(512), args, LDS_BYTES, stream);
    if (e != hipSuccess) fprintf(stderr, "cooperative launch failed: %s (grid %d)\n", hipGetErrorString(e), grid);
#endif
}
```

```cpp
#include <hip/hip_runtime.h>
#include <hip/hip_cooperative_groups.h>
#include <cstdio>
#include <cstdint>
constexpr int P_D = 1024, P_B = 8, P_SEQ = 8192, P_CTX = 256, P_RPB = P_SEQ + P_CTX  , P_M = P_B * P_RPB  ;
constexpr int P_DEPTH = 4, P_INW = 2048, P_DFF = 2816, P_UPW = 2 * P_DFF, P_MODW = 6 * P_D;
constexpr float P_C2 = 0.125f * 1.4426950408889634f;
constexpr float P_LOG2E = 1.4426950408889634f;
constexpr float P_ALPHA = 1.681792830507429f;
constexpr float P_EPS = 1e-6f;
__device__ __forceinline__ int ltid() { int t = threadIdx.x; asm volatile("" : "+v"(t)); return t; }
namespace pg8 {
#define PG8_LAS __attribute__((address_space(3)))
typedef unsigned short bf16_t;
typedef short bf16x8 __attribute__((ext_vector_type(8)));
typedef float f32x4 __attribute__((ext_vector_type(4)));
typedef unsigned u32x4 __attribute__((ext_vector_type(4)));
constexpr int BM = 256, BK = 64, HALF = 128, HTB = HALF * BK * 2  , STAGE_BYTES = 8 * HTB, NXCD = 8, WGM = 8;

__host__ __device__ __forceinline__ int lds_byte(int r, int c) { const int st = (r >> 4) * 2 + (c >> 5), rr = r & 15, cc = c & 31, ob = rr * 64 + cc * 2; return st * 1024 + (ob ^ (((ob >> 9) & 1) << 5)); }
__host__ __device__ __forceinline__ void stage_rc(int b, int& R, int& C) { const int st = b / 1024, sb = b % 1024, swz = sb ^ (((sb >> 9) & 1) << 5); R = (st >> 1) * 16 + swz / 64; C = (st & 1) * 32 + (swz % 64) / 2; }
__host__ __device__ __forceinline__ int perm32(int rho) { const int n = rho >> 4, i = rho & 15; return 8 * (i >> 2) + 4 * n + (i & 3); }

struct Unit { int pm, pn; };
struct Gemm { const bf16_t* A; const bf16_t* Bt; int M, N, K; };

struct StaticOrder {
    int nM, nN, nwg, G, c, skipctx = 0, ctxonly = 0;
    __host__ __device__ void init(int nM_, int nN_, int G_, int c_) { nM = nM_; nN = nN_; nwg = nM * nN; G = G_; c = c_; }
    __host__ __device__ bool next(int i, Unit& u) const {
        if (ctxonly) { if (i > 0 || c >= 32) return false; u.pm = (c >> 2) * 33; u.pn = c & 3; return true; }
        const long L = (long)i * G + c; if (L >= nwg) return false;
        int wgid = (int)L; { const int q = nwg / NXCD, r = nwg % NXCD, xcd = wgid % NXCD, off = wgid / NXCD; wgid = (xcd < r ? xcd * (q + 1) : r * (q + 1) + (xcd - r) * q) + off; }
        const int nig = WGM * nN, gid = wgid / nig, fm = gid * WGM, gsz = (nM - fm) < WGM ? (nM - fm) : WGM;
        u.pm = fm + ((wgid % nig) % gsz); u.pn = (wgid % nig) / gsz; if (skipctx) u.pm += (u.pm >> 5) + 1; return true;
    }
    __device__ __forceinline__ void a_ready(const Unit&) const {}
    __device__ __forceinline__ void done(const Unit&) const {}
};

__device__ __forceinline__ unsigned cvt_pk_bf16(float lo, float hi) { unsigned r; asm volatile("v_cvt_pk_bf16_f32 %0, %1, %2" : "=v"(r) : "v"(lo), "v"(hi)); return r; }
#ifndef EPI_SHFL
#define EPI_SHFL 0
#endif
typedef float f32x2 __attribute__((ext_vector_type(2)));
__device__ __forceinline__ f32x4 dppror(const f32x4 v, const bool up) {
    f32x4 r;
#if EPI_SHFL
    const int lane = threadIdx.x & 63; const int src = (lane & ~15) | ((lane + (up ? 15 : 1)) & 15);
#pragma unroll
    for (int j = 0; j < 4; ++j) r[j] = __shfl(v[j], src);
#else
#pragma unroll
    for (int j = 0; j < 4; ++j) { const float xs = v[j]; const int iv = __float_as_int(xs);
        r[j] = __int_as_float(up ? __builtin_amdgcn_mov_dpp(iv, 0x121, 0xf, 0xf, true) : __builtin_amdgcn_mov_dpp(iv, 0x12F, 0xf, 0xf, true)); }
#endif
    return r;
}
struct EpiIn {
    static constexpr bool PERM = false, AFTER_DRAIN = false;
    bf16_t* Z; const float* qn; const float* kn; const float* rc; const float* rs;
    __device__ __forceinline__ void operator()(const f32x4 (&acc)[2][2][4][2], const Unit& u, int wr, int wc, int fr, int fq) const {
        asm volatile("" : "+v"(fr), "+v"(fq));
        const int hs = u.pn * 4 + wc;
        const bool isq = (hs >= 22 && hs < 28), isk = (hs == 28 || hs == 29);
        const float sc = ((hs >= 4 && hs < 10) || isq) ? P_C2 : 1.f;
        const int tb = u.pm % 33; const bool is_ctx = (tb == 0);
#pragma unroll
        for (int ai = 0; ai < 2; ++ai)
#pragma unroll
            for (int m = 0; m < 4; ++m) {
                const int rt = ai * HALF + wr * 64 + m * 16 + fr;
                const size_t row = (size_t)u.pm * BM + rt;
                f32x4 v[2][2];
#pragma unroll
                for (int bj = 0; bj < 2; ++bj)
#pragma unroll
                    for (int n = 0; n < 2; ++n) v[bj][n] = acc[ai][bj][m][n];
                if (isq || isk) {
                    float ss = 0.f;
#pragma unroll
                    for (int bj = 0; bj < 2; ++bj)
#pragma unroll
                        for (int n = 0; n < 2; ++n) { const f32x4 x = v[bj][n]; ss += (x[0] * x[0] + x[1] * x[1]) + (x[2] * x[2] + x[3] * x[3]); }
                    ss += __shfl_xor(ss, 16); ss += __shfl_xor(ss, 32);
                    const float rstd = 1.0f / sqrtf(ss * (1.0f / 64.0f) + P_EPS);
                    const float* gp = (isq ? qn : kn) + 4 * fq;
                    const int pos = (tb - 1) * BM + rt; const int gr = pos >> 6, gc = pos & 63;
#pragma unroll
                    for (int bj = 0; bj < 2; ++bj) {
                        const f32x4 g0 = *(const f32x4*)(gp + 32 * bj), g1 = *(const f32x4*)(gp + 32 * bj + 16);
                        f32x4 x1 = v[bj][0] * rstd * g0, x2 = v[bj][1] * rstd * g1;
                        if (!is_ctx) { const int idx = bj ? gc : gr;
                            const f32x4 cs = *(const f32x4*)(rc + idx * 16 + 4 * fq), sn = *(const f32x4*)(rs + idx * 16 + 4 * fq);
                            const f32x4 y1 = x1 * cs - x2 * sn, y2 = x1 * sn + x2 * cs; x1 = y1; x2 = y2; }
                        v[bj][0] = x1; v[bj][1] = x2;
                    }
                }
                bf16_t* zp = Z + row * P_INW + hs * 64 + 4 * fq;
#pragma unroll
                for (int bj = 0; bj < 2; ++bj)
#pragma unroll
                    for (int n = 0; n < 2; ++n) { const f32x4 x = v[bj][n] * sc; unsigned long long w = (unsigned long long)cvt_pk_bf16(x[0], x[1]) | ((unsigned long long)cvt_pk_bf16(x[2], x[3]) << 32);
                        *(unsigned long long*)(zp + 32 * bj + 16 * n) = w; }
                asm volatile("" ::: "memory");
            }
    }
};
struct EpiRes {
    static constexpr bool PERM = false, AFTER_DRAIN = false;
    float* X; const float* gate;
    const float* st; const float* lg; const float* lb; const float* xin; const float* cin;
    __device__ __forceinline__ void operator()(const f32x4 (&acc)[2][2][4][2], const Unit& u, int wr, int wc, int fr, int fq) const {
        asm volatile("" : "+v"(fr), "+v"(fq));
        const int b = u.pm / 33, tb = u.pm % 33; const int mrow = tb == 0 ? 8 : b;
        const int col0 = u.pn * BM + wc * 32 + 4 * fq;
        const float* gp = gate + mrow * P_MODW + col0;
        const bool ident = (lg == nullptr);
        const float* rbase = ident ? (tb == 0 ? cin + (size_t)b * P_CTX * P_D : xin + ((size_t)b * P_SEQ + (size_t)(tb - 1) * BM) * P_D) : X + (size_t)u.pm * BM * P_D;
#pragma unroll
        for (int ai = 0; ai < 2; ++ai)
#pragma unroll
            for (int m = 0; m < 4; ++m) { const int rt = ai * HALF + wr * 64 + m * 16 + fr;
                float* xw = X + ((size_t)u.pm * BM + rt) * P_D + col0; const float* xr = rbase + (size_t)rt * P_D + col0;
                float mean = 0.f, rstd = 1.f;
                if (!ident) { const f32x2 s2 = *(const f32x2*)(st + ((size_t)u.pm * BM + rt) * 2); mean = s2[0]; rstd = s2[1]; }
#pragma unroll
                for (int bj = 0; bj < 2; ++bj)
#pragma unroll
                    for (int n = 0; n < 2; ++n) { f32x4 xo = *(const f32x4*)(xr + bj * HALF + n * 16);
                        if (!ident) { const f32x4 g4 = *(const f32x4*)(lg + col0 + bj * HALF + n * 16), b4 = *(const f32x4*)(lb + col0 + bj * HALF + n * 16); xo = (xo - mean) * rstd * g4 + b4; }
                        const f32x4 gv = *(const f32x4*)(gp + bj * HALF + n * 16);
                        xo = xo * P_ALPHA + gv * acc[ai][bj][m][n]; *(f32x4*)(xw + bj * HALF + n * 16) = xo; }
                asm volatile("" ::: "memory"); }
    }
};
struct EpiUp {
    static constexpr bool PERM = true, AFTER_DRAIN = false;
    bf16_t* ACT; const float* cw; const float* cb;
    __device__ __forceinline__ void operator()(const f32x4 (&acc)[2][2][4][2], const Unit& u, int wr, int wc, int fr, int fq) const {
        asm volatile("" : "+v"(fr), "+v"(fq));
#pragma unroll
        for (int n = 0; n < 2; ++n) {
            const int ch = u.pn * 128 + wc * 32 + 8 * fq + 4 * n;
            const f32x4 wa0 = *(const f32x4*)(cw + ch), wa1 = *(const f32x4*)(cw + P_UPW + ch), wa2 = *(const f32x4*)(cw + 2 * P_UPW + ch), ba = *(const f32x4*)(cb + ch);
            const f32x4 wg0 = *(const f32x4*)(cw + P_DFF + ch), wg1 = *(const f32x4*)(cw + P_UPW + P_DFF + ch), wg2 = *(const f32x4*)(cw + 2 * P_UPW + P_DFF + ch), bg = *(const f32x4*)(cb + P_DFF + ch);
#pragma unroll
            for (int ai = 0; ai < 2; ++ai) {
                const int Rb = u.pm * 248 - 1 + (2 * ai + wr) * 62;
                f32x4 ra_prev = (f32x4){0.f, 0.f, 0.f, 0.f}, rg_prev = ra_prev;
                f32x4 la_cur = dppror(acc[ai][0][0][n], false), lg_cur = dppror(acc[ai][1][0][n], false);
#pragma unroll
                for (int m = 0; m < 4; ++m) {
                    const f32x4 va = acc[ai][0][m][n], vg = acc[ai][1][m][n];
                    const f32x4 ra_cur = dppror(va, true), rg_cur = dppror(vg, true);
                    f32x4 la_next = la_cur, lg_next = lg_cur;
                    if (m < 3) { la_next = dppror(acc[ai][0][m < 3 ? m + 1 : 3][n], false); lg_next = dppror(acc[ai][1][m < 3 ? m + 1 : 3][n], false); }
                    const int i = 16 * m + fr; const int R = Rb + i;
                    const int rbm = R - (R / P_RPB) * P_RPB;
                    const bool first = (rbm == 0) || (rbm == P_CTX), last = (rbm == P_CTX - 1) || (rbm == P_RPB - 1);
                    f32x4 upa = (fr == 0) ? ra_prev : ra_cur, upg = (fr == 0) ? rg_prev : rg_cur;
                    f32x4 dna = (fr == 15) ? la_next : la_cur, dng = (fr == 15) ? lg_next : lg_cur;
                    const f32x4 z4 = (f32x4){0.f, 0.f, 0.f, 0.f};
                    if (first) { upa = z4; upg = z4; }
                    if (last) { dna = z4; dng = z4; }
                    const f32x4 av = wa0 * upa + wa1 * va + wa2 * dna + ba;
                    const f32x4 gv = wg0 * upg + wg1 * vg + wg2 * dng + bg;
                    f32x4 o;
#pragma unroll
                    for (int j = 0; j < 4; ++j) o[j] = av[j] * gv[j] * __builtin_amdgcn_rcpf(1.0f + __expf(-gv[j]));
                    unsigned long long w = (unsigned long long)cvt_pk_bf16(o[0], o[1]) | ((unsigned long long)cvt_pk_bf16(o[2], o[3]) << 32);
                    asm volatile("" : "+v"(w));
                    if (i >= 1 && i <= 62 && R < P_M) *(unsigned long long*)(ACT + (size_t)R * P_DFF + ch) = w;
                    ra_prev = ra_cur; rg_prev = rg_cur; la_cur = la_next; lg_cur = lg_next;
                }
            }
        }
    }
};

template <class Epi, class Sched, bool ALIGN_EPI = false, bool SP2 = false, int AMODE = 0>
__device__ __forceinline__ void gemm_phase(PG8_LAS unsigned char* lds, const Gemm g, const Sched& S, const Epi& E) {
    const int tid = ltid(), wid = __builtin_amdgcn_readfirstlane(tid >> 6), lane = tid & 63, wr = wid >> 2, wc = wid & 3, fr = lane & 15, fq = lane >> 4;
    const int K = g.K, nt = K / BK;
    unsigned voffA[2], voffB[2];
#pragma unroll
    for (int i = 0; i < 2; ++i) { int R, C; stage_rc(tid * 16 + i * 8192, R, C); const int Rb = Epi::PERM ? ((R & ~31) + perm32(R & 31)) : R;
        voffA[i] = (unsigned)((AMODE ? ((R >> 6) * 62 + (R & 63)) : R) * K + C) * 2u; voffB[i] = (unsigned)(Rb * K + C) * 2u; }
    const size_t kstep = (size_t)(BK * 2);
    const size_t hstepB = (size_t)HALF * K * 2; const size_t hstepA = (size_t)(AMODE ? 124 : HALF) * K * 2;
    const size_t tstepB = 2 * hstepB; const size_t tstepA = 2 * hstepA;
    const unsigned ldsw = (unsigned)wid * 1024u;
    const int aoff = lds_byte(wr * 64 + fr, fq * 8), boff = lds_byte(wc * 32 + fr, fq * 8);
#define PG8_SA(b, h) (((b) * 2 + (h)) * HTB)
#define PG8_SB(b, h) ((4 + (b) * 2 + (h)) * HTB)
#define PG8_STAGE(bufoff, gbase, voff) do { _Pragma("unroll") for (int _i = 0; _i < 2; ++_i) \
        __builtin_amdgcn_global_load_lds((const unsigned*)((const char*)(gbase) + (voff)[_i]), (PG8_LAS unsigned*)(lds + (bufoff) + ldsw + _i * 8192), 16, 0, 0); } while (0)
#define PG8_LDA(dst, b, h) do { _Pragma("unroll") for (int m = 0; m < 4; ++m) _Pragma("unroll") for (int k = 0; k < 2; ++k) dst[m][k] = *(const PG8_LAS bf16x8*)(lds + PG8_SA(b, h) + aoff + m * 2048 + k * 1024); } while (0)
#define PG8_LDB(dst, b, h) do { _Pragma("unroll") for (int n = 0; n < 2; ++n) _Pragma("unroll") for (int k = 0; k < 2; ++k) dst[n][k] = *(const PG8_LAS bf16x8*)(lds + PG8_SB(b, h) + boff + n * 2048 + k * 1024); } while (0)
#define PG8_MMA(ai, bj, At, Bt) do { __builtin_amdgcn_s_setprio(1); _Pragma("unroll") for (int m = 0; m < 4; ++m) _Pragma("unroll") for (int n = 0; n < 2; ++n) _Pragma("unroll") for (int k = 0; k < 2; ++k) \
        acc[ai][bj][m][n] = __builtin_amdgcn_mfma_f32_16x16x32_bf16(Bt[n][k], At[m][k], acc[ai][bj][m][n], 0, 0, 0); __builtin_amdgcn_s_setprio(0); } while (0)
#define PG8_WAIT_V(n) asm volatile("s_waitcnt vmcnt(" #n ")" ::: "memory")
#define PG8_WAIT_L(n) asm volatile("s_waitcnt lgkmcnt(" #n ")" ::: "memory")
#define PG8_BAR __builtin_amdgcn_s_barrier()
#define PG8_SCHED __builtin_amdgcn_sched_barrier(0)
    Unit cur, nxt; int ui = 0;
    if (!S.next(0, cur)) return;
    f32x4 acc[2][2][4][2];
#pragma unroll
    for (int a = 0; a < 2; ++a)
#pragma unroll
        for (int b = 0; b < 2; ++b)
#pragma unroll
            for (int m = 0; m < 4; ++m)
#pragma unroll
                for (int n = 0; n < 2; ++n) acc[a][b][m][n] = (f32x4){0.f, 0.f, 0.f, 0.f};
    bf16x8 At[4][2], B0[2][2], B1[2][2];
    const char* cA = (const char*)g.A + (size_t)cur.pm * tstepA; const char* cB = (const char*)g.Bt + (size_t)cur.pn * tstepB;
    S.a_ready(cur);
    if constexpr (SP2) {
        PG8_STAGE(PG8_SB(0, 0), cB, voffB); PG8_STAGE(PG8_SB(0, 1), cB + hstepB, voffB); PG8_STAGE(PG8_SA(0, 0), cA, voffA); PG8_STAGE(PG8_SA(0, 1), cA + hstepA, voffA);
        if (wr == 1) PG8_BAR;
        PG8_WAIT_V(2); PG8_BAR;
        PG8_STAGE(PG8_SB(1, 0), cB + kstep, voffB); PG8_STAGE(PG8_SA(1, 0), cA + kstep, voffA); PG8_STAGE(PG8_SB(1, 1), cB + hstepB + kstep, voffB);
        PG8_WAIT_V(6); PG8_BAR;
    } else {
        PG8_STAGE(PG8_SB(0, 0), cB, voffB); PG8_STAGE(PG8_SA(0, 0), cA, voffA); PG8_STAGE(PG8_SB(0, 1), cB + hstepB, voffB); PG8_STAGE(PG8_SA(0, 1), cA + hstepA, voffA);
        if (wr == 1) PG8_BAR;
        PG8_WAIT_V(4); PG8_BAR;
        PG8_STAGE(PG8_SB(1, 0), cB + kstep, voffB); PG8_STAGE(PG8_SA(1, 0), cA + kstep, voffA); PG8_STAGE(PG8_SB(1, 1), cB + hstepB + kstep, voffB);
        PG8_WAIT_V(6); PG8_BAR;
    }
    for (;;) {
        const bool has_next = S.next(ui + 1, nxt);
        const char* nA = has_next ? (const char*)g.A + (size_t)nxt.pm * tstepA : cA; const char* nB = has_next ? (const char*)g.Bt + (size_t)nxt.pn * tstepB : cB;
        for (int t = 0; t < nt; t += 2) {
            const bool last = (t == nt - 2);
            const char* a1 = cA + (size_t)(t + 1) * kstep;
            const char* a2 = last ? nA : cA + (size_t)(t + 2) * kstep; const char* b2 = last ? nB : cB + (size_t)(t + 2) * kstep;
            const char* a3 = a2 + kstep; const char* b3 = b2 + kstep;
            if (last && has_next) S.a_ready(nxt);
            if constexpr (SP2) {
            PG8_LDB(B0, 0, 0); PG8_LDB(B1, 0, 1); PG8_SCHED; PG8_LDA(At, 0, 0); PG8_STAGE(PG8_SA(1, 1), a1 + hstepA, voffA);
            PG8_WAIT_V(8); PG8_WAIT_L(0); PG8_BAR; PG8_MMA(0, 0, At, B0); PG8_MMA(0, 1, At, B1); PG8_BAR; PG8_SCHED;
            PG8_LDA(At, 0, 1); PG8_STAGE(PG8_SB(0, 0), b2, voffB); PG8_STAGE(PG8_SB(0, 1), b2 + hstepB, voffB); PG8_STAGE(PG8_SA(0, 0), a2, voffA);
            PG8_WAIT_V(8); PG8_WAIT_L(0); PG8_BAR; PG8_MMA(1, 0, At, B0); PG8_MMA(1, 1, At, B1); PG8_BAR; PG8_SCHED;
            PG8_LDB(B0, 1, 0); PG8_LDB(B1, 1, 1); PG8_SCHED; PG8_LDA(At, 1, 0); PG8_STAGE(PG8_SA(0, 1), a2 + hstepA, voffA);
            PG8_WAIT_V(8); PG8_WAIT_L(0); PG8_BAR; PG8_MMA(0, 0, At, B0); PG8_MMA(0, 1, At, B1); PG8_BAR; PG8_SCHED;
            PG8_LDA(At, 1, 1); PG8_STAGE(PG8_SB(1, 0), b3, voffB); PG8_STAGE(PG8_SB(1, 1), b3 + hstepB, voffB); PG8_STAGE(PG8_SA(1, 0), a3, voffA);
            PG8_WAIT_V(8); PG8_WAIT_L(0); PG8_BAR; PG8_MMA(1, 0, At, B0); PG8_MMA(1, 1, At, B1); PG8_BAR; PG8_SCHED;
            } else {
            PG8_LDB(B0, 0, 0); PG8_SCHED; PG8_LDA(At, 0, 0); PG8_STAGE(PG8_SA(1, 1), a1 + hstepA, voffA);
            PG8_WAIT_L(8); PG8_BAR; PG8_WAIT_L(0); PG8_MMA(0, 0, At, B0); PG8_BAR; PG8_SCHED;
            PG8_LDB(B1, 0, 1); PG8_STAGE(PG8_SB(0, 0), b2, voffB);
            PG8_BAR; PG8_WAIT_L(0); PG8_MMA(0, 1, At, B1); PG8_BAR;
            PG8_LDA(At, 0, 1); PG8_STAGE(PG8_SA(0, 0), a2, voffA);
            PG8_BAR; PG8_WAIT_L(0); PG8_MMA(1, 0, At, B0); PG8_BAR; PG8_SCHED;
            PG8_STAGE(PG8_SB(0, 1), b2 + hstepB, voffB);
            PG8_WAIT_V(6); PG8_BAR; PG8_MMA(1, 1, At, B1); PG8_BAR;
            PG8_LDB(B0, 1, 0); PG8_SCHED; PG8_LDA(At, 1, 0); PG8_STAGE(PG8_SA(0, 1), a2 + hstepA, voffA);
            PG8_WAIT_L(8); PG8_BAR; PG8_WAIT_L(0); PG8_MMA(0, 0, At, B0); PG8_BAR; PG8_SCHED;
            PG8_LDB(B1, 1, 1); PG8_STAGE(PG8_SB(1, 0), b3, voffB);
            PG8_BAR; PG8_WAIT_L(0); PG8_MMA(0, 1, At, B1); PG8_BAR;
            PG8_LDA(At, 1, 1); PG8_STAGE(PG8_SA(1, 0), a3, voffA);
            PG8_BAR; PG8_WAIT_L(0); PG8_MMA(1, 0, At, B0); PG8_BAR; PG8_SCHED;
            PG8_STAGE(PG8_SB(1, 1), b3 + hstepB, voffB);
            PG8_WAIT_V(6); PG8_BAR; PG8_MMA(1, 1, At, B1); PG8_BAR;
            }
        }
        if constexpr (ALIGN_EPI) { if (wr == 0) PG8_BAR; }
        if constexpr (!Epi::AFTER_DRAIN) { E(acc, cur, wr, wc, fr, fq); S.done(cur); }
        if (!has_next) break;
#pragma unroll
        for (int a = 0; a < 2; ++a)
#pragma unroll
            for (int b = 0; b < 2; ++b)
#pragma unroll
                for (int m = 0; m < 4; ++m)
#pragma unroll
                    for (int n = 0; n < 2; ++n) acc[a][b][m][n] = (f32x4){0.f, 0.f, 0.f, 0.f};
        cur = nxt; cA = nA; cB = nB; ++ui;
        if constexpr (ALIGN_EPI) { if (wr == 1) PG8_BAR; }
    }
    PG8_WAIT_V(0);
    if constexpr (!ALIGN_EPI) { if (wr == 0) PG8_BAR; }
    PG8_BAR;
    if constexpr (Epi::AFTER_DRAIN) { E.fused(acc, cur, wr, wc, fr, fq, lds, wid, lane); S.done(cur); }
#undef PG8_SA
#undef PG8_SB
#undef PG8_STAGE
#undef PG8_LDA
#undef PG8_LDB
#undef PG8_MMA
#undef PG8_WAIT_V
#undef PG8_WAIT_L
#undef PG8_BAR
#undef PG8_SCHED
}
}
#include <hip/hip_bf16.h>
#include <cmath>
namespace attn_body {
using bf16=__hip_bfloat16;
using bf16x8=__attribute__((ext_vector_type(8)))short;
using s16x4=__attribute__((ext_vector_type(4)))short;
using f32x16=__attribute__((ext_vector_type(16)))float;
using u32x4=__attribute__((ext_vector_type(4)))unsigned;
constexpr int D=64,DM=2048,ODM=1024;
constexpr int NW=8,QBLK=32,QB=QBLK*NW,KVBLK=64;
constexpr int ATTN_PITCH=DM, ATTN_UNIT_ROWS=QB;
__device__ __forceinline__ int crow(int r,int hi){return (r&3)+8*(r>>2)+4*hi;}
#define SBAR() __builtin_amdgcn_sched_barrier(0)
__device__ __forceinline__ void cmask(f32x16&p0,f32x16&p1,int jb,int qrel,int hi){
  const float NEG=-INFINITY; int kb=64*jb+4*hi;
  #pragma unroll
  for(int r=0;r<16;++r){int kv=kb+(r&3)+8*(r>>2); if(kv>qrel)p0[r]=NEG; if(kv+32>qrel)p1[r]=NEG;}
}

typedef const __attribute__((address_space(3))) float* lds_fptr;
__device__ __forceinline__ void nabias(f32x16&p0,f32x16&p1,int kr,int qr_,int r32,int wid,int hi,lds_fptr rp){
  const float NEG=-INFINITY;
  asm volatile("":"+v"(r32),"+v"(hi));
  const int qc=32*(wid&1)+r32;
  const int rs=min(max(qr_-4,0),120), cs=min(max(qc-8,0),48);
  if(kr<rs||kr>=rs+8){
    #pragma unroll
    for(int r=0;r<16;++r){p0[r]=NEG;p1[r]=NEG;}
  } else {
    lds_fptr tb=rp+(kr-qr_+7)*31+(15-qc);
    #pragma unroll
    for(int r=0;r<16;++r){
      const int kc=(r&3)+8*(r>>2)+4*hi;
      const bool ok0=(unsigned)(kc-cs)<16u, ok1=(unsigned)(kc+32-cs)<16u;
      const float b0=tb[ok0?kc:cs], b1=tb[ok1?kc+32:cs];
      p0[r]=ok0?p0[r]+b0:NEG; p1[r]=ok1?p1[r]+b1:NEG;
    }
  }
}
constexpr int NSLOT=3, SLOTB=8192;
constexpr int LDS_K=0, LDS_V=NSLOT*SLOTB, LDS_WS=2*NSLOT*SLOTB, LDS_OST=LDS_WS+NW*64*4, LDS_BYTES=LDS_OST+NW*4096;
constexpr float C2=0.125f*1.4426950408889634f;
__device__ __forceinline__ void glds16(const void*gsrc,unsigned lds_dst){unsigned keep;
  asm volatile("s_mov_b32 %0, m0\n\ts_mov_b32 m0, %2\n\ts_nop 0\n\tglobal_load_lds_dwordx4 %1, off\n\ts_mov_b32 m0, %0":"=&s"(keep):"v"(gsrc),"s"(lds_dst):"memory");}
__device__ __forceinline__ float max3f(float a,float b,float c){float r;asm("v_max3_f32 %0, %1, %2, %3":"=v"(r):"v"(a),"v"(b),"v"(c));return r;}
__device__ __forceinline__ float max2f(float a,float b){float r;asm("v_max_f32_e32 %0, %1, %2":"=v"(r):"v"(a),"v"(b));return r;}
__device__ __forceinline__ float fadd_s(float a,float b){float r;asm("v_add_f32_e32 %0, %1, %2":"=v"(r):"v"(a),"v"(b));return r;}
__device__ __forceinline__ float fsub_s(float a,float b){float r;asm("v_sub_f32_e32 %0, %1, %2":"=v"(r):"v"(a),"v"(b));return r;}
typedef float f32x2_t __attribute__((ext_vector_type(2))); typedef __bf16 bf16x2_t __attribute__((ext_vector_type(2)));
__device__ __forceinline__ unsigned cvtpk_s(float lo,float hi){f32x2_t v={lo,hi};bf16x2_t b=__builtin_convertvector(v,bf16x2_t);return __builtin_bit_cast(unsigned,b);}
#define WAIT_BAR(N) asm volatile("s_waitcnt vmcnt(" #N ") lgkmcnt(0)\n\ts_barrier":::"memory")

__device__ __forceinline__ void qkt(f32x16&p0,f32x16&p1,const char*Kslot,const bf16x8*qr,const f32x16&negm,int r32,int hi){
  const char*kb=Kslot+hi*1024+r32*16;
  #pragma unroll
  for(int d0=0;d0<4;++d0){
    const bf16x8 b0=*reinterpret_cast<const bf16x8*>(kb+d0*2048);
    const bf16x8 b1=*reinterpret_cast<const bf16x8*>(kb+d0*2048+512);
    if(d0==0){p0=__builtin_amdgcn_mfma_f32_32x32x16_bf16(b0,qr[0],negm,0,0,0);p1=__builtin_amdgcn_mfma_f32_32x32x16_bf16(b1,qr[0],negm,0,0,0);}
    else{p0=__builtin_amdgcn_mfma_f32_32x32x16_bf16(b0,qr[d0],p0,0,0,0);p1=__builtin_amdgcn_mfma_f32_32x32x16_bf16(b1,qr[d0],p1,0,0,0);}}
}
typedef __attribute__((address_space(3))) const char* lds_cptr;
typedef short v4i16_t __attribute__((ext_vector_type(4)));
__device__ __forceinline__ void kload8(bf16x8*kf,lds_cptr kp){
  kf[0]=*(const __attribute__((address_space(3))) bf16x8*)(kp);      kf[1]=*(const __attribute__((address_space(3))) bf16x8*)(kp+512);
  kf[2]=*(const __attribute__((address_space(3))) bf16x8*)(kp+2048); kf[3]=*(const __attribute__((address_space(3))) bf16x8*)(kp+2560);
  kf[4]=*(const __attribute__((address_space(3))) bf16x8*)(kp+4096); kf[5]=*(const __attribute__((address_space(3))) bf16x8*)(kp+4608);
  kf[6]=*(const __attribute__((address_space(3))) bf16x8*)(kp+6144); kf[7]=*(const __attribute__((address_space(3))) bf16x8*)(kp+6656);
}
__device__ __forceinline__ void kload2(bf16x8*kf,lds_cptr kp,int j){ kf[2*j]=*(const __attribute__((address_space(3))) bf16x8*)(kp+j*2048); kf[2*j+1]=*(const __attribute__((address_space(3))) bf16x8*)(kp+j*2048+512); }
__device__ __forceinline__ s16x4 vtr(lds_cptr p){ return __builtin_bit_cast(s16x4,__builtin_amdgcn_ds_read_tr16_b64_v4i16((__attribute__((address_space(3))) v4i16_t*)p)); }
__device__ __forceinline__ float rowmax(const f32x16&p0,const f32x16&p1){
  float a=max3f(p0[0],p0[1],p1[0]),b=max3f(p0[2],p0[3],p1[1]);a=max3f(a,p1[2],p1[3]);
  #pragma unroll
  for(int r=4;r<16;r+=4){a=max3f(a,p0[r],p0[r+1]);b=max3f(b,p0[r+2],p0[r+3]);a=max3f(a,p1[r],p1[r+1]);b=max3f(b,p1[r+2],p1[r+3]);}
  const float m=max2f(a,b);
  auto rr=__builtin_amdgcn_permlane32_swap(__float_as_uint(m),__float_as_uint(m),false,false);
  return max2f(__uint_as_float(rr[0]),__uint_as_float(rr[1]));
}
__device__ __forceinline__ void pv(f32x16*o,int vb,bf16x8 pa0,bf16x8 pa1,bf16x8 pa2,bf16x8 pa3){
  #pragma unroll
  for(int d0=0;d0<2;++d0){s16x4 lo[4],hi[4];
    #pragma unroll
    for(int ks=0;ks<4;++ks){
      asm volatile("ds_read_b64_tr_b16 %0,%1 offset:%c2":"=&v"(lo[ks]):"v"(vb),"i"(d0*4096+ks*1024):"memory");
      asm volatile("ds_read_b64_tr_b16 %0,%1 offset:%c2":"=&v"(hi[ks]):"v"(vb),"i"(d0*4096+ks*1024+512):"memory");}
    asm volatile("s_waitcnt lgkmcnt(0)":::"memory");SBAR();
    #define PK(k) (bf16x8){lo[k][0],lo[k][1],lo[k][2],lo[k][3],hi[k][0],hi[k][1],hi[k][2],hi[k][3]}
    o[d0]=__builtin_amdgcn_mfma_f32_32x32x16_bf16(pa0,PK(0),o[d0],0,0,0);
    o[d0]=__builtin_amdgcn_mfma_f32_32x32x16_bf16(pa1,PK(1),o[d0],0,0,0);
    o[d0]=__builtin_amdgcn_mfma_f32_32x32x16_bf16(pa2,PK(2),o[d0],0,0,0);
    o[d0]=__builtin_amdgcn_mfma_f32_32x32x16_bf16(pa3,PK(3),o[d0],0,0,0);
    #undef PK
  }
}

#ifndef ATTN_STORE16
#define ATTN_STORE16(p,v) (*(u32x4*)(p)=(v))
#endif
template<int THRL,int MODE> __device__ __forceinline__ void attn_unit(const bf16*Qw0,const bf16*__restrict__ Kh,const bf16*__restrict__ Vh,bf16*Ow0,const int NT,const int lat_off,const int na_r0,const int na_rsmin,const int rpb_off,char*shm){
  const int tid=ltid(),lane=tid&63,r32=lane&31,hi=lane>>5; const int wid=__builtin_amdgcn_readfirstlane(tid>>6);
  const bf16*Qw=Qw0+(long)(wid*QBLK)*DM;
  const unsigned lds0=(unsigned)(uintptr_t)shm;
  float*wsf=(float*)(shm+LDS_WS)+wid*64;
  const bf16*ksrc=Kh+(long)lane*DM+wid*8;
  const bf16*vsrc=Vh+(long)(16*(wid&3)+(lane>>2))*DM+(wid>>2)*32+(lane&3)*8;
  const unsigned kdst=lds0+LDS_K+wid*1024, vdst=lds0+LDS_V+wid*1024;
  #define TROW(t) (((t)<4)?(t)*64:lat_off+((t)-4)*64)
  #define DMA_K(t,slot) glds16(ksrc+(long)TROW(t)*DM,(unsigned)__builtin_amdgcn_readfirstlane(kdst+(slot)))
  #define DMA_V(t,slot) glds16(vsrc+(long)TROW(t)*DM,(unsigned)__builtin_amdgcn_readfirstlane(vdst+(slot)))
  const int vb0=(int)(lds0+LDS_V)+((lane>>4)&1)*32+(lane&3)*8+(4*hi+((lane&15)>>2))*64;
  const char*Kbase=shm+LDS_K; bf16x8 kf[8];
  const lds_cptr shm3=(lds_cptr)shm; const lds_cptr kp0=shm3+LDS_K+hi*1024+r32*16; const lds_cptr vp0=shm3+LDS_V+((lane>>4)&1)*32+(lane&3)*8+(4*hi+((lane&15)>>2))*64;
  DMA_K(0,0);DMA_V(0,0);DMA_K(1,SLOTB);
  bf16x8 qr[4];
  #pragma unroll
  for(int d0=0;d0<4;++d0)qr[d0]=*reinterpret_cast<const bf16x8*>(&Qw[(long)r32*DM+d0*16+hi*8]);
  float mhat=0.f,l_reg=0.f;f32x16 o[2];o[0]=f32x16{};o[1]=f32x16{};f32x16 negm=f32x16{};asm volatile("":"+v"(negm));
  const lds_fptr rp_=(lds_fptr)(shm3+rpb_off); const int na_qr=na_r0+(wid>>1);
  #define CMASK(P0,P1,t) do{ if(MODE==1 && (t)>=4) nabias(P0,P1,na_rsmin+(t)-4,na_qr,r32,wid,hi,rp_); }while(0)
  bool resc=false;
  #define START(P0,P1) do{ const float rm=rowmax(P0,P1); resc=false; \
    { const float dl=rm; mhat=fadd_s(mhat,dl); \
      _Pragma("unroll") for(int r=0;r<16;++r){P0[r]=fsub_s(P0[r],dl);P1[r]=fsub_s(P1[r],dl);} \
      _Pragma("unroll") for(int r=0;r<16;++r)negm[r]=-mhat; asm volatile("":"+v"(negm)); } \
    _Pragma("unroll") for(int r=0;r<16;++r)P0[r]=__builtin_amdgcn_exp2f(P0[r]); }while(0)
  #define RESC() do{ if(resc){ asm volatile("s_waitcnt lgkmcnt(0)":::"memory"); \
      _Pragma("unroll") for(int d_=0;d_<2;++d_) _Pragma("unroll") for(int r=0;r<16;++r)o[d_][r]*=wsf[crow(r,hi)]; } }while(0)
  f32x16 pA0,pA1,pB0,pB1;
  int sl_prev=0,sl_cur=0,sl_next=SLOTB;
  #define ROT() do{sl_prev=sl_cur;sl_cur=sl_next;sl_next=(sl_next==(NSLOT-1)*SLOTB)?0:sl_next+SLOTB;}while(0)
  DMA_K(2,2*SLOTB);
  WAIT_BAR(3);
  qkt(pA0,pA1,Kbase,qr,negm,r32,hi);asm volatile("s_nop 15\n\ts_nop 7":"+v"(pA0),"+v"(pA1));CMASK(pA0,pA1,0);
  START(pA0,pA1);
  _Pragma("unroll") for(int r=0;r<16;++r)pA1[r]=__builtin_amdgcn_exp2f(pA1[r]);
  WAIT_BAR(0);
  DMA_K(3,0);DMA_V(1,SLOTB);
  ROT();
  kload8(kf,kp0+sl_cur);
  WAIT_BAR(2);
  s16x4 vlo[8],vhi[8]; u32x4 pw0,pw1,pw2,pw3;
  #define PKW(P,B) cvtpk_s(P[B],P[B+1])
  #define PAF(k) __builtin_bit_cast(bf16x8,pw##k)
  #define VFR(i) (bf16x8){vlo[i][0],vlo[i][1],vlo[i][2],vlo[i][3],vhi[i][0],vhi[i][1],vhi[i][2],vhi[i][3]}
  #define PIN(x) asm volatile("":"+v"(x))
  #define MX3(a,b,c) __builtin_fmaxf(__builtin_fmaxf((a),(b)),(c))
  #define GAPA(MF,A0,A1,A2,A3,W0,W1,PW) do{ MF; sacc+=A0; sacc+=A1; sacc+=A2; sacc+=A3; PIN(sacc); W0; W1; PIN(PW); SBAR(); }while(0)
  #define EX(v) __builtin_amdgcn_exp2f(v)
  #define GAPB(MF,X,B) do{ MF; X[B]=EX(X[B]); X[B+1]=EX(X[B+1]); X[B+2]=EX(X[B+2]); X[B+3]=EX(X[B+3]); PIN(X); SBAR(); }while(0)
  #define VRD(i) do{ vlo[i]=vtr(vp_+(((i)>>2)*4096+((i)&3)*1024)); vhi[i]=vtr(vp_+(((i)>>2)*4096+((i)&3)*1024+512)); }while(0)
  #define KRD(G,j) do{ if(G){ kload2(kf,kp0+sl_next,j); SBAR(); } }while(0)
  #define STEP(C0,C1,P0,P1,t,GK,GV,GL) do{ SBAR(); \
    const lds_cptr vp_=vp0+sl_prev; \
    VRD(0); SBAR(); float sacc=(P0[0]+P0[1]); \
    GAPA(C0=__builtin_amdgcn_mfma_f32_32x32x16_bf16(kf[0],qr[0],negm,0,0,0), P0[2],P0[3],P0[4],P0[5],     pw0[0]=PKW(P0,0), pw0[1]=PKW(P0,2), pw0); \
    VRD(4); SBAR(); GAPA(C1=__builtin_amdgcn_mfma_f32_32x32x16_bf16(kf[1],qr[0],negm,0,0,0), P0[6],P0[7],P0[8],P0[9],     pw0[2]=PKW(P0,4), pw0[3]=PKW(P0,6), pw0); \
    VRD(1); SBAR(); GAPA(C0=__builtin_amdgcn_mfma_f32_32x32x16_bf16(kf[2],qr[1],C0,0,0,0),   P0[10],P0[11],P0[12],P0[13], pw1[0]=PKW(P0,8), pw1[1]=PKW(P0,10), pw1); \
    VRD(5); SBAR(); GAPA(C1=__builtin_amdgcn_mfma_f32_32x32x16_bf16(kf[3],qr[1],C1,0,0,0),   P0[14],P0[15],P1[0],P1[1],   pw1[2]=PKW(P0,12),pw1[3]=PKW(P0,14), pw1); \
    VRD(2); SBAR(); GAPA(C0=__builtin_amdgcn_mfma_f32_32x32x16_bf16(kf[4],qr[2],C0,0,0,0),   P1[2],P1[3],P1[4],P1[5],     pw2[0]=PKW(P1,0), pw2[1]=PKW(P1,2), pw2); \
    VRD(6); SBAR(); GAPA(C1=__builtin_amdgcn_mfma_f32_32x32x16_bf16(kf[5],qr[2],C1,0,0,0),   P1[6],P1[7],P1[8],P1[9],     pw2[2]=PKW(P1,4), pw2[3]=PKW(P1,6), pw2); \
    VRD(3); SBAR(); GAPA(C0=__builtin_amdgcn_mfma_f32_32x32x16_bf16(kf[6],qr[3],C0,0,0,0),   P1[10],P1[11],P1[12],P1[13], pw3[0]=PKW(P1,8), pw3[1]=PKW(P1,10), pw3); \
    VRD(7); SBAR(); GAPA(C1=__builtin_amdgcn_mfma_f32_32x32x16_bf16(kf[7],qr[3],C1,0,0,0),   P1[14],P1[15],0.f,0.f,       pw3[2]=PKW(P1,12),pw3[3]=PKW(P1,14), pw3); \
    l_reg+=sacc; \
    if(GK){DMA_K((t)+3,sl_cur);} if(GV){DMA_V((t)+1,sl_next);} \
    CMASK(C0,C1,t); \
    { float a=MX3(C0[0],C0[1],C1[0]),b=MX3(C0[2],C0[3],C1[1]); a=MX3(a,C1[2],C1[3]); \
      _Pragma("unroll") for(int r=4;r<16;r+=4){a=MX3(a,C0[r],C0[r+1]);b=MX3(b,C0[r+2],C0[r+3]);a=MX3(a,C1[r],C1[r+1]);b=MX3(b,C1[r+2],C1[r+3]);} \
      float rm=__builtin_fmaxf(a,b); { auto rr=__builtin_amdgcn_permlane32_swap(__float_as_uint(rm),__float_as_uint(rm),false,false); rm=__builtin_fmaxf(__uint_as_float(rr[0]),__uint_as_float(rr[1])); } \
      resc=false; \
      if(__builtin_expect(__any(rm>(float)THRL),0)){ const float dl=__builtin_fmaxf(rm,0.f); mhat+=dl; \
        _Pragma("unroll") for(int r=0;r<16;++r){C0[r]-=dl;C1[r]-=dl;} \
        _Pragma("unroll") for(int r=0;r<16;++r)negm[r]=-mhat; asm volatile("":"+v"(negm)); \
        const float f=__builtin_amdgcn_exp2f(-dl); l_reg*=f; if(hi==0)wsf[r32]=f; resc=true; } } \
    SBAR(); \
    GAPB(o[0]=__builtin_amdgcn_mfma_f32_32x32x16_bf16(PAF(0),VFR(0),o[0],0,0,0), C0,0); \
    GAPB(o[1]=__builtin_amdgcn_mfma_f32_32x32x16_bf16(PAF(0),VFR(4),o[1],0,0,0), C0,4); \
    KRD(GL,0); GAPB(o[0]=__builtin_amdgcn_mfma_f32_32x32x16_bf16(PAF(1),VFR(1),o[0],0,0,0), C0,8); \
    KRD(GL,1); GAPB(o[1]=__builtin_amdgcn_mfma_f32_32x32x16_bf16(PAF(1),VFR(5),o[1],0,0,0), C0,12); \
    KRD(GL,2); GAPB(o[0]=__builtin_amdgcn_mfma_f32_32x32x16_bf16(PAF(2),VFR(2),o[0],0,0,0), C1,0); \
    KRD(GL,3); GAPB(o[1]=__builtin_amdgcn_mfma_f32_32x32x16_bf16(PAF(2),VFR(6),o[1],0,0,0), C1,4); \
    GAPB(o[0]=__builtin_amdgcn_mfma_f32_32x32x16_bf16(PAF(3),VFR(3),o[0],0,0,0), C1,8); \
    GAPB(o[1]=__builtin_amdgcn_mfma_f32_32x32x16_bf16(PAF(3),VFR(7),o[1],0,0,0), C1,12); \
    }while(0)
  int t=1;
  #undef CMASK
  #define CMASK(P0,P1,t) do{ if(MODE==1 && (t)>=4) nabias(P0,P1,na_rsmin+(t)-4,na_qr,r32,wid,hi,rp_); }while(0)
  for(;t+5<NT;t+=2){
    STEP(pB0,pB1,pA0,pA1,t,true,true,true);     WAIT_BAR(2); RESC(); ROT();
    STEP(pA0,pA1,pB0,pB1,t+1,true,true,true);   WAIT_BAR(2); RESC(); ROT();
  }
  #undef CMASK
  #define CMASK(P0,P1,t) do{ if(MODE==1 && (t)>=4) nabias(P0,P1,na_rsmin+(t)-4,na_qr,r32,wid,hi,rp_); }while(0)
  #define ENDW(tt) do{ if((tt)+3<NT){WAIT_BAR(2);} else if((tt)+2<NT){WAIT_BAR(1);} else {WAIT_BAR(0);} }while(0)
  for(;t+1<NT;t+=2){
    STEP(pB0,pB1,pA0,pA1,t,(t+3<NT),(t+1<NT),(t+1<NT));       ENDW(t);   RESC(); ROT();
    STEP(pA0,pA1,pB0,pB1,t+1,(t+4<NT),(t+2<NT),(t+2<NT));     ENDW(t+1); RESC(); ROT();
  }
  STEP(pB0,pB1,pA0,pA1,NT-1,false,false,false); RESC();
  { float sacc=pB0[0]+pB0[1]; _Pragma("unroll") for(int r=2;r<16;++r)sacc+=pB0[r]; _Pragma("unroll") for(int r=0;r<16;++r)sacc+=pB1[r]; l_reg+=sacc;
    pw0=(u32x4){PKW(pB0,0),PKW(pB0,2),PKW(pB0,4),PKW(pB0,6)};pw1=(u32x4){PKW(pB0,8),PKW(pB0,10),PKW(pB0,12),PKW(pB0,14)};pw2=(u32x4){PKW(pB1,0),PKW(pB1,2),PKW(pB1,4),PKW(pB1,6)};pw3=(u32x4){PKW(pB1,8),PKW(pB1,10),PKW(pB1,12),PKW(pB1,14)};
    SBAR(); pv(o,vb0+sl_cur,PAF(0),PAF(1),PAF(2),PAF(3)); }
  #undef PKW
  #undef PAF
  #undef VFR
  #undef PIN
  #undef MX3
  #undef GAPA
  #undef GAPB
  #undef EX
  #undef VRD
  #undef KRD
  #undef STEP
  #undef ENDW
  {auto rr=__builtin_amdgcn_permlane32_swap(__float_as_uint(l_reg),__float_as_uint(l_reg),false,false);l_reg=__uint_as_float(rr[0])+__uint_as_float(rr[1]);}
  if(hi==0)wsf[32+r32]=l_reg;asm volatile("s_waitcnt lgkmcnt(0)":::"memory");
  float rli[16];
  #pragma unroll
  for(int r=0;r<16;++r)rli[r]=__builtin_amdgcn_rcpf(wsf[32+crow(r,hi)]);
  bf16*Ow=Ow0+(long)(wid*QBLK)*ODM;
  { bf16*stg=(bf16*)(shm+LDS_OST)+wid*2048;
    #pragma unroll
    for(int r=0;r<16;++r){const int orow=crow(r,hi);
      #pragma unroll
      for(int d0=0;d0<2;++d0)stg[orow*64+d0*32+r32]=__float2bfloat16(o[d0][r]*rli[r]);}
    asm volatile("s_waitcnt lgkmcnt(0)":::"memory");
    #pragma unroll
    for(int i=0;i<4;++i){const int row=i*8+(lane>>3),ch=lane&7; const u32x4 v=*(const u32x4*)(stg+row*64+ch*8); ATTN_STORE16(Ow+(long)row*ODM+ch*8,v);} }
  asm volatile("s_waitcnt lgkmcnt(0)\n\ts_barrier":::"memory");
  #undef DMA_K
  #undef TROW
  #undef DMA_V
  #undef CMASK
  #undef START
  #undef RESC
  #undef ROT
}
constexpr int ATTN_LDS_BYTES=LDS_BYTES;
}
#ifndef DBG_MASK
#define DBG_MASK 127
#endif
#ifndef DBG_DIAG
#define DBG_DIAG 0
#endif
#ifndef DBG_NA
#define DBG_NA 1
#endif
#ifndef DBG_CTX
#define DBG_CTX 1
#endif
#ifndef DBG_POOL
#define DBG_POOL 1
#endif
namespace cg = cooperative_groups;
#define GAS __attribute__((address_space(1)))
#define LAS __attribute__((address_space(3)))
typedef unsigned short bf16;
typedef unsigned v4u __attribute__((ext_vector_type(4)));
typedef float f32x4 __attribute__((ext_vector_type(4)));
#define LDS_WAIT() asm volatile("s_waitcnt lgkmcnt(0)" ::: "memory")
__device__ __forceinline__ unsigned f2bf(float f) { unsigned u = __builtin_bit_cast(unsigned, f); return (u + 0x7fffu + ((u >> 16) & 1u)) >> 16; }
__device__ __forceinline__ unsigned pk2(float lo, float hi) { return f2bf(lo) | (f2bf(hi) << 16); }
__device__ __forceinline__ float bf2f(unsigned short h) { return __builtin_bit_cast(float, (unsigned)h << 16); }
__device__ __forceinline__ float wave_sum(float v) {
#pragma unroll
    for (int o = 1; o < 64; o <<= 1) v += __shfl_xor(v, o);
    return v;
}
#define RLX_AGENT __ATOMIC_RELAXED, __HIP_MEMORY_SCOPE_AGENT
#define XB_TMO      128
#define XB_XCNT(j)  (256  + 64 * (j))
#define XB_XSUB(j)  (1280 + 64 * (j))
#define XB_XGEN(j)  (2304 + 64 * (j))
#define XB_TOP      3328
#define XB_TOPGEN   3392
#define XCD_BAR_WORDS 3456
#define XB_SPIN_CAP (1u << 18)

__device__ __forceinline__ unsigned xb_ld(unsigned* p)              { return __hip_atomic_load(p, __ATOMIC_RELAXED, __HIP_MEMORY_SCOPE_AGENT); }
__device__ __forceinline__ unsigned xb_add(unsigned* p, unsigned v) { return __hip_atomic_fetch_add(p, v, __ATOMIC_RELAXED, __HIP_MEMORY_SCOPE_AGENT); }
__device__ __forceinline__ unsigned xb_xcc_id() { return (unsigned)__builtin_amdgcn_s_getreg((3 << 11) | 20) & 0xFu; }
#define XB_SPIN(cond, bar) do { unsigned _sp = 0; while (cond) { __builtin_amdgcn_s_sleep(1); \
    if ((++_sp & 255u) == 0u) { if (xb_ld(&(bar)[XB_TMO])) break; if (_sp > XB_SPIN_CAP) { atomicAdd(&(bar)[XB_TMO], 1u); break; } } } } while (0)

struct XcdBarrier {
    unsigned* bar; unsigned x;
    volatile LAS unsigned* st;
};

__device__ __forceinline__ XcdBarrier xcd_barrier_post(unsigned* bar, volatile LAS unsigned* st) {
    XcdBarrier b; b.bar = bar; b.x = xb_xcc_id(); b.st = st;
    if (threadIdx.x == 0) (void)xb_add(&bar[XB_XCNT(b.x)], 1u);
    return b;
}
__device__ __forceinline__ void xcd_barrier_complete(unsigned* bar, unsigned x, unsigned& nloc, unsigned& nx) {
    const unsigned G = gridDim.x * gridDim.y * gridDim.z;
    unsigned sum, cnt, mine, sp = 0u;
    for (;;) {
        sum = 0u; cnt = 0u; mine = 0u;
#pragma unroll
        for (unsigned j = 0; j < 16; ++j) { const unsigned c = xb_ld(&bar[XB_XCNT(j)]); sum += c; cnt += (c > 0u) ? 1u : 0u; mine = (j == x) ? c : mine; }
        if (sum == G) break;
        __builtin_amdgcn_s_sleep(1);
        if ((++sp & 255u) == 0u) { if (xb_ld(&bar[XB_TMO])) break; if (sp > XB_SPIN_CAP) { atomicAdd(&bar[XB_TMO], 1u); break; } }
    }
    nloc = mine > 0u ? mine : 1u; nx = cnt > 0u ? cnt : 1u;
}

__device__ __forceinline__ void xcd_barrier(const XcdBarrier& b) {
    asm volatile("s_waitcnt vmcnt(0)" ::: "memory");
    __syncthreads();
    if (threadIdx.x == 0) {
        unsigned* bar = b.bar;
        __builtin_amdgcn_s_waitcnt(0);
        unsigned nloc = b.st[0], nx = b.st[1];
        if (nloc == 0u) { xcd_barrier_complete(bar, b.x, nloc, nx); b.st[0] = nloc; b.st[1] = nx; }
        const unsigned old = xb_add(&bar[XB_XSUB(b.x)], 1u);
        const unsigned gen = old / nloc;
        if (old + 1u == (gen + 1u) * nloc) {
            __builtin_amdgcn_fence(__ATOMIC_RELEASE, "agent");
            asm volatile("s_waitcnt vmcnt(0)" ::: "memory");
            const unsigned og = xb_add(&bar[XB_TOP], 1u);
            const unsigned tg = og / nx;
            if (og + 1u == (tg + 1u) * nx) xb_add(&bar[XB_TOPGEN], 1u);
            else XB_SPIN(xb_ld(&bar[XB_TOPGEN]) == tg, bar);
            __builtin_amdgcn_fence(__ATOMIC_ACQUIRE, "agent");
            xb_add(&bar[XB_XGEN(b.x)], 1u);
            asm volatile("s_waitcnt vmcnt(0)" ::: "memory");
        } else {
            XB_SPIN(xb_ld(&bar[XB_XGEN(b.x)]) == gen, bar);
            __builtin_amdgcn_fence(__ATOMIC_ACQUIRE, "agent");
            asm volatile("s_waitcnt vmcnt(0)" ::: "memory");
        }
    }
    __syncthreads();
}
constexpr size_t MiB = 1u << 20;
constexpr size_t WS_MOD = 0, WS_ROPEC = 1 * MiB, WS_ROPES = 1 * MiB + 8192, WS_BAR = 1 * MiB + 131072;
constexpr size_t WS_WIN = 2 * MiB, WS_WOUT = 18 * MiB, WS_WUP = 26 * MiB, WS_WDN = 70 * MiB;
constexpr size_t WS_ST = 92 * MiB, WS_X = 94 * MiB, WS_H = 359 * MiB, WS_Z = 492 * MiB, WS_Y = 756 * MiB, WS_ACT = WS_Z, WS_END = 888 * MiB;
static_assert(WS_WIN + (size_t)P_DEPTH * P_INW * P_D * 2 <= WS_WOUT && WS_WOUT + (size_t)P_DEPTH * P_D * P_D * 2 <= WS_WUP && WS_WUP + (size_t)P_DEPTH * P_UPW * P_D * 2 <= WS_WDN && WS_WDN + (size_t)P_DEPTH * P_D * P_DFF * 2 <= WS_ST && WS_ST + (size_t)P_M * 8 <= WS_X, "weights map");
static_assert(WS_X + (size_t)P_M * P_D * 4 <= WS_H - MiB / 2 && WS_H + (size_t)P_M * P_D * 2 + MiB / 2 <= WS_Z && WS_Z + (size_t)P_M * P_INW * 2 <= WS_Y && WS_Y + (size_t)P_M * P_D * 2 <= WS_END && WS_ACT + (size_t)P_M * P_DFF * 2 <= WS_END, "activation map");
constexpr int LDS_BYTES = 147456, RPB_OFF = 98304, BARST_OFF = 131072 + 64;
#ifndef DBG_REP
#define DBG_REP -1
#endif
constexpr int PH_PER_L = 9;
#ifndef N1_OUT
#define N1_OUT 42000
#endif
#ifndef N1_DOWN
#define N1_DOWN 0
#endif
#ifndef DBG_P0REP
#define DBG_P0REP 0
#endif
constexpr int N_PHASES = 2 + PH_PER_L * P_DEPTH + 2 * DBG_P0REP;

struct Args {
    const float *x, *c, *ctx, *c_ctx, *w_mod, *b_mod, *w_in, *pool_w, *pool_scale, *na_rpb, *q_norm, *k_norm, *w_out, *ln1_g, *ln1_b, *w_up, *conv_w, *conv_b, *w_down, *ln2_g, *ln2_b;
    float* out; unsigned char* ws; int ph_lo, ph_hi;
};
static_assert(sizeof(Args) == 23 * 8 + 8, "Args has no padding");

template <int OFF> __device__ __forceinline__ unsigned long long ldarg() {
    unsigned long long v; asm volatile("s_load_dwordx2 %0, %1, %2\n\ts_waitcnt lgkmcnt(0)" : "=s"(v) : "s"(__builtin_amdgcn_kernarg_segment_ptr()), "n"(OFF)); return v; }
#define ARGF(A, f) (A).f = (decltype(Args::f))ldarg<offsetof(Args, f)>()
__device__ __forceinline__ void p0_item(const float* W, int K, int N, bf16* WT, int k0, int n0, int drow, LAS float* scr, int lane) {
#pragma unroll 8
    for (int i = 0; i < 32; ++i) { const int kk = 2 * i + (lane >> 5); scr[kk * 33 + (lane & 31)] = W[(size_t)(k0 + kk) * N + n0 + (lane & 31)]; }
    LDS_WAIT(); asm volatile("" ::: "memory");
    const int c = lane & 7;
#pragma unroll
    for (int j = 0; j < 4; ++j) { const int n = (lane >> 3) + 8 * j; const LAS float* s = scr + (8 * c) * 33 + n;
        v4u o; o.x = pk2(s[0 * 33], s[1 * 33]); o.y = pk2(s[2 * 33], s[3 * 33]); o.z = pk2(s[4 * 33], s[5 * 33]); o.w = pk2(s[6 * 33], s[7 * 33]);
        *(GAS v4u*)(WT + (size_t)(drow + n) * K + k0 + 8 * c) = o; }
    LDS_WAIT(); asm volatile("" ::: "memory");
}

__device__ __forceinline__ void phase0(const Args& a, LAS unsigned char* lds, int vcu, int G, int tid, int lane, int wave) {
    unsigned char* ws = a.ws;
    {
        LAS float* scr = (LAS float*)(lds + wave * 16384);
        const int gw = vcu * 8 + wave, NGW = G * 8;
        constexpr int I_IN = 16 * 64, I_OUT = 16 * 32, I_UP = 16 * 176, I_DN = 44 * 32, I_L = I_IN + I_OUT + I_UP + I_DN;
        for (int it = gw; it < P_DEPTH * I_L; it += NGW) {
            const int l = it / I_L; int r = it - l * I_L;
            if (r < I_IN) { const int kb = r >> 6, nb = r & 63, L0 = 32 * nb; const int drow = (L0 & ~255) + ((L0 >> 5) & 1) * 128 + ((L0 >> 6) & 3) * 32;
                p0_item(a.w_in + (size_t)l * P_D * P_INW, P_D, P_INW, (bf16*)(ws + WS_WIN) + (size_t)l * P_INW * P_D, 64 * kb, 32 * nb, drow, scr, lane); continue; }
            r -= I_IN;
            if (r < I_OUT) { const int kb = r >> 5, nb = r & 31;
                p0_item(a.w_out + (size_t)l * P_D * P_D, P_D, P_D, (bf16*)(ws + WS_WOUT) + (size_t)l * P_D * P_D, 64 * kb, 32 * nb, 32 * nb, scr, lane); continue; }
            r -= I_OUT;
            if (r < I_UP) { const int kb = r / 176, nb = r - kb * 176, L0 = 32 * nb; const int half = L0 >= P_DFF ? 1 : 0, ch0 = L0 - half * P_DFF; const int drow = (ch0 >> 7) * 256 + half * 128 + (ch0 & 127);
                p0_item(a.w_up + (size_t)l * P_D * P_UPW, P_D, P_UPW, (bf16*)(ws + WS_WUP) + (size_t)l * P_UPW * P_D, 64 * kb, 32 * nb, drow, scr, lane); continue; }
            r -= I_UP;
            { const int kb = r >> 5, nb = r & 31;
                p0_item(a.w_down + (size_t)l * P_DFF * P_D, P_DFF, P_D, (bf16*)(ws + WS_WDN) + (size_t)l * P_D * P_DFF, 64 * kb, 32 * nb, 32 * nb, scr, lane); }
        }
    }
    __syncthreads();
    if (vcu < 192) {
        LAS float* act = (LAS float*)lds; LAS float* red = (LAS float*)(lds + 40960);
        for (int e = tid; e < 9 * P_D; e += 512) { const int r = e >> 10, k = e & 1023; const float v = r < 8 ? a.c[r * P_D + k] : a.c_ctx[k]; act[e] = v / (1.0f + expf(-v)); }
        __syncthreads();
        for (int u = vcu; u < 192; u += G) {
            const int l = u / 48, n0 = (u - l * 48) * 128, col = tid & 127, ks = tid >> 7;
            const float* wp = a.w_mod + (size_t)l * P_D * P_MODW + (size_t)(ks * 256) * P_MODW + n0 + col;
            float s[9];
#pragma unroll
            for (int r = 0; r < 9; ++r) s[r] = 0.f;
#pragma unroll 4
            for (int k = 0; k < 256; ++k) { const float w = wp[(size_t)k * P_MODW];
#pragma unroll
                for (int r = 0; r < 9; ++r) s[r] += act[r * P_D + ks * 256 + k] * w; }
#pragma unroll
            for (int r = 0; r < 9; ++r) red[(ks * 9 + r) * 128 + col] = s[r];
            __syncthreads();
            for (int e = tid; e < 9 * 128; e += 512) { const int r = e >> 7, cc = e & 127;
                const float t = (red[(0 * 9 + r) * 128 + cc] + red[(1 * 9 + r) * 128 + cc]) + (red[(2 * 9 + r) * 128 + cc] + red[(3 * 9 + r) * 128 + cc]);
                ((float*)(ws + WS_MOD))[(size_t)(l * 9 + r) * P_MODW + n0 + cc] = t + a.b_mod[l * P_MODW + n0 + cc]; }
            __syncthreads();
        }
    }
    if (vcu == G - 1) {
        for (int e = tid; e < 2048; e += 512) { const int pos = e >> 4, f = e & 15;
            const float inv = exp2f(-(float)f * (13.287712379549449f / 16.0f));
            const float ang = (float)pos * inv;
            ((float*)(ws + WS_ROPEC))[e] = cosf(ang); ((float*)(ws + WS_ROPES))[e] = sinf(ang); }
    }
}

template <int KIND> __device__ __forceinline__ void row_phase(const Args& a, int l, int mode, int n1, int bx, int vcu, int G, int wave, int lane) {
    unsigned char* ws = a.ws; const float* X = (const float*)(ws + WS_X); bf16* H = (bf16*)(ws + WS_H); const float* mod = (const float*)(ws + WS_MOD); float* ST = (float*)(ws + WS_ST);
    const bool lastl = (KIND == 2 && l == P_DEPTH - 1);
    const int ml = (KIND == 2) ? l + 1 : l; const int csh = (KIND == 1) ? 3 : 0, csc = (KIND == 1) ? 4 : 1;
    const float* lg = (KIND == 1 ? a.ln1_g : a.ln2_g) + l * P_D; const float* lb = (KIND == 1 ? a.ln1_b : a.ln2_b) + l * P_D;
#define ROW_OF(i) (mode == 1 ? (i) + (((i) >> 13) + 1) * P_CTX : (mode == 2 ? ((i) >> 8) * P_RPB + ((i) & 255) : (i)))
#define ROW_SRC(m_, b_, rb_) ((KIND == 0) ? ((rb_) < P_CTX ? a.ctx + ((size_t)(b_) * P_CTX + (rb_)) * P_D : a.x + ((size_t)(b_) * P_SEQ + ((rb_) - P_CTX)) * P_D) : X + (size_t)(m_) * P_D)
    for (int seg = 0; seg < 2; ++seg) {
        int start, stride, end;
        if (seg == 0) { start = vcu * 8 + wave; stride = G * 8; end = (mode == 0) ? P_M : (mode == 2 ? P_B * P_CTX : n1); }
        else { if (mode != 1 || bx < 32) break; start = n1 + (bx - 32) * 8 + wave; stride = (G - 32) * 8; end = P_B * P_SEQ; }
        f32x4 vn[4];
        if (start < end) { const int m0 = ROW_OF(start); const int b0 = m0 / P_RPB, rb0 = m0 - b0 * P_RPB; const f32x4* xr = (const f32x4*)ROW_SRC(m0, b0, rb0) + lane;
#pragma unroll
            for (int j = 0; j < 4; ++j) vn[j] = xr[64 * j]; }
        for (int i = start; i < end; i += stride) {
            const int m = ROW_OF(i);
            const int b = m / P_RPB, rb = m - b * P_RPB; const bool is_ctx = rb < P_CTX; const int mrow = is_ctx ? 8 : b;
            f32x4 v[4];
#pragma unroll
            for (int j = 0; j < 4; ++j) v[j] = vn[j];
            if (i + stride < end) { const int m1 = ROW_OF(i + stride); const int b1 = m1 / P_RPB, rb1 = m1 - b1 * P_RPB; const f32x4* xr = (const f32x4*)ROW_SRC(m1, b1, rb1) + lane;
#pragma unroll
                for (int j = 0; j < 4; ++j) vn[j] = xr[64 * j]; }
            if (KIND != 0) {
                float s = 0.f;
#pragma unroll
                for (int j = 0; j < 4; ++j) s += (v[j].x + v[j].y) + (v[j].z + v[j].w);
                const float mean = wave_sum(s) * (1.f / P_D); float s2 = 0.f;
#pragma unroll
                for (int j = 0; j < 4; ++j) { v[j] = v[j] - mean; s2 += (v[j].x * v[j].x + v[j].y * v[j].y) + (v[j].z * v[j].z + v[j].w * v[j].w); }
                const float rstd = 1.f / sqrtf(wave_sum(s2) * (1.f / P_D) + P_EPS);
                if (!lastl && lane == 0) { ST[(size_t)m * 2] = mean; ST[(size_t)m * 2 + 1] = rstd; }
#pragma unroll
                for (int j = 0; j < 4; ++j) { const f32x4 g = ((const f32x4*)lg)[lane + 64 * j], bb = ((const f32x4*)lb)[lane + 64 * j]; v[j] = v[j] * rstd * g + bb; }
            }
            if (lastl) {
                if (!is_ctx) { f32x4* o = (f32x4*)(a.out + ((size_t)b * P_SEQ + (rb - P_CTX)) * P_D) + lane;
#pragma unroll
                    for (int j = 0; j < 4; ++j) o[64 * j] = v[j]; }
            } else {
                const float* mp = mod + (size_t)(ml * 9 + mrow) * P_MODW;
                unsigned long long* o8 = (unsigned long long*)(H + (size_t)m * P_D) + lane;
#pragma unroll
                for (int j = 0; j < 4; ++j) { const f32x4 sh = ((const f32x4*)(mp + csh * P_D))[lane + 64 * j], sc = ((const f32x4*)(mp + csc * P_D))[lane + 64 * j];
                    const f32x4 h = v[j] * (1.0f + sc) + sh;
                    o8[64 * j] = (unsigned long long)pk2(h.x, h.y) | ((unsigned long long)pk2(h.z, h.w) << 32); }
            }
        }
    }
#undef ROW_OF
#undef ROW_SRC
}

__device__ __forceinline__ void pool_unit(const Args& a, int l, int u, LAS unsigned char* lds, int tid) {
    const bf16* Z = (const bf16*)(a.ws + WS_Z); bf16* Y = (bf16*)(a.ws + WS_Y);
    const int tk = u >> 2, g = u & 3; const int row0 = tk * 128; const int b = row0 / P_RPB, rb0 = row0 - b * P_RPB;
    const int slo = (rb0 < P_CTX) ? b * P_RPB : b * P_RPB + P_CTX, shi = (rb0 < P_CTX) ? b * P_RPB + P_CTX : (b + 1) * P_RPB;
    LAS float* zt = (LAS float*)lds;
    LAS float* pl = (LAS float*)(lds + 36864);
    LAS float* wl = (LAS float*)(lds + 36864 + 34816);
    for (int e = tid; e < 144 * 8; e += 512) { const int rr = e >> 3, c8 = e & 7; const int R = row0 - 8 + rr;
        v4u w = (v4u){0u, 0u, 0u, 0u};
        if (R >= slo && R < shi) w = *(const v4u*)(Z + (size_t)R * P_INW + g * 64 + c8 * 8);
        LAS float* d = zt + rr * 64 + c8 * 8;
        d[0] = bf2f(w.x & 0xffff); d[1] = bf2f(w.x >> 16); d[2] = bf2f(w.y & 0xffff); d[3] = bf2f(w.y >> 16); d[4] = bf2f(w.z & 0xffff); d[5] = bf2f(w.z >> 16); d[6] = bf2f(w.w & 0xffff); d[7] = bf2f(w.w >> 16); }
    { const f32x4* wsrc = (const f32x4*)(a.pool_w + ((size_t)l * 4 + g) * 4096);
      for (int e = tid; e < 1024; e += 512) ((LAS f32x4*)wl)[e] = wsrc[e]; }
    __syncthreads();
    const int hw = 1 << g;
    for (int e = tid; e < 128 * 64; e += 512) { const int t = e >> 6, c = e & 63; const int T = row0 + t;
        const int lo = max(T - hw, slo), hi = min(T + hw - 1, shi - 1);
        float s = 0.f;
        for (int p = lo; p <= hi; ++p) s += zt[(p - row0 + 8) * 64 + c];
        pl[t * 68 + c] = s / (float)(hi - lo + 1) - zt[(t + 8) * 64 + c]; }
    __syncthreads();
    { const int d = tid & 63, tq = tid >> 6;
      float acc[16];
#pragma unroll
      for (int t = 0; t < 16; ++t) acc[t] = 0.f;
      for (int c4 = 0; c4 < 16; ++c4) {
          const float w0 = wl[(4 * c4 + 0) * 64 + d], w1 = wl[(4 * c4 + 1) * 64 + d], w2 = wl[(4 * c4 + 2) * 64 + d], w3 = wl[(4 * c4 + 3) * 64 + d];
#pragma unroll
          for (int t = 0; t < 16; ++t) { const f32x4 p = *(const LAS f32x4*)(pl + (tq * 16 + t) * 68 + 4 * c4); acc[t] += (p.x * w0 + p.y * w1) + (p.z * w2 + p.w * w3); }
      }
      const float sc = a.pool_scale[l * 256 + g * 64 + d];
#pragma unroll
      for (int t = 0; t < 16; ++t) Y[(size_t)(row0 + tq * 16 + t) * P_D + g * 64 + d] = (bf16)f2bf(acc[t] * sc);
    }
    __syncthreads();
}

__device__ __forceinline__ void mix_phase(const Args& a, int l, unsigned char* ldsg, LAS unsigned char* lds, int vcu, int G, int tid) {
    using abf = attn_body::bf16;
    const abf* Z = (const abf*)(a.ws + WS_Z); abf* Y = (abf*)(a.ws + WS_Y);
    { LAS float* rp = (LAS float*)(lds + RPB_OFF); const float* src = a.na_rpb + (size_t)l * 6 * 465;
      for (int e = tid; e < 6 * 465; e += 512) rp[e] = src[e] * P_LOG2E; }
    __syncthreads();
    for (int u = vcu; u < 1536; u += G) { const int h = u >> 8, b = (u >> 5) & 7, qb = u & 31, kv = h / 3;
        const size_t brow = (size_t)b * P_RPB, qrow = brow + P_CTX + (size_t)qb * 256;
        attn_body::attn_unit<8, 0>(Z + qrow * P_INW + 1408 + 64 * h, Z + brow * P_INW + 1792 + 64 * kv, Z + brow * P_INW + 1920 + 64 * kv, Y + qrow * P_D + 640 + 64 * h, 132, 256, 0, 0, RPB_OFF, (char*)ldsg); }
    if (DBG_NA) for (int u = vcu; u < 1536; u += G) { const int h = u >> 8, b = (u >> 5) & 7, qb = u & 31;
        const size_t brow = (size_t)b * P_RPB, qrow = brow + P_CTX + (size_t)qb * 256;
        const int rsmin = min(max(4 * qb - 4, 0), 116);
        attn_body::attn_unit<8, 1>(Z + qrow * P_INW + 256 + 64 * h, Z + brow * P_INW + 640 + 64 * h, Z + brow * P_INW + 1024 + 64 * h, Y + qrow * P_D + 256 + 64 * h, 16, 256 + 64 * rsmin, 4 * qb, rsmin, RPB_OFF + h * 465 * 4, (char*)ldsg); }
    if (DBG_CTX && l < P_DEPTH - 1)
        for (int u = vcu; u < 96; u += G) { const int b = u / 12, hh = u - b * 12; const size_t brow = (size_t)b * P_RPB;
            int qc, kc, vc, oc;
            if (hh < 6) { qc = 256 + 64 * hh; kc = 640 + 64 * hh; vc = 1024 + 64 * hh; oc = 256 + 64 * hh; }
            else { const int h = hh - 6; qc = 1408 + 64 * h; kc = 1792 + 64 * (h / 3); vc = 1920 + 64 * (h / 3); oc = 640 + 64 * h; }
            attn_body::attn_unit<8, 0>(Z + brow * P_INW + qc, Z + brow * P_INW + kc, Z + brow * P_INW + vc, Y + brow * P_D + oc, 4, 256, 0, 0, RPB_OFF, (char*)ldsg); }
    if (DBG_POOL) for (int u = vcu; u < (P_M / 128) * 4; u += G) pool_unit(a, l, u, lds, tid);
}


#if DBG_DIAG
constexpr size_t WS_FLAG = 1 * MiB + 65536;
__device__ __forceinline__ bool dclose(float a, float b, float tol) { return fabsf(a - b) <= tol * (1.0f + fabsf(b)); }
__device__ __forceinline__ void diag_phase(const Args& a, int code, int vcu, int tid, int G) {
    unsigned char* ws = a.ws; unsigned* flag = (unsigned*)(ws + WS_FLAG);
    const float* mod = (const float*)(ws + WS_MOD); const float* X = (const float*)(ws + WS_X); const bf16* H = (const bf16*)(ws + WS_H);
    const bf16* Z = (const bf16*)(ws + WS_Z); const bf16* Y = (const bf16*)(ws + WS_Y); const bf16* ACT = (const bf16*)(ws + WS_ACT);
    const int b = 2, pos = 3000; const size_t Rl = (size_t)b * P_RPB + P_CTX + pos;
    const int lane = tid & 63;
    if (code == 199) {
        const unsigned fl = *flag; int first = 0; for (int i = 0; i < 16; ++i) if ((fl >> i) & 1) { first = i + 1; break; }
        if ((fl >> 20) & 1) first += 16;
        for (size_t i = (size_t)vcu * 512 + tid; i < (size_t)P_B * P_SEQ * P_D; i += (size_t)G * 512) a.out[i] = (float)first;
        return;
    }
    if (vcu != 0 || tid >= 64) return;
    bool bad = false;
    if (code == 100) {
        if (lane == 0) *flag = 0u;
        { const int got = __builtin_amdgcn_mov_dpp(lane, 0x121, 0xf, 0xf, true); const int want = (lane & ~15) | ((lane + 15) & 15);
          if (__any(got != want) && lane == 0) atomicOr(flag, 1u << 20); }
        const int ns[4] = {5, 1030, 3200, 6000};
        for (int q = 0; q < 4; ++q) { const int n = ns[q]; float s = 0.f;
            for (int k = lane; k < P_D; k += 64) { const float v = a.c[b * P_D + k]; s += v / (1.f + expf(-v)) * a.w_mod[(size_t)k * P_MODW + n]; }
            s = wave_sum(s) + a.b_mod[n]; if (!dclose(mod[(size_t)b * P_MODW + n], s, 1e-3f)) bad = true; }
        { const int k = lane * 16 + 3; const float xv = a.x[((size_t)b * P_SEQ + pos) * P_D + k];
          const float h = xv * (1.f + mod[(size_t)b * P_MODW + P_D + k]) + mod[(size_t)b * P_MODW + k];
          if (!dclose(bf2f(H[Rl * P_D + k]), h, 1e-2f)) bad = true; if (X[Rl * P_D + k] != xv) bad = true; }
        if (__any(bad) && lane == 0) atomicOr(flag, 1u);
    } else if (code == 101) {
        const int cs[5] = {100, 700, 1100, 2000, 300};
        for (int q = 0; q < 5; ++q) { const int col = cs[q]; float s = 0.f;
            for (int k = lane; k < P_D; k += 64) s += bf2f(H[Rl * P_D + k]) * a.w_in[(size_t)k * P_INW + col];
            s = wave_sum(s); if (q == 4) s *= P_C2; if (!dclose(bf2f(Z[Rl * P_INW + col]), s, 3e-2f)) bad = true; }
        if (__any(bad) && lane == 0) atomicOr(flag, 2u);
        bad = false;
        { float s = 0.f; for (int k = 0; k < P_D; ++k) s += bf2f(H[Rl * P_D + k]) * a.w_in[(size_t)k * P_INW + 1792 + lane];
          const float ss = wave_sum(s * s); float xn = s / sqrtf(ss / 64.f + P_EPS) * a.k_norm[lane];
          const int gr = pos >> 6, gc = pos & 63; const int f = lane & 15; const float inv = exp2f(-(float)f * (13.287712379549449f / 16.0f));
          const float ang = (float)((lane < 32) ? gr : gc) * inv; const float cs_ = cosf(ang), sn_ = sinf(ang);
          const float pr = __shfl_xor(xn, 16); const float o = ((lane & 16) == 0) ? xn * cs_ - pr * sn_ : pr * sn_ + xn * cs_;
          if (!dclose(bf2f(Z[Rl * P_INW + 1792 + lane]), o, 3e-2f)) bad = true; }
        if (__any(bad) && lane == 0) atomicOr(flag, 4u);
    } else if (code == 102) {
        { const int g = 3, hw = 8; float s = 0.f; for (int p = -hw; p < hw; ++p) s += bf2f(Z[(Rl + p) * P_INW + g * 64 + lane]);
          const float pooled = s / 16.f - bf2f(Z[Rl * P_INW + g * 64 + lane]); float y = 0.f;
          for (int c = 0; c < 64; ++c) y += __shfl(pooled, c) * a.pool_w[(size_t)g * 4096 + c * 64 + lane];
          y *= a.pool_scale[g * 64 + lane]; if (!dclose(bf2f(Y[Rl * P_D + g * 64 + lane]), y, 3e-2f)) bad = true; }
        if (__any(bad) && lane == 0) atomicOr(flag, 8u);
        bad = false;
        { const int h = 2; const int gr = pos >> 6, gc = pos & 63; const int rs = min(max(gr - 4, 0), 120), cs = min(max(gc - 8, 0), 48);
          float mx = -1e30f, sc[6];
          for (int i = 0; i < 6; ++i) { const int key = lane + 64 * i; size_t kr_; float bias = 0.f;
              if (key < 128) { const int kr = rs + key / 16, kc = cs + key % 16; kr_ = (size_t)b * P_RPB + P_CTX + kr * 64 + kc; bias = a.na_rpb[(size_t)h * 465 + (kr - gr + 7) * 31 + (kc - gc + 15)] * P_LOG2E; }
              else kr_ = (size_t)b * P_RPB + (key - 128);
              float s = 0.f; for (int d = 0; d < 64; ++d) s += bf2f(Z[Rl * P_INW + 256 + 64 * h + d]) * bf2f(Z[kr_ * P_INW + 640 + 64 * h + d]);
              sc[i] = s + bias; mx = fmaxf(mx, sc[i]); }
          for (int o = 1; o < 64; o <<= 1) mx = fmaxf(mx, __shfl_xor(mx, o));
          float den = 0.f; for (int i = 0; i < 6; ++i) { sc[i] = exp2f(sc[i] - mx); den += sc[i]; } den = wave_sum(den);
          float o_ = 0.f;
          for (int i = 0; i < 6; ++i) for (int l2 = 0; l2 < 64; ++l2) { const int key = l2 + 64 * i; size_t kr_;
              if (key < 128) { const int kr = rs + key / 16, kc = cs + key % 16; kr_ = (size_t)b * P_RPB + P_CTX + kr * 64 + kc; } else kr_ = (size_t)b * P_RPB + (key - 128);
              o_ += __shfl(sc[i], l2) * bf2f(Z[kr_ * P_INW + 1024 + 64 * h + lane]); }
          o_ /= den; if (!dclose(bf2f(Y[Rl * P_D + 256 + 64 * h + lane]), o_, 3e-2f)) bad = true; }
        if (__any(bad) && lane == 0) atomicOr(flag, 16u);
        bad = false;
        { const int h = 4, kv = 1; float mx = -1e30f; float den = 0.f, o_ = 0.f;
          for (int i = 0; i < 132; ++i) { const size_t kr_ = (size_t)b * P_RPB + lane + 64 * i; float s = 0.f;
              for (int d = 0; d < 64; ++d) s += bf2f(Z[Rl * P_INW + 1408 + 64 * h + d]) * bf2f(Z[kr_ * P_INW + 1792 + 64 * kv + d]); mx = fmaxf(mx, s); }
          for (int o = 1; o < 64; o <<= 1) mx = fmaxf(mx, __shfl_xor(mx, o));
          for (int i = 0; i < 132; ++i) { const size_t kr_ = (size_t)b * P_RPB + lane + 64 * i; float s = 0.f;
              for (int d = 0; d < 64; ++d) s += bf2f(Z[Rl * P_INW + 1408 + 64 * h + d]) * bf2f(Z[kr_ * P_INW + 1792 + 64 * kv + d]);
              const float p = exp2f(s - mx); den += p;
              for (int l2 = 0; l2 < 64; ++l2) o_ += __shfl(p, l2) * bf2f(Z[((size_t)b * P_RPB + l2 + 64 * i) * P_INW + 1920 + 64 * kv + lane]); }
          den = wave_sum(den); o_ /= den; if (!dclose(bf2f(Y[Rl * P_D + 640 + 64 * h + lane]), o_, 3e-2f)) bad = true; }
        if (__any(bad) && lane == 0) atomicOr(flag, 32u);
    } else if (code == 103) {
        { const int c = lane * 16 + 5; float s = 0.f; for (int k = 0; k < P_D; ++k) s += bf2f(Y[Rl * P_D + k]) * a.w_out[(size_t)k * P_D + c];
          const float e = P_ALPHA * a.x[((size_t)b * P_SEQ + pos) * P_D + c] + mod[(size_t)b * P_MODW + 2 * P_D + c] * s;
          if (!dclose(X[Rl * P_D + c], e, 3e-3f)) bad = true; }
        if (__any(bad) && lane == 0) atomicOr(flag, 64u);
    } else if (code == 104) {
        { float m = 0.f, q = 0.f; for (int k = lane; k < P_D; k += 64) { const float y = (X[Rl * P_D + k] - a.ln1_b[k]) / a.ln1_g[k]; m += y; q += y * y; }
          m = wave_sum(m) / P_D; q = wave_sum(q) / P_D; if (fabsf(m) > 1e-3f || fabsf(q - 1.f) > 2e-3f) bad = true;
          const int k = lane * 16 + 7; const float h = X[Rl * P_D + k] * (1.f + mod[(size_t)b * P_MODW + 4 * P_D + k]) + mod[(size_t)b * P_MODW + 3 * P_D + k];
          if (!dclose(bf2f(H[Rl * P_D + k]), h, 1e-2f)) bad = true; }
        if (__any(bad) && lane == 0) atomicOr(flag, 128u);
    } else if (code == 105) {
        { const int ch = 37 + lane * 43; float ua[3] = {0.f, 0.f, 0.f}, ug[3] = {0.f, 0.f, 0.f};
          for (int k = 0; k < P_D; ++k) { const float wa = a.w_up[(size_t)k * P_UPW + ch], wg = a.w_up[(size_t)k * P_UPW + P_DFF + ch];
              for (int j = 0; j < 3; ++j) { const float hv = bf2f(H[(Rl + j - 1) * P_D + k]); ua[j] += hv * wa; ug[j] += hv * wg; } }
          const float av = a.conv_w[ch] * ua[0] + a.conv_w[P_UPW + ch] * ua[1] + a.conv_w[2 * P_UPW + ch] * ua[2] + a.conv_b[ch];
          const float gv = a.conv_w[P_DFF + ch] * ug[0] + a.conv_w[P_UPW + P_DFF + ch] * ug[1] + a.conv_w[2 * P_UPW + P_DFF + ch] * ug[2] + a.conv_b[P_DFF + ch];
          const float e = av * gv / (1.f + expf(-gv)); if (!dclose(bf2f(ACT[Rl * P_DFF + ch]), e, 4e-2f)) bad = true; }
        if (__any(bad) && lane == 0) atomicOr(flag, 256u);
    } else if (code == 106) {
        { const int c = lane * 16 + 9; float s = 0.f; for (int k = 0; k < P_DFF; ++k) s += bf2f(ACT[Rl * P_DFF + k]) * a.w_down[(size_t)k * P_D + c];
          const float x1 = (bf2f(H[Rl * P_D + c]) - mod[(size_t)b * P_MODW + 3 * P_D + c]) / (1.f + mod[(size_t)b * P_MODW + 4 * P_D + c]);
          const float e = P_ALPHA * x1 + mod[(size_t)b * P_MODW + 5 * P_D + c] * s;
          if (fabsf(X[Rl * P_D + c] - e) > 0.03f) bad = true; }
        if (__any(bad) && lane == 0) atomicOr(flag, 512u);
    }
}
#endif

__global__ void __launch_bounds__(512, 2) mega(Args a) {
    extern __shared__ __attribute__((aligned(16))) unsigned char ldsraw[];
    LAS unsigned char* lds = (LAS unsigned char*)ldsraw;
    cg::grid_group grid = cg::this_grid();
    const int G = gridDim.x; const int bx = blockIdx.x; const int vcu = (G % 8 == 0) ? (bx % 8) * (G / 8) + bx / 8 : bx;
    const int ph_lo = a.ph_lo, ph_hi = a.ph_hi;
    volatile LAS unsigned* barst = (volatile LAS unsigned*)(lds + BARST_OFF);
    if (threadIdx.x < 2) barst[threadIdx.x] = 0u;
    if (ph_lo == 0 && blockIdx.x == 0) { unsigned* bw = (unsigned*)(a.ws + WS_BAR); for (int i = threadIdx.x; i < XCD_BAR_WORDS; i += 512) bw[i] = 0u; }
    __syncthreads();
    XcdBarrier xbar; xbar.bar = (unsigned*)(a.ws + WS_BAR); xbar.x = 0; xbar.st = barst;
    for (int ph_ = ph_lo; ph_ < ph_hi; ++ph_) {
        const int ph = (ph_ < 2 * DBG_P0REP) ? (ph_ & 1) : ph_ - 2 * DBG_P0REP;
        if (ph_ > ph_lo) {
            if (ph_ == ph_lo + 1) { grid.sync(); xbar = xcd_barrier_post((unsigned*)(a.ws + WS_BAR), barst); }
            else xcd_barrier(xbar);
        }
        const int tid = ltid(), lane = tid & 63, wave = __builtin_amdgcn_readfirstlane(tid >> 6);
        Args q;
        ARGF(q, ws); unsigned char* ws = q.ws;
#if DBG_DIAG
        if (ph >= 100) { q = a; diag_phase(q, ph, vcu, tid, G); continue; }
#endif
        if (ph == 0) { ARGF(q, c); ARGF(q, c_ctx); ARGF(q, w_mod); ARGF(q, b_mod); ARGF(q, w_in); ARGF(q, w_out); ARGF(q, w_up); ARGF(q, w_down); phase0(q, lds, vcu, G, tid, lane, wave); continue; }
        if (ph == 1) { ARGF(q, x); ARGF(q, ctx); row_phase<0>(q, 0, 0, 0, bx, vcu, G, wave, lane); continue; }
        const int l = (ph - 2) / PH_PER_L, sp = (ph - 2) % PH_PER_L; const bool lastL = (l == P_DEPTH - 1);
        if (sp == 0) {
            ARGF(q, q_norm); ARGF(q, k_norm);
            pg8::Gemm g{(const pg8::bf16_t*)(ws + WS_H), (const pg8::bf16_t*)(ws + WS_WIN) + (size_t)l * P_INW * P_D, P_M, P_INW, P_D};
            pg8::StaticOrder S; S.init(P_M / 256, P_INW / 256, G, bx);
            pg8::EpiIn E{(pg8::bf16_t*)(ws + WS_Z), q.q_norm + l * 64, q.k_norm + l * 64, (const float*)(ws + WS_ROPEC), (const float*)(ws + WS_ROPES)};
            pg8::gemm_phase<pg8::EpiIn, pg8::StaticOrder, true, true, 0>(lds, g, S, E);
        } else if (sp == 1) {
            ARGF(q, na_rpb); ARGF(q, pool_w); ARGF(q, pool_scale);
            mix_phase(q, l, ldsraw, lds, vcu, G, tid);
        } else if (sp == 5) {
            ARGF(q, conv_w); ARGF(q, conv_b);
            pg8::Gemm g{(const pg8::bf16_t*)(ws + WS_H) - P_D, (const pg8::bf16_t*)(ws + WS_WUP) + (size_t)l * P_UPW * P_D, P_M, P_UPW, P_D};
            pg8::StaticOrder S; S.init((P_M + 247) / 248, P_UPW / 256, G, bx);
            pg8::EpiUp E{(pg8::bf16_t*)(ws + WS_ACT), q.conv_w + (size_t)l * 3 * P_UPW, q.conv_b + (size_t)l * P_UPW};
            pg8::gemm_phase<pg8::EpiUp, pg8::StaticOrder, true, true, 1>(lds, g, S, E);
        } else {
            const bool isdown = sp >= 6, ctxpart = (sp == 3 || sp == 7);
            ARGF(q, ln1_g); ARGF(q, ln1_b); ARGF(q, ln2_g); ARGF(q, ln2_b);
            if (sp == 2 || sp == 6 || (ctxpart && !lastL)) {
                ARGF(q, x); ARGF(q, ctx);
                const bool first = (!isdown && l == 0);
                pg8::Gemm g{(const pg8::bf16_t*)(ws + (isdown ? WS_ACT : WS_Y)), isdown ? (const pg8::bf16_t*)(ws + WS_WDN) + (size_t)l * P_D * P_DFF : (const pg8::bf16_t*)(ws + WS_WOUT) + (size_t)l * P_D * P_D, P_M, P_D, isdown ? P_DFF : P_D};
                pg8::StaticOrder S; S.init(P_B * P_SEQ / 256, P_D / 256, G, bx); S.skipctx = 1; S.ctxonly = ctxpart ? 1 : 0;
                pg8::EpiRes E{(float*)(ws + WS_X), (const float*)(ws + WS_MOD) + (size_t)l * 9 * P_MODW + (isdown ? 5 : 2) * P_D, (const float*)(ws + WS_ST),
                              first ? nullptr : (isdown ? q.ln1_g + l * P_D : q.ln2_g + (l - 1) * P_D), first ? nullptr : (isdown ? q.ln1_b + l * P_D : q.ln2_b + (l - 1) * P_D), q.x, q.ctx};
                pg8::gemm_phase<pg8::EpiRes, pg8::StaticOrder, true, true, 0>(lds, g, S, E);
            }
            if (sp == 3 || (sp == 4 && !lastL)) row_phase<1>(q, l, sp == 3 ? 1 : 2, lastL ? P_B * P_SEQ : N1_OUT, bx, vcu, G, wave, lane);
            if (sp == 7 || (sp == 8 && !lastL)) { ARGF(q, out); row_phase<2>(q, l, sp == 7 ? 1 : 2, lastL ? P_B * P_SEQ : N1_DOWN, bx, vcu, G, wave, lane); }
        }
    }
}

#ifndef MK_MULTI
#define MK_MULTI 0
#endif
extern "C" void kernel_launch(void* const* d_in, const int* in_sizes, int n_in, void* d_out, int out_size, void* d_ws, size_t ws_size, hipStream_t stream) {
    static int grid = 0;
    if (grid == 0) {
        if (n_in != 21 || ws_size < WS_END) { fprintf(stderr, "kernel_launch: unexpected n_in %d / ws_size %zu\n", n_in, ws_size); grid = -1; return; }
        int dev = 0, cus = 0, per_cu = 0;
        if (hipGetDevice(&dev) != hipSuccess || hipDeviceGetAttribute(&cus, hipDeviceAttributeMultiprocessorCount, dev) != hipSuccess) { grid = -1; return; }
        if (hipFuncSetAttribute((const void*)mega, hipFuncAttributeMaxDynamicSharedMemorySize, LDS_BYTES) != hipSuccess) { fprintf(stderr, "kernel_launch: hipFuncSetAttribute failed\n"); grid = -1; return; }
        if (hipOccupancyMaxActiveBlocksPerMultiprocessor(&per_cu, (const void*)mega, 512, LDS_BYTES) != hipSuccess || per_cu < 1) { fprintf(stderr, "kernel_launch: occupancy query says %d\n", per_cu); per_cu = 1; }
        (void)hipGetLastError();
        grid = cus * 1;
        fprintf(stderr, "kernel_launch: cus %d per_cu %d grid %d\n", cus, per_cu, grid);
    }
    if (grid < 0) return;
    Args a{};
    const float** f = (const float**)&a;
    for (int i = 0; i < 21; ++i) f[i] = (const float*)d_in[i];
    a.out = (float*)d_out; a.ws = (unsigned char*)d_ws;
#if MK_MULTI
#if DBG_DIAG
    { const int seq[] = {0, 1, 100, 2, 101, 3, 102, 4, 103, 5, 104, 6, 105, 7, 106, 199};
      for (int i = 0; i < 16; ++i) { a.ph_lo = seq[i]; a.ph_hi = seq[i] + 1; hipLaunchKernelGGL(mega, dim3(grid), dim3(512), LDS_BYTES, stream, a); } }
#else
    for (int ph = 0; ph < N_PHASES; ++ph) { a.ph_lo = ph; a.ph_hi = ph + 1; hipLaunchKernelGGL(mega, dim3(grid), dim3(512), LDS_BYTES, stream, a); }
#endif
#else
    a.ph_lo = 0; a.ph_hi = N_PHASES;
    void* args[] = {&a};
    hipError_t e = hipLaunchCooperativeKernel((const void*)mega, dim3(grid), dim3(512), args, LDS_BYTES, stream);
    if (e != hipSuccess) fprintf(stderr, "cooperative launch failed: %s (grid %d)\n", hipGetErrorString(e), grid);
#endif
}
```

```cpp
#include <hip/hip_runtime.h>
#include <hip/hip_cooperative_groups.h>
#include <cstdio>
#include <cstdint>
constexpr int P_D = 1024, P_B = 8, P_SEQ = 8192, P_CTX = 256, P_RPB = P_SEQ + P_CTX  , P_M = P_B * P_RPB  ;
constexpr int P_DEPTH = 4, P_INW = 2048, P_DFF = 2816, P_UPW = 2 * P_DFF, P_MODW = 6 * P_D;
constexpr float P_C2 = 0.125f * 1.4426950408889634f;
constexpr float P_LOG2E = 1.4426950408889634f;
constexpr float P_ALPHA = 1.681792830507429f;
constexpr float P_EPS = 1e-6f;
__device__ __forceinline__ int ltid() { int t = threadIdx.x; asm volatile("" : "+v"(t)); return t; }
namespace pg8 {
#define PG8_LAS __attribute__((address_space(3)))
typedef unsigned short bf16_t;
typedef short bf16x8 __attribute__((ext_vector_type(8)));
typedef float f32x4 __attribute__((ext_vector_type(4)));
typedef unsigned u32x4 __attribute__((ext_vector_type(4)));
constexpr int BM = 256, BK = 64, HALF = 128, HTB = HALF * BK * 2  , STAGE_BYTES = 8 * HTB, NXCD = 8, WGM = 8;

__host__ __device__ __forceinline__ int lds_byte(int r, int c) { const int st = (r >> 4) * 2 + (c >> 5), rr = r & 15, cc = c & 31, ob = rr * 64 + cc * 2; return st * 1024 + (ob ^ (((ob >> 9) & 1) << 5)); }
__host__ __device__ __forceinline__ void stage_rc(int b, int& R, int& C) { const int st = b / 1024, sb = b % 1024, swz = sb ^ (((sb >> 9) & 1) << 5); R = (st >> 1) * 16 + swz / 64; C = (st & 1) * 32 + (swz % 64) / 2; }
__host__ __device__ __forceinline__ int perm32(int rho) { const int n = rho >> 4, i = rho & 15; return 8 * (i >> 2) + 4 * n + (i & 3); }

struct Unit { int pm, pn; };
struct Gemm { const bf16_t* A; const bf16_t* Bt; int M, N, K; };

struct StaticOrder {
    int nM, nN, nwg, G, c, skipctx = 0, ctxonly = 0;
    __host__ __device__ void init(int nM_, int nN_, int G_, int c_) { nM = nM_; nN = nN_; nwg = nM * nN; G = G_; c = c_; }
    __host__ __device__ bool next(int i, Unit& u) const {
        if (ctxonly) { if (i > 0 || c >= 32) return false; u.pm = (c >> 2) * 33; u.pn = c & 3; return true; }
        const long L = (long)i * G + c; if (L >= nwg) return false;
        int wgid = (int)L; { const int q = nwg / NXCD, r = nwg % NXCD, xcd = wgid % NXCD, off = wgid / NXCD; wgid = (xcd < r ? xcd * (q + 1) : r * (q + 1) + (xcd - r) * q) + off; }
        const int nig = WGM * nN, gid = wgid / nig, fm = gid * WGM, gsz = (nM - fm) < WGM ? (nM - fm) : WGM;
        u.pm = fm + ((wgid % nig) % gsz); u.pn = (wgid % nig) / gsz; if (skipctx) u.pm += (u.pm >> 5) + 1; return true;
    }
    __device__ __forceinline__ void a_ready(const Unit&) const {}
    __device__ __forceinline__ void done(const Unit&) const {}
};

__device__ __forceinline__ unsigned cvt_pk_bf16(float lo, float hi) { unsigned r; asm volatile("v_cvt_pk_bf16_f32 %0, %1, %2" : "=v"(r) : "v"(lo), "v"(hi)); return r; }
#ifndef EPI_SHFL
#define EPI_SHFL 0
#endif
typedef float f32x2 __attribute__((ext_vector_type(2)));
__device__ __forceinline__ f32x4 dppror(const f32x4 v, const bool up) {
    f32x4 r;
#if EPI_SHFL
    const int lane = threadIdx.x & 63; const int src = (lane & ~15) | ((lane + (up ? 15 : 1)) & 15);
#pragma unroll
    for (int j = 0; j < 4; ++j) r[j] = __shfl(v[j], src);
#else
#pragma unroll
    for (int j = 0; j < 4; ++j) { const float xs = v[j]; const int iv = __float_as_int(xs);
        r[j] = __int_as_float(up ? __builtin_amdgcn_mov_dpp(iv, 0x121, 0xf, 0xf, true) : __builtin_amdgcn_mov_dpp(iv, 0x12F, 0xf, 0xf, true)); }
#endif
    return r;
}
struct EpiIn {
    static constexpr bool PERM = false, AFTER_DRAIN = false;
    bf16_t* Z; const float* qn; const float* kn; const float* rc; const float* rs;
    __device__ __forceinline__ void operator()(const f32x4 (&acc)[2][2][4][2], const Unit& u, int wr, int wc, int fr, int fq) const {
        asm volatile("" : "+v"(fr), "+v"(fq));
        const int hs = u.pn * 4 + wc;
        const bool isq = (hs >= 22 && hs < 28), isk = (hs == 28 || hs == 29);
        const float sc = ((hs >= 4 && hs < 10) || isq) ? P_C2 : 1.f;
        const int tb = u.pm % 33; const bool is_ctx = (tb == 0);
#pragma unroll
        for (int ai = 0; ai < 2; ++ai)
#pragma unroll
            for (int m = 0; m < 4; ++m) {
                const int rt = ai * HALF + wr * 64 + m * 16 + fr;
                const size_t row = (size_t)u.pm * BM + rt;
                f32x4 v[2][2];
#pragma unroll
                for (int bj = 0; bj < 2; ++bj)
#pragma unroll
                    for (int n = 0; n < 2; ++n) v[bj][n] = acc[ai][bj][m][n];
                if (isq || isk) {
                    float ss = 0.f;
#pragma unroll
                    for (int bj = 0; bj < 2; ++bj)
#pragma unroll
                        for (int n = 0; n < 2; ++n) { const f32x4 x = v[bj][n]; ss += (x[0] * x[0] + x[1] * x[1]) + (x[2] * x[2] + x[3] * x[3]); }
                    ss += __shfl_xor(ss, 16); ss += __shfl_xor(ss, 32);
                    const float rstd = 1.0f / sqrtf(ss * (1.0f / 64.0f) + P_EPS);
                    const float* gp = (isq ? qn : kn) + 4 * fq;
                    const int pos = (tb - 1) * BM + rt; const int gr = pos >> 6, gc = pos & 63;
#pragma unroll
                    for (int bj = 0; bj < 2; ++bj) {
                        const f32x4 g0 = *(const f32x4*)(gp + 32 * bj), g1 = *(const f32x4*)(gp + 32 * bj + 16);
                        f32x4 x1 = v[bj][0] * rstd * g0, x2 = v[bj][1] * rstd * g1;
                        if (!is_ctx) { const int idx = bj ? gc : gr;
                            const f32x4 cs = *(const f32x4*)(rc + idx * 16 + 4 * fq), sn = *(const f32x4*)(rs + idx * 16 + 4 * fq);
                            const f32x4 y1 = x1 * cs - x2 * sn, y2 = x1 * sn + x2 * cs; x1 = y1; x2 = y2; }
                        v[bj][0] = x1; v[bj][1] = x2;
                    }
                }
                bf16_t* zp = Z + row * P_INW + hs * 64 + 4 * fq;
#pragma unroll
                for (int bj = 0; bj < 2; ++bj)
#pragma unroll
                    for (int n = 0; n < 2; ++n) { const f32x4 x = v[bj][n] * sc; unsigned long long w = (unsigned long long)cvt_pk_bf16(x[0], x[1]) | ((unsigned long long)cvt_pk_bf16(x[2], x[3]) << 32);
                        *(unsigned long long*)(zp + 32 * bj + 16 * n) = w; }
                asm volatile("" ::: "memory");
            }
    }
};
struct EpiRes {
    static constexpr bool PERM = false, AFTER_DRAIN = false;
    float* X; const float* gate;
    const float* st; const float* lg; const float* lb; const float* xin; const float* cin;
    __device__ __forceinline__ void operator()(const f32x4 (&acc)[2][2][4][2], const Unit& u, int wr, int wc, int fr, int fq) const {
        asm volatile("" : "+v"(fr), "+v"(fq));
        const int b = u.pm / 33, tb = u.pm % 33; const int mrow = tb == 0 ? 8 : b;
        const int col0 = u.pn * BM + wc * 32 + 4 * fq;
        const float* gp = gate + mrow * P_MODW + col0;
        const bool ident = (lg == nullptr);
        const float* rbase = ident ? (tb == 0 ? cin + (size_t)b * P_CTX * P_D : xin + ((size_t)b * P_SEQ + (size_t)(tb - 1) * BM) * P_D) : X + (size_t)u.pm * BM * P_D;
#pragma unroll
        for (int ai = 0; ai < 2; ++ai)
#pragma unroll
            for (int m = 0; m < 4; ++m) { const int rt = ai * HALF + wr * 64 + m * 16 + fr;
                float* xw = X + ((size_t)u.pm * BM + rt) * P_D + col0; const float* xr = rbase + (size_t)rt * P_D + col0;
                float mean = 0.f, rstd = 1.f;
                if (!ident) { const f32x2 s2 = *(const f32x2*)(st + ((size_t)u.pm * BM + rt) * 2); mean = s2[0]; rstd = s2[1]; }
#pragma unroll
                for (int bj = 0; bj < 2; ++bj)
#pragma unroll
                    for (int n = 0; n < 2; ++n) { f32x4 xo = *(const f32x4*)(xr + bj * HALF + n * 16);
                        if (!ident) { const f32x4 g4 = *(const f32x4*)(lg + col0 + bj * HALF + n * 16), b4 = *(const f32x4*)(lb + col0 + bj * HALF + n * 16); xo = (xo - mean) * rstd * g4 + b4; }
                        const f32x4 gv = *(const f32x4*)(gp + bj * HALF + n * 16);
                        xo = xo * P_ALPHA + gv * acc[ai][bj][m][n]; *(f32x4*)(xw + bj * HALF + n * 16) = xo; }
                asm volatile("" ::: "memory"); }
    }
};
struct EpiUp {
    static constexpr bool PERM = true, AFTER_DRAIN = false;
    bf16_t* ACT; const float* cw; const float* cb;
    __device__ __forceinline__ void operator()(const f32x4 (&acc)[2][2][4][2], const Unit& u, int wr, int wc, int fr, int fq) const {
        asm volatile("" : "+v"(fr), "+v"(fq));
#pragma unroll
        for (int n = 0; n < 2; ++n) {
            const int ch = u.pn * 128 + wc * 32 + 8 * fq + 4 * n;
            const f32x4 wa0 = *(const f32x4*)(cw + ch), wa1 = *(const f32x4*)(cw + P_UPW + ch), wa2 = *(const f32x4*)(cw + 2 * P_UPW + ch), ba = *(const f32x4*)(cb + ch);
            const f32x4 wg0 = *(const f32x4*)(cw + P_DFF + ch), wg1 = *(const f32x4*)(cw + P_UPW + P_DFF + ch), wg2 = *(const f32x4*)(cw + 2 * P_UPW + P_DFF + ch), bg = *(const f32x4*)(cb + P_DFF + ch);
#pragma unroll
            for (int ai = 0; ai < 2; ++ai) {
                const int Rb = u.pm * 248 - 1 + (2 * ai + wr) * 62;
                f32x4 ra_prev = (f32x4){0.f, 0.f, 0.f, 0.f}, rg_prev = ra_prev;
                f32x4 la_cur = dppror(acc[ai][0][0][n], false), lg_cur = dppror(acc[ai][1][0][n], false);
#pragma unroll
                for (int m = 0; m < 4; ++m) {
                    const f32x4 va = acc[ai][0][m][n], vg = acc[ai][1][m][n];
                    const f32x4 ra_cur = dppror(va, true), rg_cur = dppror(vg, true);
                    f32x4 la_next = la_cur, lg_next = lg_cur;
                    if (m < 3) { la_next = dppror(acc[ai][0][m < 3 ? m + 1 : 3][n], false); lg_next = dppror(acc[ai][1][m < 3 ? m + 1 : 3][n], false); }
                    const int i = 16 * m + fr; const int R = Rb + i;
                    const int rbm = R - (R / P_RPB) * P_RPB;
                    const bool first = (rbm == 0) || (rbm == P_CTX), last = (rbm == P_CTX - 1) || (rbm == P_RPB - 1);
                    f32x4 upa = (fr == 0) ? ra_prev : ra_cur, upg = (fr == 0) ? rg_prev : rg_cur;
                    f32x4 dna = (fr == 15) ? la_next : la_cur, dng = (fr == 15) ? lg_next : lg_cur;
                    const f32x4 z4 = (f32x4){0.f, 0.f, 0.f, 0.f};
                    if (first) { upa = z4; upg = z4; }
                    if (last) { dna = z4; dng = z4; }
                    const f32x4 av = wa0 * upa + wa1 * va + wa2 * dna + ba;
                    const f32x4 gv = wg0 * upg + wg1 * vg + wg2 * dng + bg;
                    f32x4 o;
#pragma unroll
                    for (int j = 0; j < 4; ++j) o[j] = av[j] * gv[j] * __builtin_amdgcn_rcpf(1.0f + __expf(-gv[j]));
                    unsigned long long w = (unsigned long long)cvt_pk_bf16(o[0], o[1]) | ((unsigned long long)cvt_pk_bf16(o[2], o[3]) << 32);
                    asm volatile("" : "+v"(w));
                    if (i >= 1 && i <= 62 && R < P_M) *(unsigned long long*)(ACT + (size_t)R * P_DFF + ch) = w;
                    ra_prev = ra_cur; rg_prev = rg_cur; la_cur = la_next; lg_cur = lg_next;
                }
            }
        }
    }
};

template <class Epi, class Sched, bool ALIGN_EPI = false, bool SP2 = false, int AMODE = 0>
__device__ __forceinline__ void gemm_phase(PG8_LAS unsigned char* lds, const Gemm g, const Sched& S, const Epi& E) {
    const int tid = ltid(), wid = __builtin_amdgcn_readfirstlane(tid >> 6), lane = tid & 63, wr = wid >> 2, wc = wid & 3, fr = lane & 15, fq = lane >> 4;
    const int K = g.K, nt = K / BK;
    unsigned voffA[2], voffB[2];
#pragma unroll
    for (int i = 0; i < 2; ++i) { int R, C; stage_rc(tid * 16 + i * 8192, R, C); const int Rb = Epi::PERM ? ((R & ~31) + perm32(R & 31)) : R;
        voffA[i] = (unsigned)((AMODE ? ((R >> 6) * 62 + (R & 63)) : R) * K + C) * 2u; voffB[i] = (unsigned)(Rb * K + C) * 2u; }
    const size_t kstep = (size_t)(BK * 2);
    const size_t hstepB = (size_t)HALF * K * 2; const size_t hstepA = (size_t)(AMODE ? 124 : HALF) * K * 2;
    const size_t tstepB = 2 * hstepB; const size_t tstepA = 2 * hstepA;
    const unsigned ldsw = (unsigned)wid * 1024u;
    const int aoff = lds_byte(wr * 64 + fr, fq * 8), boff = lds_byte(wc * 32 + fr, fq * 8);
#define PG8_SA(b, h) (((b) * 2 + (h)) * HTB)
#define PG8_SB(b, h) ((4 + (b) * 2 + (h)) * HTB)
#define PG8_STAGE(bufoff, gbase, voff) do { _Pragma("unroll") for (int _i = 0; _i < 2; ++_i) \
        __builtin_amdgcn_global_load_lds((const unsigned*)((const char*)(gbase) + (voff)[_i]), (PG8_LAS unsigned*)(lds + (bufoff) + ldsw + _i * 8192), 16, 0, 0); } while (0)
#define PG8_LDA(dst, b, h) do { _Pragma("unroll") for (int m = 0; m < 4; ++m) _Pragma("unroll") for (int k = 0; k < 2; ++k) dst[m][k] = *(const PG8_LAS bf16x8*)(lds + PG8_SA(b, h) + aoff + m * 2048 + k * 1024); } while (0)
#define PG8_LDB(dst, b, h) do { _Pragma("unroll") for (int n = 0; n < 2; ++n) _Pragma("unroll") for (int k = 0; k < 2; ++k) dst[n][k] = *(const PG8_LAS bf16x8*)(lds + PG8_SB(b, h) + boff + n * 2048 + k * 1024); } while (0)
#define PG8_MMA(ai, bj, At, Bt) do { __builtin_amdgcn_s_setprio(1); _Pragma("unroll") for (int m = 0; m < 4; ++m) _Pragma("unroll") for (int n = 0; n < 2; ++n) _Pragma("unroll") for (int k = 0; k < 2; ++k) \
        acc[ai][bj][m][n] = __builtin_amdgcn_mfma_f32_16x16x32_bf16(Bt[n][k], At[m][k], acc[ai][bj][m][n], 0, 0, 0); __builtin_amdgcn_s_setprio(0); } while (0)
#define PG8_WAIT_V(n) asm volatile("s_waitcnt vmcnt(" #n ")" ::: "memory")
#define PG8_WAIT_L(n) asm volatile("s_waitcnt lgkmcnt(" #n ")" ::: "memory")
#define PG8_BAR __builtin_amdgcn_s_barrier()
#define PG8_SCHED __builtin_amdgcn_sched_barrier(0)
    Unit cur, nxt; int ui = 0;
    if (!S.next(0, cur)) return;
    f32x4 acc[2][2][4][2];
#pragma unroll
    for (int a = 0; a < 2; ++a)
#pragma unroll
        for (int b = 0; b < 2; ++b)
#pragma unroll
            for (int m = 0; m < 4; ++m)
#pragma unroll
                for (int n = 0; n < 2; ++n) acc[a][b][m][n] = (f32x4){0.f, 0.f, 0.f, 0.f};
    bf16x8 At[4][2], B0[2][2], B1[2][2];
    const char* cA = (const char*)g.A + (size_t)cur.pm * tstepA; const char* cB = (const char*)g.Bt + (size_t)cur.pn * tstepB;
    S.a_ready(cur);
    if constexpr (SP2) {
        PG8_STAGE(PG8_SB(0, 0), cB, voffB); PG8_STAGE(PG8_SB(0, 1), cB + hstepB, voffB); PG8_STAGE(PG8_SA(0, 0), cA, voffA); PG8_STAGE(PG8_SA(0, 1), cA + hstepA, voffA);
        if (wr == 1) PG8_BAR;
        PG8_WAIT_V(2); PG8_BAR;
        PG8_STAGE(PG8_SB(1, 0), cB + kstep, voffB); PG8_STAGE(PG8_SA(1, 0), cA + kstep, voffA); PG8_STAGE(PG8_SB(1, 1), cB + hstepB + kstep, voffB);
        PG8_WAIT_V(6); PG8_BAR;
    } else {
        PG8_STAGE(PG8_SB(0, 0), cB, voffB); PG8_STAGE(PG8_SA(0, 0), cA, voffA); PG8_STAGE(PG8_SB(0, 1), cB + hstepB, voffB); PG8_STAGE(PG8_SA(0, 1), cA + hstepA, voffA);
        if (wr == 1) PG8_BAR;
        PG8_WAIT_V(4); PG8_BAR;
        PG8_STAGE(PG8_SB(1, 0), cB + kstep, voffB); PG8_STAGE(PG8_SA(1, 0), cA + kstep, voffA); PG8_STAGE(PG8_SB(1, 1), cB + hstepB + kstep, voffB);
        PG8_WAIT_V(6); PG8_BAR;
    }
    for (;;) {
        const bool has_next = S.next(ui + 1, nxt);
        const char* nA = has_next ? (const char*)g.A + (size_t)nxt.pm * tstepA : cA; const char* nB = has_next ? (const char*)g.Bt + (size_t)nxt.pn * tstepB : cB;
        for (int t = 0; t < nt; t += 2) {
            const bool last = (t == nt - 2);
            const char* a1 = cA + (size_t)(t + 1) * kstep;
            const char* a2 = last ? nA : cA + (size_t)(t + 2) * kstep; const char* b2 = last ? nB : cB + (size_t)(t + 2) * kstep;
            const char* a3 = a2 + kstep; const char* b3 = b2 + kstep;
            if (last && has_next) S.a_ready(nxt);
            if constexpr (SP2) {
            PG8_LDB(B0, 0, 0); PG8_LDB(B1, 0, 1); PG8_SCHED; PG8_LDA(At, 0, 0); PG8_STAGE(PG8_SA(1, 1), a1 + hstepA, voffA);
            PG8_WAIT_V(8); PG8_WAIT_L(0); PG8_BAR; PG8_MMA(0, 0, At, B0); PG8_MMA(0, 1, At, B1); PG8_BAR; PG8_SCHED;
            PG8_LDA(At, 0, 1); PG8_STAGE(PG8_SB(0, 0), b2, voffB); PG8_STAGE(PG8_SB(0, 1), b2 + hstepB, voffB); PG8_STAGE(PG8_SA(0, 0), a2, voffA);
            PG8_WAIT_V(8); PG8_WAIT_L(0); PG8_BAR; PG8_MMA(1, 0, At, B0); PG8_MMA(1, 1, At, B1); PG8_BAR; PG8_SCHED;
            PG8_LDB(B0, 1, 0); PG8_LDB(B1, 1, 1); PG8_SCHED; PG8_LDA(At, 1, 0); PG8_STAGE(PG8_SA(0, 1), a2 + hstepA, voffA);
            PG8_WAIT_V(8); PG8_WAIT_L(0); PG8_BAR; PG8_MMA(0, 0, At, B0); PG8_MMA(0, 1, At, B1); PG8_BAR; PG8_SCHED;
            PG8_LDA(At, 1, 1); PG8_STAGE(PG8_SB(1, 0), b3, voffB); PG8_STAGE(PG8_SB(1, 1), b3 + hstepB, voffB); PG8_STAGE(PG8_SA(1, 0), a3, voffA);
            PG8_WAIT_V(8); PG8_WAIT_L(0); PG8_BAR; PG8_MMA(1, 0, At, B0); PG8_MMA(1, 1, At, B1); PG8_BAR; PG8_SCHED;
            } else {
            PG8_LDB(B0, 0, 0); PG8_SCHED; PG8_LDA(At, 0, 0); PG8_STAGE(PG8_SA(1, 1), a1 + hstepA, voffA);
            PG8_WAIT_L(8); PG8_BAR; PG8_WAIT_L(0); PG8_MMA(0, 0, At, B0); PG8_BAR; PG8_SCHED;
            PG8_LDB(B1, 0, 1); PG8_STAGE(PG8_SB(0, 0), b2, voffB);
            PG8_BAR; PG8_WAIT_L(0); PG8_MMA(0, 1, At, B1); PG8_BAR;
            PG8_LDA(At, 0, 1); PG8_STAGE(PG8_SA(0, 0), a2, voffA);
            PG8_BAR; PG8_WAIT_L(0); PG8_MMA(1, 0, At, B0); PG8_BAR; PG8_SCHED;
            PG8_STAGE(PG8_SB(0, 1), b2 + hstepB, voffB);
            PG8_WAIT_V(6); PG8_BAR; PG8_MMA(1, 1, At, B1); PG8_BAR;
            PG8_LDB(B0, 1, 0); PG8_SCHED; PG8_LDA(At, 1, 0); PG8_STAGE(PG8_SA(0, 1), a2 + hstepA, voffA);
            PG8_WAIT_L(8); PG8_BAR; PG8_WAIT_L(0); PG8_MMA(0, 0, At, B0); PG8_BAR; PG8_SCHED;
            PG8_LDB(B1, 1, 1); PG8_STAGE(PG8_SB(1, 0), b3, voffB);
            PG8_BAR; PG8_WAIT_L(0); PG8_MMA(0, 1, At, B1); PG8_BAR;
            PG8_LDA(At, 1, 1); PG8_STAGE(PG8_SA(1, 0), a3, voffA);
            PG8_BAR; PG8_WAIT_L(0); PG8_MMA(1, 0, At, B0); PG8_BAR; PG8_SCHED;
            PG8_STAGE(PG8_SB(1, 1), b3 + hstepB, voffB);
            PG8_WAIT_V(6); PG8_BAR; PG8_MMA(1, 1, At, B1); PG8_BAR;
            }
        }
        if constexpr (ALIGN_EPI) { if (wr == 0) PG8_BAR; }
        if constexpr (!Epi::AFTER_DRAIN) { E(acc, cur, wr, wc, fr, fq); S.done(cur); }
        if (!has_next) break;
#pragma unroll
        for (int a = 0; a < 2; ++a)
#pragma unroll
            for (int b = 0; b < 2; ++b)
#pragma unroll
                for (int m = 0; m < 4; ++m)
#pragma unroll
                    for (int n = 0; n < 2; ++n) acc[a][b][m][n] = (f32x4){0.f, 0.f, 0.f, 0.f};
        cur = nxt; cA = nA; cB = nB; ++ui;
        if constexpr (ALIGN_EPI) { if (wr == 1) PG8_BAR; }
    }
    PG8_WAIT_V(0);
    if constexpr (!ALIGN_EPI) { if (wr == 0) PG8_BAR; }
    PG8_BAR;
    if constexpr (Epi::AFTER_DRAIN) { E.fused(acc, cur, wr, wc, fr, fq, lds, wid, lane); S.done(cur); }
#undef PG8_SA
#undef PG8_SB
#undef PG8_STAGE
#undef PG8_LDA
#undef PG8_LDB
#undef PG8_MMA
#undef PG8_WAIT_V
#undef PG8_WAIT_L
#undef PG8_BAR
#undef PG8_SCHED
}
}
#include <hip/hip_bf16.h>
#include <cmath>
namespace attn_body {
using bf16=__hip_bfloat16;
using bf16x8=__attribute__((ext_vector_type(8)))short;
using s16x4=__attribute__((ext_vector_type(4)))short;
using f32x16=__attribute__((ext_vector_type(16)))float;
using u32x4=__attribute__((ext_vector_type(4)))unsigned;
constexpr int D=64,DM=2048,ODM=1024;
constexpr int NW=8,QBLK=32,QB=QBLK*NW,KVBLK=64;
constexpr int ATTN_PITCH=DM, ATTN_UNIT_ROWS=QB;
__device__ __forceinline__ int crow(int r,int hi){return (r&3)+8*(r>>2)+4*hi;}
#define SBAR() __builtin_amdgcn_sched_barrier(0)
__device__ __forceinline__ void cmask(f32x16&p0,f32x16&p1,int jb,int qrel,int hi){
  const float NEG=-INFINITY; int kb=64*jb+4*hi;
  #pragma unroll
  for(int r=0;r<16;++r){int kv=kb+(r&3)+8*(r>>2); if(kv>qrel)p0[r]=NEG; if(kv+32>qrel)p1[r]=NEG;}
}

typedef const __attribute__((address_space(3))) float* lds_fptr;
__device__ __forceinline__ void nabias(f32x16&p0,f32x16&p1,int kr,int qr_,int r32,int wid,int hi,lds_fptr rp){
  const float NEG=-INFINITY;
  asm volatile("":"+v"(r32),"+v"(hi));
  const int qc=32*(wid&1)+r32;
  const int rs=min(max(qr_-4,0),120), cs=min(max(qc-8,0),48);
  if(kr<rs||kr>=rs+8){
    #pragma unroll
    for(int r=0;r<16;++r){p0[r]=NEG;p1[r]=NEG;}
  } else {
    lds_fptr tb=rp+(kr-qr_+7)*31+(15-qc);
    #pragma unroll
    for(int r=0;r<16;++r){
      const int kc=(r&3)+8*(r>>2)+4*hi;
      const bool ok0=(unsigned)(kc-cs)<16u, ok1=(unsigned)(kc+32-cs)<16u;
      const float b0=tb[ok0?kc:cs], b1=tb[ok1?kc+32:cs];
      p0[r]=ok0?p0[r]+b0:NEG; p1[r]=ok1?p1[r]+b1:NEG;
    }
  }
}
constexpr int NSLOT=3, SLOTB=8192;
constexpr int LDS_K=0, LDS_V=NSLOT*SLOTB, LDS_WS=2*NSLOT*SLOTB, LDS_OST=LDS_WS+NW*64*4, LDS_BYTES=LDS_OST+NW*4096;
constexpr float C2=0.125f*1.4426950408889634f;
__device__ __forceinline__ void glds16(const void*gsrc,unsigned lds_dst){unsigned keep;
  asm volatile("s_mov_b32 %0, m0\n\ts_mov_b32 m0, %2\n\ts_nop 0\n\tglobal_load_lds_dwordx4 %1, off\n\ts_mov_b32 m0, %0":"=&s"(keep):"v"(gsrc),"s"(lds_dst):"memory");}
__device__ __forceinline__ float max3f(float a,float b,float c){float r;asm("v_max3_f32 %0, %1, %2, %3":"=v"(r):"v"(a),"v"(b),"v"(c));return r;}
__device__ __forceinline__ float max2f(float a,float b){float r;asm("v_max_f32_e32 %0, %1, %2":"=v"(r):"v"(a),"v"(b));return r;}
__device__ __forceinline__ float fadd_s(float a,float b){float r;asm("v_add_f32_e32 %0, %1, %2":"=v"(r):"v"(a),"v"(b));return r;}
__device__ __forceinline__ float fsub_s(float a,float b){float r;asm("v_sub_f32_e32 %0, %1, %2":"=v"(r):"v"(a),"v"(b));return r;}
typedef float f32x2_t __attribute__((ext_vector_type(2))); typedef __bf16 bf16x2_t __attribute__((ext_vector_type(2)));
__device__ __forceinline__ unsigned cvtpk_s(float lo,float hi){f32x2_t v={lo,hi};bf16x2_t b=__builtin_convertvector(v,bf16x2_t);return __builtin_bit_cast(unsigned,b);}
#define WAIT_BAR(N) asm volatile("s_waitcnt vmcnt(" #N ") lgkmcnt(0)\n\ts_barrier":::"memory")

__device__ __forceinline__ void qkt(f32x16&p0,f32x16&p1,const char*Kslot,const bf16x8*qr,const f32x16&negm,int r32,int hi){
  const char*kb=Kslot+hi*1024+r32*16;
  #pragma unroll
  for(int d0=0;d0<4;++d0){
    const bf16x8 b0=*reinterpret_cast<const bf16x8*>(kb+d0*2048);
    const bf16x8 b1=*reinterpret_cast<const bf16x8*>(kb+d0*2048+512);
    if(d0==0){p0=__builtin_amdgcn_mfma_f32_32x32x16_bf16(b0,qr[0],negm,0,0,0);p1=__builtin_amdgcn_mfma_f32_32x32x16_bf16(b1,qr[0],negm,0,0,0);}
    else{p0=__builtin_amdgcn_mfma_f32_32x32x16_bf16(b0,qr[d0],p0,0,0,0);p1=__builtin_amdgcn_mfma_f32_32x32x16_bf16(b1,qr[d0],p1,0,0,0);}}
}
typedef __attribute__((address_space(3))) const char* lds_cptr;
typedef short v4i16_t __attribute__((ext_vector_type(4)));
__device__ __forceinline__ void kload8(bf16x8*kf,lds_cptr kp){
  kf[0]=*(const __attribute__((address_space(3))) bf16x8*)(kp);      kf[1]=*(const __attribute__((address_space(3))) bf16x8*)(kp+512);
  kf[2]=*(const __attribute__((address_space(3))) bf16x8*)(kp+2048); kf[3]=*(const __attribute__((address_space(3))) bf16x8*)(kp+2560);
  kf[4]=*(const __attribute__((address_space(3))) bf16x8*)(kp+4096); kf[5]=*(const __attribute__((address_space(3))) bf16x8*)(kp+4608);
  kf[6]=*(const __attribute__((address_space(3))) bf16x8*)(kp+6144); kf[7]=*(const __attribute__((address_space(3))) bf16x8*)(kp+6656);
}
__device__ __forceinline__ void kload2(bf16x8*kf,lds_cptr kp,int j){ kf[2*j]=*(const __attribute__((address_space(3))) bf16x8*)(kp+j*2048); kf[2*j+1]=*(const __attribute__((address_space(3))) bf16x8*)(kp+j*2048+512); }
__device__ __forceinline__ s16x4 vtr(lds_cptr p){ return __builtin_bit_cast(s16x4,__builtin_amdgcn_ds_read_tr16_b64_v4i16((__attribute__((address_space(3))) v4i16_t*)p)); }
__device__ __forceinline__ float rowmax(const f32x16&p0,const f32x16&p1){
  float a=max3f(p0[0],p0[1],p1[0]),b=max3f(p0[2],p0[3],p1[1]);a=max3f(a,p1[2],p1[3]);
  #pragma unroll
  for(int r=4;r<16;r+=4){a=max3f(a,p0[r],p0[r+1]);b=max3f(b,p0[r+2],p0[r+3]);a=max3f(a,p1[r],p1[r+1]);b=max3f(b,p1[r+2],p1[r+3]);}
  const float m=max2f(a,b);
  auto rr=__builtin_amdgcn_permlane32_swap(__float_as_uint(m),__float_as_uint(m),false,false);
  return max2f(__uint_as_float(rr[0]),__uint_as_float(rr[1]));
}
__device__ __forceinline__ void pv(f32x16*o,int vb,bf16x8 pa0,bf16x8 pa1,bf16x8 pa2,bf16x8 pa3){
  #pragma unroll
  for(int d0=0;d0<2;++d0){s16x4 lo[4],hi[4];
    #pragma unroll
    for(int ks=0;ks<4;++ks){
      asm volatile("ds_read_b64_tr_b16 %0,%1 offset:%c2":"=&v"(lo[ks]):"v"(vb),"i"(d0*4096+ks*1024):"memory");
      asm volatile("ds_read_b64_tr_b16 %0,%1 offset:%c2":"=&v"(hi[ks]):"v"(vb),"i"(d0*4096+ks*1024+512):"memory");}
    asm volatile("s_waitcnt lgkmcnt(0)":::"memory");SBAR();
    #define PK(k) (bf16x8){lo[k][0],lo[k][1],lo[k][2],lo[k][3],hi[k][0],hi[k][1],hi[k][2],hi[k][3]}
    o[d0]=__builtin_amdgcn_mfma_f32_32x32x16_bf16(pa0,PK(0),o[d0],0,0,0);
    o[d0]=__builtin_amdgcn_mfma_f32_32x32x16_bf16(pa1,PK(1),o[d0],0,0,0);
    o[d0]=__builtin_amdgcn_mfma_f32_32x32x16_bf16(pa2,PK(2),o[d0],0,0,0);
    o[d0]=__builtin_amdgcn_mfma_f32_32x32x16_bf16(pa3,PK(3),o[d0],0,0,0);
    #undef PK
  }
}

#ifndef ATTN_STORE16
#define ATTN_STORE16(p,v) (*(u32x4*)(p)=(v))
#endif
template<int THRL,int MODE> __device__ __forceinline__ void attn_unit(const bf16*Qw0,const bf16*__restrict__ Kh,const bf16*__restrict__ Vh,bf16*Ow0,const int NT,const int lat_off,const int na_r0,const int na_rsmin,const int rpb_off,char*shm){
  const int tid=ltid(),lane=tid&63,r32=lane&31,hi=lane>>5; const int wid=__builtin_amdgcn_readfirstlane(tid>>6);
  const bf16*Qw=Qw0+(long)(wid*QBLK)*DM;
  const unsigned lds0=(unsigned)(uintptr_t)shm;
  float*wsf=(float*)(shm+LDS_WS)+wid*64;
  const bf16*ksrc=Kh+(long)lane*DM+wid*8;
  const bf16*vsrc=Vh+(long)(16*(wid&3)+(lane>>2))*DM+(wid>>2)*32+(lane&3)*8;
  const unsigned kdst=lds0+LDS_K+wid*1024, vdst=lds0+LDS_V+wid*1024;
  #define TROW(t) (((t)<4)?(t)*64:lat_off+((t)-4)*64)
  #define DMA_K(t,slot) glds16(ksrc+(long)TROW(t)*DM,(unsigned)__builtin_amdgcn_readfirstlane(kdst+(slot)))
  #define DMA_V(t,slot) glds16(vsrc+(long)TROW(t)*DM,(unsigned)__builtin_amdgcn_readfirstlane(vdst+(slot)))
  const int vb0=(int)(lds0+LDS_V)+((lane>>4)&1)*32+(lane&3)*8+(4*hi+((lane&15)>>2))*64;
  const char*Kbase=shm+LDS_K; bf16x8 kf[8];
  const lds_cptr shm3=(lds_cptr)shm; const lds_cptr kp0=shm3+LDS_K+hi*1024+r32*16; const lds_cptr vp0=shm3+LDS_V+((lane>>4)&1)*32+(lane&3)*8+(4*hi+((lane&15)>>2))*64;
  DMA_K(0,0);DMA_V(0,0);DMA_K(1,SLOTB);
  bf16x8 qr[4];
  #pragma unroll
  for(int d0=0;d0<4;++d0)qr[d0]=*reinterpret_cast<const bf16x8*>(&Qw[(long)r32*DM+d0*16+hi*8]);
  float mhat=0.f,l_reg=0.f;f32x16 o[2];o[0]=f32x16{};o[1]=f32x16{};f32x16 negm=f32x16{};asm volatile("":"+v"(negm));
  const lds_fptr rp_=(lds_fptr)(shm3+rpb_off); const int na_qr=na_r0+(wid>>1);
  #define CMASK(P0,P1,t) do{ if(MODE==1 && (t)>=4) nabias(P0,P1,na_rsmin+(t)-4,na_qr,r32,wid,hi,rp_); }while(0)
  bool resc=false;
  #define START(P0,P1) do{ const float rm=rowmax(P0,P1); resc=false; \
    { const float dl=rm; mhat=fadd_s(mhat,dl); \
      _Pragma("unroll") for(int r=0;r<16;++r){P0[r]=fsub_s(P0[r],dl);P1[r]=fsub_s(P1[r],dl);} \
      _Pragma("unroll") for(int r=0;r<16;++r)negm[r]=-mhat; asm volatile("":"+v"(negm)); } \
    _Pragma("unroll") for(int r=0;r<16;++r)P0[r]=__builtin_amdgcn_exp2f(P0[r]); }while(0)
  #define RESC() do{ if(resc){ asm volatile("s_waitcnt lgkmcnt(0)":::"memory"); \
      _Pragma("unroll") for(int d_=0;d_<2;++d_) _Pragma("unroll") for(int r=0;r<16;++r)o[d_][r]*=wsf[crow(r,hi)]; } }while(0)
  f32x16 pA0,pA1,pB0,pB1;
  int sl_prev=0,sl_cur=0,sl_next=SLOTB;
  #define ROT() do{sl_prev=sl_cur;sl_cur=sl_next;sl_next=(sl_next==(NSLOT-1)*SLOTB)?0:sl_next+SLOTB;}while(0)
  DMA_K(2,2*SLOTB);
  WAIT_BAR(3);
  qkt(pA0,pA1,Kbase,qr,negm,r32,hi);asm volatile("s_nop 15\n\ts_nop 7":"+v"(pA0),"+v"(pA1));CMASK(pA0,pA1,0);
  START(pA0,pA1);
  _Pragma("unroll") for(int r=0;r<16;++r)pA1[r]=__builtin_amdgcn_exp2f(pA1[r]);
  WAIT_BAR(0);
  DMA_K(3,0);DMA_V(1,SLOTB);
  ROT();
  kload8(kf,kp0+sl_cur);
  WAIT_BAR(2);
  s16x4 vlo[8],vhi[8]; u32x4 pw0,pw1,pw2,pw3;
  #define PKW(P,B) cvtpk_s(P[B],P[B+1])
  #define PAF(k) __builtin_bit_cast(bf16x8,pw##k)
  #define VFR(i) (bf16x8){vlo[i][0],vlo[i][1],vlo[i][2],vlo[i][3],vhi[i][0],vhi[i][1],vhi[i][2],vhi[i][3]}
  #define PIN(x) asm volatile("":"+v"(x))
  #define MX3(a,b,c) __builtin_fmaxf(__builtin_fmaxf((a),(b)),(c))
  #define GAPA(MF,A0,A1,A2,A3,W0,W1,PW) do{ MF; sacc+=A0; sacc+=A1; sacc+=A2; sacc+=A3; PIN(sacc); W0; W1; PIN(PW); SBAR(); }while(0)
  #define EX(v) __builtin_amdgcn_exp2f(v)
  #define GAPB(MF,X,B) do{ MF; X[B]=EX(X[B]); X[B+1]=EX(X[B+1]); X[B+2]=EX(X[B+2]); X[B+3]=EX(X[B+3]); PIN(X); SBAR(); }while(0)
  #define VRD(i) do{ vlo[i]=vtr(vp_+(((i)>>2)*4096+((i)&3)*1024)); vhi[i]=vtr(vp_+(((i)>>2)*4096+((i)&3)*1024+512)); }while(0)
  #define KRD(G,j) do{ if(G){ kload2(kf,kp0+sl_next,j); SBAR(); } }while(0)
  #define STEP(C0,C1,P0,P1,t,GK,GV,GL) do{ SBAR(); \
    const lds_cptr vp_=vp0+sl_prev; \
    VRD(0); SBAR(); float sacc=(P0[0]+P0[1]); \
    GAPA(C0=__builtin_amdgcn_mfma_f32_32x32x16_bf16(kf[0],qr[0],negm,0,0,0), P0[2],P0[3],P0[4],P0[5],     pw0[0]=PKW(P0,0), pw0[1]=PKW(P0,2), pw0); \
    VRD(4); SBAR(); GAPA(C1=__builtin_amdgcn_mfma_f32_32x32x16_bf16(kf[1],qr[0],negm,0,0,0), P0[6],P0[7],P0[8],P0[9],     pw0[2]=PKW(P0,4), pw0[3]=PKW(P0,6), pw0); \
    VRD(1); SBAR(); GAPA(C0=__builtin_amdgcn_mfma_f32_32x32x16_bf16(kf[2],qr[1],C0,0,0,0),   P0[10],P0[11],P0[12],P0[13], pw1[0]=PKW(P0,8), pw1[1]=PKW(P0,10), pw1); \
    VRD(5); SBAR(); GAPA(C1=__builtin_amdgcn_mfma_f32_32x32x16_bf16(kf[3],qr[1],C1,0,0,0),   P0[14],P0[15],P1[0],P1[1],   pw1[2]=PKW(P0,12),pw1[3]=PKW(P0,14), pw1); \
    VRD(2); SBAR(); GAPA(C0=__builtin_amdgcn_mfma_f32_32x32x16_bf16(kf[4],qr[2],C0,0,0,0),   P1[2],P1[3],P1[4],P1[5],     pw2[0]=PKW(P1,0), pw2[1]=PKW(P1,2), pw2); \
    VRD(6); SBAR(); GAPA(C1=__builtin_amdgcn_mfma_f32_32x32x16_bf16(kf[5],qr[2],C1,0,0,0),   P1[6],P1[7],P1[8],P1[9],     pw2[2]=PKW(P1,4), pw2[3]=PKW(P1,6), pw2); \
    VRD(3); SBAR(); GAPA(C0=__builtin_amdgcn_mfma_f32_32x32x16_bf16(kf[6],qr[3],C0,0,0,0),   P1[10],P1[11],P1[12],P1[13], pw3[0]=PKW(P1,8), pw3[1]=PKW(P1,10), pw3); \
    VRD(7); SBAR(); GAPA(C1=__builtin_amdgcn_mfma_f32_32x32x16_bf16(kf[7],qr[3],C1,0,0,0),   P1[14],P1[15],0.f,0.f,       pw3[2]=PKW(P1,12),pw3[3]=PKW(P1,14), pw3); \
    l_reg+=sacc; \
    if(GK){DMA_K((t)+3,sl_cur);} if(GV){DMA_V((t)+1,sl_next);} \
    CMASK(C0,C1,t); \
    { float a=MX3(C0[0],C0[1],C1[0]),b=MX3(C0[2],C0[3],C1[1]); a=MX3(a,C1[2],C1[3]); \
      _Pragma("unroll") for(int r=4;r<16;r+=4){a=MX3(a,C0[r],C0[r+1]);b=MX3(b,C0[r+2],C0[r+3]);a=MX3(a,C1[r],C1[r+1]);b=MX3(b,C1[r+2],C1[r+3]);} \
      float rm=__builtin_fmaxf(a,b); { auto rr=__builtin_amdgcn_permlane32_swap(__float_as_uint(rm),__float_as_uint(rm),false,false); rm=__builtin_fmaxf(__uint_as_float(rr[0]),__uint_as_float(rr[1])); } \
      resc=false; \
      if(__builtin_expect(__any(rm>(float)THRL),0)){ const float dl=__builtin_fmaxf(rm,0.f); mhat+=dl; \
        _Pragma("unroll") for(int r=0;r<16;++r){C0[r]-=dl;C1[r]-=dl;} \
        _Pragma("unroll") for(int r=0;r<16;++r)negm[r]=-mhat; asm volatile("":"+v"(negm)); \
        const float f=__builtin_amdgcn_exp2f(-dl); l_reg*=f; if(hi==0)wsf[r32]=f; resc=true; } } \
    SBAR(); \
    GAPB(o[0]=__builtin_amdgcn_mfma_f32_32x32x16_bf16(PAF(0),VFR(0),o[0],0,0,0), C0,0); \
    GAPB(o[1]=__builtin_amdgcn_mfma_f32_32x32x16_bf16(PAF(0),VFR(4),o[1],0,0,0), C0,4); \
    KRD(GL,0); GAPB(o[0]=__builtin_amdgcn_mfma_f32_32x32x16_bf16(PAF(1),VFR(1),o[0],0,0,0), C0,8); \
    KRD(GL,1); GAPB(o[1]=__builtin_amdgcn_mfma_f32_32x32x16_bf16(PAF(1),VFR(5),o[1],0,0,0), C0,12); \
    KRD(GL,2); GAPB(o[0]=__builtin_amdgcn_mfma_f32_32x32x16_bf16(PAF(2),VFR(2),o[0],0,0,0), C1,0); \
    KRD(GL,3); GAPB(o[1]=__builtin_amdgcn_mfma_f32_32x32x16_bf16(PAF(2),VFR(6),o[1],0,0,0), C1,4); \
    GAPB(o[0]=__builtin_amdgcn_mfma_f32_32x32x16_bf16(PAF(3),VFR(3),o[0],0,0,0), C1,8); \
    GAPB(o[1]=__builtin_amdgcn_mfma_f32_32x32x16_bf16(PAF(3),VFR(7),o[1],0,0,0), C1,12); \
    }while(0)
  int t=1;
  #undef CMASK
  #define CMASK(P0,P1,t) do{ if(MODE==1 && (t)>=4) nabias(P0,P1,na_rsmin+(t)-4,na_qr,r32,wid,hi,rp_); }while(0)
  for(;t+5<NT;t+=2){
    STEP(pB0,pB1,pA0,pA1,t,true,true,true);     WAIT_BAR(2); RESC(); ROT();
    STEP(pA0,pA1,pB0,pB1,t+1,true,true,true);   WAIT_BAR(2); RESC(); ROT();
  }
  #undef CMASK
  #define CMASK(P0,P1,t) do{ if(MODE==1 && (t)>=4) nabias(P0,P1,na_rsmin+(t)-4,na_qr,r32,wid,hi,rp_); }while(0)
  #define ENDW(tt) do{ if((tt)+3<NT){WAIT_BAR(2);} else if((tt)+2<NT){WAIT_BAR(1);} else {WAIT_BAR(0);} }while(0)
  for(;t+1<NT;t+=2){
    STEP(pB0,pB1,pA0,pA1,t,(t+3<NT),(t+1<NT),(t+1<NT));       ENDW(t);   RESC(); ROT();
    STEP(pA0,pA1,pB0,pB1,t+1,(t+4<NT),(t+2<NT),(t+2<NT));     ENDW(t+1); RESC(); ROT();
  }
  STEP(pB0,pB1,pA0,pA1,NT-1,false,false,false); RESC();
  { float sacc=pB0[0]+pB0[1]; _Pragma("unroll") for(int r=2;r<16;++r)sacc+=pB0[r]; _Pragma("unroll") for(int r=0;r<16;++r)sacc+=pB1[r]; l_reg+=sacc;
    pw0=(u32x4){PKW(pB0,0),PKW(pB0,2),PKW(pB0,4),PKW(pB0,6)};pw1=(u32x4){PKW(pB0,8),PKW(pB0,10),PKW(pB0,12),PKW(pB0,14)};pw2=(u32x4){PKW(pB1,0),PKW(pB1,2),PKW(pB1,4),PKW(pB1,6)};pw3=(u32x4){PKW(pB1,8),PKW(pB1,10),PKW(pB1,12),PKW(pB1,14)};
    SBAR(); pv(o,vb0+sl_cur,PAF(0),PAF(1),PAF(2),PAF(3)); }
  #undef PKW
  #undef PAF
  #undef VFR
  #undef PIN
  #undef MX3
  #undef GAPA
  #undef GAPB
  #undef EX
  #undef VRD
  #undef KRD
  #undef STEP
  #undef ENDW
  {auto rr=__builtin_amdgcn_permlane32_swap(__float_as_uint(l_reg),__float_as_uint(l_reg),false,false);l_reg=__uint_as_float(rr[0])+__uint_as_float(rr[1]);}
  if(hi==0)wsf[32+r32]=l_reg;asm volatile("s_waitcnt lgkmcnt(0)":::"memory");
  float rli[16];
  #pragma unroll
  for(int r=0;r<16;++r)rli[r]=__builtin_amdgcn_rcpf(wsf[32+crow(r,hi)]);
  bf16*Ow=Ow0+(long)(wid*QBLK)*ODM;
  { bf16*stg=(bf16*)(shm+LDS_OST)+wid*2048;
    #pragma unroll
    for(int r=0;r<16;++r){const int orow=crow(r,hi);
      #pragma unroll
      for(int d0=0;d0<2;++d0)stg[orow*64+d0*32+r32]=__float2bfloat16(o[d0][r]*rli[r]);}
    asm volatile("s_waitcnt lgkmcnt(0)":::"memory");
    #pragma unroll
    for(int i=0;i<4;++i){const int row=i*8+(lane>>3),ch=lane&7; const u32x4 v=*(const u32x4*)(stg+row*64+ch*8); ATTN_STORE16(Ow+(long)row*ODM+ch*8,v);} }
  asm volatile("s_waitcnt lgkmcnt(0)\n\ts_barrier":::"memory");
  #undef DMA_K
  #undef TROW
  #undef DMA_V
  #undef CMASK
  #undef START
  #undef RESC
  #undef ROT
}
constexpr int ATTN_LDS_BYTES=LDS_BYTES;
}
#ifndef DBG_MASK
#define DBG_MASK 127
#endif
#ifndef DBG_DIAG
#define DBG_DIAG 0
#endif
#ifndef DBG_NA
#define DBG_NA 1
#endif
#ifndef DBG_CTX
#define DBG_CTX 1
#endif
#ifndef DBG_POOL
#define DBG_POOL 1
#endif
namespace cg = cooperative_groups;
#define GAS __attribute__((address_space(1)))
#define LAS __attribute__((address_space(3)))
typedef unsigned short bf16;
typedef unsigned v4u __attribute__((ext_vector_type(4)));
typedef float f32x4 __attribute__((ext_vector_type(4)));
#define LDS_WAIT() asm volatile("s_waitcnt lgkmcnt(0)" ::: "memory")
__device__ __forceinline__ unsigned f2bf(float f) { unsigned u = __builtin_bit_cast(unsigned, f); return (u + 0x7fffu + ((u >> 16) & 1u)) >> 16; }
__device__ __forceinline__ unsigned pk2(float lo, float hi) { return f2bf(lo) | (f2bf(hi) << 16); }
__device__ __forceinline__ float bf2f(unsigned short h) { return __builtin_bit_cast(float, (unsigned)h << 16); }
__device__ __forceinline__ float wave_sum(float v) {
#pragma unroll
    for (int o = 1; o < 64; o <<= 1) v += __shfl_xor(v, o);
    return v;
}
#define RLX_AGENT __ATOMIC_RELAXED, __HIP_MEMORY_SCOPE_AGENT
#define XB_TMO      128
#define XB_XCNT(j)  (256  + 64 * (j))
#define XB_XSUB(j)  (1280 + 64 * (j))
#define XB_XGEN(j)  (2304 + 64 * (j))
#define XB_TOP      3328
#define XB_TOPGEN   3392
#define XCD_BAR_WORDS 3456
#define XB_SPIN_CAP (1u << 18)

__device__ __forceinline__ unsigned xb_ld(unsigned* p)              { return __hip_atomic_load(p, __ATOMIC_RELAXED, __HIP_MEMORY_SCOPE_AGENT); }
__device__ __forceinline__ unsigned xb_add(unsigned* p, unsigned v) { return __hip_atomic_fetch_add(p, v, __ATOMIC_RELAXED, __HIP_MEMORY_SCOPE_AGENT); }
__device__ __forceinline__ unsigned xb_xcc_id() { return (unsigned)__builtin_amdgcn_s_getreg((3 << 11) | 20) & 0xFu; }
#define XB_SPIN(cond, bar) do { unsigned _sp = 0; while (cond) { __builtin_amdgcn_s_sleep(1); \
    if ((++_sp & 255u) == 0u) { if (xb_ld(&(bar)[XB_TMO])) break; if (_sp > XB_SPIN_CAP) { atomicAdd(&(bar)[XB_TMO], 1u); break; } } } } while (0)

struct XcdBarrier {
    unsigned* bar; unsigned x;
    volatile LAS unsigned* st;
};

__device__ __forceinline__ XcdBarrier xcd_barrier_post(unsigned* bar, volatile LAS unsigned* st) {
    XcdBarrier b; b.bar = bar; b.x = xb_xcc_id(); b.st = st;
    if (threadIdx.x == 0) (void)xb_add(&bar[XB_XCNT(b.x)], 1u);
    return b;
}
__device__ __forceinline__ void xcd_barrier_complete(unsigned* bar, unsigned x, unsigned& nloc, unsigned& nx) {
    const unsigned G = gridDim.x * gridDim.y * gridDim.z;
    unsigned sum, cnt, mine, sp = 0u;
    for (;;) {
        sum = 0u; cnt = 0u; mine = 0u;
#pragma unroll
        for (unsigned j = 0; j < 16; ++j) { const unsigned c = xb_ld(&bar[XB_XCNT(j)]); sum += c; cnt += (c > 0u) ? 1u : 0u; mine = (j == x) ? c : mine; }
        if (sum == G) break;
        __builtin_amdgcn_s_sleep(1);
        if ((++sp & 255u) == 0u) { if (xb_ld(&bar[XB_TMO])) break; if (sp > XB_SPIN_CAP) { atomicAdd(&bar[XB_TMO], 1u); break; } }
    }
    nloc = mine > 0u ? mine : 1u; nx = cnt > 0u ? cnt : 1u;
}

__device__ __forceinline__ void xcd_barrier(const XcdBarrier& b) {
    asm volatile("s_waitcnt vmcnt(0)" ::: "memory");
    __syncthreads();
    if (threadIdx.x == 0) {
        unsigned* bar = b.bar;
        __builtin_amdgcn_s_waitcnt(0);
        unsigned nloc = b.st[0], nx = b.st[1];
        if (nloc == 0u) { xcd_barrier_complete(bar, b.x, nloc, nx); b.st[0] = nloc; b.st[1] = nx; }
        const unsigned old = xb_add(&bar[XB_XSUB(b.x)], 1u);
        const unsigned gen = old / nloc;
        if (old + 1u == (gen + 1u) * nloc) {
            __builtin_amdgcn_fence(__ATOMIC_RELEASE, "agent");
            asm volatile("s_waitcnt vmcnt(0)" ::: "memory");
            const unsigned og = xb_add(&bar[XB_TOP], 1u);
            const unsigned tg = og / nx;
            if (og + 1u == (tg + 1u) * nx) xb_add(&bar[XB_TOPGEN], 1u);
            else XB_SPIN(xb_ld(&bar[XB_TOPGEN]) == tg, bar);
            __builtin_amdgcn_fence(__ATOMIC_ACQUIRE, "agent");
            xb_add(&bar[XB_XGEN(b.x)], 1u);
            asm volatile("s_waitcnt vmcnt(0)" ::: "memory");
        } else {
            XB_SPIN(xb_ld(&bar[XB_XGEN(b.x)]) == gen, bar);
            __builtin_amdgcn_fence(__ATOMIC_ACQUIRE, "agent");
            asm volatile("s_waitcnt vmcnt(0)" ::: "memory");
        }
    }
    __syncthreads();
}
constexpr size_t MiB = 1u << 20;
constexpr size_t WS_MOD = 0, WS_ROPEC = 1 * MiB, WS_ROPES = 1 * MiB + 8192, WS_BAR = 1 * MiB + 131072;
constexpr size_t WS_WIN = 2 * MiB, WS_WOUT = 18 * MiB, WS_WUP = 26 * MiB, WS_WDN = 70 * MiB;
constexpr size_t WS_ST = 92 * MiB, WS_X = 94 * MiB, WS_H = 359 * MiB, WS_Z = 492 * MiB, WS_Y = 756 * MiB, WS_ACT = WS_Z, WS_END = 888 * MiB;
static_assert(WS_WIN + (size_t)P_DEPTH * P_INW * P_D * 2 <= WS_WOUT && WS_WOUT + (size_t)P_DEPTH * P_D * P_D * 2 <= WS_WUP && WS_WUP + (size_t)P_DEPTH * P_UPW * P_D * 2 <= WS_WDN && WS_WDN + (size_t)P_DEPTH * P_D * P_DFF * 2 <= WS_ST && WS_ST + (size_t)P_M * 8 <= WS_X, "weights map");
static_assert(WS_X + (size_t)P_M * P_D * 4 <= WS_H - MiB / 2 && WS_H + (size_t)P_M * P_D * 2 + MiB / 2 <= WS_Z && WS_Z + (size_t)P_M * P_INW * 2 <= WS_Y && WS_Y + (size_t)P_M * P_D * 2 <= WS_END && WS_ACT + (size_t)P_M * P_DFF * 2 <= WS_END, "activation map");
constexpr int LDS_BYTES = 147456, RPB_OFF = 98304, BARST_OFF = 131072 + 64;
#ifndef DBG_REP
#define DBG_REP -1
#endif
constexpr int PH_PER_L = 9;
#ifndef N1_OUT
#define N1_OUT 47000
#endif
#ifndef N1_DOWN
#define N1_DOWN 0
#endif
#ifndef DBG_P0REP
#define DBG_P0REP 0
#endif
constexpr int N_PHASES = 2 + PH_PER_L * P_DEPTH + 2 * DBG_P0REP;

struct Args {
    const float *x, *c, *ctx, *c_ctx, *w_mod, *b_mod, *w_in, *pool_w, *pool_scale, *na_rpb, *q_norm, *k_norm, *w_out, *ln1_g, *ln1_b, *w_up, *conv_w, *conv_b, *w_down, *ln2_g, *ln2_b;
    float* out; unsigned char* ws; int ph_lo, ph_hi;
};
static_assert(sizeof(Args) == 23 * 8 + 8, "Args has no padding");

template <int OFF> __device__ __forceinline__ unsigned long long ldarg() {
    unsigned long long v; asm volatile("s_load_dwordx2 %0, %1, %2\n\ts_waitcnt lgkmcnt(0)" : "=s"(v) : "s"(__builtin_amdgcn_kernarg_segment_ptr()), "n"(OFF)); return v; }
#define ARGF(A, f) (A).f = (decltype(Args::f))(__attribute__((address_space(1))) void*)ldarg<offsetof(Args, f)>()
__device__ __forceinline__ void p0_item(const float* W, int K, int N, bf16* WT, int k0, int n0, int drow, LAS float* scr, int lane) {
    float wv[32];
#pragma unroll
    for (int i = 0; i < 32; ++i) wv[i] = W[(size_t)(k0 + 2 * i + (lane >> 5)) * N + n0 + (lane & 31)];
#pragma unroll
    for (int i = 0; i < 32; ++i) scr[(2 * i + (lane >> 5)) * 33 + (lane & 31)] = wv[i];
    LDS_WAIT(); asm volatile("" ::: "memory");
    const int c = lane & 7;
#pragma unroll
    for (int j = 0; j < 4; ++j) { const int n = (lane >> 3) + 8 * j; const LAS float* s = scr + (8 * c) * 33 + n;
        v4u o; o.x = pk2(s[0 * 33], s[1 * 33]); o.y = pk2(s[2 * 33], s[3 * 33]); o.z = pk2(s[4 * 33], s[5 * 33]); o.w = pk2(s[6 * 33], s[7 * 33]);
        *(GAS v4u*)(WT + (size_t)(drow + n) * K + k0 + 8 * c) = o; }
    LDS_WAIT(); asm volatile("" ::: "memory");
}

__device__ __forceinline__ void phase0(const Args& a, LAS unsigned char* lds, int vcu, int G, int tid, int lane, int wave) {
    unsigned char* ws = a.ws;
    {
        LAS float* scr = (LAS float*)(lds + wave * 16384);
        const int gw = vcu * 8 + wave, NGW = G * 8;
        constexpr int I_IN = 16 * 64, I_OUT = 16 * 32, I_UP = 16 * 176, I_DN = 44 * 32, I_L = I_IN + I_OUT + I_UP + I_DN;
        for (int it = gw; it < P_DEPTH * I_L; it += NGW) {
            const int l = it / I_L; int r = it - l * I_L;
            if (r < I_IN) { const int kb = r >> 6, nb = r & 63, L0 = 32 * nb; const int drow = (L0 & ~255) + ((L0 >> 5) & 1) * 128 + ((L0 >> 6) & 3) * 32;
                p0_item(a.w_in + (size_t)l * P_D * P_INW, P_D, P_INW, (bf16*)(ws + WS_WIN) + (size_t)l * P_INW * P_D, 64 * kb, 32 * nb, drow, scr, lane); continue; }
            r -= I_IN;
            if (r < I_OUT) { const int kb = r >> 5, nb = r & 31;
                p0_item(a.w_out + (size_t)l * P_D * P_D, P_D, P_D, (bf16*)(ws + WS_WOUT) + (size_t)l * P_D * P_D, 64 * kb, 32 * nb, 32 * nb, scr, lane); continue; }
            r -= I_OUT;
            if (r < I_UP) { const int kb = r / 176, nb = r - kb * 176, L0 = 32 * nb; const int half = L0 >= P_DFF ? 1 : 0, ch0 = L0 - half * P_DFF; const int drow = (ch0 >> 7) * 256 + half * 128 + (ch0 & 127);
                p0_item(a.w_up + (size_t)l * P_D * P_UPW, P_D, P_UPW, (bf16*)(ws + WS_WUP) + (size_t)l * P_UPW * P_D, 64 * kb, 32 * nb, drow, scr, lane); continue; }
            r -= I_UP;
            { const int kb = r >> 5, nb = r & 31;
                p0_item(a.w_down + (size_t)l * P_DFF * P_D, P_DFF, P_D, (bf16*)(ws + WS_WDN) + (size_t)l * P_D * P_DFF, 64 * kb, 32 * nb, 32 * nb, scr, lane); }
        }
    }
    __syncthreads();
    if (vcu < 192) {
        LAS float* act = (LAS float*)lds; LAS float* red = (LAS float*)(lds + 40960);
        for (int e = tid; e < 9 * P_D; e += 512) { const int r = e >> 10, k = e & 1023; const float v = r < 8 ? a.c[r * P_D + k] : a.c_ctx[k]; act[e] = v / (1.0f + expf(-v)); }
        __syncthreads();
        for (int u = vcu; u < 192; u += G) {
            const int l = u / 48, n0 = (u - l * 48) * 128, cg4 = tid & 31, ks = tid >> 5;
            const float* wp = a.w_mod + (size_t)l * P_D * P_MODW + (size_t)(ks * 64) * P_MODW + n0 + 4 * cg4;
            f32x4 s[9];
#pragma unroll
            for (int r = 0; r < 9; ++r) s[r] = (f32x4){0.f, 0.f, 0.f, 0.f};
#pragma unroll 8
            for (int k = 0; k < 64; ++k) { const f32x4 w = *(const f32x4*)(wp + (size_t)k * P_MODW);
#pragma unroll
                for (int r = 0; r < 9; ++r) s[r] += w * act[r * P_D + ks * 64 + k]; }
#pragma unroll
            for (int r = 0; r < 9; ++r) *(LAS f32x4*)(red + (ks * 9 + r) * 128 + 4 * cg4) = s[r];
            __syncthreads();
            for (int e = tid; e < 9 * 128; e += 512) { const int r = e >> 7, cc = e & 127; float t = 0.f;
#pragma unroll
                for (int k2 = 0; k2 < 16; ++k2) t += red[(k2 * 9 + r) * 128 + cc];
                ((float*)(ws + WS_MOD))[(size_t)(l * 9 + r) * P_MODW + n0 + cc] = t + a.b_mod[l * P_MODW + n0 + cc]; }
            __syncthreads();
        }
    }
    if (vcu == G - 1) {
        for (int e = tid; e < 2048; e += 512) { const int pos = e >> 4, f = e & 15;
            const float inv = exp2f(-(float)f * (13.287712379549449f / 16.0f));
            const float ang = (float)pos * inv;
            ((float*)(ws + WS_ROPEC))[e] = cosf(ang); ((float*)(ws + WS_ROPES))[e] = sinf(ang); }
    }
}

template <int KIND> __device__ __forceinline__ void row_phase(const Args& a, int l, int mode, int n1, int bx, int vcu, int G, int wave, int lane) {
    unsigned char* ws = a.ws; const float* X = (const float*)(ws + WS_X); bf16* H = (bf16*)(ws + WS_H); const float* mod = (const float*)(ws + WS_MOD); float* ST = (float*)(ws + WS_ST);
    const bool lastl = (KIND == 2 && l == P_DEPTH - 1);
    const int ml = (KIND == 2) ? l + 1 : l; const int csh = (KIND == 1) ? 3 : 0, csc = (KIND == 1) ? 4 : 1;
    const float* lg = (KIND == 1 ? a.ln1_g : a.ln2_g) + l * P_D; const float* lb = (KIND == 1 ? a.ln1_b : a.ln2_b) + l * P_D;
#define ROW_OF(i) (mode == 1 ? (i) + (((i) >> 13) + 1) * P_CTX : (mode == 2 ? ((i) >> 8) * P_RPB + ((i) & 255) : (i)))
#define ROW_SRC(m_, b_, rb_) ((KIND == 0) ? ((rb_) < P_CTX ? a.ctx + ((size_t)(b_) * P_CTX + (rb_)) * P_D : a.x + ((size_t)(b_) * P_SEQ + ((rb_) - P_CTX)) * P_D) : X + (size_t)(m_) * P_D)
    for (int seg = 0; seg < 2; ++seg) {
        int start, stride, end;
        if (seg == 0) { start = vcu * 8 + wave; stride = G * 8; end = (mode == 0) ? P_M : (mode == 2 ? P_B * P_CTX : n1); }
        else { if (mode != 1 || bx < 32) break; start = n1 + (bx - 32) * 8 + wave; stride = (G - 32) * 8; end = P_B * P_SEQ; }
        f32x4 vn[4];
        if (start < end) { const int m0 = ROW_OF(start); const int b0 = m0 / P_RPB, rb0 = m0 - b0 * P_RPB; const f32x4* xr = (const f32x4*)ROW_SRC(m0, b0, rb0) + lane;
#pragma unroll
            for (int j = 0; j < 4; ++j) vn[j] = xr[64 * j]; }
        for (int i = start; i < end; i += stride) {
            const int m = ROW_OF(i);
            const int b = m / P_RPB, rb = m - b * P_RPB; const bool is_ctx = rb < P_CTX; const int mrow = is_ctx ? 8 : b;
            f32x4 v[4];
#pragma unroll
            for (int j = 0; j < 4; ++j) v[j] = vn[j];
            if (i + stride < end) { const int m1 = ROW_OF(i + stride); const int b1 = m1 / P_RPB, rb1 = m1 - b1 * P_RPB; const f32x4* xr = (const f32x4*)ROW_SRC(m1, b1, rb1) + lane;
#pragma unroll
                for (int j = 0; j < 4; ++j) vn[j] = xr[64 * j]; }
            if (KIND != 0) {
                float s = 0.f;
#pragma unroll
                for (int j = 0; j < 4; ++j) s += (v[j].x + v[j].y) + (v[j].z + v[j].w);
                const float mean = wave_sum(s) * (1.f / P_D); float s2 = 0.f;
#pragma unroll
                for (int j = 0; j < 4; ++j) { v[j] = v[j] - mean; s2 += (v[j].x * v[j].x + v[j].y * v[j].y) + (v[j].z * v[j].z + v[j].w * v[j].w); }
                const float rstd = 1.f / sqrtf(wave_sum(s2) * (1.f / P_D) + P_EPS);
                if (!lastl && lane == 0) { ST[(size_t)m * 2] = mean; ST[(size_t)m * 2 + 1] = rstd; }
#pragma unroll
                for (int j = 0; j < 4; ++j) { const f32x4 g = ((const f32x4*)lg)[lane + 64 * j], bb = ((const f32x4*)lb)[lane + 64 * j]; v[j] = v[j] * rstd * g + bb; }
            }
            if (lastl) {
                if (!is_ctx) { f32x4* o = (f32x4*)(a.out + ((size_t)b * P_SEQ + (rb - P_CTX)) * P_D) + lane;
#pragma unroll
                    for (int j = 0; j < 4; ++j) o[64 * j] = v[j]; }
            } else {
                const float* mp = mod + (size_t)(ml * 9 + mrow) * P_MODW;
                unsigned long long* o8 = (unsigned long long*)(H + (size_t)m * P_D) + lane;
#pragma unroll
                for (int j = 0; j < 4; ++j) { const f32x4 sh = ((const f32x4*)(mp + csh * P_D))[lane + 64 * j], sc = ((const f32x4*)(mp + csc * P_D))[lane + 64 * j];
                    const f32x4 h = v[j] * (1.0f + sc) + sh;
                    o8[64 * j] = (unsigned long long)pk2(h.x, h.y) | ((unsigned long long)pk2(h.z, h.w) << 32); }
            }
        }
    }
#undef ROW_OF
#undef ROW_SRC
}

__device__ __forceinline__ void pool_unit(const Args& a, int l, int u, LAS unsigned char* lds, int tid) {
    const bf16* Z = (const bf16*)(a.ws + WS_Z); bf16* Y = (bf16*)(a.ws + WS_Y);
    const int tk = u >> 2, g = u & 3; const int row0 = tk * 128; const int b = row0 / P_RPB, rb0 = row0 - b * P_RPB;
    const int slo = (rb0 < P_CTX) ? b * P_RPB : b * P_RPB + P_CTX, shi = (rb0 < P_CTX) ? b * P_RPB + P_CTX : (b + 1) * P_RPB;
    LAS float* zt = (LAS float*)lds;
    LAS float* pl = (LAS float*)(lds + 36864);
    LAS float* wl = (LAS float*)(lds + 36864 + 34816);
    for (int e = tid; e < 144 * 8; e += 512) { const int rr = e >> 3, c8 = e & 7; const int R = row0 - 8 + rr;
        v4u w = (v4u){0u, 0u, 0u, 0u};
        if (R >= slo && R < shi) w = *(const v4u*)(Z + (size_t)R * P_INW + g * 64 + c8 * 8);
        LAS float* d = zt + rr * 64 + c8 * 8;
        d[0] = bf2f(w.x & 0xffff); d[1] = bf2f(w.x >> 16); d[2] = bf2f(w.y & 0xffff); d[3] = bf2f(w.y >> 16); d[4] = bf2f(w.z & 0xffff); d[5] = bf2f(w.z >> 16); d[6] = bf2f(w.w & 0xffff); d[7] = bf2f(w.w >> 16); }
    { const f32x4* wsrc = (const f32x4*)(a.pool_w + ((size_t)l * 4 + g) * 4096);
      for (int e = tid; e < 1024; e += 512) ((LAS f32x4*)wl)[e] = wsrc[e]; }
    __syncthreads();
    const int hw = 1 << g;
    for (int e = tid; e < 128 * 64; e += 512) { const int t = e >> 6, c = e & 63; const int T = row0 + t;
        const int lo = max(T - hw, slo), hi = min(T + hw - 1, shi - 1);
        float s = 0.f;
        for (int p = lo; p <= hi; ++p) s += zt[(p - row0 + 8) * 64 + c];
        pl[t * 68 + c] = s / (float)(hi - lo + 1) - zt[(t + 8) * 64 + c]; }
    __syncthreads();
    { const int d = tid & 63, tq = tid >> 6;
      float acc[16];
#pragma unroll
      for (int t = 0; t < 16; ++t) acc[t] = 0.f;
      for (int c4 = 0; c4 < 16; ++c4) {
          const float w0 = wl[(4 * c4 + 0) * 64 + d], w1 = wl[(4 * c4 + 1) * 64 + d], w2 = wl[(4 * c4 + 2) * 64 + d], w3 = wl[(4 * c4 + 3) * 64 + d];
#pragma unroll
          for (int t = 0; t < 16; ++t) { const f32x4 p = *(const LAS f32x4*)(pl + (tq * 16 + t) * 68 + 4 * c4); acc[t] += (p.x * w0 + p.y * w1) + (p.z * w2 + p.w * w3); }
      }
      const float sc = a.pool_scale[l * 256 + g * 64 + d];
#pragma unroll
      for (int t = 0; t < 16; ++t) Y[(size_t)(row0 + tq * 16 + t) * P_D + g * 64 + d] = (bf16)f2bf(acc[t] * sc);
    }
    __syncthreads();
}

__device__ __forceinline__ void mix_phase(const Args& a, int l, unsigned char* ldsg, LAS unsigned char* lds, int vcu, int G, int tid) {
    using abf = attn_body::bf16;
    const abf* Z = (const abf*)(a.ws + WS_Z); abf* Y = (abf*)(a.ws + WS_Y);
    { LAS float* rp = (LAS float*)(lds + RPB_OFF); const float* src = a.na_rpb + (size_t)l * 6 * 465;
      for (int e = tid; e < 6 * 465; e += 512) rp[e] = src[e] * P_LOG2E; }
    __syncthreads();
    for (int u = vcu; u < 1536; u += G) { const int h = u >> 8, b = (u >> 5) & 7, qb = u & 31, kv = h / 3;
        const size_t brow = (size_t)b * P_RPB, qrow = brow + P_CTX + (size_t)qb * 256;
        attn_body::attn_unit<8, 0>(Z + qrow * P_INW + 1408 + 64 * h, Z + brow * P_INW + 1792 + 64 * kv, Z + brow * P_INW + 1920 + 64 * kv, Y + qrow * P_D + 640 + 64 * h, 132, 256, 0, 0, RPB_OFF, (char*)ldsg); }
    if (DBG_NA) for (int u = vcu; u < 1536; u += G) { const int h = u >> 8, b = (u >> 5) & 7, qb = u & 31;
        const size_t brow = (size_t)b * P_RPB, qrow = brow + P_CTX + (size_t)qb * 256;
        const int rsmin = min(max(4 * qb - 4, 0), 116);
        attn_body::attn_unit<8, 1>(Z + qrow * P_INW + 256 + 64 * h, Z + brow * P_INW + 640 + 64 * h, Z + brow * P_INW + 1024 + 64 * h, Y + qrow * P_D + 256 + 64 * h, 16, 256 + 64 * rsmin, 4 * qb, rsmin, RPB_OFF + h * 465 * 4, (char*)ldsg); }
    if (DBG_CTX && l < P_DEPTH - 1)
        for (int u = vcu - 64; u < 96; u += G) { if (u < 0) continue; const int b = u / 12, hh = u - b * 12; const size_t brow = (size_t)b * P_RPB;
            int qc, kc, vc, oc;
            if (hh < 6) { qc = 256 + 64 * hh; kc = 640 + 64 * hh; vc = 1024 + 64 * hh; oc = 256 + 64 * hh; }
            else { const int h = hh - 6; qc = 1408 + 64 * h; kc = 1792 + 64 * (h / 3); vc = 1920 + 64 * (h / 3); oc = 640 + 64 * h; }
            attn_body::attn_unit<8, 0>(Z + brow * P_INW + qc, Z + brow * P_INW + kc, Z + brow * P_INW + vc, Y + brow * P_D + oc, 4, 256, 0, 0, RPB_OFF, (char*)ldsg); }
    if (DBG_POOL) for (int u = vcu; u < (P_M / 128) * 4; u += G) pool_unit(a, l, u, lds, tid);
}


#if DBG_DIAG
constexpr size_t WS_FLAG = 1 * MiB + 65536;
__device__ __forceinline__ bool vclose(float mine, float ref, float tol) {
    const float d = wave_sum((mine - ref) * (mine - ref)), n = wave_sum(ref * ref); return d <= tol * tol * n + 1e-12f; }
__device__ __forceinline__ float na_ref(const Args& a, const bf16* Z, int b, int h, int pos, int lane) {
    const size_t Rl = (size_t)b * P_RPB + P_CTX + pos; const int gr = pos >> 6, gc = pos & 63; const int rs = min(max(gr - 4, 0), 120), cs = min(max(gc - 8, 0), 48);
    float mx = -1e30f, sc[6];
    for (int i = 0; i < 6; ++i) { const int key = lane + 64 * i; size_t kr_; float bias = 0.f;
        if (key < 128) { const int kr = rs + key / 16, kc = cs + key % 16; kr_ = (size_t)b * P_RPB + P_CTX + kr * 64 + kc; bias = a.na_rpb[(size_t)h * 465 + (kr - gr + 7) * 31 + (kc - gc + 15)] * P_LOG2E; }
        else kr_ = (size_t)b * P_RPB + (key - 128);
        float s = 0.f; for (int d = 0; d < 64; ++d) s += bf2f(Z[Rl * P_INW + 256 + 64 * h + d]) * bf2f(Z[kr_ * P_INW + 640 + 64 * h + d]);
        sc[i] = s + bias; mx = fmaxf(mx, sc[i]); }
    for (int o = 1; o < 64; o <<= 1) mx = fmaxf(mx, __shfl_xor(mx, o));
    float den = 0.f; for (int i = 0; i < 6; ++i) { sc[i] = exp2f(sc[i] - mx); den += sc[i]; } den = wave_sum(den);
    float o_ = 0.f;
    for (int i = 0; i < 6; ++i) for (int l2 = 0; l2 < 64; ++l2) { const int key = l2 + 64 * i; size_t kr_;
        if (key < 128) { const int kr = rs + key / 16, kc = cs + key % 16; kr_ = (size_t)b * P_RPB + P_CTX + kr * 64 + kc; } else kr_ = (size_t)b * P_RPB + (key - 128);
        o_ += __shfl(sc[i], l2) * bf2f(Z[kr_ * P_INW + 1024 + 64 * h + lane]); }
    return o_ / den;
}
__device__ __forceinline__ float att_ref(const bf16* Z, size_t qrow, size_t krow0, int ntile, int qc, int kc, int vc, int lane) {
    float mx = -1e30f;
    for (int i = 0; i < ntile; ++i) { const size_t kr_ = krow0 + lane + 64 * i; float s = 0.f;
        for (int d = 0; d < 64; ++d) s += bf2f(Z[qrow * P_INW + qc + d]) * bf2f(Z[kr_ * P_INW + kc + d]); mx = fmaxf(mx, s); }
    for (int o = 1; o < 64; o <<= 1) mx = fmaxf(mx, __shfl_xor(mx, o));
    float den = 0.f, o_ = 0.f;
    for (int i = 0; i < ntile; ++i) { const size_t kr_ = krow0 + lane + 64 * i; float s = 0.f;
        for (int d = 0; d < 64; ++d) s += bf2f(Z[qrow * P_INW + qc + d]) * bf2f(Z[kr_ * P_INW + kc + d]);
        const float p = exp2f(s - mx); den += p;
        for (int l2 = 0; l2 < 64; ++l2) o_ += __shfl(p, l2) * bf2f(Z[(krow0 + l2 + 64 * i) * P_INW + vc + lane]); }
    return o_ / wave_sum(den);
}
__device__ __forceinline__ float pool_ref(const Args& a, const bf16* Z, size_t R, size_t slo, size_t shi, int g, int lane) {
    const int hw = 1 << g; const size_t lo = (R >= slo + hw) ? R - hw : slo, hi = (R + hw - 1 < shi) ? R + hw - 1 : shi - 1;
    float s = 0.f; for (size_t p = lo; p <= hi; ++p) s += bf2f(Z[p * P_INW + g * 64 + lane]);
    const float pooled = s / (float)(hi - lo + 1) - bf2f(Z[R * P_INW + g * 64 + lane]); float y = 0.f;
    for (int c = 0; c < 64; ++c) y += __shfl(pooled, c) * a.pool_w[(size_t)g * 4096 + c * 64 + lane];
    return y * a.pool_scale[g * 64 + lane];
}
__device__ __forceinline__ void diag_phase(const Args& a, int code, int vcu, int tid, int G) {
    unsigned char* ws = a.ws; unsigned* flag = (unsigned*)(ws + WS_FLAG);
    const bf16* Z = (const bf16*)(ws + WS_Z); const bf16* Y = (const bf16*)(ws + WS_Y);
    const int lane = tid & 63;
    if (code == 199) {
        const unsigned fl = *flag; int first = 0; for (int i = 0; i < 16; ++i) if ((fl >> i) & 1) { first = i + 1; break; }
        for (size_t i = (size_t)vcu * 512 + tid; i < (size_t)P_B * P_SEQ * P_D; i += (size_t)G * 512) a.out[i] = (float)first;
        return;
    }
    if (vcu != 0 || tid >= 64) return;
    if (code == 100) { if (lane == 0) *flag = 0u; return; }
    if (code == 102) {
        const float TOL = 0.006f;
        const int nb[5] = {0, 7, 3, 5, 2}, nh[5] = {0, 5, 2, 3, 1}, npos[5] = {0, 127 * 64 + 63, 60 * 64 + 3, 2 * 64 + 30, 64 * 64 + 31};
        for (int q = 0; q < 5; ++q) { const float r = na_ref(a, Z, nb[q], nh[q], npos[q], lane); const float m = bf2f(Y[((size_t)nb[q] * P_RPB + P_CTX + npos[q]) * P_D + 256 + 64 * nh[q] + lane]);
            if (!vclose(m, r, TOL) && lane == 0) atomicOr(flag, 1u << q); }
        const int gb[2] = {1, 7}, gh[2] = {0, 5}, gpos[2] = {100, 8191};
        for (int q = 0; q < 2; ++q) { const size_t brow = (size_t)gb[q] * P_RPB; const float r = att_ref(Z, brow + P_CTX + gpos[q], brow, 132, 1408 + 64 * gh[q], 1792 + 64 * (gh[q] / 3), 1920 + 64 * (gh[q] / 3), lane);
            const float m = bf2f(Y[(brow + P_CTX + gpos[q]) * P_D + 640 + 64 * gh[q] + lane]); if (!vclose(m, r, TOL) && lane == 0) atomicOr(flag, 1u << (5 + q)); }
        { const size_t brow = (size_t)1 * P_RPB; const float r = att_ref(Z, brow + 200, brow, 4, 256 + 64 * 3, 640 + 64 * 3, 1024 + 64 * 3, lane); const float m = bf2f(Y[(brow + 200) * P_D + 256 + 64 * 3 + lane]);
          if (!vclose(m, r, TOL) && lane == 0) atomicOr(flag, 1u << 7); }
        { const size_t brow = (size_t)6 * P_RPB; const float r = att_ref(Z, brow + 17, brow, 4, 1408 + 64 * 4, 1792 + 64 * 1, 1920 + 64 * 1, lane); const float m = bf2f(Y[(brow + 17) * P_D + 640 + 64 * 4 + lane]);
          if (!vclose(m, r, TOL) && lane == 0) atomicOr(flag, 1u << 8); }
        { const size_t brow = (size_t)4 * P_RPB; const size_t R = brow + P_CTX; const float r = pool_ref(a, Z, R, brow + P_CTX, brow + P_RPB, 0, lane); if (!vclose(bf2f(Y[R * P_D + lane]), r, TOL) && lane == 0) atomicOr(flag, 1u << 9); }
        { const size_t brow = (size_t)7 * P_RPB; const size_t R = brow + P_RPB - 1; const float r = pool_ref(a, Z, R, brow + P_CTX, brow + P_RPB, 3, lane); if (!vclose(bf2f(Y[R * P_D + 192 + lane]), r, TOL) && lane == 0) atomicOr(flag, 1u << 10); }
        { const size_t brow = (size_t)3 * P_RPB; const size_t R = brow + 255; const float r = pool_ref(a, Z, R, brow, brow + P_CTX, 2, lane); if (!vclose(bf2f(Y[R * P_D + 128 + lane]), r, TOL) && lane == 0) atomicOr(flag, 1u << 11); }
    }
}
#endif

__global__ void __launch_bounds__(512, 2) mega(Args a) {
    extern __shared__ __attribute__((aligned(16))) unsigned char ldsraw[];
    LAS unsigned char* lds = (LAS unsigned char*)ldsraw;
    cg::grid_group grid = cg::this_grid();
    const int G = gridDim.x; const int bx = blockIdx.x; const int vcu = (G % 8 == 0) ? (bx % 8) * (G / 8) + bx / 8 : bx;
    const int ph_lo = a.ph_lo, ph_hi = a.ph_hi;
    volatile LAS unsigned* barst = (volatile LAS unsigned*)(lds + BARST_OFF);
    if (threadIdx.x < 2) barst[threadIdx.x] = 0u;
    if (ph_lo == 0 && blockIdx.x == 0) { unsigned* bw = (unsigned*)(a.ws + WS_BAR); for (int i = threadIdx.x; i < XCD_BAR_WORDS; i += 512) bw[i] = 0u; }
    __syncthreads();
    XcdBarrier xbar; xbar.bar = (unsigned*)(a.ws + WS_BAR); xbar.x = 0; xbar.st = barst;
    for (int ph_ = ph_lo; ph_ < ph_hi; ++ph_) {
        const int ph = (ph_ < 2 * DBG_P0REP) ? (ph_ & 1) : ph_ - 2 * DBG_P0REP;
        if (ph_ > ph_lo) {
            if (ph_ == ph_lo + 1) { grid.sync(); xbar = xcd_barrier_post((unsigned*)(a.ws + WS_BAR), barst); }
            else xcd_barrier(xbar);
        }
        const int tid = ltid(), lane = tid & 63, wave = __builtin_amdgcn_readfirstlane(tid >> 6);
        Args q;
        ARGF(q, ws); unsigned char* ws = q.ws;
#if DBG_DIAG
        if (ph >= 100) { q = a; diag_phase(q, ph, vcu, tid, G); continue; }
#endif
        if (ph == 0) { ARGF(q, c); ARGF(q, c_ctx); ARGF(q, w_mod); ARGF(q, b_mod); ARGF(q, w_in); ARGF(q, w_out); ARGF(q, w_up); ARGF(q, w_down); phase0(q, lds, vcu, G, tid, lane, wave); continue; }
        if (ph == 1) { ARGF(q, x); ARGF(q, ctx); row_phase<0>(q, 0, 0, 0, bx, vcu, G, wave, lane); continue; }
        const int l = (ph - 2) / PH_PER_L, sp = (ph - 2) % PH_PER_L; const bool lastL = (l == P_DEPTH - 1);
        if (sp == 0) {
            ARGF(q, q_norm); ARGF(q, k_norm);
            pg8::Gemm g{(const pg8::bf16_t*)(ws + WS_H), (const pg8::bf16_t*)(ws + WS_WIN) + (size_t)l * P_INW * P_D, P_M, P_INW, P_D};
            pg8::StaticOrder S; S.init(P_M / 256, P_INW / 256, G, bx);
            pg8::EpiIn E{(pg8::bf16_t*)(ws + WS_Z), q.q_norm + l * 64, q.k_norm + l * 64, (const float*)(ws + WS_ROPEC), (const float*)(ws + WS_ROPES)};
            pg8::gemm_phase<pg8::EpiIn, pg8::StaticOrder, true, true, 0>(lds, g, S, E);
        } else if (sp == 1) {
            ARGF(q, na_rpb); ARGF(q, pool_w); ARGF(q, pool_scale);
            mix_phase(q, l, ldsraw, lds, vcu, G, tid);
        } else if (sp == 5) {
            ARGF(q, conv_w); ARGF(q, conv_b);
            pg8::Gemm g{(const pg8::bf16_t*)(ws + WS_H) - P_D, (const pg8::bf16_t*)(ws + WS_WUP) + (size_t)l * P_UPW * P_D, P_M, P_UPW, P_D};
            pg8::StaticOrder S; S.init((P_M + 247) / 248, P_UPW / 256, G, bx);
            pg8::EpiUp E{(pg8::bf16_t*)(ws + WS_ACT), q.conv_w + (size_t)l * 3 * P_UPW, q.conv_b + (size_t)l * P_UPW};
            pg8::gemm_phase<pg8::EpiUp, pg8::StaticOrder, true, true, 1>(lds, g, S, E);
        } else {
            const bool isdown = sp >= 6, ctxpart = (sp == 3 || sp == 7);
            ARGF(q, ln1_g); ARGF(q, ln1_b); ARGF(q, ln2_g); ARGF(q, ln2_b);
            if (sp == 2 || sp == 6 || (ctxpart && !lastL)) {
                ARGF(q, x); ARGF(q, ctx);
                const bool first = (!isdown && l == 0);
                pg8::Gemm g{(const pg8::bf16_t*)(ws + (isdown ? WS_ACT : WS_Y)), isdown ? (const pg8::bf16_t*)(ws + WS_WDN) + (size_t)l * P_D * P_DFF : (const pg8::bf16_t*)(ws + WS_WOUT) + (size_t)l * P_D * P_D, P_M, P_D, isdown ? P_DFF : P_D};
                pg8::StaticOrder S; S.init(P_B * P_SEQ / 256, P_D / 256, G, bx); S.skipctx = 1; S.ctxonly = ctxpart ? 1 : 0;
                pg8::EpiRes E{(float*)(ws + WS_X), (const float*)(ws + WS_MOD) + (size_t)l * 9 * P_MODW + (isdown ? 5 : 2) * P_D, (const float*)(ws + WS_ST),
                              first ? nullptr : (isdown ? q.ln1_g + l * P_D : q.ln2_g + (l - 1) * P_D), first ? nullptr : (isdown ? q.ln1_b + l * P_D : q.ln2_b + (l - 1) * P_D), q.x, q.ctx};
                pg8::gemm_phase<pg8::EpiRes, pg8::StaticOrder, true, true, 0>(lds, g, S, E);
            }
            if (sp == 3 || (sp == 4 && !lastL)) row_phase<1>(q, l, sp == 3 ? 1 : 2, lastL ? P_B * P_SEQ : N1_OUT, bx, vcu, G, wave, lane);
            if (sp == 7 || (sp == 8 && !lastL)) { ARGF(q, out); row_phase<2>(q, l, sp == 7 ? 1 : 2, lastL ? P_B * P_SEQ : N1_DOWN, bx, vcu, G, wave, lane); }
        }
    }
}

#ifndef MK_MULTI
#define MK_MULTI 0
#endif
extern "C" void kernel_launch(void* const* d_in, const int* in_sizes, int n_in, void* d_out, int out_size, void* d_ws, size_t ws_size, hipStream_t stream) {
    static int grid = 0;
    if (grid == 0) {
        if (n_in != 21 || ws_size < WS_END) { fprintf(stderr, "kernel_launch: unexpected n_in %d / ws_size %zu\n", n_in, ws_size); grid = -1; return; }
        int dev = 0, cus = 0, per_cu = 0;
        if (hipGetDevice(&dev) != hipSuccess || hipDeviceGetAttribute(&cus, hipDeviceAttributeMultiprocessorCount, dev) != hipSuccess) { grid = -1; return; }
        if (hipFuncSetAttribute((const void*)mega, hipFuncAttributeMaxDynamicSharedMemorySize, LDS_BYTES) != hipSuccess) { fprintf(stderr, "kernel_launch: hipFuncSetAttribute failed\n"); grid = -1; return; }
        if (hipOccupancyMaxActiveBlocksPerMultiprocessor(&per_cu, (const void*)mega, 512, LDS_BYTES) != hipSuccess || per_cu < 1) { fprintf(stderr, "kernel_launch: occupancy query says %d\n", per_cu); per_cu = 1; }
        (void)hipGetLastError();
        grid = cus * 1;
        fprintf(stderr, "kernel_launch: cus %d per_cu %d grid %d\n", cus, per_cu, grid);
    }
    if (grid < 0) return;
    Args a{};
    const float** f = (const float**)&a;
    for (int i = 0; i < 21; ++i) f[i] = (const float*)d_in[i];
    a.out = (float*)d_out; a.ws = (unsigned char*)d_ws;
#if MK_MULTI
#if DBG_DIAG
    { const int seq[] = {0, 1, 100, 2, 3, 102, 199};
      for (int i = 0; i < 7; ++i) { a.ph_lo = seq[i]; a.ph_hi = seq[i] + 1; hipLaunchKernelGGL(mega, dim3(grid), dim3(512), LDS_BYTES, stream, a); } }
#else
    for (int ph = 0; ph < N_PHASES; ++ph) { a.ph_lo = ph; a.ph_hi = ph + 1; hipLaunchKernelGGL(mega, dim3(grid), dim3(512), LDS_BYTES, stream, a); }
#endif
#else
    a.ph_lo = 0; a.ph_hi = N_PHASES;
    void* args[] = {&a};
    hipError_t e = hipLaunchCooperativeKernel((const void*)mega, dim3(grid), dim3(512), args, LDS_BYTES, stream);
    if (e != hipSuccess) fprintf(stderr, "cooperative launch failed: %s (grid %d)\n", hipGetErrorString(e), grid);
#endif
}
```

```cpp
#include <hip/hip_runtime.h>
#include <hip/hip_cooperative_groups.h>
#include <cstdio>
#include <cstdint>
constexpr int P_D = 1024, P_B = 8, P_SEQ = 8192, P_CTX = 256, P_RPB = P_SEQ + P_CTX  , P_M = P_B * P_RPB  ;
constexpr int P_DEPTH = 4, P_INW = 2048, P_DFF = 2816, P_UPW = 2 * P_DFF, P_MODW = 6 * P_D;
constexpr float P_C2 = 0.125f * 1.4426950408889634f;
constexpr float P_LOG2E = 1.4426950408889634f;
constexpr float P_ALPHA = 1.681792830507429f;
constexpr float P_EPS = 1e-6f;
__device__ __forceinline__ int ltid() { int t = threadIdx.x; asm volatile("" : "+v"(t)); return t; }
namespace pg8 {
#define PG8_LAS __attribute__((address_space(3)))
typedef unsigned short bf16_t;
typedef short bf16x8 __attribute__((ext_vector_type(8)));
typedef float f32x4 __attribute__((ext_vector_type(4)));
typedef unsigned u32x4 __attribute__((ext_vector_type(4)));
constexpr int BM = 256, BK = 64, HALF = 128, HTB = HALF * BK * 2  , STAGE_BYTES = 8 * HTB, NXCD = 8, WGM = 8;

__host__ __device__ __forceinline__ int lds_byte(int r, int c) { const int st = (r >> 4) * 2 + (c >> 5), rr = r & 15, cc = c & 31, ob = rr * 64 + cc * 2; return st * 1024 + (ob ^ (((ob >> 9) & 1) << 5)); }
__host__ __device__ __forceinline__ void stage_rc(int b, int& R, int& C) { const int st = b / 1024, sb = b % 1024, swz = sb ^ (((sb >> 9) & 1) << 5); R = (st >> 1) * 16 + swz / 64; C = (st & 1) * 32 + (swz % 64) / 2; }
__host__ __device__ __forceinline__ int perm32(int rho) { const int n = rho >> 4, i = rho & 15; return 8 * (i >> 2) + 4 * n + (i & 3); }

struct Unit { int pm, pn; };
struct Gemm { const bf16_t* A; const bf16_t* Bt; int M, N, K; };

struct StaticOrder {
    int nM, nN, nwg, G, c, skipctx = 0, ctxonly = 0;
    __host__ __device__ void init(int nM_, int nN_, int G_, int c_) { nM = nM_; nN = nN_; nwg = nM * nN; G = G_; c = c_; }
    __host__ __device__ bool next(int i, Unit& u) const {
        if (ctxonly) { if (i > 0 || c >= 32) return false; u.pm = (c >> 2) * 33; u.pn = c & 3; return true; }
        const long L = (long)i * G + c; if (L >= nwg) return false;
        int wgid = (int)L; { const int q = nwg / NXCD, r = nwg % NXCD, xcd = wgid % NXCD, off = wgid / NXCD; wgid = (xcd < r ? xcd * (q + 1) : r * (q + 1) + (xcd - r) * q) + off; }
        const int nig = WGM * nN, gid = wgid / nig, fm = gid * WGM, gsz = (nM - fm) < WGM ? (nM - fm) : WGM;
        u.pm = fm + ((wgid % nig) % gsz); u.pn = (wgid % nig) / gsz; if (skipctx) u.pm += (u.pm >> 5) + 1; return true;
    }
    __device__ __forceinline__ void a_ready(const Unit&) const {}
    __device__ __forceinline__ void done(const Unit&) const {}
};

__device__ __forceinline__ unsigned cvt_pk_bf16(float lo, float hi) { unsigned r; asm volatile("v_cvt_pk_bf16_f32 %0, %1, %2" : "=v"(r) : "v"(lo), "v"(hi)); return r; }
#ifndef EPI_SHFL
#define EPI_SHFL 0
#endif
typedef float f32x2 __attribute__((ext_vector_type(2)));
__device__ __forceinline__ f32x4 dppror(const f32x4 v, const bool up) {
    f32x4 r;
#if EPI_SHFL
    const int lane = threadIdx.x & 63; const int src = (lane & ~15) | ((lane + (up ? 15 : 1)) & 15);
#pragma unroll
    for (int j = 0; j < 4; ++j) r[j] = __shfl(v[j], src);
#else
#pragma unroll
    for (int j = 0; j < 4; ++j) { const float xs = v[j]; const int iv = __float_as_int(xs);
        r[j] = __int_as_float(up ? __builtin_amdgcn_mov_dpp(iv, 0x121, 0xf, 0xf, true) : __builtin_amdgcn_mov_dpp(iv, 0x12F, 0xf, 0xf, true)); }
#endif
    return r;
}
struct EpiIn {
    static constexpr bool PERM = false, AFTER_DRAIN = false;
    bf16_t* Z; const float* qn; const float* kn; const float* rc; const float* rs;
    __device__ __forceinline__ void operator()(const f32x4 (&acc)[2][2][4][2], const Unit& u, int wr, int wc, int fr, int fq) const {
        asm volatile("" : "+v"(fr), "+v"(fq));
        const int hs = u.pn * 4 + wc;
        const bool isq = (hs >= 22 && hs < 28), isk = (hs == 28 || hs == 29);
        const float sc = ((hs >= 4 && hs < 10) || isq) ? P_C2 : 1.f;
        const int tb = u.pm % 33; const bool is_ctx = (tb == 0);
#pragma unroll
        for (int ai = 0; ai < 2; ++ai)
#pragma unroll
            for (int m = 0; m < 4; ++m) {
                const int rt = ai * HALF + wr * 64 + m * 16 + fr;
                const size_t row = (size_t)u.pm * BM + rt;
                f32x4 v[2][2];
#pragma unroll
                for (int bj = 0; bj < 2; ++bj)
#pragma unroll
                    for (int n = 0; n < 2; ++n) v[bj][n] = acc[ai][bj][m][n];
                if (isq || isk) {
                    float ss = 0.f;
#pragma unroll
                    for (int bj = 0; bj < 2; ++bj)
#pragma unroll
                        for (int n = 0; n < 2; ++n) { const f32x4 x = v[bj][n]; ss += (x[0] * x[0] + x[1] * x[1]) + (x[2] * x[2] + x[3] * x[3]); }
                    ss += __shfl_xor(ss, 16); ss += __shfl_xor(ss, 32);
                    const float rstd = __builtin_amdgcn_rsqf(ss * (1.0f / 64.0f) + P_EPS);
                    const float* gp = (isq ? qn : kn) + 4 * fq;
                    const int pos = (tb - 1) * BM + rt; const int gr = pos >> 6, gc = pos & 63;
#pragma unroll
                    for (int bj = 0; bj < 2; ++bj) {
                        const f32x4 g0 = *(const f32x4*)(gp + 32 * bj), g1 = *(const f32x4*)(gp + 32 * bj + 16);
                        f32x4 x1 = v[bj][0] * rstd * g0, x2 = v[bj][1] * rstd * g1;
                        if (!is_ctx) { const int idx = bj ? gc : gr;
                            const f32x4 cs = *(const f32x4*)(rc + idx * 16 + 4 * fq), sn = *(const f32x4*)(rs + idx * 16 + 4 * fq);
                            const f32x4 y1 = x1 * cs - x2 * sn, y2 = x1 * sn + x2 * cs; x1 = y1; x2 = y2; }
                        v[bj][0] = x1; v[bj][1] = x2;
                    }
                }
                bf16_t* zp = Z + row * P_INW + hs * 64 + 4 * fq;
#pragma unroll
                for (int bj = 0; bj < 2; ++bj)
#pragma unroll
                    for (int n = 0; n < 2; ++n) { const f32x4 x = v[bj][n] * sc; unsigned long long w = (unsigned long long)cvt_pk_bf16(x[0], x[1]) | ((unsigned long long)cvt_pk_bf16(x[2], x[3]) << 32);
                        *(unsigned long long*)(zp + 32 * bj + 16 * n) = w; }
                asm volatile("" ::: "memory");
            }
    }
};
struct EpiRes {
    static constexpr bool PERM = false, AFTER_DRAIN = false;
    float* X; const float* gate;
    const float* st; const float* lg; const float* lb; const float* xin; const float* cin;
    __device__ __forceinline__ void operator()(const f32x4 (&acc)[2][2][4][2], const Unit& u, int wr, int wc, int fr, int fq) const {
        asm volatile("" : "+v"(fr), "+v"(fq));
        const int b = u.pm / 33, tb = u.pm % 33; const int mrow = tb == 0 ? 8 : b;
        const int col0 = u.pn * BM + wc * 32 + 4 * fq;
        const float* gp = gate + mrow * P_MODW + col0;
        const bool ident = (lg == nullptr);
        const float* rbase = ident ? (tb == 0 ? cin + (size_t)b * P_CTX * P_D : xin + ((size_t)b * P_SEQ + (size_t)(tb - 1) * BM) * P_D) : X + (size_t)u.pm * BM * P_D;
#pragma unroll
        for (int ai = 0; ai < 2; ++ai)
#pragma unroll
            for (int m = 0; m < 4; ++m) { const int rt = ai * HALF + wr * 64 + m * 16 + fr;
                float* xw = X + ((size_t)u.pm * BM + rt) * P_D + col0; const float* xr = rbase + (size_t)rt * P_D + col0;
                float mean = 0.f, rstd = 1.f;
                if (!ident) { const f32x2 s2 = *(const f32x2*)(st + ((size_t)u.pm * BM + rt) * 2); mean = s2[0]; rstd = s2[1]; }
#pragma unroll
                for (int bj = 0; bj < 2; ++bj)
#pragma unroll
                    for (int n = 0; n < 2; ++n) { f32x4 xo = *(const f32x4*)(xr + bj * HALF + n * 16);
                        if (!ident) { const f32x4 g4 = *(const f32x4*)(lg + col0 + bj * HALF + n * 16), b4 = *(const f32x4*)(lb + col0 + bj * HALF + n * 16); xo = (xo - mean) * rstd * g4 + b4; }
                        const f32x4 gv = *(const f32x4*)(gp + bj * HALF + n * 16);
                        xo = xo * P_ALPHA + gv * acc[ai][bj][m][n]; *(f32x4*)(xw + bj * HALF + n * 16) = xo; }
                asm volatile("" ::: "memory"); }
    }
};
struct EpiUp {
    static constexpr bool PERM = true, AFTER_DRAIN = false;
    bf16_t* ACT; const float* cw; const float* cb;
    __device__ __forceinline__ void operator()(const f32x4 (&acc)[2][2][4][2], const Unit& u, int wr, int wc, int fr, int fq) const {
        asm volatile("" : "+v"(fr), "+v"(fq));
#pragma unroll
        for (int n = 0; n < 2; ++n) {
            const int ch = u.pn * 128 + wc * 32 + 8 * fq + 4 * n;
            const f32x4 wa0 = *(const f32x4*)(cw + ch), wa1 = *(const f32x4*)(cw + P_UPW + ch), wa2 = *(const f32x4*)(cw + 2 * P_UPW + ch), ba = *(const f32x4*)(cb + ch);
            const f32x4 wg0 = *(const f32x4*)(cw + P_DFF + ch), wg1 = *(const f32x4*)(cw + P_UPW + P_DFF + ch), wg2 = *(const f32x4*)(cw + 2 * P_UPW + P_DFF + ch), bg = *(const f32x4*)(cb + P_DFF + ch);
#pragma unroll
            for (int ai = 0; ai < 2; ++ai) {
                const int Rb = u.pm * 248 - 1 + (2 * ai + wr) * 62;
                f32x4 ra_prev = (f32x4){0.f, 0.f, 0.f, 0.f}, rg_prev = ra_prev;
                f32x4 la_cur = dppror(acc[ai][0][0][n], false), lg_cur = dppror(acc[ai][1][0][n], false);
#pragma unroll
                for (int m = 0; m < 4; ++m) {
                    const f32x4 va = acc[ai][0][m][n], vg = acc[ai][1][m][n];
                    const f32x4 ra_cur = dppror(va, true), rg_cur = dppror(vg, true);
                    f32x4 la_next = la_cur, lg_next = lg_cur;
                    if (m < 3) { la_next = dppror(acc[ai][0][m < 3 ? m + 1 : 3][n], false); lg_next = dppror(acc[ai][1][m < 3 ? m + 1 : 3][n], false); }
                    const int i = 16 * m + fr; const int R = Rb + i;
                    const int rbm = R - (R / P_RPB) * P_RPB;
                    const bool first = (rbm == 0) || (rbm == P_CTX), last = (rbm == P_CTX - 1) || (rbm == P_RPB - 1);
                    f32x4 upa = (fr == 0) ? ra_prev : ra_cur, upg = (fr == 0) ? rg_prev : rg_cur;
                    f32x4 dna = (fr == 15) ? la_next : la_cur, dng = (fr == 15) ? lg_next : lg_cur;
                    const f32x4 z4 = (f32x4){0.f, 0.f, 0.f, 0.f};
                    if (first) { upa = z4; upg = z4; }
                    if (last) { dna = z4; dng = z4; }
                    const f32x4 av = wa0 * upa + wa1 * va + wa2 * dna + ba;
                    const f32x4 gv = wg0 * upg + wg1 * vg + wg2 * dng + bg;
                    f32x4 o;
#pragma unroll
                    for (int j = 0; j < 4; ++j) o[j] = av[j] * gv[j] * __builtin_amdgcn_rcpf(1.0f + __expf(-gv[j]));
                    unsigned long long w = (unsigned long long)cvt_pk_bf16(o[0], o[1]) | ((unsigned long long)cvt_pk_bf16(o[2], o[3]) << 32);
                    asm volatile("" : "+v"(w));
                    if (i >= 1 && i <= 62 && R < P_M) *(unsigned long long*)(ACT + (size_t)R * P_DFF + ch) = w;
                    ra_prev = ra_cur; rg_prev = rg_cur; la_cur = la_next; lg_cur = lg_next;
                }
            }
        }
    }
};

template <class Epi, class Sched, bool ALIGN_EPI = false, bool SP2 = false, int AMODE = 0>
__device__ __forceinline__ void gemm_phase(PG8_LAS unsigned char* lds, const Gemm g, const Sched& S, const Epi& E) {
    const int tid = ltid(), wid = __builtin_amdgcn_readfirstlane(tid >> 6), lane = tid & 63, wr = wid >> 2, wc = wid & 3, fr = lane & 15, fq = lane >> 4;
    const int K = g.K, nt = K / BK;
    unsigned voffA[2], voffB[2];
#pragma unroll
    for (int i = 0; i < 2; ++i) { int R, C; stage_rc(tid * 16 + i * 8192, R, C); const int Rb = Epi::PERM ? ((R & ~31) + perm32(R & 31)) : R;
        voffA[i] = (unsigned)((AMODE ? ((R >> 6) * 62 + (R & 63)) : R) * K + C) * 2u; voffB[i] = (unsigned)(Rb * K + C) * 2u; }
    const size_t kstep = (size_t)(BK * 2);
    const size_t hstepB = (size_t)HALF * K * 2; const size_t hstepA = (size_t)(AMODE ? 124 : HALF) * K * 2;
    const size_t tstepB = 2 * hstepB; const size_t tstepA = 2 * hstepA;
    const unsigned ldsw = (unsigned)wid * 1024u;
    const int aoff = lds_byte(wr * 64 + fr, fq * 8), boff = lds_byte(wc * 32 + fr, fq * 8);
#define PG8_SA(b, h) (((b) * 2 + (h)) * HTB)
#define PG8_SB(b, h) ((4 + (b) * 2 + (h)) * HTB)
#define PG8_STAGE(bufoff, gbase, voff) do { _Pragma("unroll") for (int _i = 0; _i < 2; ++_i) \
        __builtin_amdgcn_global_load_lds((const unsigned*)((const char*)(gbase) + (voff)[_i]), (PG8_LAS unsigned*)(lds + (bufoff) + ldsw + _i * 8192), 16, 0, 0); } while (0)
#define PG8_LDA(dst, b, h) do { _Pragma("unroll") for (int m = 0; m < 4; ++m) _Pragma("unroll") for (int k = 0; k < 2; ++k) dst[m][k] = *(const PG8_LAS bf16x8*)(lds + PG8_SA(b, h) + aoff + m * 2048 + k * 1024); } while (0)
#define PG8_LDB(dst, b, h) do { _Pragma("unroll") for (int n = 0; n < 2; ++n) _Pragma("unroll") for (int k = 0; k < 2; ++k) dst[n][k] = *(const PG8_LAS bf16x8*)(lds + PG8_SB(b, h) + boff + n * 2048 + k * 1024); } while (0)
#define PG8_MMA(ai, bj, At, Bt) do { __builtin_amdgcn_s_setprio(1); _Pragma("unroll") for (int m = 0; m < 4; ++m) _Pragma("unroll") for (int n = 0; n < 2; ++n) _Pragma("unroll") for (int k = 0; k < 2; ++k) \
        acc[ai][bj][m][n] = __builtin_amdgcn_mfma_f32_16x16x32_bf16(Bt[n][k], At[m][k], acc[ai][bj][m][n], 0, 0, 0); __builtin_amdgcn_s_setprio(0); } while (0)
#define PG8_WAIT_V(n) asm volatile("s_waitcnt vmcnt(" #n ")" ::: "memory")
#define PG8_WAIT_L(n) asm volatile("s_waitcnt lgkmcnt(" #n ")" ::: "memory")
#define PG8_BAR __builtin_amdgcn_s_barrier()
#define PG8_SCHED __builtin_amdgcn_sched_barrier(0)
    Unit cur, nxt; int ui = 0;
    if (!S.next(0, cur)) return;
    f32x4 acc[2][2][4][2];
#pragma unroll
    for (int a = 0; a < 2; ++a)
#pragma unroll
        for (int b = 0; b < 2; ++b)
#pragma unroll
            for (int m = 0; m < 4; ++m)
#pragma unroll
                for (int n = 0; n < 2; ++n) acc[a][b][m][n] = (f32x4){0.f, 0.f, 0.f, 0.f};
    bf16x8 At[4][2], B0[2][2], B1[2][2];
    const char* cA = (const char*)g.A + (size_t)cur.pm * tstepA; const char* cB = (const char*)g.Bt + (size_t)cur.pn * tstepB;
    S.a_ready(cur);
    if constexpr (SP2) {
        PG8_STAGE(PG8_SB(0, 0), cB, voffB); PG8_STAGE(PG8_SB(0, 1), cB + hstepB, voffB); PG8_STAGE(PG8_SA(0, 0), cA, voffA); PG8_STAGE(PG8_SA(0, 1), cA + hstepA, voffA);
        if (wr == 1) PG8_BAR;
        PG8_WAIT_V(2); PG8_BAR;
        PG8_STAGE(PG8_SB(1, 0), cB + kstep, voffB); PG8_STAGE(PG8_SA(1, 0), cA + kstep, voffA); PG8_STAGE(PG8_SB(1, 1), cB + hstepB + kstep, voffB);
        PG8_WAIT_V(6); PG8_BAR;
    } else {
        PG8_STAGE(PG8_SB(0, 0), cB, voffB); PG8_STAGE(PG8_SA(0, 0), cA, voffA); PG8_STAGE(PG8_SB(0, 1), cB + hstepB, voffB); PG8_STAGE(PG8_SA(0, 1), cA + hstepA, voffA);
        if (wr == 1) PG8_BAR;
        PG8_WAIT_V(4); PG8_BAR;
        PG8_STAGE(PG8_SB(1, 0), cB + kstep, voffB); PG8_STAGE(PG8_SA(1, 0), cA + kstep, voffA); PG8_STAGE(PG8_SB(1, 1), cB + hstepB + kstep, voffB);
        PG8_WAIT_V(6); PG8_BAR;
    }
    for (;;) {
        const bool has_next = S.next(ui + 1, nxt);
        const char* nA = has_next ? (const char*)g.A + (size_t)nxt.pm * tstepA : cA; const char* nB = has_next ? (const char*)g.Bt + (size_t)nxt.pn * tstepB : cB;
        for (int t = 0; t < nt; t += 2) {
            const bool last = (t == nt - 2);
            const char* a1 = cA + (size_t)(t + 1) * kstep;
            const char* a2 = last ? nA : cA + (size_t)(t + 2) * kstep; const char* b2 = last ? nB : cB + (size_t)(t + 2) * kstep;
            const char* a3 = a2 + kstep; const char* b3 = b2 + kstep;
            if (last && has_next) S.a_ready(nxt);
            if constexpr (SP2) {
            PG8_LDB(B0, 0, 0); PG8_LDB(B1, 0, 1); PG8_SCHED; PG8_LDA(At, 0, 0); PG8_STAGE(PG8_SA(1, 1), a1 + hstepA, voffA);
            PG8_WAIT_V(8); PG8_WAIT_L(0); PG8_BAR; PG8_MMA(0, 0, At, B0); PG8_MMA(0, 1, At, B1); PG8_BAR; PG8_SCHED;
            PG8_LDA(At, 0, 1); PG8_STAGE(PG8_SB(0, 0), b2, voffB); PG8_STAGE(PG8_SB(0, 1), b2 + hstepB, voffB); PG8_STAGE(PG8_SA(0, 0), a2, voffA);
            PG8_WAIT_V(8); PG8_WAIT_L(0); PG8_BAR; PG8_MMA(1, 0, At, B0); PG8_MMA(1, 1, At, B1); PG8_BAR; PG8_SCHED;
            PG8_LDB(B0, 1, 0); PG8_LDB(B1, 1, 1); PG8_SCHED; PG8_LDA(At, 1, 0); PG8_STAGE(PG8_SA(0, 1), a2 + hstepA, voffA);
            PG8_WAIT_V(8); PG8_WAIT_L(0); PG8_BAR; PG8_MMA(0, 0, At, B0); PG8_MMA(0, 1, At, B1); PG8_BAR; PG8_SCHED;
            PG8_LDA(At, 1, 1); PG8_STAGE(PG8_SB(1, 0), b3, voffB); PG8_STAGE(PG8_SB(1, 1), b3 + hstepB, voffB); PG8_STAGE(PG8_SA(1, 0), a3, voffA);
            PG8_WAIT_V(8); PG8_WAIT_L(0); PG8_BAR; PG8_MMA(1, 0, At, B0); PG8_MMA(1, 1, At, B1); PG8_BAR; PG8_SCHED;
            } else {
            PG8_LDB(B0, 0, 0); PG8_SCHED; PG8_LDA(At, 0, 0); PG8_STAGE(PG8_SA(1, 1), a1 + hstepA, voffA);
            PG8_WAIT_L(8); PG8_BAR; PG8_WAIT_L(0); PG8_MMA(0, 0, At, B0); PG8_BAR; PG8_SCHED;
            PG8_LDB(B1, 0, 1); PG8_STAGE(PG8_SB(0, 0), b2, voffB);
            PG8_BAR; PG8_WAIT_L(0); PG8_MMA(0, 1, At, B1); PG8_BAR;
            PG8_LDA(At, 0, 1); PG8_STAGE(PG8_SA(0, 0), a2, voffA);
            PG8_BAR; PG8_WAIT_L(0); PG8_MMA(1, 0, At, B0); PG8_BAR; PG8_SCHED;
            PG8_STAGE(PG8_SB(0, 1), b2 + hstepB, voffB);
            PG8_WAIT_V(6); PG8_BAR; PG8_MMA(1, 1, At, B1); PG8_BAR;
            PG8_LDB(B0, 1, 0); PG8_SCHED; PG8_LDA(At, 1, 0); PG8_STAGE(PG8_SA(0, 1), a2 + hstepA, voffA);
            PG8_WAIT_L(8); PG8_BAR; PG8_WAIT_L(0); PG8_MMA(0, 0, At, B0); PG8_BAR; PG8_SCHED;
            PG8_LDB(B1, 1, 1); PG8_STAGE(PG8_SB(1, 0), b3, voffB);
            PG8_BAR; PG8_WAIT_L(0); PG8_MMA(0, 1, At, B1); PG8_BAR;
            PG8_LDA(At, 1, 1); PG8_STAGE(PG8_SA(1, 0), a3, voffA);
            PG8_BAR; PG8_WAIT_L(0); PG8_MMA(1, 0, At, B0); PG8_BAR; PG8_SCHED;
            PG8_STAGE(PG8_SB(1, 1), b3 + hstepB, voffB);
            PG8_WAIT_V(6); PG8_BAR; PG8_MMA(1, 1, At, B1); PG8_BAR;
            }
        }
        if constexpr (ALIGN_EPI) { if (wr == 0) PG8_BAR; }
        if constexpr (!Epi::AFTER_DRAIN) { E(acc, cur, wr, wc, fr, fq); S.done(cur); }
        if (!has_next) break;
#pragma unroll
        for (int a = 0; a < 2; ++a)
#pragma unroll
            for (int b = 0; b < 2; ++b)
#pragma unroll
                for (int m = 0; m < 4; ++m)
#pragma unroll
                    for (int n = 0; n < 2; ++n) acc[a][b][m][n] = (f32x4){0.f, 0.f, 0.f, 0.f};
        cur = nxt; cA = nA; cB = nB; ++ui;
        if constexpr (ALIGN_EPI) { if (wr == 1) PG8_BAR; }
    }
    PG8_WAIT_V(0);
    if constexpr (!ALIGN_EPI) { if (wr == 0) PG8_BAR; }
    PG8_BAR;
    if constexpr (Epi::AFTER_DRAIN) { E.fused(acc, cur, wr, wc, fr, fq, lds, wid, lane); S.done(cur); }
#undef PG8_SA
#undef PG8_SB
#undef PG8_STAGE
#undef PG8_LDA
#undef PG8_LDB
#undef PG8_MMA
#undef PG8_WAIT_V
#undef PG8_WAIT_L
#undef PG8_BAR
#undef PG8_SCHED
}
}
#include <hip/hip_bf16.h>
#include <cmath>
namespace attn_body {
using bf16=__hip_bfloat16;
using bf16x8=__attribute__((ext_vector_type(8)))short;
using s16x4=__attribute__((ext_vector_type(4)))short;
using f32x16=__attribute__((ext_vector_type(16)))float;
using u32x4=__attribute__((ext_vector_type(4)))unsigned;
constexpr int D=64,DM=2048,ODM=1024;
constexpr int NW=8,QBLK=32,QB=QBLK*NW,KVBLK=64;
constexpr int ATTN_PITCH=DM, ATTN_UNIT_ROWS=QB;
__device__ __forceinline__ int crow(int r,int hi){return (r&3)+8*(r>>2)+4*hi;}
#define SBAR() __builtin_amdgcn_sched_barrier(0)
__device__ __forceinline__ void cmask(f32x16&p0,f32x16&p1,int jb,int qrel,int hi){
  const float NEG=-INFINITY; int kb=64*jb+4*hi;
  #pragma unroll
  for(int r=0;r<16;++r){int kv=kb+(r&3)+8*(r>>2); if(kv>qrel)p0[r]=NEG; if(kv+32>qrel)p1[r]=NEG;}
}

typedef const __attribute__((address_space(3))) float* lds_fptr;
__device__ __forceinline__ void nabias(f32x16&p0,f32x16&p1,int kr,int qr_,int r32,int wid,int hi,lds_fptr rp){
  const float NEG=-INFINITY;
  asm volatile("":"+v"(r32),"+v"(hi));
  const int qc=32*(wid&1)+r32;
  const int rs=min(max(qr_-4,0),120), cs=min(max(qc-8,0),48);
  if(kr<rs||kr>=rs+8){
    #pragma unroll
    for(int r=0;r<16;++r){p0[r]=NEG;p1[r]=NEG;}
  } else {
    lds_fptr tb=rp+(kr-qr_+7)*31+(15-qc);
    #pragma unroll
    for(int r=0;r<16;++r){
      const int kc=(r&3)+8*(r>>2)+4*hi;
      const bool ok0=(unsigned)(kc-cs)<16u, ok1=(unsigned)(kc+32-cs)<16u;
      const float b0=tb[ok0?kc:cs], b1=tb[ok1?kc+32:cs];
      p0[r]=ok0?p0[r]+b0:NEG; p1[r]=ok1?p1[r]+b1:NEG;
    }
  }
}
constexpr int NSLOT=3, SLOTB=8192;
constexpr int LDS_K=0, LDS_V=NSLOT*SLOTB, LDS_WS=2*NSLOT*SLOTB, LDS_OST=LDS_WS+NW*64*4, LDS_BYTES=LDS_OST+NW*4096;
constexpr float C2=0.125f*1.4426950408889634f;
__device__ __forceinline__ void glds16(const void*gsrc,unsigned lds_dst){unsigned keep;
  asm volatile("s_mov_b32 %0, m0\n\ts_mov_b32 m0, %2\n\ts_nop 0\n\tglobal_load_lds_dwordx4 %1, off\n\ts_mov_b32 m0, %0":"=&s"(keep):"v"(gsrc),"s"(lds_dst):"memory");}
__device__ __forceinline__ float max3f(float a,float b,float c){float r;asm("v_max3_f32 %0, %1, %2, %3":"=v"(r):"v"(a),"v"(b),"v"(c));return r;}
__device__ __forceinline__ float max2f(float a,float b){float r;asm("v_max_f32_e32 %0, %1, %2":"=v"(r):"v"(a),"v"(b));return r;}
__device__ __forceinline__ float fadd_s(float a,float b){float r;asm("v_add_f32_e32 %0, %1, %2":"=v"(r):"v"(a),"v"(b));return r;}
__device__ __forceinline__ float fsub_s(float a,float b){float r;asm("v_sub_f32_e32 %0, %1, %2":"=v"(r):"v"(a),"v"(b));return r;}
typedef float f32x2_t __attribute__((ext_vector_type(2))); typedef __bf16 bf16x2_t __attribute__((ext_vector_type(2)));
__device__ __forceinline__ unsigned cvtpk_s(float lo,float hi){f32x2_t v={lo,hi};bf16x2_t b=__builtin_convertvector(v,bf16x2_t);return __builtin_bit_cast(unsigned,b);}
#define WAIT_BAR(N) asm volatile("s_waitcnt vmcnt(" #N ") lgkmcnt(0)\n\ts_barrier":::"memory")

__device__ __forceinline__ void qkt(f32x16&p0,f32x16&p1,const char*Kslot,const bf16x8*qr,const f32x16&negm,int r32,int hi){
  const char*kb=Kslot+hi*1024+r32*16;
  #pragma unroll
  for(int d0=0;d0<4;++d0){
    const bf16x8 b0=*reinterpret_cast<const bf16x8*>(kb+d0*2048);
    const bf16x8 b1=*reinterpret_cast<const bf16x8*>(kb+d0*2048+512);
    if(d0==0){p0=__builtin_amdgcn_mfma_f32_32x32x16_bf16(b0,qr[0],negm,0,0,0);p1=__builtin_amdgcn_mfma_f32_32x32x16_bf16(b1,qr[0],negm,0,0,0);}
    else{p0=__builtin_amdgcn_mfma_f32_32x32x16_bf16(b0,qr[d0],p0,0,0,0);p1=__builtin_amdgcn_mfma_f32_32x32x16_bf16(b1,qr[d0],p1,0,0,0);}}
}
typedef __attribute__((address_space(3))) const char* lds_cptr;
typedef short v4i16_t __attribute__((ext_vector_type(4)));
__device__ __forceinline__ void kload8(bf16x8*kf,lds_cptr kp){
  kf[0]=*(const __attribute__((address_space(3))) bf16x8*)(kp);      kf[1]=*(const __attribute__((address_space(3))) bf16x8*)(kp+512);
  kf[2]=*(const __attribute__((address_space(3))) bf16x8*)(kp+2048); kf[3]=*(const __attribute__((address_space(3))) bf16x8*)(kp+2560);
  kf[4]=*(const __attribute__((address_space(3))) bf16x8*)(kp+4096); kf[5]=*(const __attribute__((address_space(3))) bf16x8*)(kp+4608);
  kf[6]=*(const __attribute__((address_space(3))) bf16x8*)(kp+6144); kf[7]=*(const __attribute__((address_space(3))) bf16x8*)(kp+6656);
}
__device__ __forceinline__ void kload2(bf16x8*kf,lds_cptr kp,int j){ kf[2*j]=*(const __attribute__((address_space(3))) bf16x8*)(kp+j*2048); kf[2*j+1]=*(const __attribute__((address_space(3))) bf16x8*)(kp+j*2048+512); }
__device__ __forceinline__ s16x4 vtr(lds_cptr p){ return __builtin_bit_cast(s16x4,__builtin_amdgcn_ds_read_tr16_b64_v4i16((__attribute__((address_space(3))) v4i16_t*)p)); }
__device__ __forceinline__ float rowmax(const f32x16&p0,const f32x16&p1){
  float a=max3f(p0[0],p0[1],p1[0]),b=max3f(p0[2],p0[3],p1[1]);a=max3f(a,p1[2],p1[3]);
  #pragma unroll
  for(int r=4;r<16;r+=4){a=max3f(a,p0[r],p0[r+1]);b=max3f(b,p0[r+2],p0[r+3]);a=max3f(a,p1[r],p1[r+1]);b=max3f(b,p1[r+2],p1[r+3]);}
  const float m=max2f(a,b);
  auto rr=__builtin_amdgcn_permlane32_swap(__float_as_uint(m),__float_as_uint(m),false,false);
  return max2f(__uint_as_float(rr[0]),__uint_as_float(rr[1]));
}
__device__ __forceinline__ void pv(f32x16*o,int vb,bf16x8 pa0,bf16x8 pa1,bf16x8 pa2,bf16x8 pa3){
  #pragma unroll
  for(int d0=0;d0<2;++d0){s16x4 lo[4],hi[4];
    #pragma unroll
    for(int ks=0;ks<4;++ks){
      asm volatile("ds_read_b64_tr_b16 %0,%1 offset:%c2":"=&v"(lo[ks]):"v"(vb),"i"(d0*4096+ks*1024):"memory");
      asm volatile("ds_read_b64_tr_b16 %0,%1 offset:%c2":"=&v"(hi[ks]):"v"(vb),"i"(d0*4096+ks*1024+512):"memory");}
    asm volatile("s_waitcnt lgkmcnt(0)":::"memory");SBAR();
    #define PK(k) (bf16x8){lo[k][0],lo[k][1],lo[k][2],lo[k][3],hi[k][0],hi[k][1],hi[k][2],hi[k][3]}
    o[d0]=__builtin_amdgcn_mfma_f32_32x32x16_bf16(pa0,PK(0),o[d0],0,0,0);
    o[d0]=__builtin_amdgcn_mfma_f32_32x32x16_bf16(pa1,PK(1),o[d0],0,0,0);
    o[d0]=__builtin_amdgcn_mfma_f32_32x32x16_bf16(pa2,PK(2),o[d0],0,0,0);
    o[d0]=__builtin_amdgcn_mfma_f32_32x32x16_bf16(pa3,PK(3),o[d0],0,0,0);
    #undef PK
  }
}

#ifndef ATTN_STORE16
#define ATTN_STORE16(p,v) (*(u32x4*)(p)=(v))
#endif
template<int THRL,int MODE> __device__ __forceinline__ void attn_unit(const bf16*Qw0,const bf16*__restrict__ Kh,const bf16*__restrict__ Vh,bf16*Ow0,const int NT,const int lat_off,const int na_r0,const int na_rsmin,const int rpb_off,char*shm){
  const int tid=ltid(),lane=tid&63,r32=lane&31,hi=lane>>5; const int wid=__builtin_amdgcn_readfirstlane(tid>>6);
  const bf16*Qw=Qw0+(long)(wid*QBLK)*DM;
  const unsigned lds0=(unsigned)(uintptr_t)shm;
  float*wsf=(float*)(shm+LDS_WS)+wid*64;
  const bf16*ksrc=Kh+(long)lane*DM+wid*8;
  const bf16*vsrc=Vh+(long)(16*(wid&3)+(lane>>2))*DM+(wid>>2)*32+(lane&3)*8;
  const unsigned kdst=lds0+LDS_K+wid*1024, vdst=lds0+LDS_V+wid*1024;
  #define TROW(t) (((t)<4)?(t)*64:lat_off+((t)-4)*64)
  #define DMA_K(t,slot) glds16(ksrc+(long)TROW(t)*DM,(unsigned)__builtin_amdgcn_readfirstlane(kdst+(slot)))
  #define DMA_V(t,slot) glds16(vsrc+(long)TROW(t)*DM,(unsigned)__builtin_amdgcn_readfirstlane(vdst+(slot)))
  const int vb0=(int)(lds0+LDS_V)+((lane>>4)&1)*32+(lane&3)*8+(4*hi+((lane&15)>>2))*64;
  const char*Kbase=shm+LDS_K; bf16x8 kf[8];
  const lds_cptr shm3=(lds_cptr)shm; const lds_cptr kp0=shm3+LDS_K+hi*1024+r32*16; const lds_cptr vp0=shm3+LDS_V+((lane>>4)&1)*32+(lane&3)*8+(4*hi+((lane&15)>>2))*64;
  DMA_K(0,0);DMA_V(0,0);DMA_K(1,SLOTB);
  bf16x8 qr[4];
  #pragma unroll
  for(int d0=0;d0<4;++d0)qr[d0]=*reinterpret_cast<const bf16x8*>(&Qw[(long)r32*DM+d0*16+hi*8]);
  float mhat=0.f,l_reg=0.f;f32x16 o[2];o[0]=f32x16{};o[1]=f32x16{};f32x16 negm=f32x16{};asm volatile("":"+v"(negm));
  const lds_fptr rp_=(lds_fptr)(shm3+rpb_off); const int na_qr=na_r0+(wid>>1);
  #define CMASK(P0,P1,t) do{ if(MODE==1 && (t)>=4) nabias(P0,P1,na_rsmin+(t)-4,na_qr,r32,wid,hi,rp_); }while(0)
  bool resc=false;
  #define START(P0,P1) do{ const float rm=rowmax(P0,P1); resc=false; \
    { const float dl=rm; mhat=fadd_s(mhat,dl); \
      _Pragma("unroll") for(int r=0;r<16;++r){P0[r]=fsub_s(P0[r],dl);P1[r]=fsub_s(P1[r],dl);} \
      _Pragma("unroll") for(int r=0;r<16;++r)negm[r]=-mhat; asm volatile("":"+v"(negm)); } \
    _Pragma("unroll") for(int r=0;r<16;++r)P0[r]=__builtin_amdgcn_exp2f(P0[r]); }while(0)
  #define RESC() do{ if(resc){ asm volatile("s_waitcnt lgkmcnt(0)":::"memory"); \
      _Pragma("unroll") for(int d_=0;d_<2;++d_) _Pragma("unroll") for(int r=0;r<16;++r)o[d_][r]*=wsf[crow(r,hi)]; } }while(0)
  f32x16 pA0,pA1,pB0,pB1;
  int sl_prev=0,sl_cur=0,sl_next=SLOTB;
  #define ROT() do{sl_prev=sl_cur;sl_cur=sl_next;sl_next=(sl_next==(NSLOT-1)*SLOTB)?0:sl_next+SLOTB;}while(0)
  DMA_K(2,2*SLOTB);
  WAIT_BAR(3);
  qkt(pA0,pA1,Kbase,qr,negm,r32,hi);asm volatile("s_nop 15\n\ts_nop 7":"+v"(pA0),"+v"(pA1));CMASK(pA0,pA1,0);
  START(pA0,pA1);
  _Pragma("unroll") for(int r=0;r<16;++r)pA1[r]=__builtin_amdgcn_exp2f(pA1[r]);
  WAIT_BAR(0);
  DMA_K(3,0);DMA_V(1,SLOTB);
  ROT();
  kload8(kf,kp0+sl_cur);
  WAIT_BAR(2);
  s16x4 vlo[8],vhi[8]; u32x4 pw0,pw1,pw2,pw3;
  #define PKW(P,B) cvtpk_s(P[B],P[B+1])
  #define PAF(k) __builtin_bit_cast(bf16x8,pw##k)
  #define VFR(i) (bf16x8){vlo[i][0],vlo[i][1],vlo[i][2],vlo[i][3],vhi[i][0],vhi[i][1],vhi[i][2],vhi[i][3]}
  #define PIN(x) asm volatile("":"+v"(x))
  #define MX3(a,b,c) __builtin_fmaxf(__builtin_fmaxf((a),(b)),(c))
  #define GAPA(MF,A0,A1,A2,A3,W0,W1,PW) do{ MF; sacc+=A0; sacc+=A1; sacc+=A2; sacc+=A3; PIN(sacc); W0; W1; PIN(PW); SBAR(); }while(0)
  #define EX(v) __builtin_amdgcn_exp2f(v)
  #define GAPB(MF,X,B) do{ MF; X[B]=EX(X[B]); X[B+1]=EX(X[B+1]); X[B+2]=EX(X[B+2]); X[B+3]=EX(X[B+3]); PIN(X); SBAR(); }while(0)
  #define VRD(i) do{ vlo[i]=vtr(vp_+(((i)>>2)*4096+((i)&3)*1024)); vhi[i]=vtr(vp_+(((i)>>2)*4096+((i)&3)*1024+512)); }while(0)
  #define KRD(G,j) do{ if(G){ kload2(kf,kp0+sl_next,j); SBAR(); } }while(0)
  #define STEP(C0,C1,P0,P1,t,GK,GV,GL) do{ SBAR(); \
    const lds_cptr vp_=vp0+sl_prev; \
    VRD(0); SBAR(); float sacc=(P0[0]+P0[1]); \
    GAPA(C0=__builtin_amdgcn_mfma_f32_32x32x16_bf16(kf[0],qr[0],negm,0,0,0), P0[2],P0[3],P0[4],P0[5],     pw0[0]=PKW(P0,0), pw0[1]=PKW(P0,2), pw0); \
    VRD(4); SBAR(); GAPA(C1=__builtin_amdgcn_mfma_f32_32x32x16_bf16(kf[1],qr[0],negm,0,0,0), P0[6],P0[7],P0[8],P0[9],     pw0[2]=PKW(P0,4), pw0[3]=PKW(P0,6), pw0); \
    VRD(1); SBAR(); GAPA(C0=__builtin_amdgcn_mfma_f32_32x32x16_bf16(kf[2],qr[1],C0,0,0,0),   P0[10],P0[11],P0[12],P0[13], pw1[0]=PKW(P0,8), pw1[1]=PKW(P0,10), pw1); \
    VRD(5); SBAR(); GAPA(C1=__builtin_amdgcn_mfma_f32_32x32x16_bf16(kf[3],qr[1],C1,0,0,0),   P0[14],P0[15],P1[0],P1[1],   pw1[2]=PKW(P0,12),pw1[3]=PKW(P0,14), pw1); \
    VRD(2); SBAR(); GAPA(C0=__builtin_amdgcn_mfma_f32_32x32x16_bf16(kf[4],qr[2],C0,0,0,0),   P1[2],P1[3],P1[4],P1[5],     pw2[0]=PKW(P1,0), pw2[1]=PKW(P1,2), pw2); \
    VRD(6); SBAR(); GAPA(C1=__builtin_amdgcn_mfma_f32_32x32x16_bf16(kf[5],qr[2],C1,0,0,0),   P1[6],P1[7],P1[8],P1[9],     pw2[2]=PKW(P1,4), pw2[3]=PKW(P1,6), pw2); \
    VRD(3); SBAR(); GAPA(C0=__builtin_amdgcn_mfma_f32_32x32x16_bf16(kf[6],qr[3],C0,0,0,0),   P1[10],P1[11],P1[12],P1[13], pw3[0]=PKW(P1,8), pw3[1]=PKW(P1,10), pw3); \
    VRD(7); SBAR(); GAPA(C1=__builtin_amdgcn_mfma_f32_32x32x16_bf16(kf[7],qr[3],C1,0,0,0),   P1[14],P1[15],0.f,0.f,       pw3[2]=PKW(P1,12),pw3[3]=PKW(P1,14), pw3); \
    l_reg+=sacc; \
    if(GK){DMA_K((t)+3,sl_cur);} if(GV){DMA_V((t)+1,sl_next);} \
    CMASK(C0,C1,t); \
    { float a=MX3(C0[0],C0[1],C1[0]),b=MX3(C0[2],C0[3],C1[1]); a=MX3(a,C1[2],C1[3]); \
      _Pragma("unroll") for(int r=4;r<16;r+=4){a=MX3(a,C0[r],C0[r+1]);b=MX3(b,C0[r+2],C0[r+3]);a=MX3(a,C1[r],C1[r+1]);b=MX3(b,C1[r+2],C1[r+3]);} \
      float rm=__builtin_fmaxf(a,b); { auto rr=__builtin_amdgcn_permlane32_swap(__float_as_uint(rm),__float_as_uint(rm),false,false); rm=__builtin_fmaxf(__uint_as_float(rr[0]),__uint_as_float(rr[1])); } \
      resc=false; \
      if(__builtin_expect(__any(rm>(float)THRL),0)){ const float dl=__builtin_fmaxf(rm,0.f); mhat+=dl; \
        _Pragma("unroll") for(int r=0;r<16;++r){C0[r]-=dl;C1[r]-=dl;} \
        _Pragma("unroll") for(int r=0;r<16;++r)negm[r]=-mhat; asm volatile("":"+v"(negm)); \
        const float f=__builtin_amdgcn_exp2f(-dl); l_reg*=f; if(hi==0)wsf[r32]=f; resc=true; } } \
    SBAR(); \
    GAPB(o[0]=__builtin_amdgcn_mfma_f32_32x32x16_bf16(PAF(0),VFR(0),o[0],0,0,0), C0,0); \
    GAPB(o[1]=__builtin_amdgcn_mfma_f32_32x32x16_bf16(PAF(0),VFR(4),o[1],0,0,0), C0,4); \
    KRD(GL,0); GAPB(o[0]=__builtin_amdgcn_mfma_f32_32x32x16_bf16(PAF(1),VFR(1),o[0],0,0,0), C0,8); \
    KRD(GL,1); GAPB(o[1]=__builtin_amdgcn_mfma_f32_32x32x16_bf16(PAF(1),VFR(5),o[1],0,0,0), C0,12); \
    KRD(GL,2); GAPB(o[0]=__builtin_amdgcn_mfma_f32_32x32x16_bf16(PAF(2),VFR(2),o[0],0,0,0), C1,0); \
    KRD(GL,3); GAPB(o[1]=__builtin_amdgcn_mfma_f32_32x32x16_bf16(PAF(2),VFR(6),o[1],0,0,0), C1,4); \
    GAPB(o[0]=__builtin_amdgcn_mfma_f32_32x32x16_bf16(PAF(3),VFR(3),o[0],0,0,0), C1,8); \
    GAPB(o[1]=__builtin_amdgcn_mfma_f32_32x32x16_bf16(PAF(3),VFR(7),o[1],0,0,0), C1,12); \
    }while(0)
  int t=1;
  #undef CMASK
  #define CMASK(P0,P1,t) do{ if(MODE==1 && (t)>=4) nabias(P0,P1,na_rsmin+(t)-4,na_qr,r32,wid,hi,rp_); }while(0)
  for(;t+5<NT;t+=2){
    STEP(pB0,pB1,pA0,pA1,t,true,true,true);     WAIT_BAR(2); RESC(); ROT();
    STEP(pA0,pA1,pB0,pB1,t+1,true,true,true);   WAIT_BAR(2); RESC(); ROT();
  }
  #undef CMASK
  #define CMASK(P0,P1,t) do{ if(MODE==1 && (t)>=4) nabias(P0,P1,na_rsmin+(t)-4,na_qr,r32,wid,hi,rp_); }while(0)
  #define ENDW(tt) do{ if((tt)+3<NT){WAIT_BAR(2);} else if((tt)+2<NT){WAIT_BAR(1);} else {WAIT_BAR(0);} }while(0)
  for(;t+1<NT;t+=2){
    STEP(pB0,pB1,pA0,pA1,t,(t+3<NT),(t+1<NT),(t+1<NT));       ENDW(t);   RESC(); ROT();
    STEP(pA0,pA1,pB0,pB1,t+1,(t+4<NT),(t+2<NT),(t+2<NT));     ENDW(t+1); RESC(); ROT();
  }
  STEP(pB0,pB1,pA0,pA1,NT-1,false,false,false); RESC();
  { float sacc=pB0[0]+pB0[1]; _Pragma("unroll") for(int r=2;r<16;++r)sacc+=pB0[r]; _Pragma("unroll") for(int r=0;r<16;++r)sacc+=pB1[r]; l_reg+=sacc;
    pw0=(u32x4){PKW(pB0,0),PKW(pB0,2),PKW(pB0,4),PKW(pB0,6)};pw1=(u32x4){PKW(pB0,8),PKW(pB0,10),PKW(pB0,12),PKW(pB0,14)};pw2=(u32x4){PKW(pB1,0),PKW(pB1,2),PKW(pB1,4),PKW(pB1,6)};pw3=(u32x4){PKW(pB1,8),PKW(pB1,10),PKW(pB1,12),PKW(pB1,14)};
    SBAR(); pv(o,vb0+sl_cur,PAF(0),PAF(1),PAF(2),PAF(3)); }
  #undef PKW
  #undef PAF
  #undef VFR
  #undef PIN
  #undef MX3
  #undef GAPA
  #undef GAPB
  #undef EX
  #undef VRD
  #undef KRD
  #undef STEP
  #undef ENDW
  {auto rr=__builtin_amdgcn_permlane32_swap(__float_as_uint(l_reg),__float_as_uint(l_reg),false,false);l_reg=__uint_as_float(rr[0])+__uint_as_float(rr[1]);}
  if(hi==0)wsf[32+r32]=l_reg;asm volatile("s_waitcnt lgkmcnt(0)":::"memory");
  float rli[16];
  #pragma unroll
  for(int r=0;r<16;++r)rli[r]=__builtin_amdgcn_rcpf(wsf[32+crow(r,hi)]);
  bf16*Ow=Ow0+(long)(wid*QBLK)*ODM;
  { bf16*stg=(bf16*)(shm+LDS_OST)+wid*2048;
    #pragma unroll
    for(int r=0;r<16;++r){const int orow=crow(r,hi);
      #pragma unroll
      for(int d0=0;d0<2;++d0)stg[orow*64+d0*32+r32]=__float2bfloat16(o[d0][r]*rli[r]);}
    asm volatile("s_waitcnt lgkmcnt(0)":::"memory");
    #pragma unroll
    for(int i=0;i<4;++i){const int row=i*8+(lane>>3),ch=lane&7; const u32x4 v=*(const u32x4*)(stg+row*64+ch*8); ATTN_STORE16(Ow+(long)row*ODM+ch*8,v);} }
  asm volatile("s_waitcnt lgkmcnt(0)\n\ts_barrier":::"memory");
  #undef DMA_K
  #undef TROW
  #undef DMA_V
  #undef CMASK
  #undef START
  #undef RESC
  #undef ROT
}
constexpr int ATTN_LDS_BYTES=LDS_BYTES;
}
#ifndef DBG_MASK
#define DBG_MASK 127
#endif
#ifndef DBG_DIAG
#define DBG_DIAG 0
#endif
#ifndef DBG_NA
#define DBG_NA 1
#endif
#ifndef DBG_CTX
#define DBG_CTX 1
#endif
#ifndef DBG_POOL
#define DBG_POOL 1
#endif
namespace cg = cooperative_groups;
#define GAS __attribute__((address_space(1)))
#define LAS __attribute__((address_space(3)))
typedef unsigned short bf16;
typedef unsigned v4u __attribute__((ext_vector_type(4)));
typedef float f32x4 __attribute__((ext_vector_type(4)));
#define LDS_WAIT() asm volatile("s_waitcnt lgkmcnt(0)" ::: "memory")
__device__ __forceinline__ unsigned f2bf(float f) { unsigned u = __builtin_bit_cast(unsigned, f); return (u + 0x7fffu + ((u >> 16) & 1u)) >> 16; }
__device__ __forceinline__ unsigned pk2(float lo, float hi) { return f2bf(lo) | (f2bf(hi) << 16); }
__device__ __forceinline__ float bf2f(unsigned short h) { return __builtin_bit_cast(float, (unsigned)h << 16); }
__device__ __forceinline__ float wave_sum(float v) {
#pragma unroll
    for (int o = 1; o < 64; o <<= 1) v += __shfl_xor(v, o);
    return v;
}
#define RLX_AGENT __ATOMIC_RELAXED, __HIP_MEMORY_SCOPE_AGENT
#define XB_TMO      128
#define XB_XCNT(j)  (256  + 64 * (j))
#define XB_XSUB(j)  (1280 + 64 * (j))
#define XB_XGEN(j)  (2304 + 64 * (j))
#define XB_TOP      3328
#define XB_TOPGEN   3392
#define XCD_BAR_WORDS 3456
#define XB_SPIN_CAP (1u << 18)

__device__ __forceinline__ unsigned xb_ld(unsigned* p)              { return __hip_atomic_load(p, __ATOMIC_RELAXED, __HIP_MEMORY_SCOPE_AGENT); }
__device__ __forceinline__ unsigned xb_add(unsigned* p, unsigned v) { return __hip_atomic_fetch_add(p, v, __ATOMIC_RELAXED, __HIP_MEMORY_SCOPE_AGENT); }
__device__ __forceinline__ unsigned xb_xcc_id() { return (unsigned)__builtin_amdgcn_s_getreg((3 << 11) | 20) & 0xFu; }
#define XB_SPIN(cond, bar) do { unsigned _sp = 0; while (cond) { __builtin_amdgcn_s_sleep(1); \
    if ((++_sp & 255u) == 0u) { if (xb_ld(&(bar)[XB_TMO])) break; if (_sp > XB_SPIN_CAP) { atomicAdd(&(bar)[XB_TMO], 1u); break; } } } } while (0)

struct XcdBarrier {
    unsigned* bar; unsigned x;
    volatile LAS unsigned* st;
};

__device__ __forceinline__ XcdBarrier xcd_barrier_post(unsigned* bar, volatile LAS unsigned* st) {
    XcdBarrier b; b.bar = bar; b.x = xb_xcc_id(); b.st = st;
    if (threadIdx.x == 0) (void)xb_add(&bar[XB_XCNT(b.x)], 1u);
    return b;
}
__device__ __forceinline__ void xcd_barrier_complete(unsigned* bar, unsigned x, unsigned& nloc, unsigned& nx) {
    const unsigned G = gridDim.x * gridDim.y * gridDim.z;
    unsigned sum, cnt, mine, sp = 0u;
    for (;;) {
        sum = 0u; cnt = 0u; mine = 0u;
#pragma unroll
        for (unsigned j = 0; j < 16; ++j) { const unsigned c = xb_ld(&bar[XB_XCNT(j)]); sum += c; cnt += (c > 0u) ? 1u : 0u; mine = (j == x) ? c : mine; }
        if (sum == G) break;
        __builtin_amdgcn_s_sleep(1);
        if ((++sp & 255u) == 0u) { if (xb_ld(&bar[XB_TMO])) break; if (sp > XB_SPIN_CAP) { atomicAdd(&bar[XB_TMO], 1u); break; } }
    }
    nloc = mine > 0u ? mine : 1u; nx = cnt > 0u ? cnt : 1u;
}

__device__ __forceinline__ void xcd_barrier(const XcdBarrier& b) {
    asm volatile("s_waitcnt vmcnt(0)" ::: "memory");
    __syncthreads();
    if (threadIdx.x == 0) {
        unsigned* bar = b.bar;
        __builtin_amdgcn_s_waitcnt(0);
        unsigned nloc = b.st[0], nx = b.st[1];
        if (nloc == 0u) { xcd_barrier_complete(bar, b.x, nloc, nx); b.st[0] = nloc; b.st[1] = nx; }
        const unsigned old = xb_add(&bar[XB_XSUB(b.x)], 1u);
        const unsigned gen = old / nloc;
        if (old + 1u == (gen + 1u) * nloc) {
            __builtin_amdgcn_fence(__ATOMIC_RELEASE, "agent");
            asm volatile("s_waitcnt vmcnt(0)" ::: "memory");
            const unsigned og = xb_add(&bar[XB_TOP], 1u);
            const unsigned tg = og / nx;
            if (og + 1u == (tg + 1u) * nx) xb_add(&bar[XB_TOPGEN], 1u);
            else XB_SPIN(xb_ld(&bar[XB_TOPGEN]) == tg, bar);
            __builtin_amdgcn_fence(__ATOMIC_ACQUIRE, "agent");
            xb_add(&bar[XB_XGEN(b.x)], 1u);
            asm volatile("s_waitcnt vmcnt(0)" ::: "memory");
        } else {
            XB_SPIN(xb_ld(&bar[XB_XGEN(b.x)]) == gen, bar);
            __builtin_amdgcn_fence(__ATOMIC_ACQUIRE, "agent");
            asm volatile("s_waitcnt vmcnt(0)" ::: "memory");
        }
    }
    __syncthreads();
}
constexpr size_t MiB = 1u << 20;
constexpr size_t WS_MOD = 0, WS_ROPEC = 1 * MiB, WS_ROPES = 1 * MiB + 8192, WS_BAR = 1 * MiB + 131072;
constexpr size_t WS_WIN = 2 * MiB, WS_WOUT = 18 * MiB, WS_WUP = 26 * MiB, WS_WDN = 70 * MiB;
constexpr size_t WS_ST = 92 * MiB, WS_X = 94 * MiB, WS_H = 359 * MiB, WS_Z = 492 * MiB, WS_Y = 756 * MiB, WS_ACT = WS_Z, WS_END = 888 * MiB;
static_assert(WS_WIN + (size_t)P_DEPTH * P_INW * P_D * 2 <= WS_WOUT && WS_WOUT + (size_t)P_DEPTH * P_D * P_D * 2 <= WS_WUP && WS_WUP + (size_t)P_DEPTH * P_UPW * P_D * 2 <= WS_WDN && WS_WDN + (size_t)P_DEPTH * P_D * P_DFF * 2 <= WS_ST && WS_ST + (size_t)P_M * 8 <= WS_X, "weights map");
static_assert(WS_X + (size_t)P_M * P_D * 4 <= WS_H - MiB / 2 && WS_H + (size_t)P_M * P_D * 2 + MiB / 2 <= WS_Z && WS_Z + (size_t)P_M * P_INW * 2 <= WS_Y && WS_Y + (size_t)P_M * P_D * 2 <= WS_END && WS_ACT + (size_t)P_M * P_DFF * 2 <= WS_END, "activation map");
constexpr int LDS_BYTES = 147456, RPB_OFF = 98304, BARST_OFF = 131072 + 64;
#ifndef DBG_REP
#define DBG_REP -1
#endif
constexpr int PH_PER_L = 9;
#ifndef N1_OUT
#define N1_OUT 47000
#endif
#ifndef N1_DOWN
#define N1_DOWN 0
#endif
#ifndef DBG_P0REP
#define DBG_P0REP 0
#endif
constexpr int N_PHASES = 2 + PH_PER_L * P_DEPTH + 2 * DBG_P0REP;

struct Args {
    const float *x, *c, *ctx, *c_ctx, *w_mod, *b_mod, *w_in, *pool_w, *pool_scale, *na_rpb, *q_norm, *k_norm, *w_out, *ln1_g, *ln1_b, *w_up, *conv_w, *conv_b, *w_down, *ln2_g, *ln2_b;
    float* out; unsigned char* ws; int ph_lo, ph_hi;
};
static_assert(sizeof(Args) == 23 * 8 + 8, "Args has no padding");

template <int OFF> __device__ __forceinline__ unsigned long long ldarg() {
    unsigned long long v; asm volatile("s_load_dwordx2 %0, %1, %2\n\ts_waitcnt lgkmcnt(0)" : "=s"(v) : "s"(__builtin_amdgcn_kernarg_segment_ptr()), "n"(OFF)); return v; }
#define ARGF(A, f) (A).f = (decltype(Args::f))(__attribute__((address_space(1))) void*)ldarg<offsetof(Args, f)>()
__device__ __forceinline__ void p0_item(const float* W, int K, int N, bf16* WT, int k0, int n0, int drow, LAS float* scr, int lane) {
    float wv[32];
#pragma unroll
    for (int i = 0; i < 32; ++i) wv[i] = W[(size_t)(k0 + 2 * i + (lane >> 5)) * N + n0 + (lane & 31)];
#pragma unroll
    for (int i = 0; i < 32; ++i) scr[(2 * i + (lane >> 5)) * 33 + (lane & 31)] = wv[i];
    LDS_WAIT(); asm volatile("" ::: "memory");
    const int c = lane & 7;
#pragma unroll
    for (int j = 0; j < 4; ++j) { const int n = (lane >> 3) + 8 * j; const LAS float* s = scr + (8 * c) * 33 + n;
        v4u o; o.x = pk2(s[0 * 33], s[1 * 33]); o.y = pk2(s[2 * 33], s[3 * 33]); o.z = pk2(s[4 * 33], s[5 * 33]); o.w = pk2(s[6 * 33], s[7 * 33]);
        *(GAS v4u*)(WT + (size_t)(drow + n) * K + k0 + 8 * c) = o; }
    LDS_WAIT(); asm volatile("" ::: "memory");
}

__device__ __forceinline__ void phase_weights(const Args& a, LAS unsigned char* lds, int vcu, int G, int tid, int lane, int wave) {
    unsigned char* ws = a.ws;
    {
        LAS float* scr = (LAS float*)(lds + wave * 16384);
        const int gw = vcu * 8 + wave, NGW = G * 8;
        constexpr int I_IN = 16 * 64, I_OUT = 16 * 32, I_UP = 16 * 176, I_DN = 44 * 32, I_L = I_IN + I_OUT + I_UP + I_DN;
        for (int it = gw; it < P_DEPTH * I_L; it += NGW) {
            const int l = it / I_L; int r = it - l * I_L;
            if (r < I_IN) { const int kb = r >> 6, nb = r & 63, L0 = 32 * nb; const int drow = (L0 & ~255) + ((L0 >> 5) & 1) * 128 + ((L0 >> 6) & 3) * 32;
                p0_item(a.w_in + (size_t)l * P_D * P_INW, P_D, P_INW, (bf16*)(ws + WS_WIN) + (size_t)l * P_INW * P_D, 64 * kb, 32 * nb, drow, scr, lane); continue; }
            r -= I_IN;
            if (r < I_OUT) { const int kb = r >> 5, nb = r & 31;
                p0_item(a.w_out + (size_t)l * P_D * P_D, P_D, P_D, (bf16*)(ws + WS_WOUT) + (size_t)l * P_D * P_D, 64 * kb, 32 * nb, 32 * nb, scr, lane); continue; }
            r -= I_OUT;
            if (r < I_UP) { const int kb = r / 176, nb = r - kb * 176, L0 = 32 * nb; const int half = L0 >= P_DFF ? 1 : 0, ch0 = L0 - half * P_DFF; const int drow = (ch0 >> 7) * 256 + half * 128 + (ch0 & 127);
                p0_item(a.w_up + (size_t)l * P_D * P_UPW, P_D, P_UPW, (bf16*)(ws + WS_WUP) + (size_t)l * P_UPW * P_D, 64 * kb, 32 * nb, drow, scr, lane); continue; }
            r -= I_UP;
            { const int kb = r >> 5, nb = r & 31;
                p0_item(a.w_down + (size_t)l * P_DFF * P_D, P_DFF, P_D, (bf16*)(ws + WS_WDN) + (size_t)l * P_D * P_DFF, 64 * kb, 32 * nb, 32 * nb, scr, lane); }
        }
    }
}
__device__ __forceinline__ void phase0(const Args& a, LAS unsigned char* lds, int vcu, int G, int tid, int lane, int wave) {
    unsigned char* ws = a.ws;
    if (vcu < 192) {
        LAS float* act = (LAS float*)lds; LAS float* red = (LAS float*)(lds + 40960);
        for (int e = tid; e < 9 * P_D; e += 512) { const int r = e >> 10, k = e & 1023; const float v = r < 8 ? a.c[r * P_D + k] : a.c_ctx[k]; act[e] = v / (1.0f + expf(-v)); }
        __syncthreads();
        for (int u = vcu; u < 192; u += G) {
            const int l = u / 48, n0 = (u - l * 48) * 128, cg4 = tid & 31, ks = tid >> 5;
            const float* wp = a.w_mod + (size_t)l * P_D * P_MODW + (size_t)(ks * 64) * P_MODW + n0 + 4 * cg4;
            f32x4 s[9];
#pragma unroll
            for (int r = 0; r < 9; ++r) s[r] = (f32x4){0.f, 0.f, 0.f, 0.f};
#pragma unroll 8
            for (int k = 0; k < 64; ++k) { const f32x4 w = *(const f32x4*)(wp + (size_t)k * P_MODW);
#pragma unroll
                for (int r = 0; r < 9; ++r) s[r] += w * act[r * P_D + ks * 64 + k]; }
#pragma unroll
            for (int r = 0; r < 9; ++r) *(LAS f32x4*)(red + (ks * 9 + r) * 128 + 4 * cg4) = s[r];
            __syncthreads();
            for (int e = tid; e < 9 * 128; e += 512) { const int r = e >> 7, cc = e & 127; float t = 0.f;
#pragma unroll
                for (int k2 = 0; k2 < 16; ++k2) t += red[(k2 * 9 + r) * 128 + cc];
                ((float*)(ws + WS_MOD))[(size_t)(l * 9 + r) * P_MODW + n0 + cc] = t + a.b_mod[l * P_MODW + n0 + cc]; }
            __syncthreads();
        }
    }
    if (vcu == G - 1) {
        for (int e = tid; e < 2048; e += 512) { const int pos = e >> 4, f = e & 15;
            const float inv = exp2f(-(float)f * (13.287712379549449f / 16.0f));
            const float ang = (float)pos * inv;
            ((float*)(ws + WS_ROPEC))[e] = cosf(ang); ((float*)(ws + WS_ROPES))[e] = sinf(ang); }
    }
}

template <int KIND> __device__ __forceinline__ void row_phase(const Args& a, int l, int mode, int n1, int bx, int vcu, int G, int wave, int lane) {
    unsigned char* ws = a.ws; const float* X = (const float*)(ws + WS_X); bf16* H = (bf16*)(ws + WS_H); const float* mod = (const float*)(ws + WS_MOD); float* ST = (float*)(ws + WS_ST);
    const bool lastl = (KIND == 2 && l == P_DEPTH - 1);
    const int ml = (KIND == 2) ? l + 1 : l; const int csh = (KIND == 1) ? 3 : 0, csc = (KIND == 1) ? 4 : 1;
    const float* lg = (KIND == 1 ? a.ln1_g : a.ln2_g) + l * P_D; const float* lb = (KIND == 1 ? a.ln1_b : a.ln2_b) + l * P_D;
#define ROW_OF(i) (mode == 1 ? (i) + (((i) >> 13) + 1) * P_CTX : (mode == 2 ? ((i) >> 8) * P_RPB + ((i) & 255) : (i)))
#define ROW_SRC(m_, b_, rb_) ((KIND == 0) ? ((rb_) < P_CTX ? a.ctx + ((size_t)(b_) * P_CTX + (rb_)) * P_D : a.x + ((size_t)(b_) * P_SEQ + ((rb_) - P_CTX)) * P_D) : X + (size_t)(m_) * P_D)
    for (int seg = 0; seg < 2; ++seg) {
        int start, stride, end;
        if (seg == 0) { start = vcu * 8 + wave; stride = G * 8; end = (mode == 0) ? P_M : (mode == 2 ? P_B * P_CTX : n1); }
        else { if (mode != 1 || bx < 32) break; start = n1 + (bx - 32) * 8 + wave; stride = (G - 32) * 8; end = P_B * P_SEQ; }
        f32x4 vn[4];
        if (start < end) { const int m0 = ROW_OF(start); const int b0 = m0 / P_RPB, rb0 = m0 - b0 * P_RPB; const f32x4* xr = (const f32x4*)ROW_SRC(m0, b0, rb0) + lane;
#pragma unroll
            for (int j = 0; j < 4; ++j) vn[j] = xr[64 * j]; }
        for (int i = start; i < end; i += stride) {
            const int m = ROW_OF(i);
            const int b = m / P_RPB, rb = m - b * P_RPB; const bool is_ctx = rb < P_CTX; const int mrow = is_ctx ? 8 : b;
            f32x4 v[4];
#pragma unroll
            for (int j = 0; j < 4; ++j) v[j] = vn[j];
            if (i + stride < end) { const int m1 = ROW_OF(i + stride); const int b1 = m1 / P_RPB, rb1 = m1 - b1 * P_RPB; const f32x4* xr = (const f32x4*)ROW_SRC(m1, b1, rb1) + lane;
#pragma unroll
                for (int j = 0; j < 4; ++j) vn[j] = xr[64 * j]; }
            if (KIND != 0) {
                float s = 0.f;
#pragma unroll
                for (int j = 0; j < 4; ++j) s += (v[j].x + v[j].y) + (v[j].z + v[j].w);
                const float mean = wave_sum(s) * (1.f / P_D); float s2 = 0.f;
#pragma unroll
                for (int j = 0; j < 4; ++j) { v[j] = v[j] - mean; s2 += (v[j].x * v[j].x + v[j].y * v[j].y) + (v[j].z * v[j].z + v[j].w * v[j].w); }
                const float rstd = 1.f / sqrtf(wave_sum(s2) * (1.f / P_D) + P_EPS);
                if (!lastl && lane == 0) { ST[(size_t)m * 2] = mean; ST[(size_t)m * 2 + 1] = rstd; }
#pragma unroll
                for (int j = 0; j < 4; ++j) { const f32x4 g = ((const f32x4*)lg)[lane + 64 * j], bb = ((const f32x4*)lb)[lane + 64 * j]; v[j] = v[j] * rstd * g + bb; }
            }
            if (lastl) {
                if (!is_ctx) { f32x4* o = (f32x4*)(a.out + ((size_t)b * P_SEQ + (rb - P_CTX)) * P_D) + lane;
#pragma unroll
                    for (int j = 0; j < 4; ++j) o[64 * j] = v[j]; }
            } else {
                const float* mp = mod + (size_t)(ml * 9 + mrow) * P_MODW;
                unsigned long long* o8 = (unsigned long long*)(H + (size_t)m * P_D) + lane;
#pragma unroll
                for (int j = 0; j < 4; ++j) { const f32x4 sh = ((const f32x4*)(mp + csh * P_D))[lane + 64 * j], sc = ((const f32x4*)(mp + csc * P_D))[lane + 64 * j];
                    const f32x4 h = v[j] * (1.0f + sc) + sh;
                    o8[64 * j] = (unsigned long long)pk2(h.x, h.y) | ((unsigned long long)pk2(h.z, h.w) << 32); }
            }
        }
    }
#undef ROW_OF
#undef ROW_SRC
}

__device__ __forceinline__ void pool_unit(const Args& a, int l, int u, LAS unsigned char* lds, int tid) {
    const bf16* Z = (const bf16*)(a.ws + WS_Z); bf16* Y = (bf16*)(a.ws + WS_Y);
    const int tk = u >> 2, g = u & 3; const int row0 = tk * 128; const int b = row0 / P_RPB, rb0 = row0 - b * P_RPB;
    const int slo = (rb0 < P_CTX) ? b * P_RPB : b * P_RPB + P_CTX, shi = (rb0 < P_CTX) ? b * P_RPB + P_CTX : (b + 1) * P_RPB;
    LAS float* zt = (LAS float*)lds;
    LAS float* pl = (LAS float*)(lds + 36864);
    LAS float* wl = (LAS float*)(lds + 36864 + 34816);
    for (int e = tid; e < 144 * 8; e += 512) { const int rr = e >> 3, c8 = e & 7; const int R = row0 - 8 + rr;
        v4u w = (v4u){0u, 0u, 0u, 0u};
        if (R >= slo && R < shi) w = *(const v4u*)(Z + (size_t)R * P_INW + g * 64 + c8 * 8);
        LAS float* d = zt + rr * 64 + c8 * 8;
        d[0] = bf2f(w.x & 0xffff); d[1] = bf2f(w.x >> 16); d[2] = bf2f(w.y & 0xffff); d[3] = bf2f(w.y >> 16); d[4] = bf2f(w.z & 0xffff); d[5] = bf2f(w.z >> 16); d[6] = bf2f(w.w & 0xffff); d[7] = bf2f(w.w >> 16); }
    { const f32x4* wsrc = (const f32x4*)(a.pool_w + ((size_t)l * 4 + g) * 4096);
      for (int e = tid; e < 1024; e += 512) ((LAS f32x4*)wl)[e] = wsrc[e]; }
    __syncthreads();
    const int hw = 1 << g;
    for (int e = tid; e < 128 * 64; e += 512) { const int t = e >> 6, c = e & 63; const int T = row0 + t;
        const int lo = max(T - hw, slo), hi = min(T + hw - 1, shi - 1);
        float s = 0.f;
        for (int p = lo; p <= hi; ++p) s += zt[(p - row0 + 8) * 64 + c];
        pl[t * 68 + c] = s / (float)(hi - lo + 1) - zt[(t + 8) * 64 + c]; }
    __syncthreads();
    { const int d = tid & 63, tq = tid >> 6;
      float acc[16];
#pragma unroll
      for (int t = 0; t < 16; ++t) acc[t] = 0.f;
      for (int c4 = 0; c4 < 16; ++c4) {
          const float w0 = wl[(4 * c4 + 0) * 64 + d], w1 = wl[(4 * c4 + 1) * 64 + d], w2 = wl[(4 * c4 + 2) * 64 + d], w3 = wl[(4 * c4 + 3) * 64 + d];
#pragma unroll
          for (int t = 0; t < 16; ++t) { const f32x4 p = *(const LAS f32x4*)(pl + (tq * 16 + t) * 68 + 4 * c4); acc[t] += (p.x * w0 + p.y * w1) + (p.z * w2 + p.w * w3); }
      }
      const float sc = a.pool_scale[l * 256 + g * 64 + d];
#pragma unroll
      for (int t = 0; t < 16; ++t) Y[(size_t)(row0 + tq * 16 + t) * P_D + g * 64 + d] = (bf16)f2bf(acc[t] * sc);
    }
    __syncthreads();
}

__device__ __forceinline__ void mix_phase(const Args& a, int l, unsigned char* ldsg, LAS unsigned char* lds, int vcu, int G, int tid) {
    using abf = attn_body::bf16;
    const abf* Z = (const abf*)(a.ws + WS_Z); abf* Y = (abf*)(a.ws + WS_Y);
    { LAS float* rp = (LAS float*)(lds + RPB_OFF); const float* src = a.na_rpb + (size_t)l * 6 * 465;
      for (int e = tid; e < 6 * 465; e += 512) rp[e] = src[e] * P_LOG2E; }
    __syncthreads();
    for (int u = vcu; u < 1536; u += G) { const int h = u >> 8, b = (u >> 5) & 7, qb = u & 31, kv = h / 3;
        const size_t brow = (size_t)b * P_RPB, qrow = brow + P_CTX + (size_t)qb * 256;
        attn_body::attn_unit<8, 0>(Z + qrow * P_INW + 1408 + 64 * h, Z + brow * P_INW + 1792 + 64 * kv, Z + brow * P_INW + 1920 + 64 * kv, Y + qrow * P_D + 640 + 64 * h, 132, 256, 0, 0, RPB_OFF, (char*)ldsg); }
    if (DBG_NA) for (int u = vcu; u < 1536; u += G) { const int h = u >> 8, b = (u >> 5) & 7, qb = u & 31;
        const size_t brow = (size_t)b * P_RPB, qrow = brow + P_CTX + (size_t)qb * 256;
        const int rsmin = min(max(4 * qb - 4, 0), 116);
        attn_body::attn_unit<8, 1>(Z + qrow * P_INW + 256 + 64 * h, Z + brow * P_INW + 640 + 64 * h, Z + brow * P_INW + 1024 + 64 * h, Y + qrow * P_D + 256 + 64 * h, 16, 256 + 64 * rsmin, 4 * qb, rsmin, RPB_OFF + h * 465 * 4, (char*)ldsg); }
    if (DBG_CTX && l < P_DEPTH - 1)
        for (int u = vcu - 64; u < 96; u += G) { if (u < 0) continue; const int b = u / 12, hh = u - b * 12; const size_t brow = (size_t)b * P_RPB;
            int qc, kc, vc, oc;
            if (hh < 6) { qc = 256 + 64 * hh; kc = 640 + 64 * hh; vc = 1024 + 64 * hh; oc = 256 + 64 * hh; }
            else { const int h = hh - 6; qc = 1408 + 64 * h; kc = 1792 + 64 * (h / 3); vc = 1920 + 64 * (h / 3); oc = 640 + 64 * h; }
            attn_body::attn_unit<8, 0>(Z + brow * P_INW + qc, Z + brow * P_INW + kc, Z + brow * P_INW + vc, Y + brow * P_D + oc, 4, 256, 0, 0, RPB_OFF, (char*)ldsg); }
    if (DBG_POOL) for (int u = vcu; u < (P_M / 128) * 4; u += G) pool_unit(a, l, u, lds, tid);
}


#if DBG_DIAG
constexpr size_t WS_FLAG = 1 * MiB + 65536;
__device__ __forceinline__ bool vclose(float mine, float ref, float tol) {
    const float d = wave_sum((mine - ref) * (mine - ref)), n = wave_sum(ref * ref); return d <= tol * tol * n + 1e-12f; }
__device__ __forceinline__ float na_ref(const Args& a, const bf16* Z, int b, int h, int pos, int lane) {
    const size_t Rl = (size_t)b * P_RPB + P_CTX + pos; const int gr = pos >> 6, gc = pos & 63; const int rs = min(max(gr - 4, 0), 120), cs = min(max(gc - 8, 0), 48);
    float mx = -1e30f, sc[6];
    for (int i = 0; i < 6; ++i) { const int key = lane + 64 * i; size_t kr_; float bias = 0.f;
        if (key < 128) { const int kr = rs + key / 16, kc = cs + key % 16; kr_ = (size_t)b * P_RPB + P_CTX + kr * 64 + kc; bias = a.na_rpb[(size_t)h * 465 + (kr - gr + 7) * 31 + (kc - gc + 15)] * P_LOG2E; }
        else kr_ = (size_t)b * P_RPB + (key - 128);
        float s = 0.f; for (int d = 0; d < 64; ++d) s += bf2f(Z[Rl * P_INW + 256 + 64 * h + d]) * bf2f(Z[kr_ * P_INW + 640 + 64 * h + d]);
        sc[i] = s + bias; mx = fmaxf(mx, sc[i]); }
    for (int o = 1; o < 64; o <<= 1) mx = fmaxf(mx, __shfl_xor(mx, o));
    float den = 0.f; for (int i = 0; i < 6; ++i) { sc[i] = exp2f(sc[i] - mx); den += sc[i]; } den = wave_sum(den);
    float o_ = 0.f;
    for (int i = 0; i < 6; ++i) for (int l2 = 0; l2 < 64; ++l2) { const int key = l2 + 64 * i; size_t kr_;
        if (key < 128) { const int kr = rs + key / 16, kc = cs + key % 16; kr_ = (size_t)b * P_RPB + P_CTX + kr * 64 + kc; } else kr_ = (size_t)b * P_RPB + (key - 128);
        o_ += __shfl(sc[i], l2) * bf2f(Z[kr_ * P_INW + 1024 + 64 * h + lane]); }
    return o_ / den;
}
__device__ __forceinline__ float att_ref(const bf16* Z, size_t qrow, size_t krow0, int ntile, int qc, int kc, int vc, int lane) {
    float mx = -1e30f;
    for (int i = 0; i < ntile; ++i) { const size_t kr_ = krow0 + lane + 64 * i; float s = 0.f;
        for (int d = 0; d < 64; ++d) s += bf2f(Z[qrow * P_INW + qc + d]) * bf2f(Z[kr_ * P_INW + kc + d]); mx = fmaxf(mx, s); }
    for (int o = 1; o < 64; o <<= 1) mx = fmaxf(mx, __shfl_xor(mx, o));
    float den = 0.f, o_ = 0.f;
    for (int i = 0; i < ntile; ++i) { const size_t kr_ = krow0 + lane + 64 * i; float s = 0.f;
        for (int d = 0; d < 64; ++d) s += bf2f(Z[qrow * P_INW + qc + d]) * bf2f(Z[kr_ * P_INW + kc + d]);
        const float p = exp2f(s - mx); den += p;
        for (int l2 = 0; l2 < 64; ++l2) o_ += __shfl(p, l2) * bf2f(Z[(krow0 + l2 + 64 * i) * P_INW + vc + lane]); }
    return o_ / wave_sum(den);
}
__device__ __forceinline__ float pool_ref(const Args& a, const bf16* Z, size_t R, size_t slo, size_t shi, int g, int lane) {
    const int hw = 1 << g; const size_t lo = (R >= slo + hw) ? R - hw : slo, hi = (R + hw - 1 < shi) ? R + hw - 1 : shi - 1;
    float s = 0.f; for (size_t p = lo; p <= hi; ++p) s += bf2f(Z[p * P_INW + g * 64 + lane]);
    const float pooled = s / (float)(hi - lo + 1) - bf2f(Z[R * P_INW + g * 64 + lane]); float y = 0.f;
    for (int c = 0; c < 64; ++c) y += __shfl(pooled, c) * a.pool_w[(size_t)g * 4096 + c * 64 + lane];
    return y * a.pool_scale[g * 64 + lane];
}
__device__ __forceinline__ void diag_phase(const Args& a, int code, int vcu, int tid, int G) {
    unsigned char* ws = a.ws; unsigned* flag = (unsigned*)(ws + WS_FLAG);
    const bf16* Z = (const bf16*)(ws + WS_Z); const bf16* Y = (const bf16*)(ws + WS_Y);
    const int lane = tid & 63;
    if (code == 199) {
        const unsigned fl = *flag; int first = 0; for (int i = 0; i < 16; ++i) if ((fl >> i) & 1) { first = i + 1; break; }
        for (size_t i = (size_t)vcu * 512 + tid; i < (size_t)P_B * P_SEQ * P_D; i += (size_t)G * 512) a.out[i] = (float)first;
        return;
    }
    if (vcu != 0 || tid >= 64) return;
    if (code == 100) { if (lane == 0) *flag = 0u; return; }
    if (code == 102) {
        const float TOL = 0.006f;
        const int nb[5] = {0, 7, 3, 5, 2}, nh[5] = {0, 5, 2, 3, 1}, npos[5] = {0, 127 * 64 + 63, 60 * 64 + 3, 2 * 64 + 30, 64 * 64 + 31};
        for (int q = 0; q < 5; ++q) { const float r = na_ref(a, Z, nb[q], nh[q], npos[q], lane); const float m = bf2f(Y[((size_t)nb[q] * P_RPB + P_CTX + npos[q]) * P_D + 256 + 64 * nh[q] + lane]);
            if (!vclose(m, r, TOL) && lane == 0) atomicOr(flag, 1u << q); }
        const int gb[2] = {1, 7}, gh[2] = {0, 5}, gpos[2] = {100, 8191};
        for (int q = 0; q < 2; ++q) { const size_t brow = (size_t)gb[q] * P_RPB; const float r = att_ref(Z, brow + P_CTX + gpos[q], brow, 132, 1408 + 64 * gh[q], 1792 + 64 * (gh[q] / 3), 1920 + 64 * (gh[q] / 3), lane);
            const float m = bf2f(Y[(brow + P_CTX + gpos[q]) * P_D + 640 + 64 * gh[q] + lane]); if (!vclose(m, r, TOL) && lane == 0) atomicOr(flag, 1u << (5 + q)); }
        { const size_t brow = (size_t)1 * P_RPB; const float r = att_ref(Z, brow + 200, brow, 4, 256 + 64 * 3, 640 + 64 * 3, 1024 + 64 * 3, lane); const float m = bf2f(Y[(brow + 200) * P_D + 256 + 64 * 3 + lane]);
          if (!vclose(m, r, TOL) && lane == 0) atomicOr(flag, 1u << 7); }
        { const size_t brow = (size_t)6 * P_RPB; const float r = att_ref(Z, brow + 17, brow, 4, 1408 + 64 * 4, 1792 + 64 * 1, 1920 + 64 * 1, lane); const float m = bf2f(Y[(brow + 17) * P_D + 640 + 64 * 4 + lane]);
          if (!vclose(m, r, TOL) && lane == 0) atomicOr(flag, 1u << 8); }
        { const size_t brow = (size_t)4 * P_RPB; const size_t R = brow + P_CTX; const float r = pool_ref(a, Z, R, brow + P_CTX, brow + P_RPB, 0, lane); if (!vclose(bf2f(Y[R * P_D + lane]), r, TOL) && lane == 0) atomicOr(flag, 1u << 9); }
        { const size_t brow = (size_t)7 * P_RPB; const size_t R = brow + P_RPB - 1; const float r = pool_ref(a, Z, R, brow + P_CTX, brow + P_RPB, 3, lane); if (!vclose(bf2f(Y[R * P_D + 192 + lane]), r, TOL) && lane == 0) atomicOr(flag, 1u << 10); }
        { const size_t brow = (size_t)3 * P_RPB; const size_t R = brow + 255; const float r = pool_ref(a, Z, R, brow, brow + P_CTX, 2, lane); if (!vclose(bf2f(Y[R * P_D + 128 + lane]), r, TOL) && lane == 0) atomicOr(flag, 1u << 11); }
    }
}
#endif

__global__ void __launch_bounds__(512, 2) mega(Args a) {
    extern __shared__ __attribute__((aligned(16))) unsigned char ldsraw[];
    LAS unsigned char* lds = (LAS unsigned char*)ldsraw;
    cg::grid_group grid = cg::this_grid();
    const int G = gridDim.x; const int bx = blockIdx.x; const int vcu = (G % 8 == 0) ? (bx % 8) * (G / 8) + bx / 8 : bx;
    const int ph_lo = a.ph_lo, ph_hi = a.ph_hi;
    volatile LAS unsigned* barst = (volatile LAS unsigned*)(lds + BARST_OFF);
    if (threadIdx.x < 2) barst[threadIdx.x] = 0u;
    if (ph_lo == 0 && blockIdx.x == 0) { unsigned* bw = (unsigned*)(a.ws + WS_BAR); for (int i = threadIdx.x; i < XCD_BAR_WORDS; i += 512) bw[i] = 0u; }
    __syncthreads();
    XcdBarrier xbar; xbar.bar = (unsigned*)(a.ws + WS_BAR); xbar.x = 0; xbar.st = barst;
    for (int ph_ = ph_lo; ph_ < ph_hi; ++ph_) {
        const int ph = (ph_ < 2 * DBG_P0REP) ? (ph_ & 1) : ph_ - 2 * DBG_P0REP;
        if (ph >= 2 && ph < 100 && (ph - 2) / PH_PER_L == P_DEPTH - 1 && ((ph - 2) % PH_PER_L == 4 || (ph - 2) % PH_PER_L == 8)) continue;
        if (ph_ > ph_lo) {
            if (ph_ == ph_lo + 1) { grid.sync(); xbar = xcd_barrier_post((unsigned*)(a.ws + WS_BAR), barst); }
            else xcd_barrier(xbar);
        }
        const int tid = ltid(), lane = tid & 63, wave = __builtin_amdgcn_readfirstlane(tid >> 6);
        Args q;
        ARGF(q, ws); unsigned char* ws = q.ws;
#if DBG_DIAG
        if (ph >= 100) { q = a; diag_phase(q, ph, vcu, tid, G); continue; }
#endif
        if (ph == 0) { ARGF(q, c); ARGF(q, c_ctx); ARGF(q, w_mod); ARGF(q, b_mod); phase0(q, lds, vcu, G, tid, lane, wave); continue; }
        if (ph == 1) { ARGF(q, x); ARGF(q, ctx); ARGF(q, w_in); ARGF(q, w_out); ARGF(q, w_up); ARGF(q, w_down); row_phase<0>(q, 0, 0, 0, bx, vcu, G, wave, lane); phase_weights(q, lds, vcu, G, tid, lane, wave); continue; }
        const int l = (ph - 2) / PH_PER_L, sp = (ph - 2) % PH_PER_L; const bool lastL = (l == P_DEPTH - 1);
        if (sp == 0) {
            ARGF(q, q_norm); ARGF(q, k_norm);
            pg8::Gemm g{(const pg8::bf16_t*)(ws + WS_H), (const pg8::bf16_t*)(ws + WS_WIN) + (size_t)l * P_INW * P_D, P_M, P_INW, P_D};
            pg8::StaticOrder S; S.init(P_M / 256, P_INW / 256, G, bx);
            pg8::EpiIn E{(pg8::bf16_t*)(ws + WS_Z), q.q_norm + l * 64, q.k_norm + l * 64, (const float*)(ws + WS_ROPEC), (const float*)(ws + WS_ROPES)};
            pg8::gemm_phase<pg8::EpiIn, pg8::StaticOrder, true, true, 0>(lds, g, S, E);
        } else if (sp == 1) {
            ARGF(q, na_rpb); ARGF(q, pool_w); ARGF(q, pool_scale);
            mix_phase(q, l, ldsraw, lds, vcu, G, tid);
        } else if (sp == 5) {
            ARGF(q, conv_w); ARGF(q, conv_b);
            pg8::Gemm g{(const pg8::bf16_t*)(ws + WS_H) - P_D, (const pg8::bf16_t*)(ws + WS_WUP) + (size_t)l * P_UPW * P_D, P_M, P_UPW, P_D};
            pg8::StaticOrder S; S.init((P_M + 247) / 248, P_UPW / 256, G, bx);
            pg8::EpiUp E{(pg8::bf16_t*)(ws + WS_ACT), q.conv_w + (size_t)l * 3 * P_UPW, q.conv_b + (size_t)l * P_UPW};
            pg8::gemm_phase<pg8::EpiUp, pg8::StaticOrder, true, true, 1>(lds, g, S, E);
        } else {
            const bool isdown = sp >= 6, ctxpart = (sp == 3 || sp == 7);
            ARGF(q, ln1_g); ARGF(q, ln1_b); ARGF(q, ln2_g); ARGF(q, ln2_b);
            if (sp == 2 || sp == 6 || (ctxpart && !lastL)) {
                ARGF(q, x); ARGF(q, ctx);
                const bool first = (!isdown && l == 0);
                pg8::Gemm g{(const pg8::bf16_t*)(ws + (isdown ? WS_ACT : WS_Y)), isdown ? (const pg8::bf16_t*)(ws + WS_WDN) + (size_t)l * P_D * P_DFF : (const pg8::bf16_t*)(ws + WS_WOUT) + (size_t)l * P_D * P_D, P_M, P_D, isdown ? P_DFF : P_D};
                pg8::StaticOrder S; S.init(P_B * P_SEQ / 256, P_D / 256, G, bx); S.skipctx = 1; S.ctxonly = ctxpart ? 1 : 0;
                pg8::EpiRes E{(float*)(ws + WS_X), (const float*)(ws + WS_MOD) + (size_t)l * 9 * P_MODW + (isdown ? 5 : 2) * P_D, (const float*)(ws + WS_ST),
                              first ? nullptr : (isdown ? q.ln1_g + l * P_D : q.ln2_g + (l - 1) * P_D), first ? nullptr : (isdown ? q.ln1_b + l * P_D : q.ln2_b + (l - 1) * P_D), q.x, q.ctx};
                pg8::gemm_phase<pg8::EpiRes, pg8::StaticOrder, true, true, 0>(lds, g, S, E);
            }
            if (sp == 3 || (sp == 4 && !lastL)) row_phase<1>(q, l, sp == 3 ? 1 : 2, lastL ? P_B * P_SEQ : N1_OUT, bx, vcu, G, wave, lane);
            if (sp == 7 || (sp == 8 && !lastL)) { ARGF(q, out); row_phase<2>(q, l, sp == 7 ? 1 : 2, lastL ? P_B * P_SEQ : N1_DOWN, bx, vcu, G, wave, lane); }
        }
    }
}

#ifndef MK_MULTI
#define MK_MULTI 0
#endif
extern "C" void kernel_launch(void* const* d_in, const int* in_sizes, int n_in, void* d_out, int out_size, void* d_ws, size_t ws_size, hipStream_t stream) {
    static int grid = 0;
    if (grid == 0) {
        if (n_in != 21 || ws_size < WS_END) { fprintf(stderr, "kernel_launch: unexpected n_in %d / ws_size %zu\n", n_in, ws_size); grid = -1; return; }
        int dev = 0, cus = 0, per_cu = 0;
        if (hipGetDevice(&dev) != hipSuccess || hipDeviceGetAttribute(&cus, hipDeviceAttributeMultiprocessorCount, dev) != hipSuccess) { grid = -1; return; }
        if (hipFuncSetAttribute((const void*)mega, hipFuncAttributeMaxDynamicSharedMemorySize, LDS_BYTES) != hipSuccess) { fprintf(stderr, "kernel_launch: hipFuncSetAttribute failed\n"); grid = -1; return; }
        if (hipOccupancyMaxActiveBlocksPerMultiprocessor(&per_cu, (const void*)mega, 512, LDS_BYTES) != hipSuccess || per_cu < 1) { fprintf(stderr, "kernel_launch: occupancy query says %d\n", per_cu); per_cu = 1; }
        (void)hipGetLastError();
        grid = cus * 1;
        fprintf(stderr, "kernel_launch: cus %d per_cu %d grid %d\n", cus, per_cu, grid);
    }
    if (grid < 0) return;
    Args a{};
    const float** f = (const float**)&a;
    for (int i = 0; i < 21; ++i) f[i] = (const float*)d_in[i];
    a.out = (float*)d_out; a.ws = (unsigned char*)d_ws;
#if MK_MULTI
#if DBG_DIAG
    { const int seq[] = {0, 1, 100, 2, 3, 102, 199};
      for (int i = 0; i < 7; ++i) { a.ph_lo = seq[i]; a.ph_hi = seq[i] + 1; hipLaunchKernelGGL(mega, dim3(grid), dim3(512), LDS_BYTES, stream, a); } }
#else
    for (int ph = 0; ph < N_PHASES; ++ph) { a.ph_lo = ph; a.ph_hi = ph + 1; hipLaunchKernelGGL(mega, dim3(grid), dim3(512), LDS_BYTES, stream, a); }
#endif
#else
    a.ph_lo = 0; a.ph_hi = N_PHASES;
    void* args[] = {&a};
    hipError_t e = hipLaunchCooperativeKernel((const void*)mega, dim3(grid), dim3(512), args, LDS_BYTES, stream);
    if (e != hipSuccess) fprintf(stderr, "cooperative launch failed: %s (grid %d)\n", hipGetErrorString(e), grid);
#endif
}
```

```cpp
#include <hip/hip_runtime.h>
#include <hip/hip_cooperative_groups.h>
#include <cstdio>
#include <cstdint>
constexpr int P_D = 1024, P_B = 8, P_SEQ = 8192, P_CTX = 256, P_RPB = P_SEQ + P_CTX  , P_M = P_B * P_RPB  ;
constexpr int P_DEPTH = 4, P_INW = 2048, P_DFF = 2816, P_UPW = 2 * P_DFF, P_MODW = 6 * P_D;
constexpr float P_C2 = 0.125f * 1.4426950408889634f;
constexpr float P_LOG2E = 1.4426950408889634f;
constexpr float P_ALPHA = 1.681792830507429f;
constexpr float P_EPS = 1e-6f;
__device__ __forceinline__ int ltid() { int t = threadIdx.x; asm volatile("" : "+v"(t)); return t; }
namespace pg8 {
#define PG8_LAS __attribute__((address_space(3)))
typedef unsigned short bf16_t;
typedef short bf16x8 __attribute__((ext_vector_type(8)));
typedef float f32x4 __attribute__((ext_vector_type(4)));
typedef unsigned u32x4 __attribute__((ext_vector_type(4)));
constexpr int BM = 256, BK = 64, HALF = 128, HTB = HALF * BK * 2  , STAGE_BYTES = 8 * HTB, NXCD = 8, WGM = 8;

__host__ __device__ __forceinline__ int lds_byte(int r, int c) { const int st = (r >> 4) * 2 + (c >> 5), rr = r & 15, cc = c & 31, ob = rr * 64 + cc * 2; return st * 1024 + (ob ^ (((ob >> 9) & 1) << 5)); }
__host__ __device__ __forceinline__ void stage_rc(int b, int& R, int& C) { const int st = b / 1024, sb = b % 1024, swz = sb ^ (((sb >> 9) & 1) << 5); R = (st >> 1) * 16 + swz / 64; C = (st & 1) * 32 + (swz % 64) / 2; }
__host__ __device__ __forceinline__ int perm32(int rho) { const int n = rho >> 4, i = rho & 15; return 8 * (i >> 2) + 4 * n + (i & 3); }

struct Unit { int pm, pn; };
struct Gemm { const bf16_t* A; const bf16_t* Bt; int M, N, K; };

struct StaticOrder {
    int nM, nN, nwg, G, c, skipctx = 0, ctxonly = 0;
    __host__ __device__ void init(int nM_, int nN_, int G_, int c_) { nM = nM_; nN = nN_; nwg = nM * nN; G = G_; c = c_; }
    __host__ __device__ bool next(int i, Unit& u) const {
        if (ctxonly) { if (i > 0 || c >= 32) return false; u.pm = (c >> 2) * 33; u.pn = c & 3; return true; }
        const long L = (long)i * G + c; if (L >= nwg) return false;
        int wgid = (int)L; { const int q = nwg / NXCD, r = nwg % NXCD, xcd = wgid % NXCD, off = wgid / NXCD; wgid = (xcd < r ? xcd * (q + 1) : r * (q + 1) + (xcd - r) * q) + off; }
        const int nig = WGM * nN, gid = wgid / nig, fm = gid * WGM, gsz = (nM - fm) < WGM ? (nM - fm) : WGM;
        u.pm = fm + ((wgid % nig) % gsz); u.pn = (wgid % nig) / gsz; if (skipctx) u.pm += (u.pm >> 5) + 1; return true;
    }
    __device__ __forceinline__ void a_ready(const Unit&) const {}
    __device__ __forceinline__ void done(const Unit&) const {}
};

__device__ __forceinline__ unsigned cvt_pk_bf16(float lo, float hi) { unsigned r; asm volatile("v_cvt_pk_bf16_f32 %0, %1, %2" : "=v"(r) : "v"(lo), "v"(hi)); return r; }
#ifndef EPI_SHFL
#define EPI_SHFL 0
#endif
typedef float f32x2 __attribute__((ext_vector_type(2)));
__device__ __forceinline__ f32x4 dppror(const f32x4 v, const bool up) {
    f32x4 r;
#if EPI_SHFL
    const int lane = threadIdx.x & 63; const int src = (lane & ~15) | ((lane + (up ? 15 : 1)) & 15);
#pragma unroll
    for (int j = 0; j < 4; ++j) r[j] = __shfl(v[j], src);
#else
#pragma unroll
    for (int j = 0; j < 4; ++j) { const float xs = v[j]; const int iv = __float_as_int(xs);
        r[j] = __int_as_float(up ? __builtin_amdgcn_mov_dpp(iv, 0x121, 0xf, 0xf, true) : __builtin_amdgcn_mov_dpp(iv, 0x12F, 0xf, 0xf, true)); }
#endif
    return r;
}
struct EpiIn {
    static constexpr bool PERM = false, AFTER_DRAIN = false;
    bf16_t* Z; const float* rc; const float* rs; PG8_LAS float* tab;
    __device__ __forceinline__ void operator()(const f32x4 (&acc)[2][2][4][2], const Unit& u, int wr, int wc, int fr, int fq) const {
        asm volatile("" : "+v"(fr), "+v"(fq));
        const int hs = u.pn * 4 + wc;
        const bool isq = (hs >= 22 && hs < 28), isk = (hs == 28 || hs == 29);
        const float sc = ((hs >= 4 && hs < 10) || isq) ? P_C2 : 1.f;
        const int tb = u.pm % 33; const bool is_ctx = (tb == 0);
        if (u.pn >= 5 && !is_ctx) {
            const int tid = ltid();
            if (tid < 64) { tab[2176 + tid] = rc[(tb - 1) * 64 + tid]; tab[2240 + tid] = rs[(tb - 1) * 64 + tid]; }
            asm volatile("s_waitcnt lgkmcnt(0)" ::: "memory"); __builtin_amdgcn_s_barrier(); asm volatile("" ::: "memory"); }
#pragma unroll
        for (int ai = 0; ai < 2; ++ai)
#pragma unroll
            for (int m = 0; m < 4; ++m) {
                const int rt = ai * HALF + wr * 64 + m * 16 + fr;
                const size_t row = (size_t)u.pm * BM + rt;
                f32x4 v[2][2];
#pragma unroll
                for (int bj = 0; bj < 2; ++bj)
#pragma unroll
                    for (int n = 0; n < 2; ++n) v[bj][n] = acc[ai][bj][m][n];
                if (isq || isk) {
                    float ss = 0.f;
#pragma unroll
                    for (int bj = 0; bj < 2; ++bj)
#pragma unroll
                        for (int n = 0; n < 2; ++n) { const f32x4 x = v[bj][n]; ss += (x[0] * x[0] + x[1] * x[1]) + (x[2] * x[2] + x[3] * x[3]); }
                    ss += __shfl_xor(ss, 16); ss += __shfl_xor(ss, 32);
                    const float rstd = __builtin_amdgcn_rsqf(ss * (1.0f / 64.0f) + P_EPS);
                    const PG8_LAS float* gp = tab + (isq ? 2048 : 2112) + 4 * fq;
                    const int pos = (tb - 1) * BM + rt; const int gr = pos >> 6, gc = pos & 63;
#pragma unroll
                    for (int bj = 0; bj < 2; ++bj) {
                        const f32x4 g0 = *(const PG8_LAS f32x4*)(gp + 32 * bj), g1 = *(const PG8_LAS f32x4*)(gp + 32 * bj + 16);
                        f32x4 x1 = v[bj][0] * rstd * g0, x2 = v[bj][1] * rstd * g1;
                        if (!is_ctx) { const PG8_LAS float* tp = bj ? tab + gc * 16 + 4 * fq : tab + 2176 + (rt >> 6) * 16 + 4 * fq;
                            const f32x4 cs = *(const PG8_LAS f32x4*)tp, sn = *(const PG8_LAS f32x4*)(tp + (bj ? 1024 : 64));
                            const f32x4 y1 = x1 * cs - x2 * sn, y2 = x1 * sn + x2 * cs; x1 = y1; x2 = y2; }
                        v[bj][0] = x1; v[bj][1] = x2;
                    }
                }
                bf16_t* zp = Z + row * P_INW + hs * 64 + 4 * fq;
#pragma unroll
                for (int bj = 0; bj < 2; ++bj)
#pragma unroll
                    for (int n = 0; n < 2; ++n) { const f32x4 x = v[bj][n] * sc; unsigned long long w = (unsigned long long)cvt_pk_bf16(x[0], x[1]) | ((unsigned long long)cvt_pk_bf16(x[2], x[3]) << 32);
                        *(unsigned long long*)(zp + 32 * bj + 16 * n) = w; }
                asm volatile("" ::: "memory");
            }
    }
};
struct EpiRes {
    static constexpr bool PERM = false, AFTER_DRAIN = false;
    float* X; const float* gate;
    const float* st; const float* lg; const float* lb; const float* xin; const float* cin; PG8_LAS float* par;
    __device__ __forceinline__ void operator()(const f32x4 (&acc)[2][2][4][2], const Unit& u, int wr, int wc, int fr, int fq) const {
        asm volatile("" : "+v"(fr), "+v"(fq));
        const int tid = ltid(); const int wv = __builtin_amdgcn_readfirstlane(tid >> 6);
        const int b = u.pm / 33, tb = u.pm % 33; const int mrow = tb == 0 ? 8 : b;
        const int col0 = u.pn * BM + wc * 32 + 4 * fq;
        const bool ident = (lg == nullptr);
        const float* rbase = ident ? (tb == 0 ? cin + (size_t)b * P_CTX * P_D : xin + ((size_t)b * P_SEQ + (size_t)(tb - 1) * BM) * P_D) : X + (size_t)u.pm * BM * P_D;
        if (wv < 3) { const int c4 = (tid & 63) * 4; const int gc = u.pn * BM + c4; f32x4 pv;
            if (wv == 0) pv = ident ? (f32x4){P_ALPHA, P_ALPHA, P_ALPHA, P_ALPHA} : *(const f32x4*)(lg + gc) * P_ALPHA;
            else if (wv == 1) pv = ident ? (f32x4){0.f, 0.f, 0.f, 0.f} : *(const f32x4*)(lb + gc) * P_ALPHA;
            else pv = *(const f32x4*)(gate + mrow * P_MODW + gc);
            *(PG8_LAS f32x4*)(par + wv * 256 + c4) = pv; }
        f32x4 tq[3][4]; f32x2 sq[3];
#define ERES_LOAD(it_) do { const int rt_ = ((it_) >> 2) * HALF + wr * 64 + ((it_) & 3) * 16 + fr; const float* xr_ = rbase + (size_t)rt_ * P_D + col0; \
            _Pragma("unroll") for (int bj = 0; bj < 2; ++bj) _Pragma("unroll") for (int n = 0; n < 2; ++n) tq[(it_) % 3][bj * 2 + n] = *(const f32x4*)(xr_ + bj * HALF + n * 16); \
            sq[(it_) % 3] = ident ? (f32x2){0.f, 1.f} : *(const f32x2*)(st + ((size_t)u.pm * BM + rt_) * 2); } while (0)
        ERES_LOAD(0); ERES_LOAD(1);
        asm volatile("s_waitcnt lgkmcnt(0)" ::: "memory"); __builtin_amdgcn_s_barrier(); asm volatile("" ::: "memory");
        const int cl = wc * 32 + 4 * fq;
#pragma unroll
        for (int it = 0; it < 8; ++it) { const int ai = it >> 2, m = it & 3; const int rt = ai * HALF + wr * 64 + m * 16 + fr;
            if (it + 2 < 8) ERES_LOAD(it + 2);
            float* xw = X + ((size_t)u.pm * BM + rt) * P_D + col0;
            const float mean = sq[it % 3][0], rstd = sq[it % 3][1];
#pragma unroll
            for (int bj = 0; bj < 2; ++bj)
#pragma unroll
                for (int n = 0; n < 2; ++n) { const int co = cl + bj * HALF + n * 16;
                    const f32x4 A4 = *(const PG8_LAS f32x4*)(par + co), B4 = *(const PG8_LAS f32x4*)(par + 256 + co), G4 = *(const PG8_LAS f32x4*)(par + 512 + co);
                    f32x4 xo = tq[it % 3][bj * 2 + n];
                    xo = ((xo - mean) * rstd) * A4 + B4 + G4 * acc[ai][bj][m][n]; *(f32x4*)(xw + bj * HALF + n * 16) = xo; }
            asm volatile("" ::: "memory"); }
#undef ERES_LOAD
    }
};
struct EpiUp {
    static constexpr bool PERM = true, AFTER_DRAIN = false;
    bf16_t* ACT; const float* cw; const float* cb; PG8_LAS float* tab;
    __device__ __forceinline__ void operator()(const f32x4 (&acc)[2][2][4][2], const Unit& u, int wr, int wc, int fr, int fq) const {
        asm volatile("" : "+v"(fr), "+v"(fq));
        { const int tid = ltid();
          if (tid < 256) { const int arr = tid >> 5, c4 = (tid & 31) * 4, k3 = arr & 3; const float* src = (k3 < 3 ? cw + k3 * P_UPW : cb) + (arr >> 2) * P_DFF + u.pn * 128 + c4;
              *(PG8_LAS f32x4*)(tab + arr * 128 + c4) = *(const f32x4*)src; }
          asm volatile("s_waitcnt lgkmcnt(0)" ::: "memory"); __builtin_amdgcn_s_barrier(); asm volatile("" ::: "memory"); }
#pragma unroll
        for (int n = 0; n < 2; ++n) {
            const int ch = u.pn * 128 + wc * 32 + 8 * fq + 4 * n; const PG8_LAS float* tp = tab + wc * 32 + 8 * fq + 4 * n;
            const f32x4 wa0 = *(const PG8_LAS f32x4*)(tp), wa1 = *(const PG8_LAS f32x4*)(tp + 128), wa2 = *(const PG8_LAS f32x4*)(tp + 256), ba = *(const PG8_LAS f32x4*)(tp + 384);
            const f32x4 wg0 = *(const PG8_LAS f32x4*)(tp + 512), wg1 = *(const PG8_LAS f32x4*)(tp + 640), wg2 = *(const PG8_LAS f32x4*)(tp + 768), bg = *(const PG8_LAS f32x4*)(tp + 896);
#pragma unroll
            for (int ai = 0; ai < 2; ++ai) {
                const int Rb = u.pm * 248 - 1 + (2 * ai + wr) * 62;
                f32x4 ra_prev = (f32x4){0.f, 0.f, 0.f, 0.f}, rg_prev = ra_prev;
                f32x4 la_cur = dppror(acc[ai][0][0][n], false), lg_cur = dppror(acc[ai][1][0][n], false);
#pragma unroll
                for (int m = 0; m < 4; ++m) {
                    const f32x4 va = acc[ai][0][m][n], vg = acc[ai][1][m][n];
                    const f32x4 ra_cur = dppror(va, true), rg_cur = dppror(vg, true);
                    f32x4 la_next = la_cur, lg_next = lg_cur;
                    if (m < 3) { la_next = dppror(acc[ai][0][m < 3 ? m + 1 : 3][n], false); lg_next = dppror(acc[ai][1][m < 3 ? m + 1 : 3][n], false); }
                    const int i = 16 * m + fr; const int R = Rb + i;
                    const int rbm = R - (R / P_RPB) * P_RPB;
                    const bool first = (rbm == 0) || (rbm == P_CTX), last = (rbm == P_CTX - 1) || (rbm == P_RPB - 1);
                    f32x4 upa = (fr == 0) ? ra_prev : ra_cur, upg = (fr == 0) ? rg_prev : rg_cur;
                    f32x4 dna = (fr == 15) ? la_next : la_cur, dng = (fr == 15) ? lg_next : lg_cur;
                    const f32x4 z4 = (f32x4){0.f, 0.f, 0.f, 0.f};
                    if (first) { upa = z4; upg = z4; }
                    if (last) { dna = z4; dng = z4; }
                    const f32x4 av = wa0 * upa + wa1 * va + wa2 * dna + ba;
                    const f32x4 gv = wg0 * upg + wg1 * vg + wg2 * dng + bg;
                    f32x4 o;
#pragma unroll
                    for (int j = 0; j < 4; ++j) o[j] = av[j] * gv[j] * __builtin_amdgcn_rcpf(1.0f + __expf(-gv[j]));
                    unsigned long long w = (unsigned long long)cvt_pk_bf16(o[0], o[1]) | ((unsigned long long)cvt_pk_bf16(o[2], o[3]) << 32);
                    asm volatile("" : "+v"(w));
                    if (i >= 1 && i <= 62 && R < P_M) *(unsigned long long*)(ACT + (size_t)R * P_DFF + ch) = w;
                    ra_prev = ra_cur; rg_prev = rg_cur; la_cur = la_next; lg_cur = lg_next;
                }
            }
        }
    }
};

template <class Epi, class Sched, bool ALIGN_EPI = false, bool SP2 = false, int AMODE = 0>
__device__ __forceinline__ void gemm_phase(PG8_LAS unsigned char* lds, const Gemm g, const Sched& S, const Epi& E) {
    const int tid = ltid(), wid = __builtin_amdgcn_readfirstlane(tid >> 6), lane = tid & 63, wr = wid >> 2, wc = wid & 3, fr = lane & 15, fq = lane >> 4;
    const int K = g.K, nt = K / BK;
    unsigned voffA[2], voffB[2];
#pragma unroll
    for (int i = 0; i < 2; ++i) { int R, C; stage_rc(tid * 16 + i * 8192, R, C); const int Rb = Epi::PERM ? ((R & ~31) + perm32(R & 31)) : R;
        voffA[i] = (unsigned)((AMODE ? ((R >> 6) * 62 + (R & 63)) : R) * K + C) * 2u; voffB[i] = (unsigned)(Rb * K + C) * 2u; }
    const size_t kstep = (size_t)(BK * 2);
    const size_t hstepB = (size_t)HALF * K * 2; const size_t hstepA = (size_t)(AMODE ? 124 : HALF) * K * 2;
    const size_t tstepB = 2 * hstepB; const size_t tstepA = 2 * hstepA;
    const unsigned ldsw = (unsigned)wid * 1024u;
    const int aoff = lds_byte(wr * 64 + fr, fq * 8), boff = lds_byte(wc * 32 + fr, fq * 8);
#define PG8_SA(b, h) (((b) * 2 + (h)) * HTB)
#define PG8_SB(b, h) ((4 + (b) * 2 + (h)) * HTB)
#define PG8_STAGE(bufoff, gbase, voff) do { _Pragma("unroll") for (int _i = 0; _i < 2; ++_i) \
        __builtin_amdgcn_global_load_lds((const unsigned*)((const char*)(gbase) + (voff)[_i]), (PG8_LAS unsigned*)(lds + (bufoff) + ldsw + _i * 8192), 16, 0, 0); } while (0)
#define PG8_LDA(dst, b, h) do { _Pragma("unroll") for (int m = 0; m < 4; ++m) _Pragma("unroll") for (int k = 0; k < 2; ++k) dst[m][k] = *(const PG8_LAS bf16x8*)(lds + PG8_SA(b, h) + aoff + m * 2048 + k * 1024); } while (0)
#define PG8_LDB(dst, b, h) do { _Pragma("unroll") for (int n = 0; n < 2; ++n) _Pragma("unroll") for (int k = 0; k < 2; ++k) dst[n][k] = *(const PG8_LAS bf16x8*)(lds + PG8_SB(b, h) + boff + n * 2048 + k * 1024); } while (0)
#define PG8_MMA(ai, bj, At, Bt) do { __builtin_amdgcn_s_setprio(1); _Pragma("unroll") for (int m = 0; m < 4; ++m) _Pragma("unroll") for (int n = 0; n < 2; ++n) _Pragma("unroll") for (int k = 0; k < 2; ++k) \
        acc[ai][bj][m][n] = __builtin_amdgcn_mfma_f32_16x16x32_bf16(Bt[n][k], At[m][k], acc[ai][bj][m][n], 0, 0, 0); __builtin_amdgcn_s_setprio(0); } while (0)
#define PG8_WAIT_V(n) asm volatile("s_waitcnt vmcnt(" #n ")" ::: "memory")
#define PG8_WAIT_L(n) asm volatile("s_waitcnt lgkmcnt(" #n ")" ::: "memory")
#define PG8_BAR __builtin_amdgcn_s_barrier()
#define PG8_SCHED __builtin_amdgcn_sched_barrier(0)
    Unit cur, nxt; int ui = 0;
    if (!S.next(0, cur)) return;
    f32x4 acc[2][2][4][2];
#pragma unroll
    for (int a = 0; a < 2; ++a)
#pragma unroll
        for (int b = 0; b < 2; ++b)
#pragma unroll
            for (int m = 0; m < 4; ++m)
#pragma unroll
                for (int n = 0; n < 2; ++n) acc[a][b][m][n] = (f32x4){0.f, 0.f, 0.f, 0.f};
    bf16x8 At[4][2], B0[2][2], B1[2][2];
    const char* cA = (const char*)g.A + (size_t)cur.pm * tstepA; const char* cB = (const char*)g.Bt + (size_t)cur.pn * tstepB;
    S.a_ready(cur);
    if constexpr (SP2) {
        PG8_STAGE(PG8_SB(0, 0), cB, voffB); PG8_STAGE(PG8_SB(0, 1), cB + hstepB, voffB); PG8_STAGE(PG8_SA(0, 0), cA, voffA); PG8_STAGE(PG8_SA(0, 1), cA + hstepA, voffA);
        if (wr == 1) PG8_BAR;
        PG8_WAIT_V(2); PG8_BAR;
        PG8_STAGE(PG8_SB(1, 0), cB + kstep, voffB); PG8_STAGE(PG8_SA(1, 0), cA + kstep, voffA); PG8_STAGE(PG8_SB(1, 1), cB + hstepB + kstep, voffB);
        PG8_WAIT_V(6); PG8_BAR;
    } else {
        PG8_STAGE(PG8_SB(0, 0), cB, voffB); PG8_STAGE(PG8_SA(0, 0), cA, voffA); PG8_STAGE(PG8_SB(0, 1), cB + hstepB, voffB); PG8_STAGE(PG8_SA(0, 1), cA + hstepA, voffA);
        if (wr == 1) PG8_BAR;
        PG8_WAIT_V(4); PG8_BAR;
        PG8_STAGE(PG8_SB(1, 0), cB + kstep, voffB); PG8_STAGE(PG8_SA(1, 0), cA + kstep, voffA); PG8_STAGE(PG8_SB(1, 1), cB + hstepB + kstep, voffB);
        PG8_WAIT_V(6); PG8_BAR;
    }
    for (;;) {
        const bool has_next = S.next(ui + 1, nxt);
        const char* nA = has_next ? (const char*)g.A + (size_t)nxt.pm * tstepA : cA; const char* nB = has_next ? (const char*)g.Bt + (size_t)nxt.pn * tstepB : cB;
        for (int t = 0; t < nt; t += 2) {
            const bool last = (t == nt - 2);
            const char* a1 = cA + (size_t)(t + 1) * kstep;
            const char* a2 = last ? nA : cA + (size_t)(t + 2) * kstep; const char* b2 = last ? nB : cB + (size_t)(t + 2) * kstep;
            const char* a3 = a2 + kstep; const char* b3 = b2 + kstep;
            if (last && has_next) S.a_ready(nxt);
            if constexpr (SP2) {
            PG8_LDB(B0, 0, 0); PG8_LDB(B1, 0, 1); PG8_SCHED; PG8_LDA(At, 0, 0); PG8_STAGE(PG8_SA(1, 1), a1 + hstepA, voffA);
            PG8_WAIT_V(8); PG8_WAIT_L(0); PG8_BAR; PG8_MMA(0, 0, At, B0); PG8_MMA(0, 1, At, B1); PG8_BAR; PG8_SCHED;
            PG8_LDA(At, 0, 1); PG8_STAGE(PG8_SB(0, 0), b2, voffB); PG8_STAGE(PG8_SB(0, 1), b2 + hstepB, voffB); PG8_STAGE(PG8_SA(0, 0), a2, voffA);
            PG8_WAIT_V(8); PG8_WAIT_L(0); PG8_BAR; PG8_MMA(1, 0, At, B0); PG8_MMA(1, 1, At, B1); PG8_BAR; PG8_SCHED;
            PG8_LDB(B0, 1, 0); PG8_LDB(B1, 1, 1); PG8_SCHED; PG8_LDA(At, 1, 0); PG8_STAGE(PG8_SA(0, 1), a2 + hstepA, voffA);
            PG8_WAIT_V(8); PG8_WAIT_L(0); PG8_BAR; PG8_MMA(0, 0, At, B0); PG8_MMA(0, 1, At, B1); PG8_BAR; PG8_SCHED;
            PG8_LDA(At, 1, 1); PG8_STAGE(PG8_SB(1, 0), b3, voffB); PG8_STAGE(PG8_SB(1, 1), b3 + hstepB, voffB); PG8_STAGE(PG8_SA(1, 0), a3, voffA);
            PG8_WAIT_V(8); PG8_WAIT_L(0); PG8_BAR; PG8_MMA(1, 0, At, B0); PG8_MMA(1, 1, At, B1); PG8_BAR; PG8_SCHED;
            } else {
            PG8_LDB(B0, 0, 0); PG8_SCHED; PG8_LDA(At, 0, 0); PG8_STAGE(PG8_SA(1, 1), a1 + hstepA, voffA);
            PG8_WAIT_L(8); PG8_BAR; PG8_WAIT_L(0); PG8_MMA(0, 0, At, B0); PG8_BAR; PG8_SCHED;
            PG8_LDB(B1, 0, 1); PG8_STAGE(PG8_SB(0, 0), b2, voffB);
            PG8_BAR; PG8_WAIT_L(0); PG8_MMA(0, 1, At, B1); PG8_BAR;
            PG8_LDA(At, 0, 1); PG8_STAGE(PG8_SA(0, 0), a2, voffA);
            PG8_BAR; PG8_WAIT_L(0); PG8_MMA(1, 0, At, B0); PG8_BAR; PG8_SCHED;
            PG8_STAGE(PG8_SB(0, 1), b2 + hstepB, voffB);
            PG8_WAIT_V(6); PG8_BAR; PG8_MMA(1, 1, At, B1); PG8_BAR;
            PG8_LDB(B0, 1, 0); PG8_SCHED; PG8_LDA(At, 1, 0); PG8_STAGE(PG8_SA(0, 1), a2 + hstepA, voffA);
            PG8_WAIT_L(8); PG8_BAR; PG8_WAIT_L(0); PG8_MMA(0, 0, At, B0); PG8_BAR; PG8_SCHED;
            PG8_LDB(B1, 1, 1); PG8_STAGE(PG8_SB(1, 0), b3, voffB);
            PG8_BAR; PG8_WAIT_L(0); PG8_MMA(0, 1, At, B1); PG8_BAR;
            PG8_LDA(At, 1, 1); PG8_STAGE(PG8_SA(1, 0), a3, voffA);
            PG8_BAR; PG8_WAIT_L(0); PG8_MMA(1, 0, At, B0); PG8_BAR; PG8_SCHED;
            PG8_STAGE(PG8_SB(1, 1), b3 + hstepB, voffB);
            PG8_WAIT_V(6); PG8_BAR; PG8_MMA(1, 1, At, B1); PG8_BAR;
            }
        }
        if constexpr (ALIGN_EPI) { if (wr == 0) PG8_BAR; }
        if constexpr (!Epi::AFTER_DRAIN) { E(acc, cur, wr, wc, fr, fq); S.done(cur); }
        if (!has_next) break;
#pragma unroll
        for (int a = 0; a < 2; ++a)
#pragma unroll
            for (int b = 0; b < 2; ++b)
#pragma unroll
                for (int m = 0; m < 4; ++m)
#pragma unroll
                    for (int n = 0; n < 2; ++n) acc[a][b][m][n] = (f32x4){0.f, 0.f, 0.f, 0.f};
        cur = nxt; cA = nA; cB = nB; ++ui;
        if constexpr (ALIGN_EPI) { if (wr == 1) PG8_BAR; }
    }
    PG8_WAIT_V(0);
    if constexpr (!ALIGN_EPI) { if (wr == 0) PG8_BAR; }
    PG8_BAR;
    if constexpr (Epi::AFTER_DRAIN) { E.fused(acc, cur, wr, wc, fr, fq, lds, wid, lane); S.done(cur); }
#undef PG8_SA
#undef PG8_SB
#undef PG8_STAGE
#undef PG8_LDA
#undef PG8_LDB
#undef PG8_MMA
#undef PG8_WAIT_V
#undef PG8_WAIT_L
#undef PG8_BAR
#undef PG8_SCHED
}
}
#include <hip/hip_bf16.h>
#include <cmath>
namespace attn_body {
using bf16=__hip_bfloat16;
using bf16x8=__attribute__((ext_vector_type(8)))short;
using s16x4=__attribute__((ext_vector_type(4)))short;
using f32x16=__attribute__((ext_vector_type(16)))float;
using u32x4=__attribute__((ext_vector_type(4)))unsigned;
constexpr int D=64,DM=2048,ODM=1024;
constexpr int NW=8,QBLK=32,QB=QBLK*NW,KVBLK=64;
constexpr int ATTN_PITCH=DM, ATTN_UNIT_ROWS=QB;
__device__ __forceinline__ int crow(int r,int hi){return (r&3)+8*(r>>2)+4*hi;}
#define SBAR() __builtin_amdgcn_sched_barrier(0)
__device__ __forceinline__ void cmask(f32x16&p0,f32x16&p1,int jb,int qrel,int hi){
  const float NEG=-INFINITY; int kb=64*jb+4*hi;
  #pragma unroll
  for(int r=0;r<16;++r){int kv=kb+(r&3)+8*(r>>2); if(kv>qrel)p0[r]=NEG; if(kv+32>qrel)p1[r]=NEG;}
}

typedef const __attribute__((address_space(3))) float* lds_fptr;
__device__ __forceinline__ void nabias(f32x16&p0,f32x16&p1,int kr,int qr_,int r32,int wid,int hi,lds_fptr rp){
  const float NEG=-INFINITY;
  asm volatile("":"+v"(r32),"+v"(hi));
  const int qc=32*(wid&1)+r32;
  const int rs=min(max(qr_-4,0),120), cs=min(max(qc-8,0),48);
  if(kr<rs||kr>=rs+8){
    #pragma unroll
    for(int r=0;r<16;++r){p0[r]=NEG;p1[r]=NEG;}
  } else {
    lds_fptr tb=rp+(kr-qr_+7)*31+(15-qc);
    #define NAB_ONE(P,KOFF) do{ const int kc_=(r&3)+8*(r>>2)+4*hi+(KOFF); const bool ok_=(unsigned)(kc_-cs)<16u; const float b_=tb[ok_?kc_:cs]; P[r]=ok_?P[r]+b_:NEG; }while(0)
    if(wid&1){
      #pragma unroll
      for(int r=0;r<16;++r){ NAB_ONE(p1,32); if(r>=12) NAB_ONE(p0,0); else p0[r]=NEG; }
    } else {
      #pragma unroll
      for(int r=0;r<16;++r){ NAB_ONE(p0,0); if(r<4) NAB_ONE(p1,32); else p1[r]=NEG; }
    }
    #undef NAB_ONE
  }
}
constexpr int NSLOT=3, SLOTB=8192;
constexpr int LDS_K=0, LDS_V=NSLOT*SLOTB, LDS_WS=2*NSLOT*SLOTB, LDS_OST=LDS_WS+NW*64*4, LDS_BYTES=LDS_OST+NW*4096;
constexpr float C2=0.125f*1.4426950408889634f;
__device__ __forceinline__ void glds16(const void*gsrc,unsigned lds_dst){unsigned keep;
  asm volatile("s_mov_b32 %0, m0\n\ts_mov_b32 m0, %2\n\ts_nop 0\n\tglobal_load_lds_dwordx4 %1, off\n\ts_mov_b32 m0, %0":"=&s"(keep):"v"(gsrc),"s"(lds_dst):"memory");}
__device__ __forceinline__ float max3f(float a,float b,float c){float r;asm("v_max3_f32 %0, %1, %2, %3":"=v"(r):"v"(a),"v"(b),"v"(c));return r;}
__device__ __forceinline__ float max2f(float a,float b){float r;asm("v_max_f32_e32 %0, %1, %2":"=v"(r):"v"(a),"v"(b));return r;}
__device__ __forceinline__ float fadd_s(float a,float b){float r;asm("v_add_f32_e32 %0, %1, %2":"=v"(r):"v"(a),"v"(b));return r;}
__device__ __forceinline__ float fsub_s(float a,float b){float r;asm("v_sub_f32_e32 %0, %1, %2":"=v"(r):"v"(a),"v"(b));return r;}
typedef float f32x2_t __attribute__((ext_vector_type(2))); typedef __bf16 bf16x2_t __attribute__((ext_vector_type(2)));
__device__ __forceinline__ unsigned cvtpk_s(float lo,float hi){f32x2_t v={lo,hi};bf16x2_t b=__builtin_convertvector(v,bf16x2_t);return __builtin_bit_cast(unsigned,b);}
#define WAIT_BAR(N) asm volatile("s_waitcnt vmcnt(" #N ") lgkmcnt(0)\n\ts_barrier":::"memory")

__device__ __forceinline__ void qkt(f32x16&p0,f32x16&p1,const char*Kslot,const bf16x8*qr,const f32x16&negm,int r32,int hi){
  const char*kb=Kslot+hi*1024+r32*16;
  #pragma unroll
  for(int d0=0;d0<4;++d0){
    const bf16x8 b0=*reinterpret_cast<const bf16x8*>(kb+d0*2048);
    const bf16x8 b1=*reinterpret_cast<const bf16x8*>(kb+d0*2048+512);
    if(d0==0){p0=__builtin_amdgcn_mfma_f32_32x32x16_bf16(b0,qr[0],negm,0,0,0);p1=__builtin_amdgcn_mfma_f32_32x32x16_bf16(b1,qr[0],negm,0,0,0);}
    else{p0=__builtin_amdgcn_mfma_f32_32x32x16_bf16(b0,qr[d0],p0,0,0,0);p1=__builtin_amdgcn_mfma_f32_32x32x16_bf16(b1,qr[d0],p1,0,0,0);}}
}
typedef __attribute__((address_space(3))) const char* lds_cptr;
typedef short v4i16_t __attribute__((ext_vector_type(4)));
__device__ __forceinline__ void kload8(bf16x8*kf,lds_cptr kp){
  kf[0]=*(const __attribute__((address_space(3))) bf16x8*)(kp);      kf[1]=*(const __attribute__((address_space(3))) bf16x8*)(kp+512);
  kf[2]=*(const __attribute__((address_space(3))) bf16x8*)(kp+2048); kf[3]=*(const __attribute__((address_space(3))) bf16x8*)(kp+2560);
  kf[4]=*(const __attribute__((address_space(3))) bf16x8*)(kp+4096); kf[5]=*(const __attribute__((address_space(3))) bf16x8*)(kp+4608);
  kf[6]=*(const __attribute__((address_space(3))) bf16x8*)(kp+6144); kf[7]=*(const __attribute__((address_space(3))) bf16x8*)(kp+6656);
}
__device__ __forceinline__ void kload2(bf16x8*kf,lds_cptr kp,int j){ kf[2*j]=*(const __attribute__((address_space(3))) bf16x8*)(kp+j*2048); kf[2*j+1]=*(const __attribute__((address_space(3))) bf16x8*)(kp+j*2048+512); }
__device__ __forceinline__ s16x4 vtr(lds_cptr p){ return __builtin_bit_cast(s16x4,__builtin_amdgcn_ds_read_tr16_b64_v4i16((__attribute__((address_space(3))) v4i16_t*)p)); }
__device__ __forceinline__ float rowmax(const f32x16&p0,const f32x16&p1){
  float a=max3f(p0[0],p0[1],p1[0]),b=max3f(p0[2],p0[3],p1[1]);a=max3f(a,p1[2],p1[3]);
  #pragma unroll
  for(int r=4;r<16;r+=4){a=max3f(a,p0[r],p0[r+1]);b=max3f(b,p0[r+2],p0[r+3]);a=max3f(a,p1[r],p1[r+1]);b=max3f(b,p1[r+2],p1[r+3]);}
  const float m=max2f(a,b);
  auto rr=__builtin_amdgcn_permlane32_swap(__float_as_uint(m),__float_as_uint(m),false,false);
  return max2f(__uint_as_float(rr[0]),__uint_as_float(rr[1]));
}
__device__ __forceinline__ void pv(f32x16*o,int vb,bf16x8 pa0,bf16x8 pa1,bf16x8 pa2,bf16x8 pa3){
  #pragma unroll
  for(int d0=0;d0<2;++d0){s16x4 lo[4],hi[4];
    #pragma unroll
    for(int ks=0;ks<4;++ks){
      asm volatile("ds_read_b64_tr_b16 %0,%1 offset:%c2":"=&v"(lo[ks]):"v"(vb),"i"(d0*4096+ks*1024):"memory");
      asm volatile("ds_read_b64_tr_b16 %0,%1 offset:%c2":"=&v"(hi[ks]):"v"(vb),"i"(d0*4096+ks*1024+512):"memory");}
    asm volatile("s_waitcnt lgkmcnt(0)":::"memory");SBAR();
    #define PK(k) (bf16x8){lo[k][0],lo[k][1],lo[k][2],lo[k][3],hi[k][0],hi[k][1],hi[k][2],hi[k][3]}
    o[d0]=__builtin_amdgcn_mfma_f32_32x32x16_bf16(pa0,PK(0),o[d0],0,0,0);
    o[d0]=__builtin_amdgcn_mfma_f32_32x32x16_bf16(pa1,PK(1),o[d0],0,0,0);
    o[d0]=__builtin_amdgcn_mfma_f32_32x32x16_bf16(pa2,PK(2),o[d0],0,0,0);
    o[d0]=__builtin_amdgcn_mfma_f32_32x32x16_bf16(pa3,PK(3),o[d0],0,0,0);
    #undef PK
  }
}

#ifndef ATTN_STORE16
#define ATTN_STORE16(p,v) (*(u32x4*)(p)=(v))
#endif
template<int THRL,int MODE> __device__ __forceinline__ void attn_unit(const bf16*Qw0,const bf16*__restrict__ Kh,const bf16*__restrict__ Vh,bf16*Ow0,const int NT,const int lat_off,const int na_r0,const int na_rsmin,const int rpb_off,char*shm){
  const int tid=ltid(),lane=tid&63,r32=lane&31,hi=lane>>5; const int wid=__builtin_amdgcn_readfirstlane(tid>>6);
  const bf16*Qw=Qw0+(long)(wid*QBLK)*DM;
  const unsigned lds0=(unsigned)(uintptr_t)shm;
  float*wsf=(float*)(shm+LDS_WS)+wid*64;
  const bf16*ksrc=Kh+(long)lane*DM+wid*8;
  const bf16*vsrc=Vh+(long)(16*(wid&3)+(lane>>2))*DM+(wid>>2)*32+(lane&3)*8;
  const unsigned kdst=lds0+LDS_K+wid*1024, vdst=lds0+LDS_V+wid*1024;
  #define TROW(t) (((t)<4)?(t)*64:lat_off+((t)-4)*64)
  #define DMA_K(t,slot) glds16(ksrc+(long)TROW(t)*DM,(unsigned)__builtin_amdgcn_readfirstlane(kdst+(slot)))
  #define DMA_V(t,slot) glds16(vsrc+(long)TROW(t)*DM,(unsigned)__builtin_amdgcn_readfirstlane(vdst+(slot)))
  const int vb0=(int)(lds0+LDS_V)+((lane>>4)&1)*32+(lane&3)*8+(4*hi+((lane&15)>>2))*64;
  const char*Kbase=shm+LDS_K; bf16x8 kf[8];
  const lds_cptr shm3=(lds_cptr)shm; const lds_cptr kp0=shm3+LDS_K+hi*1024+r32*16; const lds_cptr vp0=shm3+LDS_V+((lane>>4)&1)*32+(lane&3)*8+(4*hi+((lane&15)>>2))*64;
  DMA_K(0,0);DMA_V(0,0);DMA_K(1,SLOTB);
  bf16x8 qr[4];
  #pragma unroll
  for(int d0=0;d0<4;++d0)qr[d0]=*reinterpret_cast<const bf16x8*>(&Qw[(long)r32*DM+d0*16+hi*8]);
  float mhat=0.f,l_reg=0.f;f32x16 o[2];o[0]=f32x16{};o[1]=f32x16{};f32x16 negm=f32x16{};asm volatile("":"+v"(negm));
  const lds_fptr rp_=(lds_fptr)(shm3+rpb_off); const int na_qr=na_r0+(wid>>1);
  #define CMASK(P0,P1,t) do{ if(MODE==1 && (t)>=4) nabias(P0,P1,na_rsmin+(t)-4,na_qr,r32,wid,hi,rp_); }while(0)
  bool resc=false;
  #define START(P0,P1) do{ const float rm=rowmax(P0,P1); resc=false; \
    { const float dl=rm; mhat=fadd_s(mhat,dl); \
      _Pragma("unroll") for(int r=0;r<16;++r){P0[r]=fsub_s(P0[r],dl);P1[r]=fsub_s(P1[r],dl);} \
      _Pragma("unroll") for(int r=0;r<16;++r)negm[r]=-mhat; asm volatile("":"+v"(negm)); } \
    _Pragma("unroll") for(int r=0;r<16;++r)P0[r]=__builtin_amdgcn_exp2f(P0[r]); }while(0)
  #define RESC() do{ if(resc){ asm volatile("s_waitcnt lgkmcnt(0)":::"memory"); \
      _Pragma("unroll") for(int d_=0;d_<2;++d_) _Pragma("unroll") for(int r=0;r<16;++r)o[d_][r]*=wsf[crow(r,hi)]; } }while(0)
  f32x16 pA0,pA1,pB0,pB1;
  int sl_prev=0,sl_cur=0,sl_next=SLOTB;
  #define ROT() do{sl_prev=sl_cur;sl_cur=sl_next;sl_next=(sl_next==(NSLOT-1)*SLOTB)?0:sl_next+SLOTB;}while(0)
  DMA_K(2,2*SLOTB);
  WAIT_BAR(3);
  qkt(pA0,pA1,Kbase,qr,negm,r32,hi);asm volatile("s_nop 15\n\ts_nop 7":"+v"(pA0),"+v"(pA1));CMASK(pA0,pA1,0);
  START(pA0,pA1);
  _Pragma("unroll") for(int r=0;r<16;++r)pA1[r]=__builtin_amdgcn_exp2f(pA1[r]);
  WAIT_BAR(0);
  DMA_K(3,0);DMA_V(1,SLOTB);
  ROT();
  kload8(kf,kp0+sl_cur);
  WAIT_BAR(2);
  s16x4 vlo[8],vhi[8]; u32x4 pw0,pw1,pw2,pw3;
  #define PKW(P,B) cvtpk_s(P[B],P[B+1])
  #define PAF(k) __builtin_bit_cast(bf16x8,pw##k)
  #define VFR(i) (bf16x8){vlo[i][0],vlo[i][1],vlo[i][2],vlo[i][3],vhi[i][0],vhi[i][1],vhi[i][2],vhi[i][3]}
  #define PIN(x) asm volatile("":"+v"(x))
  #define MX3(a,b,c) __builtin_fmaxf(__builtin_fmaxf((a),(b)),(c))
  #define GAPA(MF,A0,A1,A2,A3,W0,W1,PW) do{ MF; sacc+=A0; sacc+=A1; sacc+=A2; sacc+=A3; PIN(sacc); W0; W1; PIN(PW); SBAR(); }while(0)
  #define EX(v) __builtin_amdgcn_exp2f(v)
  #define GAPB(MF,X,B) do{ MF; X[B]=EX(X[B]); X[B+1]=EX(X[B+1]); X[B+2]=EX(X[B+2]); X[B+3]=EX(X[B+3]); PIN(X); SBAR(); }while(0)
  #define VRD(i) do{ vlo[i]=vtr(vp_+(((i)>>2)*4096+((i)&3)*1024)); vhi[i]=vtr(vp_+(((i)>>2)*4096+((i)&3)*1024+512)); }while(0)
  #define KRD(G,j) do{ if(G){ kload2(kf,kp0+sl_next,j); SBAR(); } }while(0)
  #define STEP(C0,C1,P0,P1,t,GK,GV,GL) do{ SBAR(); \
    const lds_cptr vp_=vp0+sl_prev; \
    VRD(0); SBAR(); float sacc=(P0[0]+P0[1]); \
    GAPA(C0=__builtin_amdgcn_mfma_f32_32x32x16_bf16(kf[0],qr[0],negm,0,0,0), P0[2],P0[3],P0[4],P0[5],     pw0[0]=PKW(P0,0), pw0[1]=PKW(P0,2), pw0); \
    VRD(4); SBAR(); GAPA(C1=__builtin_amdgcn_mfma_f32_32x32x16_bf16(kf[1],qr[0],negm,0,0,0), P0[6],P0[7],P0[8],P0[9],     pw0[2]=PKW(P0,4), pw0[3]=PKW(P0,6), pw0); \
    VRD(1); SBAR(); GAPA(C0=__builtin_amdgcn_mfma_f32_32x32x16_bf16(kf[2],qr[1],C0,0,0,0),   P0[10],P0[11],P0[12],P0[13], pw1[0]=PKW(P0,8), pw1[1]=PKW(P0,10), pw1); \
    VRD(5); SBAR(); GAPA(C1=__builtin_amdgcn_mfma_f32_32x32x16_bf16(kf[3],qr[1],C1,0,0,0),   P0[14],P0[15],P1[0],P1[1],   pw1[2]=PKW(P0,12),pw1[3]=PKW(P0,14), pw1); \
    VRD(2); SBAR(); GAPA(C0=__builtin_amdgcn_mfma_f32_32x32x16_bf16(kf[4],qr[2],C0,0,0,0),   P1[2],P1[3],P1[4],P1[5],     pw2[0]=PKW(P1,0), pw2[1]=PKW(P1,2), pw2); \
    VRD(6); SBAR(); GAPA(C1=__builtin_amdgcn_mfma_f32_32x32x16_bf16(kf[5],qr[2],C1,0,0,0),   P1[6],P1[7],P1[8],P1[9],     pw2[2]=PKW(P1,4), pw2[3]=PKW(P1,6), pw2); \
    VRD(3); SBAR(); GAPA(C0=__builtin_amdgcn_mfma_f32_32x32x16_bf16(kf[6],qr[3],C0,0,0,0),   P1[10],P1[11],P1[12],P1[13], pw3[0]=PKW(P1,8), pw3[1]=PKW(P1,10), pw3); \
    VRD(7); SBAR(); GAPA(C1=__builtin_amdgcn_mfma_f32_32x32x16_bf16(kf[7],qr[3],C1,0,0,0),   P1[14],P1[15],0.f,0.f,       pw3[2]=PKW(P1,12),pw3[3]=PKW(P1,14), pw3); \
    l_reg+=sacc; \
    if(GK){DMA_K((t)+3,sl_cur);} if(GV){DMA_V((t)+1,sl_next);} \
    CMASK(C0,C1,t); \
    { float a=MX3(C0[0],C0[1],C1[0]),b=MX3(C0[2],C0[3],C1[1]); a=MX3(a,C1[2],C1[3]); \
      _Pragma("unroll") for(int r=4;r<16;r+=4){a=MX3(a,C0[r],C0[r+1]);b=MX3(b,C0[r+2],C0[r+3]);a=MX3(a,C1[r],C1[r+1]);b=MX3(b,C1[r+2],C1[r+3]);} \
      float rm=__builtin_fmaxf(a,b); { auto rr=__builtin_amdgcn_permlane32_swap(__float_as_uint(rm),__float_as_uint(rm),false,false); rm=__builtin_fmaxf(__uint_as_float(rr[0]),__uint_as_float(rr[1])); } \
      resc=false; \
      if(__builtin_expect(__any(rm>(float)THRL),0)){ const float dl=__builtin_fmaxf(rm,0.f); mhat+=dl; \
        _Pragma("unroll") for(int r=0;r<16;++r){C0[r]-=dl;C1[r]-=dl;} \
        _Pragma("unroll") for(int r=0;r<16;++r)negm[r]=-mhat; asm volatile("":"+v"(negm)); \
        const float f=__builtin_amdgcn_exp2f(-dl); l_reg*=f; if(hi==0)wsf[r32]=f; resc=true; } } \
    SBAR(); \
    GAPB(o[0]=__builtin_amdgcn_mfma_f32_32x32x16_bf16(PAF(0),VFR(0),o[0],0,0,0), C0,0); \
    GAPB(o[1]=__builtin_amdgcn_mfma_f32_32x32x16_bf16(PAF(0),VFR(4),o[1],0,0,0), C0,4); \
    KRD(GL,0); GAPB(o[0]=__builtin_amdgcn_mfma_f32_32x32x16_bf16(PAF(1),VFR(1),o[0],0,0,0), C0,8); \
    KRD(GL,1); GAPB(o[1]=__builtin_amdgcn_mfma_f32_32x32x16_bf16(PAF(1),VFR(5),o[1],0,0,0), C0,12); \
    KRD(GL,2); GAPB(o[0]=__builtin_amdgcn_mfma_f32_32x32x16_bf16(PAF(2),VFR(2),o[0],0,0,0), C1,0); \
    KRD(GL,3); GAPB(o[1]=__builtin_amdgcn_mfma_f32_32x32x16_bf16(PAF(2),VFR(6),o[1],0,0,0), C1,4); \
    GAPB(o[0]=__builtin_amdgcn_mfma_f32_32x32x16_bf16(PAF(3),VFR(3),o[0],0,0,0), C1,8); \
    GAPB(o[1]=__builtin_amdgcn_mfma_f32_32x32x16_bf16(PAF(3),VFR(7),o[1],0,0,0), C1,12); \
    }while(0)
  int t=1;
  #undef CMASK
  #define CMASK(P0,P1,t) do{ if(MODE==1 && (t)>=4) nabias(P0,P1,na_rsmin+(t)-4,na_qr,r32,wid,hi,rp_); }while(0)
  for(;t+5<NT;t+=2){
    STEP(pB0,pB1,pA0,pA1,t,true,true,true);     WAIT_BAR(2); RESC(); ROT();
    STEP(pA0,pA1,pB0,pB1,t+1,true,true,true);   WAIT_BAR(2); RESC(); ROT();
  }
  #undef CMASK
  #define CMASK(P0,P1,t) do{ if(MODE==1 && (t)>=4) nabias(P0,P1,na_rsmin+(t)-4,na_qr,r32,wid,hi,rp_); }while(0)
  #define ENDW(tt) do{ if((tt)+3<NT){WAIT_BAR(2);} else if((tt)+2<NT){WAIT_BAR(1);} else {WAIT_BAR(0);} }while(0)
  for(;t+1<NT;t+=2){
    STEP(pB0,pB1,pA0,pA1,t,(t+3<NT),(t+1<NT),(t+1<NT));       ENDW(t);   RESC(); ROT();
    STEP(pA0,pA1,pB0,pB1,t+1,(t+4<NT),(t+2<NT),(t+2<NT));     ENDW(t+1); RESC(); ROT();
  }
  STEP(pB0,pB1,pA0,pA1,NT-1,false,false,false); RESC();
  { float sacc=pB0[0]+pB0[1]; _Pragma("unroll") for(int r=2;r<16;++r)sacc+=pB0[r]; _Pragma("unroll") for(int r=0;r<16;++r)sacc+=pB1[r]; l_reg+=sacc;
    pw0=(u32x4){PKW(pB0,0),PKW(pB0,2),PKW(pB0,4),PKW(pB0,6)};pw1=(u32x4){PKW(pB0,8),PKW(pB0,10),PKW(pB0,12),PKW(pB0,14)};pw2=(u32x4){PKW(pB1,0),PKW(pB1,2),PKW(pB1,4),PKW(pB1,6)};pw3=(u32x4){PKW(pB1,8),PKW(pB1,10),PKW(pB1,12),PKW(pB1,14)};
    SBAR(); pv(o,vb0+sl_cur,PAF(0),PAF(1),PAF(2),PAF(3)); }
  #undef PKW
  #undef PAF
  #undef VFR
  #undef PIN
  #undef MX3
  #undef GAPA
  #undef GAPB
  #undef EX
  #undef VRD
  #undef KRD
  #undef STEP
  #undef ENDW
  {auto rr=__builtin_amdgcn_permlane32_swap(__float_as_uint(l_reg),__float_as_uint(l_reg),false,false);l_reg=__uint_as_float(rr[0])+__uint_as_float(rr[1]);}
  if(hi==0)wsf[32+r32]=l_reg;asm volatile("s_waitcnt lgkmcnt(0)":::"memory");
  float rli[16];
  #pragma unroll
  for(int r=0;r<16;++r)rli[r]=__builtin_amdgcn_rcpf(wsf[32+crow(r,hi)]);
  bf16*Ow=Ow0+(long)(wid*QBLK)*ODM;
  { bf16*stg=(bf16*)(shm+LDS_OST)+wid*2048;
    #pragma unroll
    for(int r=0;r<16;++r){const int orow=crow(r,hi);
      #pragma unroll
      for(int d0=0;d0<2;++d0)stg[orow*64+d0*32+r32]=__float2bfloat16(o[d0][r]*rli[r]);}
    asm volatile("s_waitcnt lgkmcnt(0)":::"memory");
    #pragma unroll
    for(int i=0;i<4;++i){const int row=i*8+(lane>>3),ch=lane&7; const u32x4 v=*(const u32x4*)(stg+row*64+ch*8); ATTN_STORE16(Ow+(long)row*ODM+ch*8,v);} }
  asm volatile("s_waitcnt lgkmcnt(0)\n\ts_barrier":::"memory");
  #undef DMA_K
  #undef TROW
  #undef DMA_V
  #undef CMASK
  #undef START
  #undef RESC
  #undef ROT
}
constexpr int ATTN_LDS_BYTES=LDS_BYTES;
}
#ifndef DBG_MASK
#define DBG_MASK 127
#endif
#ifndef DBG_DIAG
#define DBG_DIAG 0
#endif
#ifndef DBG_NA
#define DBG_NA 1
#endif
#ifndef DBG_CTX
#define DBG_CTX 1
#endif
#ifndef DBG_POOL
#define DBG_POOL 1
#endif
namespace cg = cooperative_groups;
#define GAS __attribute__((address_space(1)))
#define LAS __attribute__((address_space(3)))
typedef unsigned short bf16;
typedef unsigned v4u __attribute__((ext_vector_type(4)));
typedef float f32x4 __attribute__((ext_vector_type(4)));
#define LDS_WAIT() asm volatile("s_waitcnt lgkmcnt(0)" ::: "memory")
__device__ __forceinline__ unsigned f2bf(float f) { unsigned u = __builtin_bit_cast(unsigned, f); return (u + 0x7fffu + ((u >> 16) & 1u)) >> 16; }
__device__ __forceinline__ unsigned pk2(float lo, float hi) { return f2bf(lo) | (f2bf(hi) << 16); }
__device__ __forceinline__ float bf2f(unsigned short h) { return __builtin_bit_cast(float, (unsigned)h << 16); }
__device__ __forceinline__ float wave_sum(float v) {
#pragma unroll
    for (int o = 1; o < 64; o <<= 1) v += __shfl_xor(v, o);
    return v;
}
#define RLX_AGENT __ATOMIC_RELAXED, __HIP_MEMORY_SCOPE_AGENT
#define XB_TMO      128
#define XB_XCNT(j)  (256  + 64 * (j))
#define XB_XSUB(j)  (1280 + 64 * (j))
#define XB_XGEN(j)  (2304 + 64 * (j))
#define XB_TOP      3328
#define XB_TOPGEN   3392
#define XCD_BAR_WORDS 3456
#define XB_SPIN_CAP (1u << 18)

__device__ __forceinline__ unsigned xb_ld(unsigned* p)              { return __hip_atomic_load(p, __ATOMIC_RELAXED, __HIP_MEMORY_SCOPE_AGENT); }
__device__ __forceinline__ unsigned xb_add(unsigned* p, unsigned v) { return __hip_atomic_fetch_add(p, v, __ATOMIC_RELAXED, __HIP_MEMORY_SCOPE_AGENT); }
__device__ __forceinline__ unsigned xb_xcc_id() { return (unsigned)__builtin_amdgcn_s_getreg((3 << 11) | 20) & 0xFu; }
#define XB_SPIN(cond, bar) do { unsigned _sp = 0; while (cond) { __builtin_amdgcn_s_sleep(1); \
    if ((++_sp & 255u) == 0u) { if (xb_ld(&(bar)[XB_TMO])) break; if (_sp > XB_SPIN_CAP) { atomicAdd(&(bar)[XB_TMO], 1u); break; } } } } while (0)

struct XcdBarrier {
    unsigned* bar; unsigned x;
    volatile LAS unsigned* st;
};

__device__ __forceinline__ XcdBarrier xcd_barrier_post(unsigned* bar, volatile LAS unsigned* st) {
    XcdBarrier b; b.bar = bar; b.x = xb_xcc_id(); b.st = st;
    if (threadIdx.x == 0) (void)xb_add(&bar[XB_XCNT(b.x)], 1u);
    return b;
}
__device__ __forceinline__ void xcd_barrier_complete(unsigned* bar, unsigned x, unsigned& nloc, unsigned& nx) {
    const unsigned G = gridDim.x * gridDim.y * gridDim.z;
    unsigned sum, cnt, mine, sp = 0u;
    for (;;) {
        sum = 0u; cnt = 0u; mine = 0u;
#pragma unroll
        for (unsigned j = 0; j < 16; ++j) { const unsigned c = xb_ld(&bar[XB_XCNT(j)]); sum += c; cnt += (c > 0u) ? 1u : 0u; mine = (j == x) ? c : mine; }
        if (sum == G) break;
        __builtin_amdgcn_s_sleep(1);
        if ((++sp & 255u) == 0u) { if (xb_ld(&bar[XB_TMO])) break; if (sp > XB_SPIN_CAP) { atomicAdd(&bar[XB_TMO], 1u); break; } }
    }
    nloc = mine > 0u ? mine : 1u; nx = cnt > 0u ? cnt : 1u;
}

__device__ __forceinline__ void xcd_barrier(const XcdBarrier& b) {
    asm volatile("s_waitcnt vmcnt(0)" ::: "memory");
    __syncthreads();
    if (threadIdx.x == 0) {
        unsigned* bar = b.bar;
        __builtin_amdgcn_s_waitcnt(0);
        unsigned nloc = b.st[0], nx = b.st[1];
        if (nloc == 0u) { xcd_barrier_complete(bar, b.x, nloc, nx); b.st[0] = nloc; b.st[1] = nx; }
        const unsigned old = xb_add(&bar[XB_XSUB(b.x)], 1u);
        const unsigned gen = old / nloc;
        if (old + 1u == (gen + 1u) * nloc) {
            __builtin_amdgcn_fence(__ATOMIC_RELEASE, "agent");
            asm volatile("s_waitcnt vmcnt(0)" ::: "memory");
            const unsigned og = xb_add(&bar[XB_TOP], 1u);
            const unsigned tg = og / nx;
            if (og + 1u == (tg + 1u) * nx) xb_add(&bar[XB_TOPGEN], 1u);
            else XB_SPIN(xb_ld(&bar[XB_TOPGEN]) == tg, bar);
            __builtin_amdgcn_fence(__ATOMIC_ACQUIRE, "agent");
            xb_add(&bar[XB_XGEN(b.x)], 1u);
            asm volatile("s_waitcnt vmcnt(0)" ::: "memory");
        } else {
            XB_SPIN(xb_ld(&bar[XB_XGEN(b.x)]) == gen, bar);
            __builtin_amdgcn_fence(__ATOMIC_ACQUIRE, "agent");
            asm volatile("s_waitcnt vmcnt(0)" ::: "memory");
        }
    }
    __syncthreads();
}
constexpr size_t MiB = 1u << 20;
constexpr size_t WS_TS = 1 * MiB + 32768;
constexpr size_t WS_MOD = 0, WS_ROPEC = 1 * MiB, WS_ROPES = 1 * MiB + 8192, WS_BAR = 1 * MiB + 131072;
constexpr size_t WS_WIN = 2 * MiB, WS_WOUT = 18 * MiB, WS_WUP = 26 * MiB, WS_WDN = 70 * MiB;
constexpr size_t WS_ST = 92 * MiB, WS_X = 94 * MiB, WS_H = 359 * MiB, WS_Z = 492 * MiB, WS_Y = 756 * MiB, WS_ACT = WS_Z, WS_END = 888 * MiB;
static_assert(WS_WIN + (size_t)P_DEPTH * P_INW * P_D * 2 <= WS_WOUT && WS_WOUT + (size_t)P_DEPTH * P_D * P_D * 2 <= WS_WUP && WS_WUP + (size_t)P_DEPTH * P_UPW * P_D * 2 <= WS_WDN && WS_WDN + (size_t)P_DEPTH * P_D * P_DFF * 2 <= WS_ST && WS_ST + (size_t)P_M * 8 <= WS_X, "weights map");
static_assert(WS_X + (size_t)P_M * P_D * 4 <= WS_H - MiB / 2 && WS_H + (size_t)P_M * P_D * 2 + MiB / 2 <= WS_Z && WS_Z + (size_t)P_M * P_INW * 2 <= WS_Y && WS_Y + (size_t)P_M * P_D * 2 <= WS_END && WS_ACT + (size_t)P_M * P_DFF * 2 <= WS_END, "activation map");
constexpr int LDS_BYTES = 147456, RPB_OFF = 98304, BARST_OFF = 131072 + 64, PAR_OFF = 131072 + 1024, ROPE_OFF = 131072 + 4096;
#ifndef DBG_REP
#define DBG_REP -1
#endif
constexpr int PH_PER_L = 9;
#ifndef DBG_TPROBE
#define DBG_TPROBE -1
#endif
#ifndef DBG_TPROBE_N
#define DBG_TPROBE_N 1
#endif
#ifndef STAG_TICKS
#define STAG_TICKS 700
#endif
#ifndef N1_OUT
#define N1_OUT 34000
#endif
#ifndef N1_DOWN
#define N1_DOWN 0
#endif
#ifndef DBG_P0REP
#define DBG_P0REP 0
#endif
constexpr int N_PHASES = 2 + PH_PER_L * P_DEPTH + 2 * DBG_P0REP;

struct Args {
    const float *x, *c, *ctx, *c_ctx, *w_mod, *b_mod, *w_in, *pool_w, *pool_scale, *na_rpb, *q_norm, *k_norm, *w_out, *ln1_g, *ln1_b, *w_up, *conv_w, *conv_b, *w_down, *ln2_g, *ln2_b;
    float* out; unsigned char* ws; int ph_lo, ph_hi;
};
static_assert(sizeof(Args) == 23 * 8 + 8, "Args has no padding");

template <int OFF> __device__ __forceinline__ unsigned long long ldarg() {
    unsigned long long v; asm volatile("s_load_dwordx2 %0, %1, %2\n\ts_waitcnt lgkmcnt(0)" : "=s"(v) : "s"(__builtin_amdgcn_kernarg_segment_ptr()), "n"(OFF)); return v; }
#define ARGF(A, f) (A).f = (decltype(Args::f))(__attribute__((address_space(1))) void*)ldarg<offsetof(Args, f)>()
__device__ __forceinline__ void p0_item(const float* W, int K, int N, bf16* WT, int k0, int n0, int drow, LAS float* scr, int lane) {
    float wv[32];
#pragma unroll
    for (int i = 0; i < 32; ++i) wv[i] = W[(size_t)(k0 + 2 * i + (lane >> 5)) * N + n0 + (lane & 31)];
#pragma unroll
    for (int i = 0; i < 32; ++i) scr[(2 * i + (lane >> 5)) * 33 + (lane & 31)] = wv[i];
    LDS_WAIT(); asm volatile("" ::: "memory");
    const int c = lane & 7;
#pragma unroll
    for (int j = 0; j < 4; ++j) { const int n = (lane >> 3) + 8 * j; const LAS float* s = scr + (8 * c) * 33 + n;
        v4u o; o.x = pk2(s[0 * 33], s[1 * 33]); o.y = pk2(s[2 * 33], s[3 * 33]); o.z = pk2(s[4 * 33], s[5 * 33]); o.w = pk2(s[6 * 33], s[7 * 33]);
        *(GAS v4u*)(WT + (size_t)(drow + n) * K + k0 + 8 * c) = o; }
    LDS_WAIT(); asm volatile("" ::: "memory");
}

__device__ __forceinline__ void phase_weights(const Args& a, LAS unsigned char* lds, int vcu, int G, int tid, int lane, int wave) {
    unsigned char* ws = a.ws;
    {
        LAS float* scr = (LAS float*)(lds + wave * 16384);
        const int gw = vcu * 8 + wave, NGW = G * 8;
        constexpr int I_IN = 16 * 64, I_OUT = 16 * 32, I_UP = 16 * 176, I_DN = 44 * 32, I_L = I_IN + I_OUT + I_UP + I_DN;
        for (int it = gw; it < P_DEPTH * I_L; it += NGW) {
            const int l = it / I_L; int r = it - l * I_L;
            if (r < I_IN) { const int kb = r >> 6, nb = r & 63, L0 = 32 * nb; const int drow = (L0 & ~255) + ((L0 >> 5) & 1) * 128 + ((L0 >> 6) & 3) * 32;
                p0_item(a.w_in + (size_t)l * P_D * P_INW, P_D, P_INW, (bf16*)(ws + WS_WIN) + (size_t)l * P_INW * P_D, 64 * kb, 32 * nb, drow, scr, lane); continue; }
            r -= I_IN;
            if (r < I_OUT) { const int kb = r >> 5, nb = r & 31;
                p0_item(a.w_out + (size_t)l * P_D * P_D, P_D, P_D, (bf16*)(ws + WS_WOUT) + (size_t)l * P_D * P_D, 64 * kb, 32 * nb, 32 * nb, scr, lane); continue; }
            r -= I_OUT;
            if (r < I_UP) { const int kb = r / 176, nb = r - kb * 176, L0 = 32 * nb; const int half = L0 >= P_DFF ? 1 : 0, ch0 = L0 - half * P_DFF; const int drow = (ch0 >> 7) * 256 + half * 128 + (ch0 & 127);
                p0_item(a.w_up + (size_t)l * P_D * P_UPW, P_D, P_UPW, (bf16*)(ws + WS_WUP) + (size_t)l * P_UPW * P_D, 64 * kb, 32 * nb, drow, scr, lane); continue; }
            r -= I_UP;
            { const int kb = r >> 5, nb = r & 31;
                p0_item(a.w_down + (size_t)l * P_DFF * P_D, P_DFF, P_D, (bf16*)(ws + WS_WDN) + (size_t)l * P_D * P_DFF, 64 * kb, 32 * nb, 32 * nb, scr, lane); }
        }
    }
}
__device__ __forceinline__ void phase0(const Args& a, LAS unsigned char* lds, int vcu, int G, int tid, int lane, int wave) {
    unsigned char* ws = a.ws;
    if (vcu < 192) {
        LAS float* act = (LAS float*)lds; LAS float* red = (LAS float*)(lds + 40960);
        for (int e = tid; e < 9 * P_D; e += 512) { const int r = e >> 10, k = e & 1023; const float v = r < 8 ? a.c[r * P_D + k] : a.c_ctx[k]; act[e] = v / (1.0f + expf(-v)); }
        __syncthreads();
        for (int u = vcu; u < 192; u += G) {
            const int l = u / 48, n0 = (u - l * 48) * 128, cg4 = tid & 31, ks = tid >> 5;
            const float* wp = a.w_mod + (size_t)l * P_D * P_MODW + (size_t)(ks * 64) * P_MODW + n0 + 4 * cg4;
            f32x4 s[9];
#pragma unroll
            for (int r = 0; r < 9; ++r) s[r] = (f32x4){0.f, 0.f, 0.f, 0.f};
#pragma unroll 8
            for (int k = 0; k < 64; ++k) { const f32x4 w = *(const f32x4*)(wp + (size_t)k * P_MODW);
#pragma unroll
                for (int r = 0; r < 9; ++r) s[r] += w * act[r * P_D + ks * 64 + k]; }
#pragma unroll
            for (int r = 0; r < 9; ++r) *(LAS f32x4*)(red + (ks * 9 + r) * 128 + 4 * cg4) = s[r];
            __syncthreads();
            for (int e = tid; e < 9 * 128; e += 512) { const int r = e >> 7, cc = e & 127; float t = 0.f;
#pragma unroll
                for (int k2 = 0; k2 < 16; ++k2) t += red[(k2 * 9 + r) * 128 + cc];
                ((float*)(ws + WS_MOD))[(size_t)(l * 9 + r) * P_MODW + n0 + cc] = t + a.b_mod[l * P_MODW + n0 + cc]; }
            __syncthreads();
        }
    }
    if (vcu == G - 1) {
        for (int e = tid; e < 2048; e += 512) { const int pos = e >> 4, f = e & 15;
            const float inv = exp2f(-(float)f * (13.287712379549449f / 16.0f));
            const float ang = (float)pos * inv;
            ((float*)(ws + WS_ROPEC))[e] = cosf(ang); ((float*)(ws + WS_ROPES))[e] = sinf(ang); }
    }
}

template <int KIND> __device__ __forceinline__ void row_phase(const Args& a, int l, int mode, int n1, int bx, int vcu, int G, int wave, int lane, LAS unsigned char* lds) {
    unsigned char* ws = a.ws; const float* X = (const float*)(ws + WS_X); bf16* H = (bf16*)(ws + WS_H); const float* mod = (const float*)(ws + WS_MOD); float* ST = (float*)(ws + WS_ST);
    const bool lastl = (KIND == 2 && l == P_DEPTH - 1);
    const int ml = (KIND == 2) ? l + 1 : l; const int csh = (KIND == 1) ? 3 : 0, csc = (KIND == 1) ? 4 : 1;
    const float* lg = (KIND == 1 ? a.ln1_g : a.ln2_g) + l * P_D; const float* lb = (KIND == 1 ? a.ln1_b : a.ln2_b) + l * P_D;
    LAS f32x4* T4 = (LAS f32x4*)lds;
    { const int tid = wave * 64 + lane;
      if (KIND != 0) for (int e = tid; e < 256; e += 512) { T4[e] = ((const f32x4*)lg)[e]; T4[256 + e] = ((const f32x4*)lb)[e]; }
      if (!lastl) for (int e = tid; e < 9 * 256; e += 512) { const int r = e >> 8, c = e & 255; const float* mp = mod + (size_t)(ml * 9 + r) * P_MODW;
          T4[512 + e] = ((const f32x4*)(mp + csh * P_D))[c]; T4[512 + 2304 + e] = ((const f32x4*)(mp + csc * P_D))[c]; }
      __syncthreads(); }
#define ROW_OF(i) (mode == 1 ? (i) + (((i) >> 13) + 1) * P_CTX : (mode == 2 ? ((i) >> 8) * P_RPB + ((i) & 255) : (i)))
#define ROW_SRC(m_, b_, rb_) ((KIND == 0) ? ((rb_) < P_CTX ? a.ctx + ((size_t)(b_) * P_CTX + (rb_)) * P_D : a.x + ((size_t)(b_) * P_SEQ + ((rb_) - P_CTX)) * P_D) : X + (size_t)(m_) * P_D)
    for (int seg = 0; seg < 2; ++seg) {
        int start, stride, end;
        if (seg == 0) { start = vcu * 8 + wave; stride = G * 8; end = (mode == 0) ? P_M : (mode == 2 ? P_B * P_CTX : n1); }
        else { if (mode != 1 || bx < 32) break; start = n1 + (bx - 32) * 8 + wave; stride = (G - 32) * 8; end = P_B * P_SEQ; }
        f32x4 vn[4];
        if (start < end) { const int m0 = ROW_OF(start); const int b0 = m0 / P_RPB, rb0 = m0 - b0 * P_RPB; const f32x4* xr = (const f32x4*)ROW_SRC(m0, b0, rb0) + lane;
#pragma unroll
            for (int j = 0; j < 4; ++j) vn[j] = xr[64 * j]; }
        for (int i = start; i < end; i += stride) {
            const int m = ROW_OF(i);
            const int b = m / P_RPB, rb = m - b * P_RPB; const bool is_ctx = rb < P_CTX; const int mrow = is_ctx ? 8 : b;
            f32x4 v[4];
#pragma unroll
            for (int j = 0; j < 4; ++j) v[j] = vn[j];
            if (i + stride < end) { const int m1 = ROW_OF(i + stride); const int b1 = m1 / P_RPB, rb1 = m1 - b1 * P_RPB; const f32x4* xr = (const f32x4*)ROW_SRC(m1, b1, rb1) + lane;
#pragma unroll
                for (int j = 0; j < 4; ++j) vn[j] = xr[64 * j]; }
            if (KIND != 0) {
                float s = 0.f;
#pragma unroll
                for (int j = 0; j < 4; ++j) s += (v[j].x + v[j].y) + (v[j].z + v[j].w);
                const float mean = wave_sum(s) * (1.f / P_D); float s2 = 0.f;
#pragma unroll
                for (int j = 0; j < 4; ++j) { v[j] = v[j] - mean; s2 += (v[j].x * v[j].x + v[j].y * v[j].y) + (v[j].z * v[j].z + v[j].w * v[j].w); }
                const float rstd = 1.f / sqrtf(wave_sum(s2) * (1.f / P_D) + P_EPS);
                if (!lastl && lane == 0) { ST[(size_t)m * 2] = mean; ST[(size_t)m * 2 + 1] = rstd; }
#pragma unroll
                for (int j = 0; j < 4; ++j) { const f32x4 g = T4[lane + 64 * j], bb = T4[256 + lane + 64 * j]; v[j] = v[j] * rstd * g + bb; }
            }
            if (lastl) {
#if DBG_TPROBE >= 0
                if (i < 64) { const unsigned long long* ts = (const unsigned long long*)(ws + WS_TS); const float d_us = (float)(ts[DBG_TPROBE + DBG_TPROBE_N] - ts[DBG_TPROBE]) * 0.01f;
                    const float eps_ = sqrtf(d_us * 2.07e-6f);
#pragma unroll
                    for (int j = 0; j < 4; ++j) v[j] = v[j] + eps_; }
#endif
                if (!is_ctx) { f32x4* o = (f32x4*)(a.out + ((size_t)b * P_SEQ + (rb - P_CTX)) * P_D) + lane;
#pragma unroll
                    for (int j = 0; j < 4; ++j) o[64 * j] = v[j]; }
            } else {
                unsigned long long* o8 = (unsigned long long*)(H + (size_t)m * P_D) + lane;
#pragma unroll
                for (int j = 0; j < 4; ++j) { const f32x4 sh = T4[512 + mrow * 256 + lane + 64 * j], sc = T4[512 + 2304 + mrow * 256 + lane + 64 * j];
                    const f32x4 h = v[j] * (1.0f + sc) + sh;
                    o8[64 * j] = (unsigned long long)pk2(h.x, h.y) | ((unsigned long long)pk2(h.z, h.w) << 32); }
            }
        }
    }
#undef ROW_OF
#undef ROW_SRC
    __syncthreads();
}

__device__ __forceinline__ void pool_phase(const Args& a, int l, LAS unsigned char* lds, int vcu, int G, int tid) {
    typedef float f32x16 __attribute__((ext_vector_type(16)));
    const bf16* Z = (const bf16*)(a.ws + WS_Z); bf16* Y = (bf16*)(a.ws + WS_Y);
    LAS float* zt = (LAS float*)lds;
    LAS float* pl = (LAS float*)(lds + 36864);
    LAS float* wl = (LAS float*)(lds + 36864 + 33280);
    constexpr int NU = (P_M / 128) * 4;
    v4u pre[3]; f32x4 wpre[2];
#define POOL_DECODE(u_) const int tk_ = (u_) >> 2, g_ = (u_) & 3; const int row0_ = tk_ * 128; const int b_ = row0_ / P_RPB, rb0_ = row0_ - b_ * P_RPB; \
        const int slo_ = (rb0_ < P_CTX) ? b_ * P_RPB : b_ * P_RPB + P_CTX, shi_ = (rb0_ < P_CTX) ? b_ * P_RPB + P_CTX : (b_ + 1) * P_RPB;
#define POOL_ISSUE(u_) do { POOL_DECODE(u_) \
        _Pragma("unroll") for (int i = 0; i < 3; ++i) { const int e = tid + 512 * i; const int rr = e >> 3, c8 = e & 7; const int R = row0_ - 8 + rr; \
            pre[i] = (v4u){0u, 0u, 0u, 0u}; if (e < 144 * 8 && R >= slo_ && R < shi_) pre[i] = *(const v4u*)(Z + (size_t)R * P_INW + g_ * 64 + c8 * 8); } \
        const f32x4* wsrc = (const f32x4*)(a.pool_w + ((size_t)l * 4 + g_) * 4096); wpre[0] = wsrc[tid]; wpre[1] = wsrc[tid + 512]; } while (0)
    int u = vcu;
    if (u < NU) POOL_ISSUE(u);
    for (; u < NU; u += G) {
        POOL_DECODE(u)
#pragma unroll
        for (int i = 0; i < 3; ++i) { const int e = tid + 512 * i; if (e < 144 * 8) { const int rr = e >> 3, c8 = e & 7; const v4u w = pre[i]; LAS float* d = zt + rr * 64 + c8 * 8;
            *(LAS f32x4*)d = (f32x4){bf2f(w.x & 0xffff), bf2f(w.x >> 16), bf2f(w.y & 0xffff), bf2f(w.y >> 16)}; *(LAS f32x4*)(d + 4) = (f32x4){bf2f(w.z & 0xffff), bf2f(w.z >> 16), bf2f(w.w & 0xffff), bf2f(w.w >> 16)}; } }
        ((LAS f32x4*)wl)[tid] = wpre[0]; ((LAS f32x4*)wl)[tid + 512] = wpre[1];
        if (u + G < NU) POOL_ISSUE(u + G);
        __syncthreads();
        { const int c = tid & 63, t0 = (tid >> 6) * 16, hw = 1 << g_;
          float s = 0.f;
          for (int p = t0 - hw; p < t0 + hw; ++p) s += zt[(p + 8) * 64 + c];
#pragma unroll 4
          for (int k = 0; k < 16; ++k) { const int t = t0 + k, T = row0_ + t; const int lo = max(T - hw, slo_), hi = min(T + hw - 1, shi_ - 1);
              pl[t * 65 + c] = s * __builtin_amdgcn_rcpf((float)(hi - lo + 1)) - zt[(t + 8) * 64 + c];
              s += zt[(t + hw + 8) * 64 + c] - zt[(t - hw + 8) * 64 + c]; } }
        __syncthreads();
        { const int lane = tid & 63, wid = tid >> 6, r32 = lane & 31, hi = lane >> 5, tw = wid >> 1, dw = wid & 1;
          f32x16 acc;
#pragma unroll
          for (int r = 0; r < 16; ++r) acc[r] = 0.f;
          const LAS float* ap = pl + (32 * tw + r32) * 65 + hi; const LAS float* bp = wl + hi * 64 + 32 * dw + r32;
#pragma unroll 8
          for (int kk = 0; kk < 32; ++kk) acc = __builtin_amdgcn_mfma_f32_32x32x2f32(ap[2 * kk], bp[2 * kk * 64], acc, 0, 0, 0);
          const float sc = a.pool_scale[l * 256 + g_ * 64 + 32 * dw + r32];
          bf16* yp = Y + (size_t)(row0_ + 32 * tw + 4 * hi) * P_D + g_ * 64 + 32 * dw + r32;
#pragma unroll
          for (int r = 0; r < 16; ++r) yp[(size_t)((r & 3) + 8 * (r >> 2)) * P_D] = (bf16)f2bf(acc[r] * sc); }
        __syncthreads();
    }
#undef POOL_DECODE
#undef POOL_ISSUE
}

__device__ __forceinline__ void mix_phase(const Args& a, int l, unsigned char* ldsg, LAS unsigned char* lds, int vcu, int G, int tid) {
    using abf = attn_body::bf16;
    const abf* Z = (const abf*)(a.ws + WS_Z); abf* Y = (abf*)(a.ws + WS_Y);
    { LAS float* rp = (LAS float*)(lds + RPB_OFF); const float* src = a.na_rpb + (size_t)l * 6 * 465;
      for (int e = tid; e < 6 * 465; e += 512) rp[e] = src[e] * P_LOG2E; }
    __syncthreads();
#if DBG_TPROBE >= 0
#define MIXSTAMP(k) do { if (l == 1 && blockIdx.x == 0 && tid == 0) ((unsigned long long*)(a.ws + WS_TS))[k] = __builtin_amdgcn_s_memrealtime(); } while (0)
#else
#define MIXSTAMP(k) do {} while (0)
#endif
    MIXSTAMP(40);
    for (int u = vcu; u < 1536; u += G) { const int h = u >> 8, b = (u >> 5) & 7, qb = u & 31, kv = h / 3;
        const size_t brow = (size_t)b * P_RPB, qrow = brow + P_CTX + (size_t)qb * 256;
        attn_body::attn_unit<8, 0>(Z + qrow * P_INW + 1408 + 64 * h, Z + brow * P_INW + 1792 + 64 * kv, Z + brow * P_INW + 1920 + 64 * kv, Y + qrow * P_D + 640 + 64 * h, 132, 256, 0, 0, RPB_OFF, (char*)ldsg); }
    MIXSTAMP(41);
    if (DBG_NA) for (int u = vcu; u < 1536; u += G) { const int h = u >> 8, b = (u >> 5) & 7, qb = u & 31;
        const size_t brow = (size_t)b * P_RPB, qrow = brow + P_CTX + (size_t)qb * 256;
        const int rsmin = min(max(4 * qb - 4, 0), 116);
        attn_body::attn_unit<8, 1>(Z + qrow * P_INW + 256 + 64 * h, Z + brow * P_INW + 640 + 64 * h, Z + brow * P_INW + 1024 + 64 * h, Y + qrow * P_D + 256 + 64 * h, 16, 256 + 64 * rsmin, 4 * qb, rsmin, RPB_OFF + h * 465 * 4, (char*)ldsg); }
    MIXSTAMP(42);
    if (DBG_CTX && l < P_DEPTH - 1)
        for (int u = vcu - 64; u < 96; u += G) { if (u < 0) continue; const int b = u / 12, hh = u - b * 12; const size_t brow = (size_t)b * P_RPB;
            int qc, kc, vc, oc;
            if (hh < 6) { qc = 256 + 64 * hh; kc = 640 + 64 * hh; vc = 1024 + 64 * hh; oc = 256 + 64 * hh; }
            else { const int h = hh - 6; qc = 1408 + 64 * h; kc = 1792 + 64 * (h / 3); vc = 1920 + 64 * (h / 3); oc = 640 + 64 * h; }
            attn_body::attn_unit<8, 0>(Z + brow * P_INW + qc, Z + brow * P_INW + kc, Z + brow * P_INW + vc, Y + brow * P_D + oc, 4, 256, 0, 0, RPB_OFF, (char*)ldsg); }
    MIXSTAMP(43);
    if (DBG_POOL) pool_phase(a, l, lds, vcu, G, tid);
    MIXSTAMP(44);
}


#if DBG_DIAG
constexpr size_t WS_FLAG = 1 * MiB + 65536;
__device__ __forceinline__ bool vclose(float mine, float ref, float tol) {
    const float d = wave_sum((mine - ref) * (mine - ref)), n = wave_sum(ref * ref); return d <= tol * tol * n + 1e-12f; }
__device__ __forceinline__ float na_ref(const Args& a, const bf16* Z, int b, int h, int pos, int lane) {
    const size_t Rl = (size_t)b * P_RPB + P_CTX + pos; const int gr = pos >> 6, gc = pos & 63; const int rs = min(max(gr - 4, 0), 120), cs = min(max(gc - 8, 0), 48);
    float mx = -1e30f, sc[6];
    for (int i = 0; i < 6; ++i) { const int key = lane + 64 * i; size_t kr_; float bias = 0.f;
        if (key < 128) { const int kr = rs + key / 16, kc = cs + key % 16; kr_ = (size_t)b * P_RPB + P_CTX + kr * 64 + kc; bias = a.na_rpb[(size_t)h * 465 + (kr - gr + 7) * 31 + (kc - gc + 15)] * P_LOG2E; }
        else kr_ = (size_t)b * P_RPB + (key - 128);
        float s = 0.f; for (int d = 0; d < 64; ++d) s += bf2f(Z[Rl * P_INW + 256 + 64 * h + d]) * bf2f(Z[kr_ * P_INW + 640 + 64 * h + d]);
        sc[i] = s + bias; mx = fmaxf(mx, sc[i]); }
    for (int o = 1; o < 64; o <<= 1) mx = fmaxf(mx, __shfl_xor(mx, o));
    float den = 0.f; for (int i = 0; i < 6; ++i) { sc[i] = exp2f(sc[i] - mx); den += sc[i]; } den = wave_sum(den);
    float o_ = 0.f;
    for (int i = 0; i < 6; ++i) for (int l2 = 0; l2 < 64; ++l2) { const int key = l2 + 64 * i; size_t kr_;
        if (key < 128) { const int kr = rs + key / 16, kc = cs + key % 16; kr_ = (size_t)b * P_RPB + P_CTX + kr * 64 + kc; } else kr_ = (size_t)b * P_RPB + (key - 128);
        o_ += __shfl(sc[i], l2) * bf2f(Z[kr_ * P_INW + 1024 + 64 * h + lane]); }
    return o_ / den;
}
__device__ __forceinline__ float att_ref(const bf16* Z, size_t qrow, size_t krow0, int ntile, int qc, int kc, int vc, int lane) {
    float mx = -1e30f;
    for (int i = 0; i < ntile; ++i) { const size_t kr_ = krow0 + lane + 64 * i; float s = 0.f;
        for (int d = 0; d < 64; ++d) s += bf2f(Z[qrow * P_INW + qc + d]) * bf2f(Z[kr_ * P_INW + kc + d]); mx = fmaxf(mx, s); }
    for (int o = 1; o < 64; o <<= 1) mx = fmaxf(mx, __shfl_xor(mx, o));
    float den = 0.f, o_ = 0.f;
    for (int i = 0; i < ntile; ++i) { const size_t kr_ = krow0 + lane + 64 * i; float s = 0.f;
        for (int d = 0; d < 64; ++d) s += bf2f(Z[qrow * P_INW + qc + d]) * bf2f(Z[kr_ * P_INW + kc + d]);
        const float p = exp2f(s - mx); den += p;
        for (int l2 = 0; l2 < 64; ++l2) o_ += __shfl(p, l2) * bf2f(Z[(krow0 + l2 + 64 * i) * P_INW + vc + lane]); }
    return o_ / wave_sum(den);
}
__device__ __forceinline__ float pool_ref(const Args& a, const bf16* Z, size_t R, size_t slo, size_t shi, int g, int lane) {
    const int hw = 1 << g; const size_t lo = (R >= slo + hw) ? R - hw : slo, hi = (R + hw - 1 < shi) ? R + hw - 1 : shi - 1;
    float s = 0.f; for (size_t p = lo; p <= hi; ++p) s += bf2f(Z[p * P_INW + g * 64 + lane]);
    const float pooled = s / (float)(hi - lo + 1) - bf2f(Z[R * P_INW + g * 64 + lane]); float y = 0.f;
    for (int c = 0; c < 64; ++c) y += __shfl(pooled, c) * a.pool_w[(size_t)g * 4096 + c * 64 + lane];
    return y * a.pool_scale[g * 64 + lane];
}
__device__ __forceinline__ void diag_phase(const Args& a, int code, int vcu, int tid, int G) {
    unsigned char* ws = a.ws; unsigned* flag = (unsigned*)(ws + WS_FLAG);
    const bf16* Z = (const bf16*)(ws + WS_Z); const bf16* Y = (const bf16*)(ws + WS_Y);
    const int lane = tid & 63;
    if (code == 199) {
        const unsigned fl = *flag; int first = 0; for (int i = 0; i < 16; ++i) if ((fl >> i) & 1) { first = i + 1; break; }
        for (size_t i = (size_t)vcu * 512 + tid; i < (size_t)P_B * P_SEQ * P_D; i += (size_t)G * 512) a.out[i] = (float)first;
        return;
    }
    if (vcu != 0 || tid >= 64) return;
    if (code == 100) { if (lane == 0) *flag = 0u; return; }
    if (code == 102) {
        const float TOL = 0.006f;
        const int nb[5] = {0, 7, 3, 5, 2}, nh[5] = {0, 5, 2, 3, 1}, npos[5] = {0, 127 * 64 + 63, 60 * 64 + 3, 2 * 64 + 30, 64 * 64 + 31};
        for (int q = 0; q < 5; ++q) { const float r = na_ref(a, Z, nb[q], nh[q], npos[q], lane); const float m = bf2f(Y[((size_t)nb[q] * P_RPB + P_CTX + npos[q]) * P_D + 256 + 64 * nh[q] + lane]);
            if (!vclose(m, r, TOL) && lane == 0) atomicOr(flag, 1u << q); }
        const int gb[2] = {1, 7}, gh[2] = {0, 5}, gpos[2] = {100, 8191};
        for (int q = 0; q < 2; ++q) { const size_t brow = (size_t)gb[q] * P_RPB; const float r = att_ref(Z, brow + P_CTX + gpos[q], brow, 132, 1408 + 64 * gh[q], 1792 + 64 * (gh[q] / 3), 1920 + 64 * (gh[q] / 3), lane);
            const float m = bf2f(Y[(brow + P_CTX + gpos[q]) * P_D + 640 + 64 * gh[q] + lane]); if (!vclose(m, r, TOL) && lane == 0) atomicOr(flag, 1u << (5 + q)); }
        { const size_t brow = (size_t)1 * P_RPB; const float r = att_ref(Z, brow + 200, brow, 4, 256 + 64 * 3, 640 + 64 * 3, 1024 + 64 * 3, lane); const float m = bf2f(Y[(brow + 200) * P_D + 256 + 64 * 3 + lane]);
          if (!vclose(m, r, TOL) && lane == 0) atomicOr(flag, 1u << 7); }
        { const size_t brow = (size_t)6 * P_RPB; const float r = att_ref(Z, brow + 17, brow, 4, 1408 + 64 * 4, 1792 + 64 * 1, 1920 + 64 * 1, lane); const float m = bf2f(Y[(brow + 17) * P_D + 640 + 64 * 4 + lane]);
          if (!vclose(m, r, TOL) && lane == 0) atomicOr(flag, 1u << 8); }
        { const size_t brow = (size_t)4 * P_RPB; const size_t R = brow + P_CTX; const float r = pool_ref(a, Z, R, brow + P_CTX, brow + P_RPB, 0, lane); if (!vclose(bf2f(Y[R * P_D + lane]), r, TOL) && lane == 0) atomicOr(flag, 1u << 9); }
        { const size_t brow = (size_t)7 * P_RPB; const size_t R = brow + P_RPB - 1; const float r = pool_ref(a, Z, R, brow + P_CTX, brow + P_RPB, 3, lane); if (!vclose(bf2f(Y[R * P_D + 192 + lane]), r, TOL) && lane == 0) atomicOr(flag, 1u << 10); }
        { const size_t brow = (size_t)3 * P_RPB; const size_t R = brow + 255; const float r = pool_ref(a, Z, R, brow, brow + P_CTX, 2, lane); if (!vclose(bf2f(Y[R * P_D + 128 + lane]), r, TOL) && lane == 0) atomicOr(flag, 1u << 11); }
    }
}
#endif

__global__ void __launch_bounds__(512, 2) mega(Args a) {
    extern __shared__ __attribute__((aligned(16))) unsigned char ldsraw[];
    LAS unsigned char* lds = (LAS unsigned char*)ldsraw;
    cg::grid_group grid = cg::this_grid();
    const int G = gridDim.x; const int bx = blockIdx.x; const int vcu = (G % 8 == 0) ? (bx % 8) * (G / 8) + bx / 8 : bx;
    const int ph_lo = a.ph_lo, ph_hi = a.ph_hi;
    volatile LAS unsigned* barst = (volatile LAS unsigned*)(lds + BARST_OFF);
    if (threadIdx.x < 2) barst[threadIdx.x] = 0u;
    if (ph_lo == 0 && blockIdx.x == 0) { unsigned* bw = (unsigned*)(a.ws + WS_BAR); for (int i = threadIdx.x; i < XCD_BAR_WORDS; i += 512) bw[i] = 0u; }
    __syncthreads();
    XcdBarrier xbar; xbar.bar = (unsigned*)(a.ws + WS_BAR); xbar.x = 0; xbar.st = barst;
    for (int ph_ = ph_lo; ph_ < ph_hi; ++ph_) {
        const int ph = (ph_ < 2 * DBG_P0REP) ? (ph_ & 1) : ph_ - 2 * DBG_P0REP;
        if (ph >= 2 && ph < 100 && (ph - 2) / PH_PER_L == P_DEPTH - 1 && ((ph - 2) % PH_PER_L == 4 || (ph - 2) % PH_PER_L == 8)) continue;
        if (ph_ > ph_lo) {
            if (ph_ == ph_lo + 1) { grid.sync(); xbar = xcd_barrier_post((unsigned*)(a.ws + WS_BAR), barst); }
            else xcd_barrier(xbar);
        }
        const int tid = ltid(), lane = tid & 63, wave = __builtin_amdgcn_readfirstlane(tid >> 6);
#if DBG_TPROBE >= 0
        if (blockIdx.x == 0 && tid == 0) ((unsigned long long*)(a.ws + WS_TS))[ph] = __builtin_amdgcn_s_memrealtime();
#endif
        Args q;
        ARGF(q, ws); unsigned char* ws = q.ws;
#if DBG_DIAG
        if (ph >= 100) { q = a; diag_phase(q, ph, vcu, tid, G); continue; }
#endif
        if (ph == 0) { ARGF(q, c); ARGF(q, c_ctx); ARGF(q, w_mod); ARGF(q, b_mod); phase0(q, lds, vcu, G, tid, lane, wave); continue; }
        if (ph == 1) { ARGF(q, x); ARGF(q, ctx); ARGF(q, w_in); ARGF(q, w_out); ARGF(q, w_up); ARGF(q, w_down); row_phase<0>(q, 0, 0, 0, bx, vcu, G, wave, lane, lds); phase_weights(q, lds, vcu, G, tid, lane, wave); continue; }
        const int l = (ph - 2) / PH_PER_L, sp = (ph - 2) % PH_PER_L; const bool lastL = (l == P_DEPTH - 1);
        if (sp == 0) {
            ARGF(q, q_norm); ARGF(q, k_norm);
            pg8::Gemm g{(const pg8::bf16_t*)(ws + WS_H), (const pg8::bf16_t*)(ws + WS_WIN) + (size_t)l * P_INW * P_D, P_M, P_INW, P_D};
            pg8::StaticOrder S; S.init(P_M / 256, P_INW / 256, G, bx);
            { LAS float* tab = (LAS float*)(lds + ROPE_OFF); const float* rc = (const float*)(ws + WS_ROPEC); const float* rs = (const float*)(ws + WS_ROPES);
              for (int e2 = tid; e2 < 1024; e2 += 512) { tab[e2] = rc[e2]; tab[1024 + e2] = rs[e2]; }
              if (tid < 64) { tab[2048 + tid] = q.q_norm[l * 64 + tid]; tab[2112 + tid] = q.k_norm[l * 64 + tid]; }
              __syncthreads(); }
            pg8::EpiIn E{(pg8::bf16_t*)(ws + WS_Z), (const float*)(ws + WS_ROPEC), (const float*)(ws + WS_ROPES), (LAS float*)(lds + ROPE_OFF)};
            pg8::gemm_phase<pg8::EpiIn, pg8::StaticOrder, true, true, 0>(lds, g, S, E);
        } else if (sp == 1) {
            ARGF(q, na_rpb); ARGF(q, pool_w); ARGF(q, pool_scale);
            mix_phase(q, l, ldsraw, lds, vcu, G, tid);
        } else if (sp == 5) {
            ARGF(q, conv_w); ARGF(q, conv_b);
            pg8::Gemm g{(const pg8::bf16_t*)(ws + WS_H) - P_D, (const pg8::bf16_t*)(ws + WS_WUP) + (size_t)l * P_UPW * P_D, P_M, P_UPW, P_D};
            pg8::StaticOrder S; S.init((P_M + 247) / 248, P_UPW / 256, G, bx);
            pg8::EpiUp E{(pg8::bf16_t*)(ws + WS_ACT), q.conv_w + (size_t)l * 3 * P_UPW, q.conv_b + (size_t)l * P_UPW, (LAS float*)(lds + PAR_OFF)};
            pg8::gemm_phase<pg8::EpiUp, pg8::StaticOrder, true, true, 1>(lds, g, S, E);
        } else {
            const bool isdown = sp >= 6, ctxpart = (sp == 3 || sp == 7);
            ARGF(q, ln1_g); ARGF(q, ln1_b); ARGF(q, ln2_g); ARGF(q, ln2_b);
            if (sp == 2 || sp == 6 || (ctxpart && !lastL)) {
                ARGF(q, x); ARGF(q, ctx);
                const bool first = (!isdown && l == 0);
                pg8::Gemm g{(const pg8::bf16_t*)(ws + (isdown ? WS_ACT : WS_Y)), isdown ? (const pg8::bf16_t*)(ws + WS_WDN) + (size_t)l * P_D * P_DFF : (const pg8::bf16_t*)(ws + WS_WOUT) + (size_t)l * P_D * P_D, P_M, P_D, isdown ? P_DFF : P_D};
                pg8::StaticOrder S; S.init(P_B * P_SEQ / 256, P_D / 256, G, bx); S.skipctx = 1; S.ctxonly = ctxpart ? 1 : 0;
                pg8::EpiRes E{(float*)(ws + WS_X), (const float*)(ws + WS_MOD) + (size_t)l * 9 * P_MODW + (isdown ? 5 : 2) * P_D, (const float*)(ws + WS_ST),
                              first ? nullptr : (isdown ? q.ln1_g + l * P_D : q.ln2_g + (l - 1) * P_D), first ? nullptr : (isdown ? q.ln1_b + l * P_D : q.ln2_b + (l - 1) * P_D), q.x, q.ctx, (LAS float*)(lds + PAR_OFF)};
                pg8::gemm_phase<pg8::EpiRes, pg8::StaticOrder, true, true, 0>(lds, g, S, E);
            }
            if (sp == 3 || (sp == 4 && !lastL)) row_phase<1>(q, l, sp == 3 ? 1 : 2, lastL ? P_B * P_SEQ : N1_OUT, bx, vcu, G, wave, lane, lds);
            if (sp == 7 || (sp == 8 && !lastL)) { ARGF(q, out); row_phase<2>(q, l, sp == 7 ? 1 : 2, lastL ? P_B * P_SEQ : N1_DOWN, bx, vcu, G, wave, lane, lds); }
        }
    }
}

#ifndef MK_MULTI
#define MK_MULTI 0
#endif
extern "C" void kernel_launch(void* const* d_in, const int* in_sizes, int n_in, void* d_out, int out_size, void* d_ws, size_t ws_size, hipStream_t stream) {
    static int grid = 0;
    if (grid == 0) {
        if (n_in != 21 || ws_size < WS_END) { fprintf(stderr, "kernel_launch: unexpected n_in %d / ws_size %zu\n", n_in, ws_size); grid = -1; return; }
        int dev = 0, cus = 0, per_cu = 0;
        if (hipGetDevice(&dev) != hipSuccess || hipDeviceGetAttribute(&cus, hipDeviceAttributeMultiprocessorCount, dev) != hipSuccess) { grid = -1; return; }
        if (hipFuncSetAttribute((const void*)mega, hipFuncAttributeMaxDynamicSharedMemorySize, LDS_BYTES) != hipSuccess) { fprintf(stderr, "kernel_launch: hipFuncSetAttribute failed\n"); grid = -1; return; }
        if (hipOccupancyMaxActiveBlocksPerMultiprocessor(&per_cu, (const void*)mega, 512, LDS_BYTES) != hipSuccess || per_cu < 1) { fprintf(stderr, "kernel_launch: occupancy query says %d\n", per_cu); per_cu = 1; }
        (void)hipGetLastError();
        grid = cus * 1;
        fprintf(stderr, "kernel_launch: cus %d per_cu %d grid %d\n", cus, per_cu, grid);
    }
    if (grid < 0) return;
    Args a{};
    const float** f = (const float**)&a;
    for (int i = 0; i < 21; ++i) f[i] = (const float*)d_in[i];
    a.out = (float*)d_out; a.ws = (unsigned char*)d_ws;
#if MK_MULTI
#if DBG_DIAG
    { const int seq[] = {0, 1, 100, 2, 3, 102, 199};
      for (int i = 0; i < 7; ++i) { a.ph_lo = seq[i]; a.ph_hi = seq[i] + 1; hipLaunchKernelGGL(mega, dim3(grid), dim3(512), LDS_BYTES, stream, a); } }
#else
    for (int ph = 0; ph < N_PHASES; ++ph) { a.ph_lo = ph; a.ph_hi = ph + 1; hipLaunchKernelGGL(mega, dim3(grid), dim3(512), LDS_BYTES, stream, a); }
#endif
#else
    a.ph_lo = 0; a.ph_hi = N_PHASES;
    void* args[] = {&a};
    hipError_t e = hipLaunchCooperativeKernel((const void*)mega, dim3(grid), dim3(512), args, LDS_BYTES, stream);
    if (e != hipSuccess) fprintf(stderr, "cooperative launch failed: %s (grid %d)\n", hipGetErrorString(e), grid);
#endif
}
```

```cpp
#include <hip/hip_runtime.h>
#include <hip/hip_cooperative_groups.h>
#include <cstdio>
#include <cstdint>
constexpr int P_D = 1024, P_B = 8, P_SEQ = 8192, P_CTX = 256, P_RPB = P_SEQ + P_CTX  , P_M = P_B * P_RPB  ;
constexpr int P_DEPTH = 4, P_INW = 2048, P_DFF = 2816, P_UPW = 2 * P_DFF, P_MODW = 6 * P_D;
constexpr float P_C2 = 0.125f * 1.4426950408889634f;
constexpr float P_LOG2E = 1.4426950408889634f;
constexpr float P_ALPHA = 1.681792830507429f;
constexpr float P_EPS = 1e-6f;
__device__ __forceinline__ int ltid() { int t = threadIdx.x; asm volatile("" : "+v"(t)); return t; }
namespace pg8 {
#define PG8_LAS __attribute__((address_space(3)))
typedef unsigned short bf16_t;
typedef short bf16x8 __attribute__((ext_vector_type(8)));
typedef float f32x4 __attribute__((ext_vector_type(4)));
typedef unsigned u32x4 __attribute__((ext_vector_type(4)));
constexpr int BM = 256, BK = 64, HALF = 128, HTB = HALF * BK * 2  , STAGE_BYTES = 8 * HTB, NXCD = 8, WGM = 8;

__host__ __device__ __forceinline__ int lds_byte(int r, int c) { const int st = (r >> 4) * 2 + (c >> 5), rr = r & 15, cc = c & 31, ob = rr * 64 + cc * 2; return st * 1024 + (ob ^ (((ob >> 9) & 1) << 5)); }
__host__ __device__ __forceinline__ void stage_rc(int b, int& R, int& C) { const int st = b / 1024, sb = b % 1024, swz = sb ^ (((sb >> 9) & 1) << 5); R = (st >> 1) * 16 + swz / 64; C = (st & 1) * 32 + (swz % 64) / 2; }
__host__ __device__ __forceinline__ int perm32(int rho) { const int n = rho >> 4, i = rho & 15; return 8 * (i >> 2) + 4 * n + (i & 3); }

struct Unit { int pm, pn; };
struct Gemm { const bf16_t* A; const bf16_t* Bt; int M, N, K; };

struct StaticOrder {
    int nM, nN, nwg, G, c, skipctx = 0, ctxonly = 0;
    __host__ __device__ void init(int nM_, int nN_, int G_, int c_) { nM = nM_; nN = nN_; nwg = nM * nN; G = G_; c = c_; }
    __host__ __device__ bool next(int i, Unit& u) const {
        if (ctxonly) { if (i > 0 || c >= 32) return false; u.pm = (c >> 2) * 33; u.pn = c & 3; return true; }
        const long L = (long)i * G + c; if (L >= nwg) return false;
        int wgid = (int)L; { const int q = nwg / NXCD, r = nwg % NXCD, xcd = wgid % NXCD, off = wgid / NXCD; wgid = (xcd < r ? xcd * (q + 1) : r * (q + 1) + (xcd - r) * q) + off; }
        const int nig = WGM * nN, gid = wgid / nig, fm = gid * WGM, gsz = (nM - fm) < WGM ? (nM - fm) : WGM;
        u.pm = fm + ((wgid % nig) % gsz); u.pn = (wgid % nig) / gsz; if (skipctx) u.pm += (u.pm >> 5) + 1; return true;
    }
    __device__ __forceinline__ void a_ready(const Unit&) const {}
    __device__ __forceinline__ void done(const Unit&) const {}
};

__device__ __forceinline__ unsigned cvt_pk_bf16(float lo, float hi) { unsigned r; asm volatile("v_cvt_pk_bf16_f32 %0, %1, %2" : "=v"(r) : "v"(lo), "v"(hi)); return r; }
#ifndef EPI_SHFL
#define EPI_SHFL 0
#endif
typedef float f32x2 __attribute__((ext_vector_type(2)));
__device__ __forceinline__ f32x4 dppror(const f32x4 v, const bool up) {
    f32x4 r;
#if EPI_SHFL
    const int lane = threadIdx.x & 63; const int src = (lane & ~15) | ((lane + (up ? 15 : 1)) & 15);
#pragma unroll
    for (int j = 0; j < 4; ++j) r[j] = __shfl(v[j], src);
#else
#pragma unroll
    for (int j = 0; j < 4; ++j) { const float xs = v[j]; const int iv = __float_as_int(xs);
        r[j] = __int_as_float(up ? __builtin_amdgcn_mov_dpp(iv, 0x121, 0xf, 0xf, true) : __builtin_amdgcn_mov_dpp(iv, 0x12F, 0xf, 0xf, true)); }
#endif
    return r;
}
struct EpiIn {
    static constexpr bool PERM = false, AFTER_DRAIN = false;
    bf16_t* Z; const float* rc; const float* rs; PG8_LAS float* tab;
    __device__ __forceinline__ void operator()(const f32x4 (&acc)[2][2][4][2], const Unit& u, int wr, int wc, int fr, int fq) const {
        asm volatile("" : "+v"(fr), "+v"(fq));
        const int hs = u.pn * 4 + wc;
        const bool isq = (hs >= 22 && hs < 28), isk = (hs == 28 || hs == 29);
        const float sc = ((hs >= 4 && hs < 10) || isq) ? P_C2 : 1.f;
        const int tb = u.pm % 33; const bool is_ctx = (tb == 0);
        if (u.pn >= 5 && !is_ctx) {
            const int tid = ltid();
            if (tid < 64) { tab[2176 + tid] = rc[(tb - 1) * 64 + tid]; tab[2240 + tid] = rs[(tb - 1) * 64 + tid]; }
            asm volatile("s_waitcnt lgkmcnt(0)" ::: "memory"); __builtin_amdgcn_s_barrier(); asm volatile("" ::: "memory"); }
#pragma unroll
        for (int ai = 0; ai < 2; ++ai)
#pragma unroll
            for (int m = 0; m < 4; ++m) {
                const int rt = ai * HALF + wr * 64 + m * 16 + fr;
                const size_t row = (size_t)u.pm * BM + rt;
                f32x4 v[2][2];
#pragma unroll
                for (int bj = 0; bj < 2; ++bj)
#pragma unroll
                    for (int n = 0; n < 2; ++n) v[bj][n] = acc[ai][bj][m][n];
                if (isq || isk) {
                    float ss = 0.f;
#pragma unroll
                    for (int bj = 0; bj < 2; ++bj)
#pragma unroll
                        for (int n = 0; n < 2; ++n) { const f32x4 x = v[bj][n]; ss += (x[0] * x[0] + x[1] * x[1]) + (x[2] * x[2] + x[3] * x[3]); }
                    ss += __shfl_xor(ss, 16); ss += __shfl_xor(ss, 32);
                    const float rstd = __builtin_amdgcn_rsqf(ss * (1.0f / 64.0f) + P_EPS);
                    const PG8_LAS float* gp = tab + (isq ? 2048 : 2112) + 4 * fq;
                    const int pos = (tb - 1) * BM + rt; const int gr = pos >> 6, gc = pos & 63;
#pragma unroll
                    for (int bj = 0; bj < 2; ++bj) {
                        const f32x4 g0 = *(const PG8_LAS f32x4*)(gp + 32 * bj), g1 = *(const PG8_LAS f32x4*)(gp + 32 * bj + 16);
                        f32x4 x1 = v[bj][0] * rstd * g0, x2 = v[bj][1] * rstd * g1;
                        if (!is_ctx) { const PG8_LAS float* tp = bj ? tab + gc * 16 + 4 * fq : tab + 2176 + (rt >> 6) * 16 + 4 * fq;
                            const f32x4 cs = *(const PG8_LAS f32x4*)tp, sn = *(const PG8_LAS f32x4*)(tp + (bj ? 1024 : 64));
                            const f32x4 y1 = x1 * cs - x2 * sn, y2 = x1 * sn + x2 * cs; x1 = y1; x2 = y2; }
                        v[bj][0] = x1; v[bj][1] = x2;
                    }
                }
                bf16_t* zp = Z + row * P_INW + hs * 64 + 4 * fq;
#pragma unroll
                for (int bj = 0; bj < 2; ++bj)
#pragma unroll
                    for (int n = 0; n < 2; ++n) { const f32x4 x = v[bj][n] * sc; unsigned long long w = (unsigned long long)cvt_pk_bf16(x[0], x[1]) | ((unsigned long long)cvt_pk_bf16(x[2], x[3]) << 32);
                        *(unsigned long long*)(zp + 32 * bj + 16 * n) = w; }
                asm volatile("" ::: "memory");
            }
    }
};
struct EpiRes {
    static constexpr bool PERM = false, AFTER_DRAIN = false;
    float* X; const float* gate;
    const float* st; const float* lg; const float* lb; const float* xin; const float* cin; PG8_LAS float* par;
    __device__ __forceinline__ void operator()(const f32x4 (&acc)[2][2][4][2], const Unit& u, int wr, int wc, int fr, int fq) const {
        asm volatile("" : "+v"(fr), "+v"(fq));
        const int tid = ltid(); const int wv = __builtin_amdgcn_readfirstlane(tid >> 6);
        const int b = u.pm / 33, tb = u.pm % 33; const int mrow = tb == 0 ? 8 : b;
        const int col0 = u.pn * BM + wc * 32 + 4 * fq;
        const bool ident = (lg == nullptr);
        const float* rbase = ident ? (tb == 0 ? cin + (size_t)b * P_CTX * P_D : xin + ((size_t)b * P_SEQ + (size_t)(tb - 1) * BM) * P_D) : X + (size_t)u.pm * BM * P_D;
        if (wv < 3) { const int c4 = (tid & 63) * 4; const int gc = u.pn * BM + c4; f32x4 pv;
            if (wv == 0) pv = ident ? (f32x4){P_ALPHA, P_ALPHA, P_ALPHA, P_ALPHA} : *(const f32x4*)(lg + gc) * P_ALPHA;
            else if (wv == 1) pv = ident ? (f32x4){0.f, 0.f, 0.f, 0.f} : *(const f32x4*)(lb + gc) * P_ALPHA;
            else pv = *(const f32x4*)(gate + mrow * P_MODW + gc);
            *(PG8_LAS f32x4*)(par + wv * 256 + c4) = pv; }
        f32x4 tq[3][4]; f32x2 sq[3];
#define ERES_LOAD(it_) do { const int rt_ = ((it_) >> 2) * HALF + wr * 64 + ((it_) & 3) * 16 + fr; const float* xr_ = rbase + (size_t)rt_ * P_D + col0; \
            _Pragma("unroll") for (int bj = 0; bj < 2; ++bj) _Pragma("unroll") for (int n = 0; n < 2; ++n) tq[(it_) % 3][bj * 2 + n] = *(const f32x4*)(xr_ + bj * HALF + n * 16); \
            sq[(it_) % 3] = ident ? (f32x2){0.f, 1.f} : *(const f32x2*)(st + ((size_t)u.pm * BM + rt_) * 2); } while (0)
        ERES_LOAD(0); ERES_LOAD(1);
        asm volatile("s_waitcnt lgkmcnt(0)" ::: "memory"); __builtin_amdgcn_s_barrier(); asm volatile("" ::: "memory");
        const int cl = wc * 32 + 4 * fq;
#pragma unroll
        for (int it = 0; it < 8; ++it) { const int ai = it >> 2, m = it & 3; const int rt = ai * HALF + wr * 64 + m * 16 + fr;
            if (it + 2 < 8) ERES_LOAD(it + 2);
            float* xw = X + ((size_t)u.pm * BM + rt) * P_D + col0;
            const float mean = sq[it % 3][0], rstd = sq[it % 3][1];
#pragma unroll
            for (int bj = 0; bj < 2; ++bj)
#pragma unroll
                for (int n = 0; n < 2; ++n) { const int co = cl + bj * HALF + n * 16;
                    const f32x4 A4 = *(const PG8_LAS f32x4*)(par + co), B4 = *(const PG8_LAS f32x4*)(par + 256 + co), G4 = *(const PG8_LAS f32x4*)(par + 512 + co);
                    f32x4 xo = tq[it % 3][bj * 2 + n];
                    xo = ((xo - mean) * rstd) * A4 + B4 + G4 * acc[ai][bj][m][n]; *(f32x4*)(xw + bj * HALF + n * 16) = xo; }
            asm volatile("" ::: "memory"); }
#undef ERES_LOAD
    }
};
struct EpiUp {
    static constexpr bool PERM = true, AFTER_DRAIN = false;
    bf16_t* ACT; const float* cw; const float* cb; PG8_LAS float* tab;
    __device__ __forceinline__ void operator()(const f32x4 (&acc)[2][2][4][2], const Unit& u, int wr, int wc, int fr, int fq) const {
        asm volatile("" : "+v"(fr), "+v"(fq));
        { const int tid = ltid();
          if (tid < 256) { const int arr = tid >> 5, c4 = (tid & 31) * 4, k3 = arr & 3; const float* src = (k3 < 3 ? cw + k3 * P_UPW : cb) + (arr >> 2) * P_DFF + u.pn * 128 + c4;
              *(PG8_LAS f32x4*)(tab + arr * 128 + c4) = *(const f32x4*)src; }
          asm volatile("s_waitcnt lgkmcnt(0)" ::: "memory"); __builtin_amdgcn_s_barrier(); asm volatile("" ::: "memory"); }
#pragma unroll
        for (int n = 0; n < 2; ++n) {
            const int ch = u.pn * 128 + wc * 32 + 8 * fq + 4 * n; const PG8_LAS float* tp = tab + wc * 32 + 8 * fq + 4 * n;
            const f32x4 wa0 = *(const PG8_LAS f32x4*)(tp), wa1 = *(const PG8_LAS f32x4*)(tp + 128), wa2 = *(const PG8_LAS f32x4*)(tp + 256), ba = *(const PG8_LAS f32x4*)(tp + 384);
            const f32x4 wg0 = *(const PG8_LAS f32x4*)(tp + 512), wg1 = *(const PG8_LAS f32x4*)(tp + 640), wg2 = *(const PG8_LAS f32x4*)(tp + 768), bg = *(const PG8_LAS f32x4*)(tp + 896);
#pragma unroll
            for (int ai = 0; ai < 2; ++ai) {
                const int Rb = u.pm * 248 - 1 + (2 * ai + wr) * 62;
                f32x4 ra_prev = (f32x4){0.f, 0.f, 0.f, 0.f}, rg_prev = ra_prev;
                f32x4 la_cur = dppror(acc[ai][0][0][n], false), lg_cur = dppror(acc[ai][1][0][n], false);
#pragma unroll
                for (int m = 0; m < 4; ++m) {
                    const f32x4 va = acc[ai][0][m][n], vg = acc[ai][1][m][n];
                    const f32x4 ra_cur = dppror(va, true), rg_cur = dppror(vg, true);
                    f32x4 la_next = la_cur, lg_next = lg_cur;
                    if (m < 3) { la_next = dppror(acc[ai][0][m < 3 ? m + 1 : 3][n], false); lg_next = dppror(acc[ai][1][m < 3 ? m + 1 : 3][n], false); }
                    const int i = 16 * m + fr; const int R = Rb + i;
                    const int rbm = R - (R / P_RPB) * P_RPB;
                    const bool first = (rbm == 0) || (rbm == P_CTX), last = (rbm == P_CTX - 1) || (rbm == P_RPB - 1);
                    f32x4 upa = (fr == 0) ? ra_prev : ra_cur, upg = (fr == 0) ? rg_prev : rg_cur;
                    f32x4 dna = (fr == 15) ? la_next : la_cur, dng = (fr == 15) ? lg_next : lg_cur;
                    const f32x4 z4 = (f32x4){0.f, 0.f, 0.f, 0.f};
                    if (first) { upa = z4; upg = z4; }
                    if (last) { dna = z4; dng = z4; }
                    const f32x4 av = wa0 * upa + wa1 * va + wa2 * dna + ba;
                    const f32x4 gv = wg0 * upg + wg1 * vg + wg2 * dng + bg;
                    f32x4 o;
#pragma unroll
                    for (int j = 0; j < 4; ++j) o[j] = av[j] * gv[j] * __builtin_amdgcn_rcpf(1.0f + __expf(-gv[j]));
                    unsigned long long w = (unsigned long long)cvt_pk_bf16(o[0], o[1]) | ((unsigned long long)cvt_pk_bf16(o[2], o[3]) << 32);
                    asm volatile("" : "+v"(w));
                    if (i >= 1 && i <= 62 && R < P_M) *(unsigned long long*)(ACT + (size_t)R * P_DFF + ch) = w;
                    ra_prev = ra_cur; rg_prev = rg_cur; la_cur = la_next; lg_cur = lg_next;
                }
            }
        }
    }
};

template <class Epi, class Sched, bool ALIGN_EPI = false, bool SP2 = false, int AMODE = 0>
__device__ __forceinline__ void gemm_phase(PG8_LAS unsigned char* lds, const Gemm g, const Sched& S, const Epi& E) {
    const int tid = ltid(), wid = __builtin_amdgcn_readfirstlane(tid >> 6), lane = tid & 63, wr = wid >> 2, wc = wid & 3, fr = lane & 15, fq = lane >> 4;
    const int K = g.K, nt = K / BK;
    unsigned voffA[2], voffB[2];
#pragma unroll
    for (int i = 0; i < 2; ++i) { int R, C; stage_rc(tid * 16 + i * 8192, R, C); const int Rb = Epi::PERM ? ((R & ~31) + perm32(R & 31)) : R;
        voffA[i] = (unsigned)((AMODE ? ((R >> 6) * 62 + (R & 63)) : R) * K + C) * 2u; voffB[i] = (unsigned)(Rb * K + C) * 2u; }
    const size_t kstep = (size_t)(BK * 2);
    const size_t hstepB = (size_t)HALF * K * 2; const size_t hstepA = (size_t)(AMODE ? 124 : HALF) * K * 2;
    const size_t tstepB = 2 * hstepB; const size_t tstepA = 2 * hstepA;
    const unsigned ldsw = (unsigned)wid * 1024u;
    const int aoff = lds_byte(wr * 64 + fr, fq * 8), boff = lds_byte(wc * 32 + fr, fq * 8);
#define PG8_SA(b, h) (((b) * 2 + (h)) * HTB)
#define PG8_SB(b, h) ((4 + (b) * 2 + (h)) * HTB)
#define PG8_STAGE(bufoff, gbase, voff) do { _Pragma("unroll") for (int _i = 0; _i < 2; ++_i) \
        __builtin_amdgcn_global_load_lds((const unsigned*)((const char*)(gbase) + (voff)[_i]), (PG8_LAS unsigned*)(lds + (bufoff) + ldsw + _i * 8192), 16, 0, 0); } while (0)
#define PG8_LDA(dst, b, h) do { _Pragma("unroll") for (int m = 0; m < 4; ++m) _Pragma("unroll") for (int k = 0; k < 2; ++k) dst[m][k] = *(const PG8_LAS bf16x8*)(lds + PG8_SA(b, h) + aoff + m * 2048 + k * 1024); } while (0)
#define PG8_LDB(dst, b, h) do { _Pragma("unroll") for (int n = 0; n < 2; ++n) _Pragma("unroll") for (int k = 0; k < 2; ++k) dst[n][k] = *(const PG8_LAS bf16x8*)(lds + PG8_SB(b, h) + boff + n * 2048 + k * 1024); } while (0)
#define PG8_MMA(ai, bj, At, Bt) do { __builtin_amdgcn_s_setprio(1); _Pragma("unroll") for (int m = 0; m < 4; ++m) _Pragma("unroll") for (int n = 0; n < 2; ++n) _Pragma("unroll") for (int k = 0; k < 2; ++k) \
        acc[ai][bj][m][n] = __builtin_amdgcn_mfma_f32_16x16x32_bf16(Bt[n][k], At[m][k], acc[ai][bj][m][n], 0, 0, 0); __builtin_amdgcn_s_setprio(0); } while (0)
#define PG8_WAIT_V(n) asm volatile("s_waitcnt vmcnt(" #n ")" ::: "memory")
#define PG8_WAIT_L(n) asm volatile("s_waitcnt lgkmcnt(" #n ")" ::: "memory")
#define PG8_BAR __builtin_amdgcn_s_barrier()
#define PG8_SCHED __builtin_amdgcn_sched_barrier(0)
    Unit cur, nxt; int ui = 0;
    if (!S.next(0, cur)) return;
    f32x4 acc[2][2][4][2];
#pragma unroll
    for (int a = 0; a < 2; ++a)
#pragma unroll
        for (int b = 0; b < 2; ++b)
#pragma unroll
            for (int m = 0; m < 4; ++m)
#pragma unroll
                for (int n = 0; n < 2; ++n) acc[a][b][m][n] = (f32x4){0.f, 0.f, 0.f, 0.f};
    bf16x8 At[4][2], B0[2][2], B1[2][2];
    const char* cA = (const char*)g.A + (size_t)cur.pm * tstepA; const char* cB = (const char*)g.Bt + (size_t)cur.pn * tstepB;
    S.a_ready(cur);
    if constexpr (SP2) {
        PG8_STAGE(PG8_SB(0, 0), cB, voffB); PG8_STAGE(PG8_SB(0, 1), cB + hstepB, voffB); PG8_STAGE(PG8_SA(0, 0), cA, voffA); PG8_STAGE(PG8_SA(0, 1), cA + hstepA, voffA);
        if (wr == 1) PG8_BAR;
        PG8_WAIT_V(2); PG8_BAR;
        PG8_STAGE(PG8_SB(1, 0), cB + kstep, voffB); PG8_STAGE(PG8_SA(1, 0), cA + kstep, voffA); PG8_STAGE(PG8_SB(1, 1), cB + hstepB + kstep, voffB);
        PG8_WAIT_V(6); PG8_BAR;
    } else {
        PG8_STAGE(PG8_SB(0, 0), cB, voffB); PG8_STAGE(PG8_SA(0, 0), cA, voffA); PG8_STAGE(PG8_SB(0, 1), cB + hstepB, voffB); PG8_STAGE(PG8_SA(0, 1), cA + hstepA, voffA);
        if (wr == 1) PG8_BAR;
        PG8_WAIT_V(4); PG8_BAR;
        PG8_STAGE(PG8_SB(1, 0), cB + kstep, voffB); PG8_STAGE(PG8_SA(1, 0), cA + kstep, voffA); PG8_STAGE(PG8_SB(1, 1), cB + hstepB + kstep, voffB);
        PG8_WAIT_V(6); PG8_BAR;
    }
    for (;;) {
        const bool has_next = S.next(ui + 1, nxt);
        const char* nA = has_next ? (const char*)g.A + (size_t)nxt.pm * tstepA : cA; const char* nB = has_next ? (const char*)g.Bt + (size_t)nxt.pn * tstepB : cB;
        for (int t = 0; t < nt; t += 2) {
            const bool last = (t == nt - 2);
            const char* a1 = cA + (size_t)(t + 1) * kstep;
            const char* a2 = last ? nA : cA + (size_t)(t + 2) * kstep; const char* b2 = last ? nB : cB + (size_t)(t + 2) * kstep;
            const char* a3 = a2 + kstep; const char* b3 = b2 + kstep;
            if (last && has_next) S.a_ready(nxt);
            if constexpr (SP2) {
            PG8_LDB(B0, 0, 0); PG8_LDB(B1, 0, 1); PG8_SCHED; PG8_LDA(At, 0, 0); PG8_STAGE(PG8_SA(1, 1), a1 + hstepA, voffA);
            PG8_WAIT_V(8); PG8_WAIT_L(0); PG8_BAR; PG8_MMA(0, 0, At, B0); PG8_MMA(0, 1, At, B1); PG8_BAR; PG8_SCHED;
            PG8_LDA(At, 0, 1); PG8_STAGE(PG8_SB(0, 0), b2, voffB); PG8_STAGE(PG8_SB(0, 1), b2 + hstepB, voffB); PG8_STAGE(PG8_SA(0, 0), a2, voffA);
            PG8_WAIT_V(8); PG8_WAIT_L(0); PG8_BAR; PG8_MMA(1, 0, At, B0); PG8_MMA(1, 1, At, B1); PG8_BAR; PG8_SCHED;
            PG8_LDB(B0, 1, 0); PG8_LDB(B1, 1, 1); PG8_SCHED; PG8_LDA(At, 1, 0); PG8_STAGE(PG8_SA(0, 1), a2 + hstepA, voffA);
            PG8_WAIT_V(8); PG8_WAIT_L(0); PG8_BAR; PG8_MMA(0, 0, At, B0); PG8_MMA(0, 1, At, B1); PG8_BAR; PG8_SCHED;
            PG8_LDA(At, 1, 1); PG8_STAGE(PG8_SB(1, 0), b3, voffB); PG8_STAGE(PG8_SB(1, 1), b3 + hstepB, voffB); PG8_STAGE(PG8_SA(1, 0), a3, voffA);
            PG8_WAIT_V(8); PG8_WAIT_L(0); PG8_BAR; PG8_MMA(1, 0, At, B0); PG8_MMA(1, 1, At, B1); PG8_BAR; PG8_SCHED;
            } else {
            PG8_LDB(B0, 0, 0); PG8_SCHED; PG8_LDA(At, 0, 0); PG8_STAGE(PG8_SA(1, 1), a1 + hstepA, voffA);
            PG8_WAIT_L(8); PG8_BAR; PG8_WAIT_L(0); PG8_MMA(0, 0, At, B0); PG8_BAR; PG8_SCHED;
            PG8_LDB(B1, 0, 1); PG8_STAGE(PG8_SB(0, 0), b2, voffB);
            PG8_BAR; PG8_WAIT_L(0); PG8_MMA(0, 1, At, B1); PG8_BAR;
            PG8_LDA(At, 0, 1); PG8_STAGE(PG8_SA(0, 0), a2, voffA);
            PG8_BAR; PG8_WAIT_L(0); PG8_MMA(1, 0, At, B0); PG8_BAR; PG8_SCHED;
            PG8_STAGE(PG8_SB(0, 1), b2 + hstepB, voffB);
            PG8_WAIT_V(6); PG8_BAR; PG8_MMA(1, 1, At, B1); PG8_BAR;
            PG8_LDB(B0, 1, 0); PG8_SCHED; PG8_LDA(At, 1, 0); PG8_STAGE(PG8_SA(0, 1), a2 + hstepA, voffA);
            PG8_WAIT_L(8); PG8_BAR; PG8_WAIT_L(0); PG8_MMA(0, 0, At, B0); PG8_BAR; PG8_SCHED;
            PG8_LDB(B1, 1, 1); PG8_STAGE(PG8_SB(1, 0), b3, voffB);
            PG8_BAR; PG8_WAIT_L(0); PG8_MMA(0, 1, At, B1); PG8_BAR;
            PG8_LDA(At, 1, 1); PG8_STAGE(PG8_SA(1, 0), a3, voffA);
            PG8_BAR; PG8_WAIT_L(0); PG8_MMA(1, 0, At, B0); PG8_BAR; PG8_SCHED;
            PG8_STAGE(PG8_SB(1, 1), b3 + hstepB, voffB);
            PG8_WAIT_V(6); PG8_BAR; PG8_MMA(1, 1, At, B1); PG8_BAR;
            }
        }
        if constexpr (ALIGN_EPI) { if (wr == 0) PG8_BAR; }
        if constexpr (!Epi::AFTER_DRAIN) { E(acc, cur, wr, wc, fr, fq); S.done(cur); }
        if (!has_next) break;
#pragma unroll
        for (int a = 0; a < 2; ++a)
#pragma unroll
            for (int b = 0; b < 2; ++b)
#pragma unroll
                for (int m = 0; m < 4; ++m)
#pragma unroll
                    for (int n = 0; n < 2; ++n) acc[a][b][m][n] = (f32x4){0.f, 0.f, 0.f, 0.f};
        cur = nxt; cA = nA; cB = nB; ++ui;
        if constexpr (ALIGN_EPI) { if (wr == 1) PG8_BAR; }
    }
    PG8_WAIT_V(0);
    if constexpr (!ALIGN_EPI) { if (wr == 0) PG8_BAR; }
    PG8_BAR;
    if constexpr (Epi::AFTER_DRAIN) { E.fused(acc, cur, wr, wc, fr, fq, lds, wid, lane); S.done(cur); }
#undef PG8_SA
#undef PG8_SB
#undef PG8_STAGE
#undef PG8_LDA
#undef PG8_LDB
#undef PG8_MMA
#undef PG8_WAIT_V
#undef PG8_WAIT_L
#undef PG8_BAR
#undef PG8_SCHED
}
}
#include <hip/hip_bf16.h>
#include <cmath>
namespace attn_body {
using bf16=__hip_bfloat16;
using bf16x8=__attribute__((ext_vector_type(8)))short;
using s16x4=__attribute__((ext_vector_type(4)))short;
using f32x16=__attribute__((ext_vector_type(16)))float;
using u32x4=__attribute__((ext_vector_type(4)))unsigned;
constexpr int D=64,DM=2048,ODM=1024;
constexpr int NW=8,QBLK=32,QB=QBLK*NW,KVBLK=64;
constexpr int ATTN_PITCH=DM, ATTN_UNIT_ROWS=QB;
__device__ __forceinline__ int crow(int r,int hi){return (r&3)+8*(r>>2)+4*hi;}
#define SBAR() __builtin_amdgcn_sched_barrier(0)
__device__ __forceinline__ void cmask(f32x16&p0,f32x16&p1,int jb,int qrel,int hi){
  const float NEG=-INFINITY; int kb=64*jb+4*hi;
  #pragma unroll
  for(int r=0;r<16;++r){int kv=kb+(r&3)+8*(r>>2); if(kv>qrel)p0[r]=NEG; if(kv+32>qrel)p1[r]=NEG;}
}

typedef const __attribute__((address_space(3))) float* lds_fptr;
__device__ __forceinline__ void nabias(f32x16&p0,f32x16&p1,int kr,int qr_,int r32,int wid,int hi,lds_fptr rp){
  const float NEG=-INFINITY;
  asm volatile("":"+v"(r32),"+v"(hi));
  const int qc=32*(wid&1)+r32;
  const int rs=min(max(qr_-4,0),120), cs=min(max(qc-8,0),48);
  if(kr<rs||kr>=rs+8){
    #pragma unroll
    for(int r=0;r<16;++r){p0[r]=NEG;p1[r]=NEG;}
  } else {
    lds_fptr tb=rp+(kr-qr_+7)*31+(15-qc);
    #define NAB_ONE(P,KOFF) do{ const int kc_=(r&3)+8*(r>>2)+4*hi+(KOFF); const bool ok_=(unsigned)(kc_-cs)<16u; const float b_=tb[ok_?kc_:cs]; P[r]=ok_?P[r]+b_:NEG; }while(0)
    if(wid&1){
      #pragma unroll
      for(int r=0;r<16;++r){ NAB_ONE(p1,32); if(r>=12) NAB_ONE(p0,0); else p0[r]=NEG; }
    } else {
      #pragma unroll
      for(int r=0;r<16;++r){ NAB_ONE(p0,0); if(r<4) NAB_ONE(p1,32); else p1[r]=NEG; }
    }
    #undef NAB_ONE
  }
}
constexpr int NSLOT=3, SLOTB=8192;
constexpr int LDS_K=0, LDS_V=NSLOT*SLOTB, LDS_WS=2*NSLOT*SLOTB, LDS_OST=LDS_WS+NW*64*4, LDS_BYTES=LDS_OST+NW*4096;
constexpr float C2=0.125f*1.4426950408889634f;
__device__ __forceinline__ void glds16(const void*gsrc,unsigned lds_dst){unsigned keep;
  asm volatile("s_mov_b32 %0, m0\n\ts_mov_b32 m0, %2\n\ts_nop 0\n\tglobal_load_lds_dwordx4 %1, off\n\ts_mov_b32 m0, %0":"=&s"(keep):"v"(gsrc),"s"(lds_dst):"memory");}
__device__ __forceinline__ float max3f(float a,float b,float c){float r;asm("v_max3_f32 %0, %1, %2, %3":"=v"(r):"v"(a),"v"(b),"v"(c));return r;}
__device__ __forceinline__ float max2f(float a,float b){float r;asm("v_max_f32_e32 %0, %1, %2":"=v"(r):"v"(a),"v"(b));return r;}
__device__ __forceinline__ float fadd_s(float a,float b){float r;asm("v_add_f32_e32 %0, %1, %2":"=v"(r):"v"(a),"v"(b));return r;}
__device__ __forceinline__ float fsub_s(float a,float b){float r;asm("v_sub_f32_e32 %0, %1, %2":"=v"(r):"v"(a),"v"(b));return r;}
typedef float f32x2_t __attribute__((ext_vector_type(2))); typedef __bf16 bf16x2_t __attribute__((ext_vector_type(2)));
__device__ __forceinline__ unsigned cvtpk_s(float lo,float hi){f32x2_t v={lo,hi};bf16x2_t b=__builtin_convertvector(v,bf16x2_t);return __builtin_bit_cast(unsigned,b);}
#define WAIT_BAR(N) asm volatile("s_waitcnt vmcnt(" #N ") lgkmcnt(0)\n\ts_barrier":::"memory")

__device__ __forceinline__ void qkt(f32x16&p0,f32x16&p1,const char*Kslot,const bf16x8*qr,const f32x16&negm,int r32,int hi){
  const char*kb=Kslot+hi*1024+r32*16;
  #pragma unroll
  for(int d0=0;d0<4;++d0){
    const bf16x8 b0=*reinterpret_cast<const bf16x8*>(kb+d0*2048);
    const bf16x8 b1=*reinterpret_cast<const bf16x8*>(kb+d0*2048+512);
    if(d0==0){p0=__builtin_amdgcn_mfma_f32_32x32x16_bf16(b0,qr[0],negm,0,0,0);p1=__builtin_amdgcn_mfma_f32_32x32x16_bf16(b1,qr[0],negm,0,0,0);}
    else{p0=__builtin_amdgcn_mfma_f32_32x32x16_bf16(b0,qr[d0],p0,0,0,0);p1=__builtin_amdgcn_mfma_f32_32x32x16_bf16(b1,qr[d0],p1,0,0,0);}}
}
typedef __attribute__((address_space(3))) const char* lds_cptr;
typedef short v4i16_t __attribute__((ext_vector_type(4)));
__device__ __forceinline__ void kload8(bf16x8*kf,lds_cptr kp){
  kf[0]=*(const __attribute__((address_space(3))) bf16x8*)(kp);      kf[1]=*(const __attribute__((address_space(3))) bf16x8*)(kp+512);
  kf[2]=*(const __attribute__((address_space(3))) bf16x8*)(kp+2048); kf[3]=*(const __attribute__((address_space(3))) bf16x8*)(kp+2560);
  kf[4]=*(const __attribute__((address_space(3))) bf16x8*)(kp+4096); kf[5]=*(const __attribute__((address_space(3))) bf16x8*)(kp+4608);
  kf[6]=*(const __attribute__((address_space(3))) bf16x8*)(kp+6144); kf[7]=*(const __attribute__((address_space(3))) bf16x8*)(kp+6656);
}
__device__ __forceinline__ void kload2(bf16x8*kf,lds_cptr kp,int j){ kf[2*j]=*(const __attribute__((address_space(3))) bf16x8*)(kp+j*2048); kf[2*j+1]=*(const __attribute__((address_space(3))) bf16x8*)(kp+j*2048+512); }
__device__ __forceinline__ s16x4 vtr(lds_cptr p){ return __builtin_bit_cast(s16x4,__builtin_amdgcn_ds_read_tr16_b64_v4i16((__attribute__((address_space(3))) v4i16_t*)p)); }
__device__ __forceinline__ float rowmax(const f32x16&p0,const f32x16&p1){
  float a=max3f(p0[0],p0[1],p1[0]),b=max3f(p0[2],p0[3],p1[1]);a=max3f(a,p1[2],p1[3]);
  #pragma unroll
  for(int r=4;r<16;r+=4){a=max3f(a,p0[r],p0[r+1]);b=max3f(b,p0[r+2],p0[r+3]);a=max3f(a,p1[r],p1[r+1]);b=max3f(b,p1[r+2],p1[r+3]);}
  const float m=max2f(a,b);
  auto rr=__builtin_amdgcn_permlane32_swap(__float_as_uint(m),__float_as_uint(m),false,false);
  return max2f(__uint_as_float(rr[0]),__uint_as_float(rr[1]));
}
__device__ __forceinline__ void pv(f32x16*o,int vb,bf16x8 pa0,bf16x8 pa1,bf16x8 pa2,bf16x8 pa3){
  #pragma unroll
  for(int d0=0;d0<2;++d0){s16x4 lo[4],hi[4];
    #pragma unroll
    for(int ks=0;ks<4;++ks){
      asm volatile("ds_read_b64_tr_b16 %0,%1 offset:%c2":"=&v"(lo[ks]):"v"(vb),"i"(d0*4096+ks*1024):"memory");
      asm volatile("ds_read_b64_tr_b16 %0,%1 offset:%c2":"=&v"(hi[ks]):"v"(vb),"i"(d0*4096+ks*1024+512):"memory");}
    asm volatile("s_waitcnt lgkmcnt(0)":::"memory");SBAR();
    #define PK(k) (bf16x8){lo[k][0],lo[k][1],lo[k][2],lo[k][3],hi[k][0],hi[k][1],hi[k][2],hi[k][3]}
    o[d0]=__builtin_amdgcn_mfma_f32_32x32x16_bf16(pa0,PK(0),o[d0],0,0,0);
    o[d0]=__builtin_amdgcn_mfma_f32_32x32x16_bf16(pa1,PK(1),o[d0],0,0,0);
    o[d0]=__builtin_amdgcn_mfma_f32_32x32x16_bf16(pa2,PK(2),o[d0],0,0,0);
    o[d0]=__builtin_amdgcn_mfma_f32_32x32x16_bf16(pa3,PK(3),o[d0],0,0,0);
    #undef PK
  }
}

#ifndef ATTN_STORE16
#define ATTN_STORE16(p,v) (*(u32x4*)(p)=(v))
#endif
template<int THRL,int MODE> __device__ __forceinline__ void attn_unit(const bf16*Qw0,const bf16*__restrict__ Kh,const bf16*__restrict__ Vh,bf16*Ow0,const int NT,const int lat_off,const int na_r0,const int na_rsmin,const int rpb_off,char*shm){
  const int tid=ltid(),lane=tid&63,r32=lane&31,hi=lane>>5; const int wid=__builtin_amdgcn_readfirstlane(tid>>6);
  const bf16*Qw=Qw0+(long)(wid*QBLK)*DM;
  const unsigned lds0=(unsigned)(uintptr_t)shm;
  float*wsf=(float*)(shm+LDS_WS)+wid*64;
  const bf16*ksrc=Kh+(long)lane*DM+wid*8;
  const bf16*vsrc=Vh+(long)(16*(wid&3)+(lane>>2))*DM+(wid>>2)*32+(lane&3)*8;
  const unsigned kdst=lds0+LDS_K+wid*1024, vdst=lds0+LDS_V+wid*1024;
  #define TROW(t) (((t)<4)?(t)*64:lat_off+((t)-4)*64)
  #define DMA_K(t,slot) glds16(ksrc+(long)TROW(t)*DM,(unsigned)__builtin_amdgcn_readfirstlane(kdst+(slot)))
  #define DMA_V(t,slot) glds16(vsrc+(long)TROW(t)*DM,(unsigned)__builtin_amdgcn_readfirstlane(vdst+(slot)))
  const int vb0=(int)(lds0+LDS_V)+((lane>>4)&1)*32+(lane&3)*8+(4*hi+((lane&15)>>2))*64;
  const char*Kbase=shm+LDS_K; bf16x8 kf[8];
  const lds_cptr shm3=(lds_cptr)shm; const lds_cptr kp0=shm3+LDS_K+hi*1024+r32*16; const lds_cptr vp0=shm3+LDS_V+((lane>>4)&1)*32+(lane&3)*8+(4*hi+((lane&15)>>2))*64;
  DMA_K(0,0);DMA_V(0,0);DMA_K(1,SLOTB);
  bf16x8 qr[4];
  #pragma unroll
  for(int d0=0;d0<4;++d0)qr[d0]=*reinterpret_cast<const bf16x8*>(&Qw[(long)r32*DM+d0*16+hi*8]);
  float mhat=0.f,l_reg=0.f;f32x16 o[2];o[0]=f32x16{};o[1]=f32x16{};f32x16 negm=f32x16{};asm volatile("":"+v"(negm));
  const lds_fptr rp_=(lds_fptr)(shm3+rpb_off); const int na_qr=na_r0+(wid>>1);
  #define CMASK(P0,P1,t) do{ if(MODE==1 && (t)>=4) nabias(P0,P1,na_rsmin+(t)-4,na_qr,r32,wid,hi,rp_); }while(0)
  bool resc=false;
  #define START(P0,P1) do{ const float rm=rowmax(P0,P1); resc=false; \
    { const float dl=rm; mhat=fadd_s(mhat,dl); \
      _Pragma("unroll") for(int r=0;r<16;++r){P0[r]=fsub_s(P0[r],dl);P1[r]=fsub_s(P1[r],dl);} \
      _Pragma("unroll") for(int r=0;r<16;++r)negm[r]=-mhat; asm volatile("":"+v"(negm)); } \
    _Pragma("unroll") for(int r=0;r<16;++r)P0[r]=__builtin_amdgcn_exp2f(P0[r]); }while(0)
  #define RESC() do{ if(resc){ asm volatile("s_waitcnt lgkmcnt(0)":::"memory"); \
      _Pragma("unroll") for(int d_=0;d_<2;++d_) _Pragma("unroll") for(int r=0;r<16;++r)o[d_][r]*=wsf[crow(r,hi)]; } }while(0)
  f32x16 pA0,pA1,pB0,pB1;
  int sl_prev=0,sl_cur=0,sl_next=SLOTB;
  #define ROT() do{sl_prev=sl_cur;sl_cur=sl_next;sl_next=(sl_next==(NSLOT-1)*SLOTB)?0:sl_next+SLOTB;}while(0)
  DMA_K(2,2*SLOTB);
  WAIT_BAR(3);
  qkt(pA0,pA1,Kbase,qr,negm,r32,hi);asm volatile("s_nop 15\n\ts_nop 7":"+v"(pA0),"+v"(pA1));CMASK(pA0,pA1,0);
  START(pA0,pA1);
  _Pragma("unroll") for(int r=0;r<16;++r)pA1[r]=__builtin_amdgcn_exp2f(pA1[r]);
  WAIT_BAR(0);
  DMA_K(3,0);DMA_V(1,SLOTB);
  ROT();
  kload8(kf,kp0+sl_cur);
  WAIT_BAR(2);
  s16x4 vlo[8],vhi[8]; u32x4 pw0,pw1,pw2,pw3;
  #define PKW(P,B) cvtpk_s(P[B],P[B+1])
  #define PAF(k) __builtin_bit_cast(bf16x8,pw##k)
  #define VFR(i) (bf16x8){vlo[i][0],vlo[i][1],vlo[i][2],vlo[i][3],vhi[i][0],vhi[i][1],vhi[i][2],vhi[i][3]}
  #define PIN(x) asm volatile("":"+v"(x))
  #define MX3(a,b,c) __builtin_fmaxf(__builtin_fmaxf((a),(b)),(c))
  #define GAPA(MF,A0,A1,A2,A3,W0,W1,PW) do{ MF; sacc+=A0; sacc+=A1; sacc+=A2; sacc+=A3; PIN(sacc); W0; W1; PIN(PW); SBAR(); }while(0)
  #define EX(v) __builtin_amdgcn_exp2f(v)
  #define GAPB(MF,X,B) do{ MF; X[B]=EX(X[B]); X[B+1]=EX(X[B+1]); X[B+2]=EX(X[B+2]); X[B+3]=EX(X[B+3]); PIN(X); SBAR(); }while(0)
  #define VRD(i) do{ vlo[i]=vtr(vp_+(((i)>>2)*4096+((i)&3)*1024)); vhi[i]=vtr(vp_+(((i)>>2)*4096+((i)&3)*1024+512)); }while(0)
  #define KRD(G,j) do{ if(G){ kload2(kf,kp0+sl_next,j); SBAR(); } }while(0)
  #define STEP(C0,C1,P0,P1,t,GK,GV,GL) do{ SBAR(); \
    const lds_cptr vp_=vp0+sl_prev; \
    VRD(0); SBAR(); float sacc=(P0[0]+P0[1]); \
    GAPA(C0=__builtin_amdgcn_mfma_f32_32x32x16_bf16(kf[0],qr[0],negm,0,0,0), P0[2],P0[3],P0[4],P0[5],     pw0[0]=PKW(P0,0), pw0[1]=PKW(P0,2), pw0); \
    VRD(4); SBAR(); GAPA(C1=__builtin_amdgcn_mfma_f32_32x32x16_bf16(kf[1],qr[0],negm,0,0,0), P0[6],P0[7],P0[8],P0[9],     pw0[2]=PKW(P0,4), pw0[3]=PKW(P0,6), pw0); \
    VRD(1); SBAR(); GAPA(C0=__builtin_amdgcn_mfma_f32_32x32x16_bf16(kf[2],qr[1],C0,0,0,0),   P0[10],P0[11],P0[12],P0[13], pw1[0]=PKW(P0,8), pw1[1]=PKW(P0,10), pw1); \
    VRD(5); SBAR(); GAPA(C1=__builtin_amdgcn_mfma_f32_32x32x16_bf16(kf[3],qr[1],C1,0,0,0),   P0[14],P0[15],P1[0],P1[1],   pw1[2]=PKW(P0,12),pw1[3]=PKW(P0,14), pw1); \
    VRD(2); SBAR(); GAPA(C0=__builtin_amdgcn_mfma_f32_32x32x16_bf16(kf[4],qr[2],C0,0,0,0),   P1[2],P1[3],P1[4],P1[5],     pw2[0]=PKW(P1,0), pw2[1]=PKW(P1,2), pw2); \
    VRD(6); SBAR(); GAPA(C1=__builtin_amdgcn_mfma_f32_32x32x16_bf16(kf[5],qr[2],C1,0,0,0),   P1[6],P1[7],P1[8],P1[9],     pw2[2]=PKW(P1,4), pw2[3]=PKW(P1,6), pw2); \
    VRD(3); SBAR(); GAPA(C0=__builtin_amdgcn_mfma_f32_32x32x16_bf16(kf[6],qr[3],C0,0,0,0),   P1[10],P1[11],P1[12],P1[13], pw3[0]=PKW(P1,8), pw3[1]=PKW(P1,10), pw3); \
    VRD(7); SBAR(); GAPA(C1=__builtin_amdgcn_mfma_f32_32x32x16_bf16(kf[7],qr[3],C1,0,0,0),   P1[14],P1[15],0.f,0.f,       pw3[2]=PKW(P1,12),pw3[3]=PKW(P1,14), pw3); \
    l_reg+=sacc; \
    if(GK){DMA_K((t)+3,sl_cur);} if(GV){DMA_V((t)+1,sl_next);} \
    CMASK(C0,C1,t); \
    { float a=MX3(C0[0],C0[1],C1[0]),b=MX3(C0[2],C0[3],C1[1]); a=MX3(a,C1[2],C1[3]); \
      _Pragma("unroll") for(int r=4;r<16;r+=4){a=MX3(a,C0[r],C0[r+1]);b=MX3(b,C0[r+2],C0[r+3]);a=MX3(a,C1[r],C1[r+1]);b=MX3(b,C1[r+2],C1[r+3]);} \
      float rm=__builtin_fmaxf(a,b); { auto rr=__builtin_amdgcn_permlane32_swap(__float_as_uint(rm),__float_as_uint(rm),false,false); rm=__builtin_fmaxf(__uint_as_float(rr[0]),__uint_as_float(rr[1])); } \
      resc=false; \
      if(__builtin_expect(__any(rm>(float)THRL),0)){ const float dl=__builtin_fmaxf(rm,0.f); mhat+=dl; \
        _Pragma("unroll") for(int r=0;r<16;++r){C0[r]-=dl;C1[r]-=dl;} \
        _Pragma("unroll") for(int r=0;r<16;++r)negm[r]=-mhat; asm volatile("":"+v"(negm)); \
        const float f=__builtin_amdgcn_exp2f(-dl); l_reg*=f; if(hi==0)wsf[r32]=f; resc=true; } } \
    SBAR(); \
    GAPB(o[0]=__builtin_amdgcn_mfma_f32_32x32x16_bf16(PAF(0),VFR(0),o[0],0,0,0), C0,0); \
    GAPB(o[1]=__builtin_amdgcn_mfma_f32_32x32x16_bf16(PAF(0),VFR(4),o[1],0,0,0), C0,4); \
    KRD(GL,0); GAPB(o[0]=__builtin_amdgcn_mfma_f32_32x32x16_bf16(PAF(1),VFR(1),o[0],0,0,0), C0,8); \
    KRD(GL,1); GAPB(o[1]=__builtin_amdgcn_mfma_f32_32x32x16_bf16(PAF(1),VFR(5),o[1],0,0,0), C0,12); \
    KRD(GL,2); GAPB(o[0]=__builtin_amdgcn_mfma_f32_32x32x16_bf16(PAF(2),VFR(2),o[0],0,0,0), C1,0); \
    KRD(GL,3); GAPB(o[1]=__builtin_amdgcn_mfma_f32_32x32x16_bf16(PAF(2),VFR(6),o[1],0,0,0), C1,4); \
    GAPB(o[0]=__builtin_amdgcn_mfma_f32_32x32x16_bf16(PAF(3),VFR(3),o[0],0,0,0), C1,8); \
    GAPB(o[1]=__builtin_amdgcn_mfma_f32_32x32x16_bf16(PAF(3),VFR(7),o[1],0,0,0), C1,12); \
    }while(0)
  int t=1;
  #undef CMASK
  #define CMASK(P0,P1,t) do{ if(MODE==1 && (t)>=4) nabias(P0,P1,na_rsmin+(t)-4,na_qr,r32,wid,hi,rp_); }while(0)
  for(;t+5<NT;t+=2){
    STEP(pB0,pB1,pA0,pA1,t,true,true,true);     WAIT_BAR(2); RESC(); ROT();
    STEP(pA0,pA1,pB0,pB1,t+1,true,true,true);   WAIT_BAR(2); RESC(); ROT();
  }
  #undef CMASK
  #define CMASK(P0,P1,t) do{ if(MODE==1 && (t)>=4) nabias(P0,P1,na_rsmin+(t)-4,na_qr,r32,wid,hi,rp_); }while(0)
  #define ENDW(tt) do{ if((tt)+3<NT){WAIT_BAR(2);} else if((tt)+2<NT){WAIT_BAR(1);} else {WAIT_BAR(0);} }while(0)
  for(;t+1<NT;t+=2){
    STEP(pB0,pB1,pA0,pA1,t,(t+3<NT),(t+1<NT),(t+1<NT));       ENDW(t);   RESC(); ROT();
    STEP(pA0,pA1,pB0,pB1,t+1,(t+4<NT),(t+2<NT),(t+2<NT));     ENDW(t+1); RESC(); ROT();
  }
  STEP(pB0,pB1,pA0,pA1,NT-1,false,false,false); RESC();
  { float sacc=pB0[0]+pB0[1]; _Pragma("unroll") for(int r=2;r<16;++r)sacc+=pB0[r]; _Pragma("unroll") for(int r=0;r<16;++r)sacc+=pB1[r]; l_reg+=sacc;
    pw0=(u32x4){PKW(pB0,0),PKW(pB0,2),PKW(pB0,4),PKW(pB0,6)};pw1=(u32x4){PKW(pB0,8),PKW(pB0,10),PKW(pB0,12),PKW(pB0,14)};pw2=(u32x4){PKW(pB1,0),PKW(pB1,2),PKW(pB1,4),PKW(pB1,6)};pw3=(u32x4){PKW(pB1,8),PKW(pB1,10),PKW(pB1,12),PKW(pB1,14)};
    SBAR(); pv(o,vb0+sl_cur,PAF(0),PAF(1),PAF(2),PAF(3)); }
  #undef PKW
  #undef PAF
  #undef VFR
  #undef PIN
  #undef MX3
  #undef GAPA
  #undef GAPB
  #undef EX
  #undef VRD
  #undef KRD
  #undef STEP
  #undef ENDW
  {auto rr=__builtin_amdgcn_permlane32_swap(__float_as_uint(l_reg),__float_as_uint(l_reg),false,false);l_reg=__uint_as_float(rr[0])+__uint_as_float(rr[1]);}
  if(hi==0)wsf[32+r32]=l_reg;asm volatile("s_waitcnt lgkmcnt(0)":::"memory");
  float rli[16];
  #pragma unroll
  for(int r=0;r<16;++r)rli[r]=__builtin_amdgcn_rcpf(wsf[32+crow(r,hi)]);
  bf16*Ow=Ow0+(long)(wid*QBLK)*ODM;
  { bf16*stg=(bf16*)(shm+LDS_OST)+wid*2048;
    #pragma unroll
    for(int r=0;r<16;++r){const int orow=crow(r,hi);
      #pragma unroll
      for(int d0=0;d0<2;++d0)stg[orow*64+d0*32+r32]=__float2bfloat16(o[d0][r]*rli[r]);}
    asm volatile("s_waitcnt lgkmcnt(0)":::"memory");
    #pragma unroll
    for(int i=0;i<4;++i){const int row=i*8+(lane>>3),ch=lane&7; const u32x4 v=*(const u32x4*)(stg+row*64+ch*8); ATTN_STORE16(Ow+(long)row*ODM+ch*8,v);} }
  asm volatile("s_waitcnt lgkmcnt(0)\n\ts_barrier":::"memory");
  #undef DMA_K
  #undef TROW
  #undef DMA_V
  #undef CMASK
  #undef START
  #undef RESC
  #undef ROT
}
constexpr int ATTN_LDS_BYTES=LDS_BYTES;
}
#ifndef DBG_MASK
#define DBG_MASK 127
#endif
#ifndef DBG_DIAG
#define DBG_DIAG 0
#endif
#ifndef DBG_NA
#define DBG_NA 1
#endif
#ifndef DBG_CTX
#define DBG_CTX 1
#endif
#ifndef DBG_POOL
#define DBG_POOL 1
#endif
namespace cg = cooperative_groups;
#define GAS __attribute__((address_space(1)))
#define LAS __attribute__((address_space(3)))
typedef unsigned short bf16;
typedef unsigned v4u __attribute__((ext_vector_type(4)));
typedef float f32x4 __attribute__((ext_vector_type(4)));
#define LDS_WAIT() asm volatile("s_waitcnt lgkmcnt(0)" ::: "memory")
__device__ __forceinline__ unsigned f2bf(float f) { unsigned u = __builtin_bit_cast(unsigned, f); return (u + 0x7fffu + ((u >> 16) & 1u)) >> 16; }
__device__ __forceinline__ unsigned pk2(float lo, float hi) { return f2bf(lo) | (f2bf(hi) << 16); }
__device__ __forceinline__ float bf2f(unsigned short h) { return __builtin_bit_cast(float, (unsigned)h << 16); }
__device__ __forceinline__ float wave_sum(float v) {
#pragma unroll
    for (int o = 1; o < 64; o <<= 1) v += __shfl_xor(v, o);
    return v;
}
#define RLX_AGENT __ATOMIC_RELAXED, __HIP_MEMORY_SCOPE_AGENT
#define XB_TMO      128
#define XB_XCNT(j)  (256  + 64 * (j))
#define XB_XSUB(j)  (1280 + 64 * (j))
#define XB_XGEN(j)  (2304 + 64 * (j))
#define XB_TOP      3328
#define XB_TOPGEN   3392
#define XCD_BAR_WORDS 3456
#define XB_SPIN_CAP (1u << 18)

__device__ __forceinline__ unsigned xb_ld(unsigned* p)              { return __hip_atomic_load(p, __ATOMIC_RELAXED, __HIP_MEMORY_SCOPE_AGENT); }
__device__ __forceinline__ unsigned xb_add(unsigned* p, unsigned v) { return __hip_atomic_fetch_add(p, v, __ATOMIC_RELAXED, __HIP_MEMORY_SCOPE_AGENT); }
__device__ __forceinline__ unsigned xb_xcc_id() { return (unsigned)__builtin_amdgcn_s_getreg((3 << 11) | 20) & 0xFu; }
#define XB_SPIN(cond, bar) do { unsigned _sp = 0; while (cond) { __builtin_amdgcn_s_sleep(1); \
    if ((++_sp & 255u) == 0u) { if (xb_ld(&(bar)[XB_TMO])) break; if (_sp > XB_SPIN_CAP) { atomicAdd(&(bar)[XB_TMO], 1u); break; } } } } while (0)

struct XcdBarrier {
    unsigned* bar; unsigned x;
    volatile LAS unsigned* st;
};

__device__ __forceinline__ XcdBarrier xcd_barrier_post(unsigned* bar, volatile LAS unsigned* st) {
    XcdBarrier b; b.bar = bar; b.x = xb_xcc_id(); b.st = st;
    if (threadIdx.x == 0) (void)xb_add(&bar[XB_XCNT(b.x)], 1u);
    return b;
}
__device__ __forceinline__ void xcd_barrier_complete(unsigned* bar, unsigned x, unsigned& nloc, unsigned& nx) {
    const unsigned G = gridDim.x * gridDim.y * gridDim.z;
    unsigned sum, cnt, mine, sp = 0u;
    for (;;) {
        sum = 0u; cnt = 0u; mine = 0u;
#pragma unroll
        for (unsigned j = 0; j < 16; ++j) { const unsigned c = xb_ld(&bar[XB_XCNT(j)]); sum += c; cnt += (c > 0u) ? 1u : 0u; mine = (j == x) ? c : mine; }
        if (sum == G) break;
        __builtin_amdgcn_s_sleep(1);
        if ((++sp & 255u) == 0u) { if (xb_ld(&bar[XB_TMO])) break; if (sp > XB_SPIN_CAP) { atomicAdd(&bar[XB_TMO], 1u); break; } }
    }
    nloc = mine > 0u ? mine : 1u; nx = cnt > 0u ? cnt : 1u;
}

__device__ __forceinline__ void xcd_barrier(const XcdBarrier& b) {
    asm volatile("s_waitcnt vmcnt(0)" ::: "memory");
    __syncthreads();
    if (threadIdx.x == 0) {
        unsigned* bar = b.bar;
        __builtin_amdgcn_s_waitcnt(0);
        unsigned nloc = b.st[0], nx = b.st[1];
        if (nloc == 0u) { xcd_barrier_complete(bar, b.x, nloc, nx); b.st[0] = nloc; b.st[1] = nx; }
        const unsigned old = xb_add(&bar[XB_XSUB(b.x)], 1u);
        const unsigned gen = old / nloc;
        if (old + 1u == (gen + 1u) * nloc) {
            __builtin_amdgcn_fence(__ATOMIC_RELEASE, "agent");
            asm volatile("s_waitcnt vmcnt(0)" ::: "memory");
            const unsigned og = xb_add(&bar[XB_TOP], 1u);
            const unsigned tg = og / nx;
            if (og + 1u == (tg + 1u) * nx) xb_add(&bar[XB_TOPGEN], 1u);
            else XB_SPIN(xb_ld(&bar[XB_TOPGEN]) == tg, bar);
            __builtin_amdgcn_fence(__ATOMIC_ACQUIRE, "agent");
            xb_add(&bar[XB_XGEN(b.x)], 1u);
            asm volatile("s_waitcnt vmcnt(0)" ::: "memory");
        } else {
            XB_SPIN(xb_ld(&bar[XB_XGEN(b.x)]) == gen, bar);
            __builtin_amdgcn_fence(__ATOMIC_ACQUIRE, "agent");
            asm volatile("s_waitcnt vmcnt(0)" ::: "memory");
        }
    }
    __syncthreads();
}
constexpr size_t MiB = 1u << 20;
constexpr size_t WS_TS = 1 * MiB + 32768;
constexpr size_t WS_MOD = 0, WS_ROPEC = 1 * MiB, WS_ROPES = 1 * MiB + 8192, WS_BAR = 1 * MiB + 131072, WS_QUEUE = 1 * MiB + 131072 + 16384;
constexpr size_t WS_WIN = 2 * MiB, WS_WOUT = 18 * MiB, WS_WUP = 26 * MiB, WS_WDN = 70 * MiB;
constexpr size_t WS_ST = 92 * MiB, WS_X = 94 * MiB, WS_H = 359 * MiB, WS_Z = 492 * MiB, WS_Y = 756 * MiB, WS_ACT = WS_Z, WS_END = 888 * MiB;
static_assert(WS_WIN + (size_t)P_DEPTH * P_INW * P_D * 2 <= WS_WOUT && WS_WOUT + (size_t)P_DEPTH * P_D * P_D * 2 <= WS_WUP && WS_WUP + (size_t)P_DEPTH * P_UPW * P_D * 2 <= WS_WDN && WS_WDN + (size_t)P_DEPTH * P_D * P_DFF * 2 <= WS_ST && WS_ST + (size_t)P_M * 8 <= WS_X, "weights map");
static_assert(WS_X + (size_t)P_M * P_D * 4 <= WS_H - MiB / 2 && WS_H + (size_t)P_M * P_D * 2 + MiB / 2 <= WS_Z && WS_Z + (size_t)P_M * P_INW * 2 <= WS_Y && WS_Y + (size_t)P_M * P_D * 2 <= WS_END && WS_ACT + (size_t)P_M * P_DFF * 2 <= WS_END, "activation map");
constexpr int LDS_BYTES = 147456, RPB_OFF = 98304, BARST_OFF = 131072 + 64, PAR_OFF = 131072 + 1024, ROPE_OFF = 131072 + 4096;
#ifndef DBG_REP
#define DBG_REP -1
#endif
constexpr int PH_PER_L = 9;
#ifndef DBG_TPROBE
#define DBG_TPROBE -1
#endif
#ifndef DBG_TPROBE_N
#define DBG_TPROBE_N 1
#endif
#ifndef STAG_TICKS
#define STAG_TICKS 700
#endif
#ifndef N1_OUT
#define N1_OUT 34000
#endif
#ifndef N1_DOWN
#define N1_DOWN 0
#endif
#ifndef DBG_P0REP
#define DBG_P0REP 0
#endif
constexpr int N_PHASES = 2 + PH_PER_L * P_DEPTH + 2 * DBG_P0REP;

struct Args {
    const float *x, *c, *ctx, *c_ctx, *w_mod, *b_mod, *w_in, *pool_w, *pool_scale, *na_rpb, *q_norm, *k_norm, *w_out, *ln1_g, *ln1_b, *w_up, *conv_w, *conv_b, *w_down, *ln2_g, *ln2_b;
    float* out; unsigned char* ws; int ph_lo, ph_hi;
};
static_assert(sizeof(Args) == 23 * 8 + 8, "Args has no padding");

template <int OFF> __device__ __forceinline__ unsigned long long ldarg() {
    unsigned long long v; asm volatile("s_load_dwordx2 %0, %1, %2\n\ts_waitcnt lgkmcnt(0)" : "=s"(v) : "s"(__builtin_amdgcn_kernarg_segment_ptr()), "n"(OFF)); return v; }
#define ARGF(A, f) (A).f = (decltype(Args::f))(__attribute__((address_space(1))) void*)ldarg<offsetof(Args, f)>()
__device__ __forceinline__ void p0_item(const float* W, int K, int N, bf16* WT, int k0, int n0, int drow, LAS float* scr, int lane) {
    float wv[32];
#pragma unroll
    for (int i = 0; i < 32; ++i) wv[i] = W[(size_t)(k0 + 2 * i + (lane >> 5)) * N + n0 + (lane & 31)];
#pragma unroll
    for (int i = 0; i < 32; ++i) scr[(2 * i + (lane >> 5)) * 33 + (lane & 31)] = wv[i];
    LDS_WAIT(); asm volatile("" ::: "memory");
    const int c = lane & 7;
#pragma unroll
    for (int j = 0; j < 4; ++j) { const int n = (lane >> 3) + 8 * j; const LAS float* s = scr + (8 * c) * 33 + n;
        v4u o; o.x = pk2(s[0 * 33], s[1 * 33]); o.y = pk2(s[2 * 33], s[3 * 33]); o.z = pk2(s[4 * 33], s[5 * 33]); o.w = pk2(s[6 * 33], s[7 * 33]);
        *(GAS v4u*)(WT + (size_t)(drow + n) * K + k0 + 8 * c) = o; }
    LDS_WAIT(); asm volatile("" ::: "memory");
}

__device__ __forceinline__ void phase_weights(const Args& a, LAS unsigned char* lds, int vcu, int G, int tid, int lane, int wave) {
    unsigned char* ws = a.ws;
    {
        LAS float* scr = (LAS float*)(lds + wave * 16384);
        const int gw = vcu * 8 + wave, NGW = G * 8;
        constexpr int I_IN = 16 * 64, I_OUT = 16 * 32, I_UP = 16 * 176, I_DN = 44 * 32, I_L = I_IN + I_OUT + I_UP + I_DN;
        for (int it = gw; it < P_DEPTH * I_L; it += NGW) {
            const int l = it / I_L; int r = it - l * I_L;
            if (r < I_IN) { const int kb = r >> 6, nb = r & 63, L0 = 32 * nb; const int drow = (L0 & ~255) + ((L0 >> 5) & 1) * 128 + ((L0 >> 6) & 3) * 32;
                p0_item(a.w_in + (size_t)l * P_D * P_INW, P_D, P_INW, (bf16*)(ws + WS_WIN) + (size_t)l * P_INW * P_D, 64 * kb, 32 * nb, drow, scr, lane); continue; }
            r -= I_IN;
            if (r < I_OUT) { const int kb = r >> 5, nb = r & 31;
                p0_item(a.w_out + (size_t)l * P_D * P_D, P_D, P_D, (bf16*)(ws + WS_WOUT) + (size_t)l * P_D * P_D, 64 * kb, 32 * nb, 32 * nb, scr, lane); continue; }
            r -= I_OUT;
            if (r < I_UP) { const int kb = r / 176, nb = r - kb * 176, L0 = 32 * nb; const int half = L0 >= P_DFF ? 1 : 0, ch0 = L0 - half * P_DFF; const int drow = (ch0 >> 7) * 256 + half * 128 + (ch0 & 127);
                p0_item(a.w_up + (size_t)l * P_D * P_UPW, P_D, P_UPW, (bf16*)(ws + WS_WUP) + (size_t)l * P_UPW * P_D, 64 * kb, 32 * nb, drow, scr, lane); continue; }
            r -= I_UP;
            { const int kb = r >> 5, nb = r & 31;
                p0_item(a.w_down + (size_t)l * P_DFF * P_D, P_DFF, P_D, (bf16*)(ws + WS_WDN) + (size_t)l * P_D * P_DFF, 64 * kb, 32 * nb, 32 * nb, scr, lane); }
        }
    }
}
__device__ __forceinline__ void phase0(const Args& a, LAS unsigned char* lds, int vcu, int G, int tid, int lane, int wave) {
    unsigned char* ws = a.ws;
    if (vcu < 192) {
        LAS float* act = (LAS float*)lds; LAS float* red = (LAS float*)(lds + 40960);
        for (int e = tid; e < 9 * P_D; e += 512) { const int r = e >> 10, k = e & 1023; const float v = r < 8 ? a.c[r * P_D + k] : a.c_ctx[k]; act[e] = v / (1.0f + expf(-v)); }
        __syncthreads();
        for (int u = vcu; u < 192; u += G) {
            const int l = u / 48, n0 = (u - l * 48) * 128, cg4 = tid & 31, ks = tid >> 5;
            const float* wp = a.w_mod + (size_t)l * P_D * P_MODW + (size_t)(ks * 64) * P_MODW + n0 + 4 * cg4;
            f32x4 s[9];
#pragma unroll
            for (int r = 0; r < 9; ++r) s[r] = (f32x4){0.f, 0.f, 0.f, 0.f};
#pragma unroll 8
            for (int k = 0; k < 64; ++k) { const f32x4 w = *(const f32x4*)(wp + (size_t)k * P_MODW);
#pragma unroll
                for (int r = 0; r < 9; ++r) s[r] += w * act[r * P_D + ks * 64 + k]; }
#pragma unroll
            for (int r = 0; r < 9; ++r) *(LAS f32x4*)(red + (ks * 9 + r) * 128 + 4 * cg4) = s[r];
            __syncthreads();
            for (int e = tid; e < 9 * 128; e += 512) { const int r = e >> 7, cc = e & 127; float t = 0.f;
#pragma unroll
                for (int k2 = 0; k2 < 16; ++k2) t += red[(k2 * 9 + r) * 128 + cc];
                ((float*)(ws + WS_MOD))[(size_t)(l * 9 + r) * P_MODW + n0 + cc] = t + a.b_mod[l * P_MODW + n0 + cc]; }
            __syncthreads();
        }
    }
    if (vcu == G - 1) {
        for (int e = tid; e < 2048; e += 512) { const int pos = e >> 4, f = e & 15;
            const float inv = exp2f(-(float)f * (13.287712379549449f / 16.0f));
            const float ang = (float)pos * inv;
            ((float*)(ws + WS_ROPEC))[e] = cosf(ang); ((float*)(ws + WS_ROPES))[e] = sinf(ang); }
    }
}

template <int KIND> __device__ __forceinline__ void row_phase(const Args& a, int l, int mode, int n1, int bx, int vcu, int G, int wave, int lane, LAS unsigned char* lds) {
    unsigned char* ws = a.ws; const float* X = (const float*)(ws + WS_X); bf16* H = (bf16*)(ws + WS_H); const float* mod = (const float*)(ws + WS_MOD); float* ST = (float*)(ws + WS_ST);
    const bool lastl = (KIND == 2 && l == P_DEPTH - 1);
    const int ml = (KIND == 2) ? l + 1 : l; const int csh = (KIND == 1) ? 3 : 0, csc = (KIND == 1) ? 4 : 1;
    const float* lg = (KIND == 1 ? a.ln1_g : a.ln2_g) + l * P_D; const float* lb = (KIND == 1 ? a.ln1_b : a.ln2_b) + l * P_D;
    LAS f32x4* T4 = (LAS f32x4*)lds;
    { const int tid = wave * 64 + lane;
      if (KIND != 0) for (int e = tid; e < 256; e += 512) { T4[e] = ((const f32x4*)lg)[e]; T4[256 + e] = ((const f32x4*)lb)[e]; }
      if (!lastl) for (int e = tid; e < 9 * 256; e += 512) { const int r = e >> 8, c = e & 255; const float* mp = mod + (size_t)(ml * 9 + r) * P_MODW;
          T4[512 + e] = ((const f32x4*)(mp + csh * P_D))[c]; T4[512 + 2304 + e] = ((const f32x4*)(mp + csc * P_D))[c]; }
      __syncthreads(); }
#define ROW_OF(i) (mode == 1 ? (i) + (((i) >> 13) + 1) * P_CTX : (mode == 2 ? ((i) >> 8) * P_RPB + ((i) & 255) : (i)))
#define ROW_SRC(m_, b_, rb_) ((KIND == 0) ? ((rb_) < P_CTX ? a.ctx + ((size_t)(b_) * P_CTX + (rb_)) * P_D : a.x + ((size_t)(b_) * P_SEQ + ((rb_) - P_CTX)) * P_D) : X + (size_t)(m_) * P_D)
    for (int seg = 0; seg < 2; ++seg) {
        int start, stride, end;
        if (seg == 0) { start = vcu * 8 + wave; stride = G * 8; end = (mode == 0) ? P_M : (mode == 2 ? P_B * P_CTX : n1); }
        else { if (mode != 1 || bx < 32) break; start = n1 + (bx - 32) * 8 + wave; stride = (G - 32) * 8; end = P_B * P_SEQ; }
        f32x4 vn[4];
        if (start < end) { const int m0 = ROW_OF(start); const int b0 = m0 / P_RPB, rb0 = m0 - b0 * P_RPB; const f32x4* xr = (const f32x4*)ROW_SRC(m0, b0, rb0) + lane;
#pragma unroll
            for (int j = 0; j < 4; ++j) vn[j] = xr[64 * j]; }
        for (int i = start; i < end; i += stride) {
            const int m = ROW_OF(i);
            const int b = m / P_RPB, rb = m - b * P_RPB; const bool is_ctx = rb < P_CTX; const int mrow = is_ctx ? 8 : b;
            f32x4 v[4];
#pragma unroll
            for (int j = 0; j < 4; ++j) v[j] = vn[j];
            if (i + stride < end) { const int m1 = ROW_OF(i + stride); const int b1 = m1 / P_RPB, rb1 = m1 - b1 * P_RPB; const f32x4* xr = (const f32x4*)ROW_SRC(m1, b1, rb1) + lane;
#pragma unroll
                for (int j = 0; j < 4; ++j) vn[j] = xr[64 * j]; }
            if (KIND != 0) {
                float s = 0.f;
#pragma unroll
                for (int j = 0; j < 4; ++j) s += (v[j].x + v[j].y) + (v[j].z + v[j].w);
                const float mean = wave_sum(s) * (1.f / P_D); float s2 = 0.f;
#pragma unroll
                for (int j = 0; j < 4; ++j) { v[j] = v[j] - mean; s2 += (v[j].x * v[j].x + v[j].y * v[j].y) + (v[j].z * v[j].z + v[j].w * v[j].w); }
                const float rstd = 1.f / sqrtf(wave_sum(s2) * (1.f / P_D) + P_EPS);
                if (!lastl && lane == 0) { ST[(size_t)m * 2] = mean; ST[(size_t)m * 2 + 1] = rstd; }
#pragma unroll
                for (int j = 0; j < 4; ++j) { const f32x4 g = T4[lane + 64 * j], bb = T4[256 + lane + 64 * j]; v[j] = v[j] * rstd * g + bb; }
            }
            if (lastl) {
#if DBG_TPROBE >= 0
                if (i < 64) { const unsigned long long* ts = (const unsigned long long*)(ws + WS_TS); const float d_us = (float)(ts[DBG_TPROBE + DBG_TPROBE_N] - ts[DBG_TPROBE]) * 0.01f;
                    const float eps_ = sqrtf(d_us * 2.07e-6f);
#pragma unroll
                    for (int j = 0; j < 4; ++j) v[j] = v[j] + eps_; }
#endif
                if (!is_ctx) { f32x4* o = (f32x4*)(a.out + ((size_t)b * P_SEQ + (rb - P_CTX)) * P_D) + lane;
#pragma unroll
                    for (int j = 0; j < 4; ++j) o[64 * j] = v[j]; }
            } else {
                unsigned long long* o8 = (unsigned long long*)(H + (size_t)m * P_D) + lane;
#pragma unroll
                for (int j = 0; j < 4; ++j) { const f32x4 sh = T4[512 + mrow * 256 + lane + 64 * j], sc = T4[512 + 2304 + mrow * 256 + lane + 64 * j];
                    const f32x4 h = v[j] * (1.0f + sc) + sh;
                    o8[64 * j] = (unsigned long long)pk2(h.x, h.y) | ((unsigned long long)pk2(h.z, h.w) << 32); }
            }
        }
    }
#undef ROW_OF
#undef ROW_SRC
    __syncthreads();
}

__device__ __forceinline__ void pool_phase(const Args& a, int l, LAS unsigned char* lds, int ubeg, int uend, int ustride, int tid) {
    typedef float f32x16 __attribute__((ext_vector_type(16)));
    const bf16* Z = (const bf16*)(a.ws + WS_Z); bf16* Y = (bf16*)(a.ws + WS_Y);
    LAS float* zt = (LAS float*)lds;
    LAS float* pl = (LAS float*)(lds + 36864);
    LAS float* wl = (LAS float*)(lds + 36864 + 33280);
    v4u pre[3]; f32x4 wpre[2];
#define POOL_DECODE(u_) const int tk_ = (u_) >> 2, g_ = (u_) & 3; const int row0_ = tk_ * 128; const int b_ = row0_ / P_RPB, rb0_ = row0_ - b_ * P_RPB; \
        const int slo_ = (rb0_ < P_CTX) ? b_ * P_RPB : b_ * P_RPB + P_CTX, shi_ = (rb0_ < P_CTX) ? b_ * P_RPB + P_CTX : (b_ + 1) * P_RPB;
#define POOL_ISSUE(u_) do { POOL_DECODE(u_) \
        _Pragma("unroll") for (int i = 0; i < 3; ++i) { const int e = tid + 512 * i; const int rr = e >> 3, c8 = e & 7; const int R = row0_ - 8 + rr; \
            pre[i] = (v4u){0u, 0u, 0u, 0u}; if (e < 144 * 8 && R >= slo_ && R < shi_) pre[i] = *(const v4u*)(Z + (size_t)R * P_INW + g_ * 64 + c8 * 8); } \
        const f32x4* wsrc = (const f32x4*)(a.pool_w + ((size_t)l * 4 + g_) * 4096); wpre[0] = wsrc[tid]; wpre[1] = wsrc[tid + 512]; } while (0)
    int u = ubeg;
    if (u < uend) POOL_ISSUE(u);
    for (; u < uend; u += ustride) {
        POOL_DECODE(u)
#pragma unroll
        for (int i = 0; i < 3; ++i) { const int e = tid + 512 * i; if (e < 144 * 8) { const int rr = e >> 3, c8 = e & 7; const v4u w = pre[i]; LAS float* d = zt + rr * 64 + c8 * 8;
            *(LAS f32x4*)d = (f32x4){bf2f(w.x & 0xffff), bf2f(w.x >> 16), bf2f(w.y & 0xffff), bf2f(w.y >> 16)}; *(LAS f32x4*)(d + 4) = (f32x4){bf2f(w.z & 0xffff), bf2f(w.z >> 16), bf2f(w.w & 0xffff), bf2f(w.w >> 16)}; } }
        ((LAS f32x4*)wl)[tid] = wpre[0]; ((LAS f32x4*)wl)[tid + 512] = wpre[1];
        if (u + ustride < uend) POOL_ISSUE(u + ustride);
        __syncthreads();
        { const int c = tid & 63, t0 = (tid >> 6) * 16, hw = 1 << g_;
          float s = 0.f;
          for (int p = t0 - hw; p < t0 + hw; ++p) s += zt[(p + 8) * 64 + c];
#pragma unroll 4
          for (int k = 0; k < 16; ++k) { const int t = t0 + k, T = row0_ + t; const int lo = max(T - hw, slo_), hi = min(T + hw - 1, shi_ - 1);
              pl[t * 65 + c] = s * __builtin_amdgcn_rcpf((float)(hi - lo + 1)) - zt[(t + 8) * 64 + c];
              s += zt[(t + hw + 8) * 64 + c] - zt[(t - hw + 8) * 64 + c]; } }
        __syncthreads();
        { const int lane = tid & 63, wid = tid >> 6, r32 = lane & 31, hi = lane >> 5, tw = wid >> 1, dw = wid & 1;
          f32x16 acc;
#pragma unroll
          for (int r = 0; r < 16; ++r) acc[r] = 0.f;
          const LAS float* ap = pl + (32 * tw + r32) * 65 + hi; const LAS float* bp = wl + hi * 64 + 32 * dw + r32;
#pragma unroll 8
          for (int kk = 0; kk < 32; ++kk) acc = __builtin_amdgcn_mfma_f32_32x32x2f32(ap[2 * kk], bp[2 * kk * 64], acc, 0, 0, 0);
          const float sc = a.pool_scale[l * 256 + g_ * 64 + 32 * dw + r32];
          bf16* yp = Y + (size_t)(row0_ + 32 * tw + 4 * hi) * P_D + g_ * 64 + 32 * dw + r32;
#pragma unroll
          for (int r = 0; r < 16; ++r) yp[(size_t)((r & 3) + 8 * (r >> 2)) * P_D] = (bf16)f2bf(acc[r] * sc); }
        __syncthreads();
    }
#undef POOL_DECODE
#undef POOL_ISSUE
}

__device__ __forceinline__ void mix_phase(const Args& a, int l, unsigned char* ldsg, LAS unsigned char* lds, int vcu, int G, int tid) {
    using abf = attn_body::bf16;
    const abf* Z = (const abf*)(a.ws + WS_Z); abf* Y = (abf*)(a.ws + WS_Y);
    { LAS float* rp = (LAS float*)(lds + RPB_OFF); const float* src = a.na_rpb + (size_t)l * 6 * 465;
      for (int e = tid; e < 6 * 465; e += 512) rp[e] = src[e] * P_LOG2E; }
    __syncthreads();
#if DBG_TPROBE >= 0
#define MIXSTAMP(k) do { if (l == 1 && blockIdx.x == 0 && tid == 0) ((unsigned long long*)(a.ws + WS_TS))[k] = __builtin_amdgcn_s_memrealtime(); } while (0)
#else
#define MIXSTAMP(k) do {} while (0)
#endif
    MIXSTAMP(40);
    for (int u = vcu; u < 1536; u += G) { const int h = u >> 8, b = (u >> 5) & 7, qb = u & 31, kv = h / 3;
        const size_t brow = (size_t)b * P_RPB, qrow = brow + P_CTX + (size_t)qb * 256;
        attn_body::attn_unit<8, 0>(Z + qrow * P_INW + 1408 + 64 * h, Z + brow * P_INW + 1792 + 64 * kv, Z + brow * P_INW + 1920 + 64 * kv, Y + qrow * P_D + 640 + 64 * h, 132, 256, 0, 0, RPB_OFF, (char*)ldsg); }
    MIXSTAMP(41);
    {
        unsigned* Qc = (unsigned*)(a.ws + WS_QUEUE) + l * 64;
        volatile LAS unsigned* qslot = (volatile LAS unsigned*)(lds + BARST_OFF + 32);
        const int N_NA = 1536, N_CTX = (l < P_DEPTH - 1) ? 96 : 0, N_POOL = P_M / 128, NI = N_NA + N_CTX + N_POOL;
        unsigned mine = 0u; if (tid == 0) mine = atomicAdd(Qc, 1u);
        for (;;) {
            if (tid == 0) *qslot = mine;
            __syncthreads();
            const int item = __builtin_amdgcn_readfirstlane((int)*qslot);
            if (item >= NI) break;
            if (tid == 0) mine = atomicAdd(Qc, 1u);
            if (item < N_NA) { const int u = item; const int h = u >> 8, b = (u >> 5) & 7, qb = u & 31;
                const size_t brow = (size_t)b * P_RPB, qrow = brow + P_CTX + (size_t)qb * 256;
                const int rsmin = min(max(4 * qb - 4, 0), 116);
                attn_body::attn_unit<8, 1>(Z + qrow * P_INW + 256 + 64 * h, Z + brow * P_INW + 640 + 64 * h, Z + brow * P_INW + 1024 + 64 * h, Y + qrow * P_D + 256 + 64 * h, 16, 256 + 64 * rsmin, 4 * qb, rsmin, RPB_OFF + h * 465 * 4, (char*)ldsg);
            } else if (item < N_NA + N_CTX) { const int u = item - N_NA; const int b = u / 12, hh = u - b * 12; const size_t brow = (size_t)b * P_RPB;
                int qc, kc, vc, oc;
                if (hh < 6) { qc = 256 + 64 * hh; kc = 640 + 64 * hh; vc = 1024 + 64 * hh; oc = 256 + 64 * hh; }
                else { const int h = hh - 6; qc = 1408 + 64 * h; kc = 1792 + 64 * (h / 3); vc = 1920 + 64 * (h / 3); oc = 640 + 64 * h; }
                attn_body::attn_unit<8, 0>(Z + brow * P_INW + qc, Z + brow * P_INW + kc, Z + brow * P_INW + vc, Y + brow * P_D + oc, 4, 256, 0, 0, RPB_OFF, (char*)ldsg);
            } else { const int tk = item - N_NA - N_CTX; pool_phase(a, l, lds, 4 * tk, 4 * tk + 4, 1, ltid()); }
        }
    }
    MIXSTAMP(44);
}


#if DBG_DIAG
constexpr size_t WS_FLAG = 1 * MiB + 65536;
__device__ __forceinline__ bool vclose(float mine, float ref, float tol) {
    const float d = wave_sum((mine - ref) * (mine - ref)), n = wave_sum(ref * ref); return d <= tol * tol * n + 1e-12f; }
__device__ __forceinline__ float na_ref(const Args& a, const bf16* Z, int b, int h, int pos, int lane) {
    const size_t Rl = (size_t)b * P_RPB + P_CTX + pos; const int gr = pos >> 6, gc = pos & 63; const int rs = min(max(gr - 4, 0), 120), cs = min(max(gc - 8, 0), 48);
    float mx = -1e30f, sc[6];
    for (int i = 0; i < 6; ++i) { const int key = lane + 64 * i; size_t kr_; float bias = 0.f;
        if (key < 128) { const int kr = rs + key / 16, kc = cs + key % 16; kr_ = (size_t)b * P_RPB + P_CTX + kr * 64 + kc; bias = a.na_rpb[(size_t)h * 465 + (kr - gr + 7) * 31 + (kc - gc + 15)] * P_LOG2E; }
        else kr_ = (size_t)b * P_RPB + (key - 128);
        float s = 0.f; for (int d = 0; d < 64; ++d) s += bf2f(Z[Rl * P_INW + 256 + 64 * h + d]) * bf2f(Z[kr_ * P_INW + 640 + 64 * h + d]);
        sc[i] = s + bias; mx = fmaxf(mx, sc[i]); }
    for (int o = 1; o < 64; o <<= 1) mx = fmaxf(mx, __shfl_xor(mx, o));
    float den = 0.f; for (int i = 0; i < 6; ++i) { sc[i] = exp2f(sc[i] - mx); den += sc[i]; } den = wave_sum(den);
    float o_ = 0.f;
    for (int i = 0; i < 6; ++i) for (int l2 = 0; l2 < 64; ++l2) { const int key = l2 + 64 * i; size_t kr_;
        if (key < 128) { const int kr = rs + key / 16, kc = cs + key % 16; kr_ = (size_t)b * P_RPB + P_CTX + kr * 64 + kc; } else kr_ = (size_t)b * P_RPB + (key - 128);
        o_ += __shfl(sc[i], l2) * bf2f(Z[kr_ * P_INW + 1024 + 64 * h + lane]); }
    return o_ / den;
}
__device__ __forceinline__ float att_ref(const bf16* Z, size_t qrow, size_t krow0, int ntile, int qc, int kc, int vc, int lane) {
    float mx = -1e30f;
    for (int i = 0; i < ntile; ++i) { const size_t kr_ = krow0 + lane + 64 * i; float s = 0.f;
        for (int d = 0; d < 64; ++d) s += bf2f(Z[qrow * P_INW + qc + d]) * bf2f(Z[kr_ * P_INW + kc + d]); mx = fmaxf(mx, s); }
    for (int o = 1; o < 64; o <<= 1) mx = fmaxf(mx, __shfl_xor(mx, o));
    float den = 0.f, o_ = 0.f;
    for (int i = 0; i < ntile; ++i) { const size_t kr_ = krow0 + lane + 64 * i; float s = 0.f;
        for (int d = 0; d < 64; ++d) s += bf2f(Z[qrow * P_INW + qc + d]) * bf2f(Z[kr_ * P_INW + kc + d]);
        const float p = exp2f(s - mx); den += p;
        for (int l2 = 0; l2 < 64; ++l2) o_ += __shfl(p, l2) * bf2f(Z[(krow0 + l2 + 64 * i) * P_INW + vc + lane]); }
    return o_ / wave_sum(den);
}
__device__ __forceinline__ float pool_ref(const Args& a, const bf16* Z, size_t R, size_t slo, size_t shi, int g, int lane) {
    const int hw = 1 << g; const size_t lo = (R >= slo + hw) ? R - hw : slo, hi = (R + hw - 1 < shi) ? R + hw - 1 : shi - 1;
    float s = 0.f; for (size_t p = lo; p <= hi; ++p) s += bf2f(Z[p * P_INW + g * 64 + lane]);
    const float pooled = s / (float)(hi - lo + 1) - bf2f(Z[R * P_INW + g * 64 + lane]); float y = 0.f;
    for (int c = 0; c < 64; ++c) y += __shfl(pooled, c) * a.pool_w[(size_t)g * 4096 + c * 64 + lane];
    return y * a.pool_scale[g * 64 + lane];
}
__device__ __forceinline__ void diag_phase(const Args& a, int code, int vcu, int tid, int G) {
    unsigned char* ws = a.ws; unsigned* flag = (unsigned*)(ws + WS_FLAG);
    const bf16* Z = (const bf16*)(ws + WS_Z); const bf16* Y = (const bf16*)(ws + WS_Y);
    const int lane = tid & 63;
    if (code == 199) {
        const unsigned fl = *flag; int first = 0; for (int i = 0; i < 16; ++i) if ((fl >> i) & 1) { first = i + 1; break; }
        for (size_t i = (size_t)vcu * 512 + tid; i < (size_t)P_B * P_SEQ * P_D; i += (size_t)G * 512) a.out[i] = (float)first;
        return;
    }
    if (vcu != 0 || tid >= 64) return;
    if (code == 100) { if (lane == 0) *flag = 0u; return; }
    if (code == 102) {
        const float TOL = 0.006f;
        const int nb[5] = {0, 7, 3, 5, 2}, nh[5] = {0, 5, 2, 3, 1}, npos[5] = {0, 127 * 64 + 63, 60 * 64 + 3, 2 * 64 + 30, 64 * 64 + 31};
        for (int q = 0; q < 5; ++q) { const float r = na_ref(a, Z, nb[q], nh[q], npos[q], lane); const float m = bf2f(Y[((size_t)nb[q] * P_RPB + P_CTX + npos[q]) * P_D + 256 + 64 * nh[q] + lane]);
            if (!vclose(m, r, TOL) && lane == 0) atomicOr(flag, 1u << q); }
        const int gb[2] = {1, 7}, gh[2] = {0, 5}, gpos[2] = {100, 8191};
        for (int q = 0; q < 2; ++q) { const size_t brow = (size_t)gb[q] * P_RPB; const float r = att_ref(Z, brow + P_CTX + gpos[q], brow, 132, 1408 + 64 * gh[q], 1792 + 64 * (gh[q] / 3), 1920 + 64 * (gh[q] / 3), lane);
            const float m = bf2f(Y[(brow + P_CTX + gpos[q]) * P_D + 640 + 64 * gh[q] + lane]); if (!vclose(m, r, TOL) && lane == 0) atomicOr(flag, 1u << (5 + q)); }
        { const size_t brow = (size_t)1 * P_RPB; const float r = att_ref(Z, brow + 200, brow, 4, 256 + 64 * 3, 640 + 64 * 3, 1024 + 64 * 3, lane); const float m = bf2f(Y[(brow + 200) * P_D + 256 + 64 * 3 + lane]);
          if (!vclose(m, r, TOL) && lane == 0) atomicOr(flag, 1u << 7); }
        { const size_t brow = (size_t)6 * P_RPB; const float r = att_ref(Z, brow + 17, brow, 4, 1408 + 64 * 4, 1792 + 64 * 1, 1920 + 64 * 1, lane); const float m = bf2f(Y[(brow + 17) * P_D + 640 + 64 * 4 + lane]);
          if (!vclose(m, r, TOL) && lane == 0) atomicOr(flag, 1u << 8); }
        { const size_t brow = (size_t)4 * P_RPB; const size_t R = brow + P_CTX; const float r = pool_ref(a, Z, R, brow + P_CTX, brow + P_RPB, 0, lane); if (!vclose(bf2f(Y[R * P_D + lane]), r, TOL) && lane == 0) atomicOr(flag, 1u << 9); }
        { const size_t brow = (size_t)7 * P_RPB; const size_t R = brow + P_RPB - 1; const float r = pool_ref(a, Z, R, brow + P_CTX, brow + P_RPB, 3, lane); if (!vclose(bf2f(Y[R * P_D + 192 + lane]), r, TOL) && lane == 0) atomicOr(flag, 1u << 10); }
        { const size_t brow = (size_t)3 * P_RPB; const size_t R = brow + 255; const float r = pool_ref(a, Z, R, brow, brow + P_CTX, 2, lane); if (!vclose(bf2f(Y[R * P_D + 128 + lane]), r, TOL) && lane == 0) atomicOr(flag, 1u << 11); }
    }
}
#endif

__global__ void __launch_bounds__(512, 2) mega(Args a) {
    extern __shared__ __attribute__((aligned(16))) unsigned char ldsraw[];
    LAS unsigned char* lds = (LAS unsigned char*)ldsraw;
    cg::grid_group grid = cg::this_grid();
    const int G = gridDim.x; const int bx = blockIdx.x; const int vcu = (G % 8 == 0) ? (bx % 8) * (G / 8) + bx / 8 : bx;
    const int ph_lo = a.ph_lo, ph_hi = a.ph_hi;
    volatile LAS unsigned* barst = (volatile LAS unsigned*)(lds + BARST_OFF);
    if (threadIdx.x < 2) barst[threadIdx.x] = 0u;
    if (ph_lo == 0 && blockIdx.x == 0) { unsigned* bw = (unsigned*)(a.ws + WS_BAR); for (int i = threadIdx.x; i < XCD_BAR_WORDS; i += 512) bw[i] = 0u;
        if (threadIdx.x < P_DEPTH * 64) ((unsigned*)(a.ws + WS_QUEUE))[threadIdx.x] = 0u; }
    __syncthreads();
    XcdBarrier xbar; xbar.bar = (unsigned*)(a.ws + WS_BAR); xbar.x = 0; xbar.st = barst;
    for (int ph_ = ph_lo; ph_ < ph_hi; ++ph_) {
        const int ph = (ph_ < 2 * DBG_P0REP) ? (ph_ & 1) : ph_ - 2 * DBG_P0REP;
        if (ph >= 2 && ph < 100 && (ph - 2) / PH_PER_L == P_DEPTH - 1 && ((ph - 2) % PH_PER_L == 4 || (ph - 2) % PH_PER_L == 8)) continue;
        if (ph_ > ph_lo) {
            if (ph_ == ph_lo + 1) { grid.sync(); xbar = xcd_barrier_post((unsigned*)(a.ws + WS_BAR), barst); }
            else xcd_barrier(xbar);
        }
        const int tid = ltid(), lane = tid & 63, wave = __builtin_amdgcn_readfirstlane(tid >> 6);
#if DBG_TPROBE >= 0
        if (blockIdx.x == 0 && tid == 0) ((unsigned long long*)(a.ws + WS_TS))[ph] = __builtin_amdgcn_s_memrealtime();
#endif
        Args q;
        ARGF(q, ws); unsigned char* ws = q.ws;
#if DBG_DIAG
        if (ph >= 100) { q = a; diag_phase(q, ph, vcu, tid, G); continue; }
#endif
        if (ph == 0) { ARGF(q, c); ARGF(q, c_ctx); ARGF(q, w_mod); ARGF(q, b_mod); phase0(q, lds, vcu, G, tid, lane, wave); continue; }
        if (ph == 1) { ARGF(q, x); ARGF(q, ctx); ARGF(q, w_in); ARGF(q, w_out); ARGF(q, w_up); ARGF(q, w_down); row_phase<0>(q, 0, 0, 0, bx, vcu, G, wave, lane, lds); phase_weights(q, lds, vcu, G, tid, lane, wave); continue; }
        const int l = (ph - 2) / PH_PER_L, sp = (ph - 2) % PH_PER_L; const bool lastL = (l == P_DEPTH - 1);
        if (sp == 0) {
            ARGF(q, q_norm); ARGF(q, k_norm);
            pg8::Gemm g{(const pg8::bf16_t*)(ws + WS_H), (const pg8::bf16_t*)(ws + WS_WIN) + (size_t)l * P_INW * P_D, P_M, P_INW, P_D};
            pg8::StaticOrder S; S.init(P_M / 256, P_INW / 256, G, bx);
            { LAS float* tab = (LAS float*)(lds + ROPE_OFF); const float* rc = (const float*)(ws + WS_ROPEC); const float* rs = (const float*)(ws + WS_ROPES);
              for (int e2 = tid; e2 < 1024; e2 += 512) { tab[e2] = rc[e2]; tab[1024 + e2] = rs[e2]; }
              if (tid < 64) { tab[2048 + tid] = q.q_norm[l * 64 + tid]; tab[2112 + tid] = q.k_norm[l * 64 + tid]; }
              __syncthreads(); }
            pg8::EpiIn E{(pg8::bf16_t*)(ws + WS_Z), (const float*)(ws + WS_ROPEC), (const float*)(ws + WS_ROPES), (LAS float*)(lds + ROPE_OFF)};
            pg8::gemm_phase<pg8::EpiIn, pg8::StaticOrder, true, true, 0>(lds, g, S, E);
        } else if (sp == 1) {
            ARGF(q, na_rpb); ARGF(q, pool_w); ARGF(q, pool_scale);
            mix_phase(q, l, ldsraw, lds, vcu, G, tid);
        } else if (sp == 5) {
            ARGF(q, conv_w); ARGF(q, conv_b);
            pg8::Gemm g{(const pg8::bf16_t*)(ws + WS_H) - P_D, (const pg8::bf16_t*)(ws + WS_WUP) + (size_t)l * P_UPW * P_D, P_M, P_UPW, P_D};
            pg8::StaticOrder S; S.init((P_M + 247) / 248, P_UPW / 256, G, bx);
            pg8::EpiUp E{(pg8::bf16_t*)(ws + WS_ACT), q.conv_w + (size_t)l * 3 * P_UPW, q.conv_b + (size_t)l * P_UPW, (LAS float*)(lds + PAR_OFF)};
            pg8::gemm_phase<pg8::EpiUp, pg8::StaticOrder, true, true, 1>(lds, g, S, E);
        } else {
            const bool isdown = sp >= 6, ctxpart = (sp == 3 || sp == 7);
            ARGF(q, ln1_g); ARGF(q, ln1_b); ARGF(q, ln2_g); ARGF(q, ln2_b);
            if (sp == 2 || sp == 6 || (ctxpart && !lastL)) {
                ARGF(q, x); ARGF(q, ctx);
                const bool first = (!isdown && l == 0);
                pg8::Gemm g{(const pg8::bf16_t*)(ws + (isdown ? WS_ACT : WS_Y)), isdown ? (const pg8::bf16_t*)(ws + WS_WDN) + (size_t)l * P_D * P_DFF : (const pg8::bf16_t*)(ws + WS_WOUT) + (size_t)l * P_D * P_D, P_M, P_D, isdown ? P_DFF : P_D};
                pg8::StaticOrder S; S.init(P_B * P_SEQ / 256, P_D / 256, G, bx); S.skipctx = 1; S.ctxonly = ctxpart ? 1 : 0;
                pg8::EpiRes E{(float*)(ws + WS_X), (const float*)(ws + WS_MOD) + (size_t)l * 9 * P_MODW + (isdown ? 5 : 2) * P_D, (const float*)(ws + WS_ST),
                              first ? nullptr : (isdown ? q.ln1_g + l * P_D : q.ln2_g + (l - 1) * P_D), first ? nullptr : (isdown ? q.ln1_b + l * P_D : q.ln2_b + (l - 1) * P_D), q.x, q.ctx, (LAS float*)(lds + PAR_OFF)};
                pg8::gemm_phase<pg8::EpiRes, pg8::StaticOrder, true, true, 0>(lds, g, S, E);
            }
            if (sp == 3 || (sp == 4 && !lastL)) row_phase<1>(q, l, sp == 3 ? 1 : 2, lastL ? P_B * P_SEQ : N1_OUT, bx, vcu, G, wave, lane, lds);
            if (sp == 7 || (sp == 8 && !lastL)) { ARGF(q, out); row_phase<2>(q, l, sp == 7 ? 1 : 2, lastL ? P_B * P_SEQ : N1_DOWN, bx, vcu, G, wave, lane, lds); }
        }
    }
}

#ifndef MK_MULTI
#define MK_MULTI 0
#endif
extern "C" void kernel_launch(void* const* d_in, const int* in_sizes, int n_in, void* d_out, int out_size, void* d_ws, size_t ws_size, hipStream_t stream) {
    static int grid = 0;
    if (grid == 0) {
        if (n_in != 21 || ws_size < WS_END) { fprintf(stderr, "kernel_launch: unexpected n_in %d / ws_size %zu\n", n_in, ws_size); grid = -1; return; }
        int dev = 0, cus = 0, per_cu = 0;
        if (hipGetDevice(&dev) != hipSuccess || hipDeviceGetAttribute(&cus, hipDeviceAttributeMultiprocessorCount, dev) != hipSuccess) { grid = -1; return; }
        if (hipFuncSetAttribute((const void*)mega, hipFuncAttributeMaxDynamicSharedMemorySize, LDS_BYTES) != hipSuccess) { fprintf(stderr, "kernel_launch: hipFuncSetAttribute failed\n"); grid = -1; return; }
        if (hipOccupancyMaxActiveBlocksPerMultiprocessor(&per_cu, (const void*)mega, 512, LDS_BYTES) != hipSuccess || per_cu < 1) { fprintf(stderr, "kernel_launch: occupancy query says %d\n", per_cu); per_cu = 1; }
        (void)hipGetLastError();
        grid = cus * 1;
        fprintf(stderr, "kernel_launch: cus %d per_cu %d grid %d\n", cus, per_cu, grid);
    }
    if (grid < 0) return;
    Args a{};
    const float** f = (const float**)&a;
    for (int i = 0; i < 21; ++i) f[i] = (const float*)d_in[i];
    a.out = (float*)d_out; a.ws = (unsigned char*)d_ws;
#if MK_MULTI
#if DBG_DIAG
    { const int seq[] = {0, 1, 100, 2, 3, 102, 199};
      for (int i = 0; i < 7; ++i) { a.ph_lo = seq[i]; a.ph_hi = seq[i] + 1; hipLaunchKernelGGL(mega, dim3(grid), dim3(512), LDS_BYTES, stream, a); } }
#else
    for (int ph = 0; ph < N_PHASES; ++ph) { a.ph_lo = ph; a.ph_hi = ph + 1; hipLaunchKernelGGL(mega, dim3(grid), dim3(512), LDS_BYTES, stream, a); }
#endif
#else
    a.ph_lo = 0; a.ph_hi = N_PHASES;
    void* args[] = {&a};
    hipError_t e = hipLaunchCooperativeKernel((const void*)mega, dim3(grid), dim3(512), args, LDS_BYTES, stream);
    if (e != hipSuccess) fprintf(stderr, "cooperative launch failed: %s (grid %d)\n", hipGetErrorString(e), grid);
#endif
}
```

```cpp
#include <hip/hip_runtime.h>
#include <hip/hip_cooperative_groups.h>
#include <cstdio>
#include <cstdint>
constexpr int P_D = 1024, P_B = 8, P_SEQ = 8192, P_CTX = 256, P_RPB = P_SEQ + P_CTX  , P_M = P_B * P_RPB  ;
constexpr int P_DEPTH = 4, P_INW = 2048, P_DFF = 2816, P_UPW = 2 * P_DFF, P_MODW = 6 * P_D;
constexpr float P_C2 = 0.125f * 1.4426950408889634f;
constexpr float P_LOG2E = 1.4426950408889634f;
constexpr float P_ALPHA = 1.681792830507429f;
constexpr float P_EPS = 1e-6f;
__device__ __forceinline__ int ltid() { int t = threadIdx.x; asm volatile("" : "+v"(t)); return t; }
namespace pg8 {
#define PG8_LAS __attribute__((address_space(3)))
typedef unsigned short bf16_t;
typedef short bf16x8 __attribute__((ext_vector_type(8)));
typedef float f32x4 __attribute__((ext_vector_type(4)));
typedef unsigned u32x4 __attribute__((ext_vector_type(4)));
constexpr int BM = 256, BK = 64, HALF = 128, HTB = HALF * BK * 2  , STAGE_BYTES = 8 * HTB, NXCD = 8, WGM = 8;

__host__ __device__ __forceinline__ int lds_byte(int r, int c) { const int st = (r >> 4) * 2 + (c >> 5), rr = r & 15, cc = c & 31, ob = rr * 64 + cc * 2; return st * 1024 + (ob ^ (((ob >> 9) & 1) << 5)); }
__host__ __device__ __forceinline__ void stage_rc(int b, int& R, int& C) { const int st = b / 1024, sb = b % 1024, swz = sb ^ (((sb >> 9) & 1) << 5); R = (st >> 1) * 16 + swz / 64; C = (st & 1) * 32 + (swz % 64) / 2; }
__host__ __device__ __forceinline__ int perm32(int rho) { const int n = rho >> 4, i = rho & 15; return 8 * (i >> 2) + 4 * n + (i & 3); }

struct Unit { int pm, pn; };
struct Gemm { const bf16_t* A; const bf16_t* Bt; int M, N, K; };

struct StaticOrder {
    int nM, nN, nwg, G, c, skipctx = 0, ctxonly = 0;
    __host__ __device__ void init(int nM_, int nN_, int G_, int c_) { nM = nM_; nN = nN_; nwg = nM * nN; G = G_; c = c_; }
    __host__ __device__ bool next(int i, Unit& u) const {
        if (ctxonly) { if (i > 0 || c >= 32) return false; u.pm = (c >> 2) * 33; u.pn = c & 3; return true; }
        const long L = (long)i * G + c; if (L >= nwg) return false;
        int wgid = (int)L; { const int q = nwg / NXCD, r = nwg % NXCD, xcd = wgid % NXCD, off = wgid / NXCD; wgid = (xcd < r ? xcd * (q + 1) : r * (q + 1) + (xcd - r) * q) + off; }
        const int nig = WGM * nN, gid = wgid / nig, fm = gid * WGM, gsz = (nM - fm) < WGM ? (nM - fm) : WGM;
        u.pm = fm + ((wgid % nig) % gsz); u.pn = (wgid % nig) / gsz; if (skipctx) u.pm += (u.pm >> 5) + 1; return true;
    }
    __device__ __forceinline__ void a_ready(const Unit&) const {}
    __device__ __forceinline__ void done(const Unit&) const {}
};

__device__ __forceinline__ unsigned cvt_pk_bf16(float lo, float hi) { unsigned r; asm volatile("v_cvt_pk_bf16_f32 %0, %1, %2" : "=v"(r) : "v"(lo), "v"(hi)); return r; }
#ifndef EPI_SHFL
#define EPI_SHFL 0
#endif
typedef float f32x2 __attribute__((ext_vector_type(2)));
__device__ __forceinline__ f32x4 dppror(const f32x4 v, const bool up) {
    f32x4 r;
#if EPI_SHFL
    const int lane = threadIdx.x & 63; const int src = (lane & ~15) | ((lane + (up ? 15 : 1)) & 15);
#pragma unroll
    for (int j = 0; j < 4; ++j) r[j] = __shfl(v[j], src);
#else
#pragma unroll
    for (int j = 0; j < 4; ++j) { const float xs = v[j]; const int iv = __float_as_int(xs);
        r[j] = __int_as_float(up ? __builtin_amdgcn_mov_dpp(iv, 0x121, 0xf, 0xf, true) : __builtin_amdgcn_mov_dpp(iv, 0x12F, 0xf, 0xf, true)); }
#endif
    return r;
}
struct EpiIn {
    static constexpr bool PERM = false, AFTER_DRAIN = false;
    bf16_t* Z; const float* rc; const float* rs; PG8_LAS float* tab;
    __device__ __forceinline__ void operator()(const f32x4 (&acc)[2][2][4][2], const Unit& u, int wr, int wc, int fr, int fq) const {
        asm volatile("" : "+v"(fr), "+v"(fq));
        const int hs = u.pn * 4 + wc;
        const bool isq = (hs >= 22 && hs < 28), isk = (hs == 28 || hs == 29);
        const float sc = ((hs >= 4 && hs < 10) || isq) ? P_C2 : 1.f;
        const int tb = u.pm % 33; const bool is_ctx = (tb == 0);
        if (u.pn >= 5 && !is_ctx) {
            const int tid = ltid();
            if (tid < 64) { tab[2176 + tid] = rc[(tb - 1) * 64 + tid]; tab[2240 + tid] = rs[(tb - 1) * 64 + tid]; }
            asm volatile("s_waitcnt lgkmcnt(0)" ::: "memory"); __builtin_amdgcn_s_barrier(); asm volatile("" ::: "memory"); }
#pragma unroll
        for (int ai = 0; ai < 2; ++ai)
#pragma unroll
            for (int m = 0; m < 4; ++m) {
                const int rt = ai * HALF + wr * 64 + m * 16 + fr;
                const size_t row = (size_t)u.pm * BM + rt;
                f32x4 v[2][2];
#pragma unroll
                for (int bj = 0; bj < 2; ++bj)
#pragma unroll
                    for (int n = 0; n < 2; ++n) v[bj][n] = acc[ai][bj][m][n];
                if (isq || isk) {
                    float ss = 0.f;
#pragma unroll
                    for (int bj = 0; bj < 2; ++bj)
#pragma unroll
                        for (int n = 0; n < 2; ++n) { const f32x4 x = v[bj][n]; ss += (x[0] * x[0] + x[1] * x[1]) + (x[2] * x[2] + x[3] * x[3]); }
                    ss += __shfl_xor(ss, 16); ss += __shfl_xor(ss, 32);
                    const float rstd = __builtin_amdgcn_rsqf(ss * (1.0f / 64.0f) + P_EPS);
                    const PG8_LAS float* gp = tab + (isq ? 2048 : 2112) + 4 * fq;
                    const int pos = (tb - 1) * BM + rt; const int gr = pos >> 6, gc = pos & 63;
#pragma unroll
                    for (int bj = 0; bj < 2; ++bj) {
                        const f32x4 g0 = *(const PG8_LAS f32x4*)(gp + 32 * bj), g1 = *(const PG8_LAS f32x4*)(gp + 32 * bj + 16);
                        f32x4 x1 = v[bj][0] * rstd * g0, x2 = v[bj][1] * rstd * g1;
                        if (!is_ctx) { const PG8_LAS float* tp = bj ? tab + gc * 16 + 4 * fq : tab + 2176 + (rt >> 6) * 16 + 4 * fq;
                            const f32x4 cs = *(const PG8_LAS f32x4*)tp, sn = *(const PG8_LAS f32x4*)(tp + (bj ? 1024 : 64));
                            const f32x4 y1 = x1 * cs - x2 * sn, y2 = x1 * sn + x2 * cs; x1 = y1; x2 = y2; }
                        v[bj][0] = x1; v[bj][1] = x2;
                    }
                }
                bf16_t* zp = Z + row * P_INW + hs * 64 + 4 * fq;
#pragma unroll
                for (int bj = 0; bj < 2; ++bj)
#pragma unroll
                    for (int n = 0; n < 2; ++n) { const f32x4 x = v[bj][n] * sc; unsigned long long w = (unsigned long long)cvt_pk_bf16(x[0], x[1]) | ((unsigned long long)cvt_pk_bf16(x[2], x[3]) << 32);
                        *(unsigned long long*)(zp + 32 * bj + 16 * n) = w; }
                asm volatile("" ::: "memory");
            }
    }
};
struct EpiRes {
    static constexpr bool PERM = false, AFTER_DRAIN = false;
    typedef _Float16 h16x4 __attribute__((ext_vector_type(4)));
    _Float16* X; const float* gate;
    const float* st; const float* lg; const float* lb; const float* xin; const float* cin; PG8_LAS float* par;
    __device__ __forceinline__ void operator()(const f32x4 (&acc)[2][2][4][2], const Unit& u, int wr, int wc, int fr, int fq) const {
        asm volatile("" : "+v"(fr), "+v"(fq));
        const int tid = ltid(); const int wv = __builtin_amdgcn_readfirstlane(tid >> 6);
        const int b = u.pm / 33, tb = u.pm % 33; const int mrow = tb == 0 ? 8 : b;
        const int col0 = u.pn * BM + wc * 32 + 4 * fq;
        const bool ident = (lg == nullptr);
        if (wv < 3) { const int c4 = (tid & 63) * 4; const int gc = u.pn * BM + c4; f32x4 pv;
            if (wv == 0) pv = ident ? (f32x4){P_ALPHA, P_ALPHA, P_ALPHA, P_ALPHA} : *(const f32x4*)(lg + gc) * P_ALPHA;
            else if (wv == 1) pv = ident ? (f32x4){0.f, 0.f, 0.f, 0.f} : *(const f32x4*)(lb + gc) * P_ALPHA;
            else pv = *(const f32x4*)(gate + mrow * P_MODW + gc);
            *(PG8_LAS f32x4*)(par + wv * 256 + c4) = pv; }
        const int cl = wc * 32 + 4 * fq;
        _Float16* xwb = X + (size_t)u.pm * BM * P_D + col0;
#define ERES_BODY(XO_, MEAN_, RSTD_) do { _Float16* xw = xwb + (size_t)rt * P_D; \
            _Pragma("unroll") for (int bj = 0; bj < 2; ++bj) _Pragma("unroll") for (int n = 0; n < 2; ++n) { const int co = cl + bj * HALF + n * 16; \
                const f32x4 A4 = *(const PG8_LAS f32x4*)(par + co), B4 = *(const PG8_LAS f32x4*)(par + 256 + co), G4 = *(const PG8_LAS f32x4*)(par + 512 + co); \
                f32x4 xo = XO_; xo = ((xo - MEAN_) * RSTD_) * A4 + B4 + G4 * acc[ai][bj][m][n]; *(h16x4*)(xw + bj * HALF + n * 16) = __builtin_convertvector(xo, h16x4); } } while (0)
        if (ident) {
            const float* rbase = (tb == 0 ? cin + (size_t)b * P_CTX * P_D : xin + ((size_t)b * P_SEQ + (size_t)(tb - 1) * BM) * P_D) + col0;
            f32x4 tq[3][4];
#define ERES_LOAD(it_) do { const int rt_ = ((it_) >> 2) * HALF + wr * 64 + ((it_) & 3) * 16 + fr; const float* xr_ = rbase + (size_t)rt_ * P_D; \
            _Pragma("unroll") for (int bj = 0; bj < 2; ++bj) _Pragma("unroll") for (int n = 0; n < 2; ++n) tq[(it_) % 3][bj * 2 + n] = *(const f32x4*)(xr_ + bj * HALF + n * 16); } while (0)
            ERES_LOAD(0); ERES_LOAD(1);
            asm volatile("s_waitcnt lgkmcnt(0)" ::: "memory"); __builtin_amdgcn_s_barrier(); asm volatile("" ::: "memory");
#pragma unroll
            for (int it = 0; it < 8; ++it) { const int ai = it >> 2, m = it & 3; const int rt = ai * HALF + wr * 64 + m * 16 + fr;
                if (it + 2 < 8) ERES_LOAD(it + 2);
                ERES_BODY(tq[it % 3][bj * 2 + n], 0.f, 1.f);
                asm volatile("" ::: "memory"); }
#undef ERES_LOAD
        } else {
            const _Float16* rbase = xwb;
            h16x4 th[4][4]; f32x2 sq[4];
#define ERES_LOAD(it_) do { const int rt_ = ((it_) >> 2) * HALF + wr * 64 + ((it_) & 3) * 16 + fr; const _Float16* xr_ = rbase + (size_t)rt_ * P_D; \
            _Pragma("unroll") for (int bj = 0; bj < 2; ++bj) _Pragma("unroll") for (int n = 0; n < 2; ++n) th[(it_) & 3][bj * 2 + n] = *(const h16x4*)(xr_ + bj * HALF + n * 16); \
            sq[(it_) & 3] = *(const f32x2*)(st + ((size_t)u.pm * BM + rt_) * 2); } while (0)
            ERES_LOAD(0); ERES_LOAD(1); ERES_LOAD(2);
            asm volatile("s_waitcnt lgkmcnt(0)" ::: "memory"); __builtin_amdgcn_s_barrier(); asm volatile("" ::: "memory");
#pragma unroll
            for (int it = 0; it < 8; ++it) { const int ai = it >> 2, m = it & 3; const int rt = ai * HALF + wr * 64 + m * 16 + fr;
                if (it + 3 < 8) ERES_LOAD(it + 3);
                const float mean = sq[it & 3][0], rstd = sq[it & 3][1];
                ERES_BODY(__builtin_convertvector(th[it & 3][bj * 2 + n], f32x4), mean, rstd);
                asm volatile("" ::: "memory"); }
#undef ERES_LOAD
        }
#undef ERES_BODY
    }
};
struct EpiUp {
    static constexpr bool PERM = true, AFTER_DRAIN = false;
    bf16_t* ACT; const float* cw; const float* cb; PG8_LAS float* tab;
    __device__ __forceinline__ void operator()(const f32x4 (&acc)[2][2][4][2], const Unit& u, int wr, int wc, int fr, int fq) const {
        asm volatile("" : "+v"(fr), "+v"(fq));
        { const int tid = ltid();
          if (tid < 256) { const int arr = tid >> 5, c4 = (tid & 31) * 4, k3 = arr & 3; const float* src = (k3 < 3 ? cw + k3 * P_UPW : cb) + (arr >> 2) * P_DFF + u.pn * 128 + c4;
              *(PG8_LAS f32x4*)(tab + arr * 128 + c4) = *(const f32x4*)src; }
          asm volatile("s_waitcnt lgkmcnt(0)" ::: "memory"); __builtin_amdgcn_s_barrier(); asm volatile("" ::: "memory"); }
#pragma unroll
        for (int n = 0; n < 2; ++n) {
            const int ch = u.pn * 128 + wc * 32 + 8 * fq + 4 * n; const PG8_LAS float* tp = tab + wc * 32 + 8 * fq + 4 * n;
            const f32x4 wa0 = *(const PG8_LAS f32x4*)(tp), wa1 = *(const PG8_LAS f32x4*)(tp + 128), wa2 = *(const PG8_LAS f32x4*)(tp + 256), ba = *(const PG8_LAS f32x4*)(tp + 384);
            const f32x4 wg0 = *(const PG8_LAS f32x4*)(tp + 512), wg1 = *(const PG8_LAS f32x4*)(tp + 640), wg2 = *(const PG8_LAS f32x4*)(tp + 768), bg = *(const PG8_LAS f32x4*)(tp + 896);
#pragma unroll
            for (int ai = 0; ai < 2; ++ai) {
                const int Rb = u.pm * 248 - 1 + (2 * ai + wr) * 62;
                f32x4 ra_prev = (f32x4){0.f, 0.f, 0.f, 0.f}, rg_prev = ra_prev;
                f32x4 la_cur = dppror(acc[ai][0][0][n], false), lg_cur = dppror(acc[ai][1][0][n], false);
#pragma unroll
                for (int m = 0; m < 4; ++m) {
                    const f32x4 va = acc[ai][0][m][n], vg = acc[ai][1][m][n];
                    const f32x4 ra_cur = dppror(va, true), rg_cur = dppror(vg, true);
                    f32x4 la_next = la_cur, lg_next = lg_cur;
                    if (m < 3) { la_next = dppror(acc[ai][0][m < 3 ? m + 1 : 3][n], false); lg_next = dppror(acc[ai][1][m < 3 ? m + 1 : 3][n], false); }
                    const int i = 16 * m + fr; const int R = Rb + i;
                    const int rbm = R - (R / P_RPB) * P_RPB;
                    const bool first = (rbm == 0) || (rbm == P_CTX), last = (rbm == P_CTX - 1) || (rbm == P_RPB - 1);
                    f32x4 upa = (fr == 0) ? ra_prev : ra_cur, upg = (fr == 0) ? rg_prev : rg_cur;
                    f32x4 dna = (fr == 15) ? la_next : la_cur, dng = (fr == 15) ? lg_next : lg_cur;
                    const f32x4 z4 = (f32x4){0.f, 0.f, 0.f, 0.f};
                    if (first) { upa = z4; upg = z4; }
                    if (last) { dna = z4; dng = z4; }
                    const f32x4 av = wa0 * upa + wa1 * va + wa2 * dna + ba;
                    const f32x4 gv = wg0 * upg + wg1 * vg + wg2 * dng + bg;
                    f32x4 o;
#pragma unroll
                    for (int j = 0; j < 4; ++j) o[j] = av[j] * gv[j] * __builtin_amdgcn_rcpf(1.0f + __expf(-gv[j]));
                    unsigned long long w = (unsigned long long)cvt_pk_bf16(o[0], o[1]) | ((unsigned long long)cvt_pk_bf16(o[2], o[3]) << 32);
                    asm volatile("" : "+v"(w));
                    if (i >= 1 && i <= 62 && R < P_M) *(unsigned long long*)(ACT + (size_t)R * P_DFF + ch) = w;
                    ra_prev = ra_cur; rg_prev = rg_cur; la_cur = la_next; lg_cur = lg_next;
                }
            }
        }
    }
};

template <class Epi, class Sched, bool ALIGN_EPI = false, bool SP2 = false, int AMODE = 0>
__device__ __forceinline__ void gemm_phase(PG8_LAS unsigned char* lds, const Gemm g, const Sched& S, const Epi& E) {
    const int tid = ltid(), wid = __builtin_amdgcn_readfirstlane(tid >> 6), lane = tid & 63, wr = wid >> 2, wc = wid & 3, fr = lane & 15, fq = lane >> 4;
    const int K = g.K, nt = K / BK;
    unsigned voffA[2], voffB[2];
#pragma unroll
    for (int i = 0; i < 2; ++i) { int R, C; stage_rc(tid * 16 + i * 8192, R, C); const int Rb = Epi::PERM ? ((R & ~31) + perm32(R & 31)) : R;
        voffA[i] = (unsigned)((AMODE ? ((R >> 6) * 62 + (R & 63)) : R) * K + C) * 2u; voffB[i] = (unsigned)(Rb * K + C) * 2u; }
    const size_t kstep = (size_t)(BK * 2);
    const size_t hstepB = (size_t)HALF * K * 2; const size_t hstepA = (size_t)(AMODE ? 124 : HALF) * K * 2;
    const size_t tstepB = 2 * hstepB; const size_t tstepA = 2 * hstepA;
    const unsigned ldsw = (unsigned)wid * 1024u;
    const int aoff = lds_byte(wr * 64 + fr, fq * 8), boff = lds_byte(wc * 32 + fr, fq * 8);
#define PG8_SA(b, h) (((b) * 2 + (h)) * HTB)
#define PG8_SB(b, h) ((4 + (b) * 2 + (h)) * HTB)
#define PG8_STAGE(bufoff, gbase, voff) do { _Pragma("unroll") for (int _i = 0; _i < 2; ++_i) \
        __builtin_amdgcn_global_load_lds((const unsigned*)((const char*)(gbase) + (voff)[_i]), (PG8_LAS unsigned*)(lds + (bufoff) + ldsw + _i * 8192), 16, 0, 0); } while (0)
#define PG8_LDA(dst, b, h) do { _Pragma("unroll") for (int m = 0; m < 4; ++m) _Pragma("unroll") for (int k = 0; k < 2; ++k) dst[m][k] = *(const PG8_LAS bf16x8*)(lds + PG8_SA(b, h) + aoff + m * 2048 + k * 1024); } while (0)
#define PG8_LDB(dst, b, h) do { _Pragma("unroll") for (int n = 0; n < 2; ++n) _Pragma("unroll") for (int k = 0; k < 2; ++k) dst[n][k] = *(const PG8_LAS bf16x8*)(lds + PG8_SB(b, h) + boff + n * 2048 + k * 1024); } while (0)
#define PG8_MMA(ai, bj, At, Bt) do { __builtin_amdgcn_s_setprio(1); _Pragma("unroll") for (int m = 0; m < 4; ++m) _Pragma("unroll") for (int n = 0; n < 2; ++n) _Pragma("unroll") for (int k = 0; k < 2; ++k) \
        acc[ai][bj][m][n] = __builtin_amdgcn_mfma_f32_16x16x32_bf16(Bt[n][k], At[m][k], acc[ai][bj][m][n], 0, 0, 0); __builtin_amdgcn_s_setprio(0); } while (0)
#define PG8_WAIT_V(n) asm volatile("s_waitcnt vmcnt(" #n ")" ::: "memory")
#define PG8_WAIT_L(n) asm volatile("s_waitcnt lgkmcnt(" #n ")" ::: "memory")
#define PG8_BAR __builtin_amdgcn_s_barrier()
#define PG8_SCHED __builtin_amdgcn_sched_barrier(0)
    Unit cur, nxt; int ui = 0;
    if (!S.next(0, cur)) return;
    f32x4 acc[2][2][4][2];
#pragma unroll
    for (int a = 0; a < 2; ++a)
#pragma unroll
        for (int b = 0; b < 2; ++b)
#pragma unroll
            for (int m = 0; m < 4; ++m)
#pragma unroll
                for (int n = 0; n < 2; ++n) acc[a][b][m][n] = (f32x4){0.f, 0.f, 0.f, 0.f};
    bf16x8 At[4][2], B0[2][2], B1[2][2];
    const char* cA = (const char*)g.A + (size_t)cur.pm * tstepA; const char* cB = (const char*)g.Bt + (size_t)cur.pn * tstepB;
    S.a_ready(cur);
    if constexpr (SP2) {
        PG8_STAGE(PG8_SB(0, 0), cB, voffB); PG8_STAGE(PG8_SB(0, 1), cB + hstepB, voffB); PG8_STAGE(PG8_SA(0, 0), cA, voffA); PG8_STAGE(PG8_SA(0, 1), cA + hstepA, voffA);
        if (wr == 1) PG8_BAR;
        PG8_WAIT_V(2); PG8_BAR;
        PG8_STAGE(PG8_SB(1, 0), cB + kstep, voffB); PG8_STAGE(PG8_SA(1, 0), cA + kstep, voffA); PG8_STAGE(PG8_SB(1, 1), cB + hstepB + kstep, voffB);
        PG8_WAIT_V(6); PG8_BAR;
    } else {
        PG8_STAGE(PG8_SB(0, 0), cB, voffB); PG8_STAGE(PG8_SA(0, 0), cA, voffA); PG8_STAGE(PG8_SB(0, 1), cB + hstepB, voffB); PG8_STAGE(PG8_SA(0, 1), cA + hstepA, voffA);
        if (wr == 1) PG8_BAR;
        PG8_WAIT_V(4); PG8_BAR;
        PG8_STAGE(PG8_SB(1, 0), cB + kstep, voffB); PG8_STAGE(PG8_SA(1, 0), cA + kstep, voffA); PG8_STAGE(PG8_SB(1, 1), cB + hstepB + kstep, voffB);
        PG8_WAIT_V(6); PG8_BAR;
    }
    for (;;) {
        const bool has_next = S.next(ui + 1, nxt);
        const char* nA = has_next ? (const char*)g.A + (size_t)nxt.pm * tstepA : cA; const char* nB = has_next ? (const char*)g.Bt + (size_t)nxt.pn * tstepB : cB;
        for (int t = 0; t < nt; t += 2) {
            const bool last = (t == nt - 2);
            const char* a1 = cA + (size_t)(t + 1) * kstep;
            const char* a2 = last ? nA : cA + (size_t)(t + 2) * kstep; const char* b2 = last ? nB : cB + (size_t)(t + 2) * kstep;
            const char* a3 = a2 + kstep; const char* b3 = b2 + kstep;
            if (last && has_next) S.a_ready(nxt);
            if constexpr (SP2) {
            PG8_LDB(B0, 0, 0); PG8_LDB(B1, 0, 1); PG8_SCHED; PG8_LDA(At, 0, 0); PG8_STAGE(PG8_SA(1, 1), a1 + hstepA, voffA);
            PG8_WAIT_V(8); PG8_WAIT_L(0); PG8_BAR; PG8_MMA(0, 0, At, B0); PG8_MMA(0, 1, At, B1); PG8_BAR; PG8_SCHED;
            PG8_LDA(At, 0, 1); PG8_STAGE(PG8_SB(0, 0), b2, voffB); PG8_STAGE(PG8_SB(0, 1), b2 + hstepB, voffB); PG8_STAGE(PG8_SA(0, 0), a2, voffA);
            PG8_WAIT_V(8); PG8_WAIT_L(0); PG8_BAR; PG8_MMA(1, 0, At, B0); PG8_MMA(1, 1, At, B1); PG8_BAR; PG8_SCHED;
            PG8_LDB(B0, 1, 0); PG8_LDB(B1, 1, 1); PG8_SCHED; PG8_LDA(At, 1, 0); PG8_STAGE(PG8_SA(0, 1), a2 + hstepA, voffA);
            PG8_WAIT_V(8); PG8_WAIT_L(0); PG8_BAR; PG8_MMA(0, 0, At, B0); PG8_MMA(0, 1, At, B1); PG8_BAR; PG8_SCHED;
            PG8_LDA(At, 1, 1); PG8_STAGE(PG8_SB(1, 0), b3, voffB); PG8_STAGE(PG8_SB(1, 1), b3 + hstepB, voffB); PG8_STAGE(PG8_SA(1, 0), a3, voffA);
            PG8_WAIT_V(8); PG8_WAIT_L(0); PG8_BAR; PG8_MMA(1, 0, At, B0); PG8_MMA(1, 1, At, B1); PG8_BAR; PG8_SCHED;
            } else {
            PG8_LDB(B0, 0, 0); PG8_SCHED; PG8_LDA(At, 0, 0); PG8_STAGE(PG8_SA(1, 1), a1 + hstepA, voffA);
            PG8_WAIT_L(8); PG8_BAR; PG8_WAIT_L(0); PG8_MMA(0, 0, At, B0); PG8_BAR; PG8_SCHED;
            PG8_LDB(B1, 0, 1); PG8_STAGE(PG8_SB(0, 0), b2, voffB);
            PG8_BAR; PG8_WAIT_L(0); PG8_MMA(0, 1, At, B1); PG8_BAR;
            PG8_LDA(At, 0, 1); PG8_STAGE(PG8_SA(0, 0), a2, voffA);
            PG8_BAR; PG8_WAIT_L(0); PG8_MMA(1, 0, At, B0); PG8_BAR; PG8_SCHED;
            PG8_STAGE(PG8_SB(0, 1), b2 + hstepB, voffB);
            PG8_WAIT_V(6); PG8_BAR; PG8_MMA(1, 1, At, B1); PG8_BAR;
            PG8_LDB(B0, 1, 0); PG8_SCHED; PG8_LDA(At, 1, 0); PG8_STAGE(PG8_SA(0, 1), a2 + hstepA, voffA);
            PG8_WAIT_L(8); PG8_BAR; PG8_WAIT_L(0); PG8_MMA(0, 0, At, B0); PG8_BAR; PG8_SCHED;
            PG8_LDB(B1, 1, 1); PG8_STAGE(PG8_SB(1, 0), b3, voffB);
            PG8_BAR; PG8_WAIT_L(0); PG8_MMA(0, 1, At, B1); PG8_BAR;
            PG8_LDA(At, 1, 1); PG8_STAGE(PG8_SA(1, 0), a3, voffA);
            PG8_BAR; PG8_WAIT_L(0); PG8_MMA(1, 0, At, B0); PG8_BAR; PG8_SCHED;
            PG8_STAGE(PG8_SB(1, 1), b3 + hstepB, voffB);
            PG8_WAIT_V(6); PG8_BAR; PG8_MMA(1, 1, At, B1); PG8_BAR;
            }
        }
        if constexpr (ALIGN_EPI) { if (wr == 0) PG8_BAR; }
        if constexpr (!Epi::AFTER_DRAIN) { E(acc, cur, wr, wc, fr, fq); S.done(cur); }
        if (!has_next) break;
#pragma unroll
        for (int a = 0; a < 2; ++a)
#pragma unroll
            for (int b = 0; b < 2; ++b)
#pragma unroll
                for (int m = 0; m < 4; ++m)
#pragma unroll
                    for (int n = 0; n < 2; ++n) acc[a][b][m][n] = (f32x4){0.f, 0.f, 0.f, 0.f};
        cur = nxt; cA = nA; cB = nB; ++ui;
        if constexpr (ALIGN_EPI) { if (wr == 1) PG8_BAR; }
    }
    PG8_WAIT_V(0);
    if constexpr (!ALIGN_EPI) { if (wr == 0) PG8_BAR; }
    PG8_BAR;
    if constexpr (Epi::AFTER_DRAIN) { E.fused(acc, cur, wr, wc, fr, fq, lds, wid, lane); S.done(cur); }
#undef PG8_SA
#undef PG8_SB
#undef PG8_STAGE
#undef PG8_LDA
#undef PG8_LDB
#undef PG8_MMA
#undef PG8_WAIT_V
#undef PG8_WAIT_L
#undef PG8_BAR
#undef PG8_SCHED
}
}
#include <hip/hip_bf16.h>
#include <cmath>
namespace attn_body {
using bf16=__hip_bfloat16;
using bf16x8=__attribute__((ext_vector_type(8)))short;
using s16x4=__attribute__((ext_vector_type(4)))short;
using f32x16=__attribute__((ext_vector_type(16)))float;
using u32x4=__attribute__((ext_vector_type(4)))unsigned;
constexpr int D=64,DM=2048,ODM=1024;
constexpr int NW=8,QBLK=32,QB=QBLK*NW,KVBLK=64;
constexpr int ATTN_PITCH=DM, ATTN_UNIT_ROWS=QB;
__device__ __forceinline__ int crow(int r,int hi){return (r&3)+8*(r>>2)+4*hi;}
#define SBAR() __builtin_amdgcn_sched_barrier(0)
__device__ __forceinline__ void cmask(f32x16&p0,f32x16&p1,int jb,int qrel,int hi){
  const float NEG=-INFINITY; int kb=64*jb+4*hi;
  #pragma unroll
  for(int r=0;r<16;++r){int kv=kb+(r&3)+8*(r>>2); if(kv>qrel)p0[r]=NEG; if(kv+32>qrel)p1[r]=NEG;}
}

typedef const __attribute__((address_space(3))) float* lds_fptr;
__device__ __forceinline__ void nabias(f32x16&p0,f32x16&p1,int kr,int qr_,int r32,int wid,int hi,lds_fptr rp){
  const float NEG=-INFINITY;
  asm volatile("":"+v"(r32),"+v"(hi));
  const int qc=32*(wid&1)+r32;
  const int rs=min(max(qr_-4,0),120), cs=min(max(qc-8,0),48);
  if(kr<rs||kr>=rs+8){
    #pragma unroll
    for(int r=0;r<16;++r){p0[r]=NEG;p1[r]=NEG;}
  } else {
    lds_fptr tb=rp+(kr-qr_+7)*31+(15-qc);
    #define NAB_ONE(P,KOFF) do{ const int kc_=(r&3)+8*(r>>2)+4*hi+(KOFF); const bool ok_=(unsigned)(kc_-cs)<16u; const float b_=tb[ok_?kc_:cs]; P[r]=ok_?P[r]+b_:NEG; }while(0)
    if(wid&1){
      #pragma unroll
      for(int r=0;r<16;++r){ NAB_ONE(p1,32); if(r>=12) NAB_ONE(p0,0); else p0[r]=NEG; }
    } else {
      #pragma unroll
      for(int r=0;r<16;++r){ NAB_ONE(p0,0); if(r<4) NAB_ONE(p1,32); else p1[r]=NEG; }
    }
    #undef NAB_ONE
  }
}
constexpr int NSLOT=3, SLOTB=8192;
constexpr int LDS_K=0, LDS_V=NSLOT*SLOTB, LDS_WS=2*NSLOT*SLOTB, LDS_OST=LDS_WS+NW*64*4, LDS_BYTES=LDS_OST+NW*4096;
constexpr float C2=0.125f*1.4426950408889634f;
__device__ __forceinline__ void glds16(const void*gsrc,unsigned lds_dst){unsigned keep;
  asm volatile("s_mov_b32 %0, m0\n\ts_mov_b32 m0, %2\n\ts_nop 0\n\tglobal_load_lds_dwordx4 %1, off\n\ts_mov_b32 m0, %0":"=&s"(keep):"v"(gsrc),"s"(lds_dst):"memory");}
__device__ __forceinline__ float max3f(float a,float b,float c){float r;asm("v_max3_f32 %0, %1, %2, %3":"=v"(r):"v"(a),"v"(b),"v"(c));return r;}
__device__ __forceinline__ float max2f(float a,float b){float r;asm("v_max_f32_e32 %0, %1, %2":"=v"(r):"v"(a),"v"(b));return r;}
__device__ __forceinline__ float fadd_s(float a,float b){float r;asm("v_add_f32_e32 %0, %1, %2":"=v"(r):"v"(a),"v"(b));return r;}
__device__ __forceinline__ float fsub_s(float a,float b){float r;asm("v_sub_f32_e32 %0, %1, %2":"=v"(r):"v"(a),"v"(b));return r;}
typedef float f32x2_t __attribute__((ext_vector_type(2))); typedef __bf16 bf16x2_t __attribute__((ext_vector_type(2)));
__device__ __forceinline__ unsigned cvtpk_s(float lo,float hi){f32x2_t v={lo,hi};bf16x2_t b=__builtin_convertvector(v,bf16x2_t);return __builtin_bit_cast(unsigned,b);}
#define WAIT_BAR(N) asm volatile("s_waitcnt vmcnt(" #N ") lgkmcnt(0)\n\ts_barrier":::"memory")

__device__ __forceinline__ void qkt(f32x16&p0,f32x16&p1,const char*Kslot,const bf16x8*qr,const f32x16&negm,int r32,int hi){
  const char*kb=Kslot+hi*1024+r32*16;
  #pragma unroll
  for(int d0=0;d0<4;++d0){
    const bf16x8 b0=*reinterpret_cast<const bf16x8*>(kb+d0*2048);
    const bf16x8 b1=*reinterpret_cast<const bf16x8*>(kb+d0*2048+512);
    if(d0==0){p0=__builtin_amdgcn_mfma_f32_32x32x16_bf16(b0,qr[0],negm,0,0,0);p1=__builtin_amdgcn_mfma_f32_32x32x16_bf16(b1,qr[0],negm,0,0,0);}
    else{p0=__builtin_amdgcn_mfma_f32_32x32x16_bf16(b0,qr[d0],p0,0,0,0);p1=__builtin_amdgcn_mfma_f32_32x32x16_bf16(b1,qr[d0],p1,0,0,0);}}
}
typedef __attribute__((address_space(3))) const char* lds_cptr;
typedef short v4i16_t __attribute__((ext_vector_type(4)));
__device__ __forceinline__ void kload8(bf16x8*kf,lds_cptr kp){
  kf[0]=*(const __attribute__((address_space(3))) bf16x8*)(kp);      kf[1]=*(const __attribute__((address_space(3))) bf16x8*)(kp+512);
  kf[2]=*(const __attribute__((address_space(3))) bf16x8*)(kp+2048); kf[3]=*(const __attribute__((address_space(3))) bf16x8*)(kp+2560);
  kf[4]=*(const __attribute__((address_space(3))) bf16x8*)(kp+4096); kf[5]=*(const __attribute__((address_space(3))) bf16x8*)(kp+4608);
  kf[6]=*(const __attribute__((address_space(3))) bf16x8*)(kp+6144); kf[7]=*(const __attribute__((address_space(3))) bf16x8*)(kp+6656);
}
__device__ __forceinline__ void kload2(bf16x8*kf,lds_cptr kp,int j){ kf[2*j]=*(const __attribute__((address_space(3))) bf16x8*)(kp+j*2048); kf[2*j+1]=*(const __attribute__((address_space(3))) bf16x8*)(kp+j*2048+512); }
__device__ __forceinline__ s16x4 vtr(lds_cptr p){ return __builtin_bit_cast(s16x4,__builtin_amdgcn_ds_read_tr16_b64_v4i16((__attribute__((address_space(3))) v4i16_t*)p)); }
__device__ __forceinline__ float rowmax(const f32x16&p0,const f32x16&p1){
  float a=max3f(p0[0],p0[1],p1[0]),b=max3f(p0[2],p0[3],p1[1]);a=max3f(a,p1[2],p1[3]);
  #pragma unroll
  for(int r=4;r<16;r+=4){a=max3f(a,p0[r],p0[r+1]);b=max3f(b,p0[r+2],p0[r+3]);a=max3f(a,p1[r],p1[r+1]);b=max3f(b,p1[r+2],p1[r+3]);}
  const float m=max2f(a,b);
  auto rr=__builtin_amdgcn_permlane32_swap(__float_as_uint(m),__float_as_uint(m),false,false);
  return max2f(__uint_as_float(rr[0]),__uint_as_float(rr[1]));
}
__device__ __forceinline__ void pv(f32x16*o,int vb,bf16x8 pa0,bf16x8 pa1,bf16x8 pa2,bf16x8 pa3){
  #pragma unroll
  for(int d0=0;d0<2;++d0){s16x4 lo[4],hi[4];
    #pragma unroll
    for(int ks=0;ks<4;++ks){
      asm volatile("ds_read_b64_tr_b16 %0,%1 offset:%c2":"=&v"(lo[ks]):"v"(vb),"i"(d0*4096+ks*1024):"memory");
      asm volatile("ds_read_b64_tr_b16 %0,%1 offset:%c2":"=&v"(hi[ks]):"v"(vb),"i"(d0*4096+ks*1024+512):"memory");}
    asm volatile("s_waitcnt lgkmcnt(0)":::"memory");SBAR();
    #define PK(k) (bf16x8){lo[k][0],lo[k][1],lo[k][2],lo[k][3],hi[k][0],hi[k][1],hi[k][2],hi[k][3]}
    o[d0]=__builtin_amdgcn_mfma_f32_32x32x16_bf16(pa0,PK(0),o[d0],0,0,0);
    o[d0]=__builtin_amdgcn_mfma_f32_32x32x16_bf16(pa1,PK(1),o[d0],0,0,0);
    o[d0]=__builtin_amdgcn_mfma_f32_32x32x16_bf16(pa2,PK(2),o[d0],0,0,0);
    o[d0]=__builtin_amdgcn_mfma_f32_32x32x16_bf16(pa3,PK(3),o[d0],0,0,0);
    #undef PK
  }
}

#ifndef ATTN_STORE16
#define ATTN_STORE16(p,v) (*(u32x4*)(p)=(v))
#endif
template<int THRL,int MODE> __device__ __forceinline__ void attn_unit(const bf16*Qw0,const bf16*__restrict__ Kh,const bf16*__restrict__ Vh,bf16*Ow0,const int NT,const int lat_off,const int na_r0,const int na_rsmin,const int rpb_off,char*shm){
  const int tid=ltid(),lane=tid&63,r32=lane&31,hi=lane>>5; const int wid=__builtin_amdgcn_readfirstlane(tid>>6);
  const bf16*Qw=Qw0+(long)(wid*QBLK)*DM;
  const unsigned lds0=(unsigned)(uintptr_t)shm;
  float*wsf=(float*)(shm+LDS_WS)+wid*64;
  const bf16*ksrc=Kh+(long)lane*DM+wid*8;
  const bf16*vsrc=Vh+(long)(16*(wid&3)+(lane>>2))*DM+(wid>>2)*32+(lane&3)*8;
  const unsigned kdst=lds0+LDS_K+wid*1024, vdst=lds0+LDS_V+wid*1024;
  #define TROW(t) (((t)<4)?(t)*64:lat_off+((t)-4)*64)
  #define DMA_K(t,slot) glds16(ksrc+(long)TROW(t)*DM,(unsigned)__builtin_amdgcn_readfirstlane(kdst+(slot)))
  #define DMA_V(t,slot) glds16(vsrc+(long)TROW(t)*DM,(unsigned)__builtin_amdgcn_readfirstlane(vdst+(slot)))
  const int vb0=(int)(lds0+LDS_V)+((lane>>4)&1)*32+(lane&3)*8+(4*hi+((lane&15)>>2))*64;
  const char*Kbase=shm+LDS_K; bf16x8 kf[8];
  const lds_cptr shm3=(lds_cptr)shm; const lds_cptr kp0=shm3+LDS_K+hi*1024+r32*16; const lds_cptr vp0=shm3+LDS_V+((lane>>4)&1)*32+(lane&3)*8+(4*hi+((lane&15)>>2))*64;
  DMA_K(0,0);DMA_V(0,0);DMA_K(1,SLOTB);
  bf16x8 qr[4];
  #pragma unroll
  for(int d0=0;d0<4;++d0)qr[d0]=*reinterpret_cast<const bf16x8*>(&Qw[(long)r32*DM+d0*16+hi*8]);
  float mhat=0.f,l_reg=0.f;f32x16 o[2];o[0]=f32x16{};o[1]=f32x16{};f32x16 negm=f32x16{};asm volatile("":"+v"(negm));
  const lds_fptr rp_=(lds_fptr)(shm3+rpb_off); const int na_qr=na_r0+(wid>>1);
  #define CMASK(P0,P1,t) do{ if(MODE==1 && (t)>=4) nabias(P0,P1,na_rsmin+(t)-4,na_qr,r32,wid,hi,rp_); }while(0)
  bool resc=false;
  #define START(P0,P1) do{ const float rm=rowmax(P0,P1); resc=false; \
    { const float dl=rm; mhat=fadd_s(mhat,dl); \
      _Pragma("unroll") for(int r=0;r<16;++r){P0[r]=fsub_s(P0[r],dl);P1[r]=fsub_s(P1[r],dl);} \
      _Pragma("unroll") for(int r=0;r<16;++r)negm[r]=-mhat; asm volatile("":"+v"(negm)); } \
    _Pragma("unroll") for(int r=0;r<16;++r)P0[r]=__builtin_amdgcn_exp2f(P0[r]); }while(0)
  #define RESC() do{ if(resc){ asm volatile("s_waitcnt lgkmcnt(0)":::"memory"); \
      _Pragma("unroll") for(int d_=0;d_<2;++d_) _Pragma("unroll") for(int r=0;r<16;++r)o[d_][r]*=wsf[crow(r,hi)]; } }while(0)
  f32x16 pA0,pA1,pB0,pB1;
  int sl_prev=0,sl_cur=0,sl_next=SLOTB;
  #define ROT() do{sl_prev=sl_cur;sl_cur=sl_next;sl_next=(sl_next==(NSLOT-1)*SLOTB)?0:sl_next+SLOTB;}while(0)
  DMA_K(2,2*SLOTB);
  WAIT_BAR(3);
  qkt(pA0,pA1,Kbase,qr,negm,r32,hi);asm volatile("s_nop 15\n\ts_nop 7":"+v"(pA0),"+v"(pA1));CMASK(pA0,pA1,0);
  START(pA0,pA1);
  _Pragma("unroll") for(int r=0;r<16;++r)pA1[r]=__builtin_amdgcn_exp2f(pA1[r]);
  WAIT_BAR(0);
  DMA_K(3,0);DMA_V(1,SLOTB);
  ROT();
  kload8(kf,kp0+sl_cur);
  WAIT_BAR(2);
  s16x4 vlo[8],vhi[8]; u32x4 pw0,pw1,pw2,pw3;
  #define PKW(P,B) cvtpk_s(P[B],P[B+1])
  #define PAF(k) __builtin_bit_cast(bf16x8,pw##k)
  #define VFR(i) (bf16x8){vlo[i][0],vlo[i][1],vlo[i][2],vlo[i][3],vhi[i][0],vhi[i][1],vhi[i][2],vhi[i][3]}
  #define PIN(x) asm volatile("":"+v"(x))
  #define MX3(a,b,c) __builtin_fmaxf(__builtin_fmaxf((a),(b)),(c))
  #define GAPA(MF,A0,A1,A2,A3,W0,W1,PW) do{ MF; sacc+=A0; sacc+=A1; sacc+=A2; sacc+=A3; PIN(sacc); W0; W1; PIN(PW); SBAR(); }while(0)
  #define EX(v) __builtin_amdgcn_exp2f(v)
  #define GAPB(MF,X,B) do{ MF; X[B]=EX(X[B]); X[B+1]=EX(X[B+1]); X[B+2]=EX(X[B+2]); X[B+3]=EX(X[B+3]); PIN(X); SBAR(); }while(0)
  #define VRD(i) do{ vlo[i]=vtr(vp_+(((i)>>2)*4096+((i)&3)*1024)); vhi[i]=vtr(vp_+(((i)>>2)*4096+((i)&3)*1024+512)); }while(0)
  #define KRD(G,j) do{ if(G){ kload2(kf,kp0+sl_next,j); SBAR(); } }while(0)
  #define STEP(C0,C1,P0,P1,t,GK,GV,GL) do{ SBAR(); \
    const lds_cptr vp_=vp0+sl_prev; \
    VRD(0); SBAR(); float sacc=(P0[0]+P0[1]); \
    GAPA(C0=__builtin_amdgcn_mfma_f32_32x32x16_bf16(kf[0],qr[0],negm,0,0,0), P0[2],P0[3],P0[4],P0[5],     pw0[0]=PKW(P0,0), pw0[1]=PKW(P0,2), pw0); \
    VRD(4); SBAR(); GAPA(C1=__builtin_amdgcn_mfma_f32_32x32x16_bf16(kf[1],qr[0],negm,0,0,0), P0[6],P0[7],P0[8],P0[9],     pw0[2]=PKW(P0,4), pw0[3]=PKW(P0,6), pw0); \
    VRD(1); SBAR(); GAPA(C0=__builtin_amdgcn_mfma_f32_32x32x16_bf16(kf[2],qr[1],C0,0,0,0),   P0[10],P0[11],P0[12],P0[13], pw1[0]=PKW(P0,8), pw1[1]=PKW(P0,10), pw1); \
    VRD(5); SBAR(); GAPA(C1=__builtin_amdgcn_mfma_f32_32x32x16_bf16(kf[3],qr[1],C1,0,0,0),   P0[14],P0[15],P1[0],P1[1],   pw1[2]=PKW(P0,12),pw1[3]=PKW(P0,14), pw1); \
    VRD(2); SBAR(); GAPA(C0=__builtin_amdgcn_mfma_f32_32x32x16_bf16(kf[4],qr[2],C0,0,0,0),   P1[2],P1[3],P1[4],P1[5],     pw2[0]=PKW(P1,0), pw2[1]=PKW(P1,2), pw2); \
    VRD(6); SBAR(); GAPA(C1=__builtin_amdgcn_mfma_f32_32x32x16_bf16(kf[5],qr[2],C1,0,0,0),   P1[6],P1[7],P1[8],P1[9],     pw2[2]=PKW(P1,4), pw2[3]=PKW(P1,6), pw2); \
    VRD(3); SBAR(); GAPA(C0=__builtin_amdgcn_mfma_f32_32x32x16_bf16(kf[6],qr[3],C0,0,0,0),   P1[10],P1[11],P1[12],P1[13], pw3[0]=PKW(P1,8), pw3[1]=PKW(P1,10), pw3); \
    VRD(7); SBAR(); GAPA(C1=__builtin_amdgcn_mfma_f32_32x32x16_bf16(kf[7],qr[3],C1,0,0,0),   P1[14],P1[15],0.f,0.f,       pw3[2]=PKW(P1,12),pw3[3]=PKW(P1,14), pw3); \
    l_reg+=sacc; \
    if(GK){DMA_K((t)+3,sl_cur);} if(GV){DMA_V((t)+1,sl_next);} \
    CMASK(C0,C1,t); \
    { float a=MX3(C0[0],C0[1],C1[0]),b=MX3(C0[2],C0[3],C1[1]); a=MX3(a,C1[2],C1[3]); \
      _Pragma("unroll") for(int r=4;r<16;r+=4){a=MX3(a,C0[r],C0[r+1]);b=MX3(b,C0[r+2],C0[r+3]);a=MX3(a,C1[r],C1[r+1]);b=MX3(b,C1[r+2],C1[r+3]);} \
      float rm=__builtin_fmaxf(a,b); { auto rr=__builtin_amdgcn_permlane32_swap(__float_as_uint(rm),__float_as_uint(rm),false,false); rm=__builtin_fmaxf(__uint_as_float(rr[0]),__uint_as_float(rr[1])); } \
      resc=false; \
      if(__builtin_expect(__any(rm>(float)THRL),0)){ const float dl=__builtin_fmaxf(rm,0.f); mhat+=dl; \
        _Pragma("unroll") for(int r=0;r<16;++r){C0[r]-=dl;C1[r]-=dl;} \
        _Pragma("unroll") for(int r=0;r<16;++r)negm[r]=-mhat; asm volatile("":"+v"(negm)); \
        const float f=__builtin_amdgcn_exp2f(-dl); l_reg*=f; if(hi==0)wsf[r32]=f; resc=true; } } \
    SBAR(); \
    GAPB(o[0]=__builtin_amdgcn_mfma_f32_32x32x16_bf16(PAF(0),VFR(0),o[0],0,0,0), C0,0); \
    GAPB(o[1]=__builtin_amdgcn_mfma_f32_32x32x16_bf16(PAF(0),VFR(4),o[1],0,0,0), C0,4); \
    KRD(GL,0); GAPB(o[0]=__builtin_amdgcn_mfma_f32_32x32x16_bf16(PAF(1),VFR(1),o[0],0,0,0), C0,8); \
    KRD(GL,1); GAPB(o[1]=__builtin_amdgcn_mfma_f32_32x32x16_bf16(PAF(1),VFR(5),o[1],0,0,0), C0,12); \
    KRD(GL,2); GAPB(o[0]=__builtin_amdgcn_mfma_f32_32x32x16_bf16(PAF(2),VFR(2),o[0],0,0,0), C1,0); \
    KRD(GL,3); GAPB(o[1]=__builtin_amdgcn_mfma_f32_32x32x16_bf16(PAF(2),VFR(6),o[1],0,0,0), C1,4); \
    GAPB(o[0]=__builtin_amdgcn_mfma_f32_32x32x16_bf16(PAF(3),VFR(3),o[0],0,0,0), C1,8); \
    GAPB(o[1]=__builtin_amdgcn_mfma_f32_32x32x16_bf16(PAF(3),VFR(7),o[1],0,0,0), C1,12); \
    }while(0)
  int t=1;
  #undef CMASK
  #define CMASK(P0,P1,t) do{ if(MODE==1 && (t)>=4) nabias(P0,P1,na_rsmin+(t)-4,na_qr,r32,wid,hi,rp_); }while(0)
  for(;t+5<NT;t+=2){
    STEP(pB0,pB1,pA0,pA1,t,true,true,true);     WAIT_BAR(2); RESC(); ROT();
    STEP(pA0,pA1,pB0,pB1,t+1,true,true,true);   WAIT_BAR(2); RESC(); ROT();
  }
  #undef CMASK
  #define CMASK(P0,P1,t) do{ if(MODE==1 && (t)>=4) nabias(P0,P1,na_rsmin+(t)-4,na_qr,r32,wid,hi,rp_); }while(0)
  #define ENDW(tt) do{ if((tt)+3<NT){WAIT_BAR(2);} else if((tt)+2<NT){WAIT_BAR(1);} else {WAIT_BAR(0);} }while(0)
  for(;t+1<NT;t+=2){
    STEP(pB0,pB1,pA0,pA1,t,(t+3<NT),(t+1<NT),(t+1<NT));       ENDW(t);   RESC(); ROT();
    STEP(pA0,pA1,pB0,pB1,t+1,(t+4<NT),(t+2<NT),(t+2<NT));     ENDW(t+1); RESC(); ROT();
  }
  STEP(pB0,pB1,pA0,pA1,NT-1,false,false,false); RESC();
  { float sacc=pB0[0]+pB0[1]; _Pragma("unroll") for(int r=2;r<16;++r)sacc+=pB0[r]; _Pragma("unroll") for(int r=0;r<16;++r)sacc+=pB1[r]; l_reg+=sacc;
    pw0=(u32x4){PKW(pB0,0),PKW(pB0,2),PKW(pB0,4),PKW(pB0,6)};pw1=(u32x4){PKW(pB0,8),PKW(pB0,10),PKW(pB0,12),PKW(pB0,14)};pw2=(u32x4){PKW(pB1,0),PKW(pB1,2),PKW(pB1,4),PKW(pB1,6)};pw3=(u32x4){PKW(pB1,8),PKW(pB1,10),PKW(pB1,12),PKW(pB1,14)};
    SBAR(); pv(o,vb0+sl_cur,PAF(0),PAF(1),PAF(2),PAF(3)); }
  #undef PKW
  #undef PAF
  #undef VFR
  #undef PIN
  #undef MX3
  #undef GAPA
  #undef GAPB
  #undef EX
  #undef VRD
  #undef KRD
  #undef STEP
  #undef ENDW
  {auto rr=__builtin_amdgcn_permlane32_swap(__float_as_uint(l_reg),__float_as_uint(l_reg),false,false);l_reg=__uint_as_float(rr[0])+__uint_as_float(rr[1]);}
  if(hi==0)wsf[32+r32]=l_reg;asm volatile("s_waitcnt lgkmcnt(0)":::"memory");
  float rli[16];
  #pragma unroll
  for(int r=0;r<16;++r)rli[r]=__builtin_amdgcn_rcpf(wsf[32+crow(r,hi)]);
  bf16*Ow=Ow0+(long)(wid*QBLK)*ODM;
  { bf16*stg=(bf16*)(shm+LDS_OST)+wid*2048;
    #pragma unroll
    for(int r=0;r<16;++r){const int orow=crow(r,hi);
      #pragma unroll
      for(int d0=0;d0<2;++d0)stg[orow*64+d0*32+r32]=__float2bfloat16(o[d0][r]*rli[r]);}
    asm volatile("s_waitcnt lgkmcnt(0)":::"memory");
    #pragma unroll
    for(int i=0;i<4;++i){const int row=i*8+(lane>>3),ch=lane&7; const u32x4 v=*(const u32x4*)(stg+row*64+ch*8); ATTN_STORE16(Ow+(long)row*ODM+ch*8,v);} }
  asm volatile("s_waitcnt lgkmcnt(0)\n\ts_barrier":::"memory");
  #undef DMA_K
  #undef TROW
  #undef DMA_V
  #undef CMASK
  #undef START
  #undef RESC
  #undef ROT
}
constexpr int ATTN_LDS_BYTES=LDS_BYTES;
}
#ifndef DBG_MASK
#define DBG_MASK 127
#endif
#ifndef DBG_DIAG
#define DBG_DIAG 0
#endif
#ifndef DBG_NA
#define DBG_NA 1
#endif
#ifndef DBG_CTX
#define DBG_CTX 1
#endif
#ifndef DBG_POOL
#define DBG_POOL 1
#endif
namespace cg = cooperative_groups;
#define GAS __attribute__((address_space(1)))
#define LAS __attribute__((address_space(3)))
typedef unsigned short bf16;
typedef unsigned v4u __attribute__((ext_vector_type(4)));
typedef float f32x4 __attribute__((ext_vector_type(4)));
#define LDS_WAIT() asm volatile("s_waitcnt lgkmcnt(0)" ::: "memory")
__device__ __forceinline__ unsigned f2bf(float f) { unsigned u = __builtin_bit_cast(unsigned, f); return (u + 0x7fffu + ((u >> 16) & 1u)) >> 16; }
__device__ __forceinline__ unsigned pk2(float lo, float hi) { return f2bf(lo) | (f2bf(hi) << 16); }
__device__ __forceinline__ float bf2f(unsigned short h) { return __builtin_bit_cast(float, (unsigned)h << 16); }
__device__ __forceinline__ float wave_sum(float v) {
#pragma unroll
    for (int o = 1; o < 64; o <<= 1) v += __shfl_xor(v, o);
    return v;
}
#define RLX_AGENT __ATOMIC_RELAXED, __HIP_MEMORY_SCOPE_AGENT
#define XB_TMO      128
#define XB_XCNT(j)  (256  + 64 * (j))
#define XB_XSUB(j)  (1280 + 64 * (j))
#define XB_XGEN(j)  (2304 + 64 * (j))
#define XB_TOP      3328
#define XB_TOPGEN   3392
#define XCD_BAR_WORDS 3456
#define XB_SPIN_CAP (1u << 18)

__device__ __forceinline__ unsigned xb_ld(unsigned* p)              { return __hip_atomic_load(p, __ATOMIC_RELAXED, __HIP_MEMORY_SCOPE_AGENT); }
__device__ __forceinline__ unsigned xb_add(unsigned* p, unsigned v) { return __hip_atomic_fetch_add(p, v, __ATOMIC_RELAXED, __HIP_MEMORY_SCOPE_AGENT); }
__device__ __forceinline__ unsigned xb_xcc_id() { return (unsigned)__builtin_amdgcn_s_getreg((3 << 11) | 20) & 0xFu; }
#define XB_SPIN(cond, bar) do { unsigned _sp = 0; while (cond) { __builtin_amdgcn_s_sleep(1); \
    if ((++_sp & 255u) == 0u) { if (xb_ld(&(bar)[XB_TMO])) break; if (_sp > XB_SPIN_CAP) { atomicAdd(&(bar)[XB_TMO], 1u); break; } } } } while (0)

struct XcdBarrier {
    unsigned* bar; unsigned x;
    volatile LAS unsigned* st;
};

__device__ __forceinline__ XcdBarrier xcd_barrier_post(unsigned* bar, volatile LAS unsigned* st) {
    XcdBarrier b; b.bar = bar; b.x = xb_xcc_id(); b.st = st;
    if (threadIdx.x == 0) (void)xb_add(&bar[XB_XCNT(b.x)], 1u);
    return b;
}
__device__ __forceinline__ void xcd_barrier_complete(unsigned* bar, unsigned x, unsigned& nloc, unsigned& nx) {
    const unsigned G = gridDim.x * gridDim.y * gridDim.z;
    unsigned sum, cnt, mine, sp = 0u;
    for (;;) {
        sum = 0u; cnt = 0u; mine = 0u;
#pragma unroll
        for (unsigned j = 0; j < 16; ++j) { const unsigned c = xb_ld(&bar[XB_XCNT(j)]); sum += c; cnt += (c > 0u) ? 1u : 0u; mine = (j == x) ? c : mine; }
        if (sum == G) break;
        __builtin_amdgcn_s_sleep(1);
        if ((++sp & 255u) == 0u) { if (xb_ld(&bar[XB_TMO])) break; if (sp > XB_SPIN_CAP) { atomicAdd(&bar[XB_TMO], 1u); break; } }
    }
    nloc = mine > 0u ? mine : 1u; nx = cnt > 0u ? cnt : 1u;
}

__device__ __forceinline__ void xcd_barrier(const XcdBarrier& b) {
    asm volatile("s_waitcnt vmcnt(0)" ::: "memory");
    __syncthreads();
    if (threadIdx.x == 0) {
        unsigned* bar = b.bar;
        __builtin_amdgcn_s_waitcnt(0);
        unsigned nloc = b.st[0], nx = b.st[1];
        if (nloc == 0u) { xcd_barrier_complete(bar, b.x, nloc, nx); b.st[0] = nloc; b.st[1] = nx; }
        const unsigned old = xb_add(&bar[XB_XSUB(b.x)], 1u);
        const unsigned gen = old / nloc;
        if (old + 1u == (gen + 1u) * nloc) {
            __builtin_amdgcn_fence(__ATOMIC_RELEASE, "agent");
            asm volatile("s_waitcnt vmcnt(0)" ::: "memory");
            const unsigned og = xb_add(&bar[XB_TOP], 1u);
            const unsigned tg = og / nx;
            if (og + 1u == (tg + 1u) * nx) xb_add(&bar[XB_TOPGEN], 1u);
            else XB_SPIN(xb_ld(&bar[XB_TOPGEN]) == tg, bar);
            __builtin_amdgcn_fence(__ATOMIC_ACQUIRE, "agent");
            xb_add(&bar[XB_XGEN(b.x)], 1u);
            asm volatile("s_waitcnt vmcnt(0)" ::: "memory");
        } else {
            XB_SPIN(xb_ld(&bar[XB_XGEN(b.x)]) == gen, bar);
            __builtin_amdgcn_fence(__ATOMIC_ACQUIRE, "agent");
            asm volatile("s_waitcnt vmcnt(0)" ::: "memory");
        }
    }
    __syncthreads();
}
constexpr size_t MiB = 1u << 20;
constexpr size_t WS_TS = 1 * MiB + 32768;
constexpr size_t WS_MOD = 0, WS_ROPEC = 1 * MiB, WS_ROPES = 1 * MiB + 8192, WS_BAR = 1 * MiB + 131072, WS_QUEUE = 1 * MiB + 131072 + 16384;
constexpr size_t WS_WIN = 2 * MiB, WS_WOUT = 18 * MiB, WS_WUP = 26 * MiB, WS_WDN = 70 * MiB;
constexpr size_t WS_ST = 92 * MiB, WS_X = 94 * MiB, WS_H = 359 * MiB, WS_Z = 492 * MiB, WS_Y = 756 * MiB, WS_ACT = WS_Z, WS_END = 888 * MiB;
static_assert(WS_WIN + (size_t)P_DEPTH * P_INW * P_D * 2 <= WS_WOUT && WS_WOUT + (size_t)P_DEPTH * P_D * P_D * 2 <= WS_WUP && WS_WUP + (size_t)P_DEPTH * P_UPW * P_D * 2 <= WS_WDN && WS_WDN + (size_t)P_DEPTH * P_D * P_DFF * 2 <= WS_ST && WS_ST + (size_t)P_M * 8 <= WS_X, "weights map");
static_assert(WS_X + (size_t)P_M * P_D * 4 <= WS_H - MiB / 2 && WS_H + (size_t)P_M * P_D * 2 + MiB / 2 <= WS_Z && WS_Z + (size_t)P_M * P_INW * 2 <= WS_Y && WS_Y + (size_t)P_M * P_D * 2 <= WS_END && WS_ACT + (size_t)P_M * P_DFF * 2 <= WS_END, "activation map");
constexpr int LDS_BYTES = 147456, RPB_OFF = 98304, BARST_OFF = 131072 + 64, PAR_OFF = 131072 + 1024, ROPE_OFF = 131072 + 4096;
#ifndef DBG_REP
#define DBG_REP -1
#endif
constexpr int PH_PER_L = 9;
#ifndef DBG_TPROBE
#define DBG_TPROBE -1
#endif
#ifndef DBG_TPROBE_N
#define DBG_TPROBE_N 1
#endif
#ifndef STAG_TICKS
#define STAG_TICKS 700
#endif
#ifndef N1_OUT
#define N1_OUT 34000
#endif
#ifndef N1_DOWN
#define N1_DOWN 0
#endif
#ifndef DBG_P0REP
#define DBG_P0REP 0
#endif
constexpr int N_PHASES = 2 + PH_PER_L * P_DEPTH + 2 * DBG_P0REP;

struct Args {
    const float *x, *c, *ctx, *c_ctx, *w_mod, *b_mod, *w_in, *pool_w, *pool_scale, *na_rpb, *q_norm, *k_norm, *w_out, *ln1_g, *ln1_b, *w_up, *conv_w, *conv_b, *w_down, *ln2_g, *ln2_b;
    float* out; unsigned char* ws; int ph_lo, ph_hi;
};
static_assert(sizeof(Args) == 23 * 8 + 8, "Args has no padding");

template <int OFF> __device__ __forceinline__ unsigned long long ldarg() {
    unsigned long long v; asm volatile("s_load_dwordx2 %0, %1, %2\n\ts_waitcnt lgkmcnt(0)" : "=s"(v) : "s"(__builtin_amdgcn_kernarg_segment_ptr()), "n"(OFF)); return v; }
#define ARGF(A, f) (A).f = (decltype(Args::f))(__attribute__((address_space(1))) void*)ldarg<offsetof(Args, f)>()
__device__ __forceinline__ void p0_item(const float* W, int K, int N, bf16* WT, int k0, int n0, int drow, LAS float* scr, int lane) {
    float wv[32];
#pragma unroll
    for (int i = 0; i < 32; ++i) wv[i] = W[(size_t)(k0 + 2 * i + (lane >> 5)) * N + n0 + (lane & 31)];
#pragma unroll
    for (int i = 0; i < 32; ++i) scr[(2 * i + (lane >> 5)) * 33 + (lane & 31)] = wv[i];
    LDS_WAIT(); asm volatile("" ::: "memory");
    const int c = lane & 7;
#pragma unroll
    for (int j = 0; j < 4; ++j) { const int n = (lane >> 3) + 8 * j; const LAS float* s = scr + (8 * c) * 33 + n;
        v4u o; o.x = pk2(s[0 * 33], s[1 * 33]); o.y = pk2(s[2 * 33], s[3 * 33]); o.z = pk2(s[4 * 33], s[5 * 33]); o.w = pk2(s[6 * 33], s[7 * 33]);
        *(GAS v4u*)(WT + (size_t)(drow + n) * K + k0 + 8 * c) = o; }
    LDS_WAIT(); asm volatile("" ::: "memory");
}

__device__ __forceinline__ void phase_weights(const Args& a, LAS unsigned char* lds, int vcu, int G, int tid, int lane, int wave) {
    unsigned char* ws = a.ws;
    {
        LAS float* scr = (LAS float*)(lds + wave * 16384);
        const int gw = vcu * 8 + wave, NGW = G * 8;
        constexpr int I_IN = 16 * 64, I_OUT = 16 * 32, I_UP = 16 * 176, I_DN = 44 * 32, I_L = I_IN + I_OUT + I_UP + I_DN;
        for (int it = gw; it < P_DEPTH * I_L; it += NGW) {
            const int l = it / I_L; int r = it - l * I_L;
            if (r < I_IN) { const int kb = r >> 6, nb = r & 63, L0 = 32 * nb; const int drow = (L0 & ~255) + ((L0 >> 5) & 1) * 128 + ((L0 >> 6) & 3) * 32;
                p0_item(a.w_in + (size_t)l * P_D * P_INW, P_D, P_INW, (bf16*)(ws + WS_WIN) + (size_t)l * P_INW * P_D, 64 * kb, 32 * nb, drow, scr, lane); continue; }
            r -= I_IN;
            if (r < I_OUT) { const int kb = r >> 5, nb = r & 31;
                p0_item(a.w_out + (size_t)l * P_D * P_D, P_D, P_D, (bf16*)(ws + WS_WOUT) + (size_t)l * P_D * P_D, 64 * kb, 32 * nb, 32 * nb, scr, lane); continue; }
            r -= I_OUT;
            if (r < I_UP) { const int kb = r / 176, nb = r - kb * 176, L0 = 32 * nb; const int half = L0 >= P_DFF ? 1 : 0, ch0 = L0 - half * P_DFF; const int drow = (ch0 >> 7) * 256 + half * 128 + (ch0 & 127);
                p0_item(a.w_up + (size_t)l * P_D * P_UPW, P_D, P_UPW, (bf16*)(ws + WS_WUP) + (size_t)l * P_UPW * P_D, 64 * kb, 32 * nb, drow, scr, lane); continue; }
            r -= I_UP;
            { const int kb = r >> 5, nb = r & 31;
                p0_item(a.w_down + (size_t)l * P_DFF * P_D, P_DFF, P_D, (bf16*)(ws + WS_WDN) + (size_t)l * P_D * P_DFF, 64 * kb, 32 * nb, 32 * nb, scr, lane); }
        }
    }
}
__device__ __forceinline__ void phase0(const Args& a, LAS unsigned char* lds, int vcu, int G, int tid, int lane, int wave) {
    unsigned char* ws = a.ws;
    if (vcu < 192) {
        LAS float* act = (LAS float*)lds; LAS float* red = (LAS float*)(lds + 40960);
        for (int e = tid; e < 9 * P_D; e += 512) { const int r = e >> 10, k = e & 1023; const float v = r < 8 ? a.c[r * P_D + k] : a.c_ctx[k]; act[e] = v / (1.0f + expf(-v)); }
        __syncthreads();
        for (int u = vcu; u < 192; u += G) {
            const int l = u / 48, n0 = (u - l * 48) * 128, cg4 = tid & 31, ks = tid >> 5;
            const float* wp = a.w_mod + (size_t)l * P_D * P_MODW + (size_t)(ks * 64) * P_MODW + n0 + 4 * cg4;
            f32x4 s[9];
#pragma unroll
            for (int r = 0; r < 9; ++r) s[r] = (f32x4){0.f, 0.f, 0.f, 0.f};
#pragma unroll 8
            for (int k = 0; k < 64; ++k) { const f32x4 w = *(const f32x4*)(wp + (size_t)k * P_MODW);
#pragma unroll
                for (int r = 0; r < 9; ++r) s[r] += w * act[r * P_D + ks * 64 + k]; }
#pragma unroll
            for (int r = 0; r < 9; ++r) *(LAS f32x4*)(red + (ks * 9 + r) * 128 + 4 * cg4) = s[r];
            __syncthreads();
            for (int e = tid; e < 9 * 128; e += 512) { const int r = e >> 7, cc = e & 127; float t = 0.f;
#pragma unroll
                for (int k2 = 0; k2 < 16; ++k2) t += red[(k2 * 9 + r) * 128 + cc];
                ((float*)(ws + WS_MOD))[(size_t)(l * 9 + r) * P_MODW + n0 + cc] = t + a.b_mod[l * P_MODW + n0 + cc]; }
            __syncthreads();
        }
    }
    if (vcu == G - 1) {
        for (int e = tid; e < 2048; e += 512) { const int pos = e >> 4, f = e & 15;
            const float inv = exp2f(-(float)f * (13.287712379549449f / 16.0f));
            const float ang = (float)pos * inv;
            ((float*)(ws + WS_ROPEC))[e] = cosf(ang); ((float*)(ws + WS_ROPES))[e] = sinf(ang); }
    }
}

template <int KIND> __device__ __forceinline__ void row_phase(const Args& a, int l, int mode, int n1, int bx, int vcu, int G, int wave, int lane, LAS unsigned char* lds) {
    typedef _Float16 h16x4 __attribute__((ext_vector_type(4)));
    unsigned char* ws = a.ws; const _Float16* X = (const _Float16*)(ws + WS_X); bf16* H = (bf16*)(ws + WS_H); const float* mod = (const float*)(ws + WS_MOD); float* ST = (float*)(ws + WS_ST);
    const bool lastl = (KIND == 2 && l == P_DEPTH - 1);
    const int ml = (KIND == 2) ? l + 1 : l; const int csh = (KIND == 1) ? 3 : 0, csc = (KIND == 1) ? 4 : 1;
    const float* lg = (KIND == 1 ? a.ln1_g : a.ln2_g) + l * P_D; const float* lb = (KIND == 1 ? a.ln1_b : a.ln2_b) + l * P_D;
    LAS f32x4* T4 = (LAS f32x4*)lds;
    { const int tid = wave * 64 + lane;
      if (KIND != 0) for (int e = tid; e < 256; e += 512) { T4[e] = ((const f32x4*)lg)[e]; T4[256 + e] = ((const f32x4*)lb)[e]; }
      if (!lastl) for (int e = tid; e < 9 * 256; e += 512) { const int r = e >> 8, c = e & 255; const float* mp = mod + (size_t)(ml * 9 + r) * P_MODW;
          T4[512 + e] = ((const f32x4*)(mp + csh * P_D))[c]; T4[512 + 2304 + e] = ((const f32x4*)(mp + csc * P_D))[c]; }
      __syncthreads(); }
#define ROW_OF(i) (mode == 1 ? (i) + (((i) >> 13) + 1) * P_CTX : (mode == 2 ? ((i) >> 8) * P_RPB + ((i) & 255) : (i)))
#define ROW_SRC(m_, b_, rb_) ((rb_) < P_CTX ? a.ctx + ((size_t)(b_) * P_CTX + (rb_)) * P_D : a.x + ((size_t)(b_) * P_SEQ + ((rb_) - P_CTX)) * P_D)
#define ROW_LOAD(dst_, m_, b_, rb_) do { if constexpr (KIND == 0) { const f32x4* xr = (const f32x4*)ROW_SRC(m_, b_, rb_) + lane; _Pragma("unroll") for (int j = 0; j < 4; ++j) dst_##f[j] = xr[64 * j]; } \
        else { const h16x4* xr = (const h16x4*)(X + (size_t)(m_) * P_D) + lane; _Pragma("unroll") for (int j = 0; j < 4; ++j) dst_##h[j] = xr[64 * j]; } } while (0)
    for (int seg = 0; seg < 2; ++seg) {
        int start, stride, end;
        if (seg == 0) { start = vcu * 8 + wave; stride = G * 8; end = (mode == 0) ? P_M : (mode == 2 ? P_B * P_CTX : n1); }
        else { if (mode != 1 || bx < 32) break; start = n1 + (bx - 32) * 8 + wave; stride = (G - 32) * 8; end = P_B * P_SEQ; }
        f32x4 vnf[4]; h16x4 vnh[4];
        if (start < end) { const int m0 = ROW_OF(start); const int b0 = m0 / P_RPB, rb0 = m0 - b0 * P_RPB; ROW_LOAD(vn, m0, b0, rb0); }
        for (int i = start; i < end; i += stride) {
            const int m = ROW_OF(i);
            const int b = m / P_RPB, rb = m - b * P_RPB; const bool is_ctx = rb < P_CTX; const int mrow = is_ctx ? 8 : b;
            f32x4 v[4];
#pragma unroll
            for (int j = 0; j < 4; ++j) { if constexpr (KIND == 0) v[j] = vnf[j]; else v[j] = __builtin_convertvector(vnh[j], f32x4); }
            if (i + stride < end) { const int m1 = ROW_OF(i + stride); const int b1 = m1 / P_RPB, rb1 = m1 - b1 * P_RPB; ROW_LOAD(vn, m1, b1, rb1); }
            if (KIND != 0) {
                float s = 0.f;
#pragma unroll
                for (int j = 0; j < 4; ++j) s += (v[j].x + v[j].y) + (v[j].z + v[j].w);
                const float mean = wave_sum(s) * (1.f / P_D); float s2 = 0.f;
#pragma unroll
                for (int j = 0; j < 4; ++j) { v[j] = v[j] - mean; s2 += (v[j].x * v[j].x + v[j].y * v[j].y) + (v[j].z * v[j].z + v[j].w * v[j].w); }
                const float rstd = 1.f / sqrtf(wave_sum(s2) * (1.f / P_D) + P_EPS);
                if (!lastl && lane == 0) { ST[(size_t)m * 2] = mean; ST[(size_t)m * 2 + 1] = rstd; }
#pragma unroll
                for (int j = 0; j < 4; ++j) { const f32x4 g = T4[lane + 64 * j], bb = T4[256 + lane + 64 * j]; v[j] = v[j] * rstd * g + bb; }
            }
            if (lastl) {
#if DBG_TPROBE >= 0
                if (i < 64) { const unsigned long long* ts = (const unsigned long long*)(ws + WS_TS); const float d_us = (float)(ts[DBG_TPROBE + DBG_TPROBE_N] - ts[DBG_TPROBE]) * 0.01f;
                    const float eps_ = sqrtf(d_us * 2.07e-6f);
#pragma unroll
                    for (int j = 0; j < 4; ++j) v[j] = v[j] + eps_; }
#endif
                if (!is_ctx) { f32x4* o = (f32x4*)(a.out + ((size_t)b * P_SEQ + (rb - P_CTX)) * P_D) + lane;
#pragma unroll
                    for (int j = 0; j < 4; ++j) o[64 * j] = v[j]; }
            } else {
                unsigned long long* o8 = (unsigned long long*)(H + (size_t)m * P_D) + lane;
#pragma unroll
                for (int j = 0; j < 4; ++j) { const f32x4 sh = T4[512 + mrow * 256 + lane + 64 * j], sc = T4[512 + 2304 + mrow * 256 + lane + 64 * j];
                    const f32x4 h = v[j] * (1.0f + sc) + sh;
                    o8[64 * j] = (unsigned long long)pk2(h.x, h.y) | ((unsigned long long)pk2(h.z, h.w) << 32); }
            }
        }
    }
#undef ROW_OF
#undef ROW_SRC
#undef ROW_LOAD
    __syncthreads();
}

__device__ __forceinline__ void pool_phase(const Args& a, int l, LAS unsigned char* lds, int ubeg, int uend, int ustride, int tid) {
    typedef float f32x16 __attribute__((ext_vector_type(16)));
    const bf16* Z = (const bf16*)(a.ws + WS_Z); bf16* Y = (bf16*)(a.ws + WS_Y);
    LAS float* zt = (LAS float*)lds;
    LAS float* pl = (LAS float*)(lds + 36864);
    LAS float* wl = (LAS float*)(lds + 36864 + 33280);
    v4u pre[3]; f32x4 wpre[2];
#define POOL_DECODE(u_) const int tk_ = (u_) >> 2, g_ = (u_) & 3; const int row0_ = tk_ * 128; const int b_ = row0_ / P_RPB, rb0_ = row0_ - b_ * P_RPB; \
        const int slo_ = (rb0_ < P_CTX) ? b_ * P_RPB : b_ * P_RPB + P_CTX, shi_ = (rb0_ < P_CTX) ? b_ * P_RPB + P_CTX : (b_ + 1) * P_RPB;
#define POOL_ISSUE(u_) do { POOL_DECODE(u_) \
        _Pragma("unroll") for (int i = 0; i < 3; ++i) { const int e = tid + 512 * i; const int rr = e >> 3, c8 = e & 7; const int R = row0_ - 8 + rr; \
            pre[i] = (v4u){0u, 0u, 0u, 0u}; if (e < 144 * 8 && R >= slo_ && R < shi_) pre[i] = *(const v4u*)(Z + (size_t)R * P_INW + g_ * 64 + c8 * 8); } \
        const f32x4* wsrc = (const f32x4*)(a.pool_w + ((size_t)l * 4 + g_) * 4096); wpre[0] = wsrc[tid]; wpre[1] = wsrc[tid + 512]; } while (0)
    int u = ubeg;
    if (u < uend) POOL_ISSUE(u);
    for (; u < uend; u += ustride) {
        POOL_DECODE(u)
#pragma unroll
        for (int i = 0; i < 3; ++i) { const int e = tid + 512 * i; if (e < 144 * 8) { const int rr = e >> 3, c8 = e & 7; const v4u w = pre[i]; LAS float* d = zt + rr * 64 + c8 * 8;
            *(LAS f32x4*)d = (f32x4){bf2f(w.x & 0xffff), bf2f(w.x >> 16), bf2f(w.y & 0xffff), bf2f(w.y >> 16)}; *(LAS f32x4*)(d + 4) = (f32x4){bf2f(w.z & 0xffff), bf2f(w.z >> 16), bf2f(w.w & 0xffff), bf2f(w.w >> 16)}; } }
        ((LAS f32x4*)wl)[tid] = wpre[0]; ((LAS f32x4*)wl)[tid + 512] = wpre[1];
        if (u + ustride < uend) POOL_ISSUE(u + ustride);
        __syncthreads();
        { const int c = tid & 63, t0 = (tid >> 6) * 16, hw = 1 << g_;
          float s = 0.f;
          for (int p = t0 - hw; p < t0 + hw; ++p) s += zt[(p + 8) * 64 + c];
#pragma unroll 4
          for (int k = 0; k < 16; ++k) { const int t = t0 + k, T = row0_ + t; const int lo = max(T - hw, slo_), hi = min(T + hw - 1, shi_ - 1);
              pl[t * 65 + c] = s * __builtin_amdgcn_rcpf((float)(hi - lo + 1)) - zt[(t + 8) * 64 + c];
              s += zt[(t + hw + 8) * 64 + c] - zt[(t - hw + 8) * 64 + c]; } }
        __syncthreads();
        { const int lane = tid & 63, wid = tid >> 6, r32 = lane & 31, hi = lane >> 5, tw = wid >> 1, dw = wid & 1;
          f32x16 acc;
#pragma unroll
          for (int r = 0; r < 16; ++r) acc[r] = 0.f;
          const LAS float* ap = pl + (32 * tw + r32) * 65 + hi; const LAS float* bp = wl + hi * 64 + 32 * dw + r32;
#pragma unroll 8
          for (int kk = 0; kk < 32; ++kk) acc = __builtin_amdgcn_mfma_f32_32x32x2f32(ap[2 * kk], bp[2 * kk * 64], acc, 0, 0, 0);
          const float sc = a.pool_scale[l * 256 + g_ * 64 + 32 * dw + r32];
          bf16* yp = Y + (size_t)(row0_ + 32 * tw + 4 * hi) * P_D + g_ * 64 + 32 * dw + r32;
#pragma unroll
          for (int r = 0; r < 16; ++r) yp[(size_t)((r & 3) + 8 * (r >> 2)) * P_D] = (bf16)f2bf(acc[r] * sc); }
        __syncthreads();
    }
#undef POOL_DECODE
#undef POOL_ISSUE
}

__device__ __forceinline__ void mix_phase(const Args& a, int l, unsigned char* ldsg, LAS unsigned char* lds, int vcu, int G, int tid) {
    using abf = attn_body::bf16;
    const abf* Z = (const abf*)(a.ws + WS_Z); abf* Y = (abf*)(a.ws + WS_Y);
    { LAS float* rp = (LAS float*)(lds + RPB_OFF); const float* src = a.na_rpb + (size_t)l * 6 * 465;
      for (int e = tid; e < 6 * 465; e += 512) rp[e] = src[e] * P_LOG2E; }
    __syncthreads();
#if DBG_TPROBE >= 0
#define MIXSTAMP(k) do { if (l == 1 && blockIdx.x == 0 && tid == 0) ((unsigned long long*)(a.ws + WS_TS))[k] = __builtin_amdgcn_s_memrealtime(); } while (0)
#else
#define MIXSTAMP(k) do {} while (0)
#endif
    MIXSTAMP(40);
    for (int u = vcu; u < 1536; u += G) { const int h = u >> 8, b = (u >> 5) & 7, qb = u & 31, kv = h / 3;
        const size_t brow = (size_t)b * P_RPB, qrow = brow + P_CTX + (size_t)qb * 256;
        attn_body::attn_unit<8, 0>(Z + qrow * P_INW + 1408 + 64 * h, Z + brow * P_INW + 1792 + 64 * kv, Z + brow * P_INW + 1920 + 64 * kv, Y + qrow * P_D + 640 + 64 * h, 132, 256, 0, 0, RPB_OFF, (char*)ldsg); }
    MIXSTAMP(41);
    {
        unsigned* Qc = (unsigned*)(a.ws + WS_QUEUE) + l * 64;
        volatile LAS unsigned* qslot = (volatile LAS unsigned*)(lds + BARST_OFF + 32);
        const int N_NA = 1536, N_CTX = (l < P_DEPTH - 1) ? 96 : 0, N_POOL = P_M / 128, NI = N_NA + N_CTX + N_POOL;
        unsigned mine = 0u; if (tid == 0) mine = atomicAdd(Qc, 1u);
        for (;;) {
            if (tid == 0) *qslot = mine;
            __syncthreads();
            const int item = __builtin_amdgcn_readfirstlane((int)*qslot);
            if (item >= NI) break;
            if (tid == 0) mine = atomicAdd(Qc, 1u);
            if (item < N_NA) { const int u = item; const int h = u >> 8, b = (u >> 5) & 7, qb = u & 31;
                const size_t brow = (size_t)b * P_RPB, qrow = brow + P_CTX + (size_t)qb * 256;
                const int rsmin = min(max(4 * qb - 4, 0), 116);
                attn_body::attn_unit<8, 1>(Z + qrow * P_INW + 256 + 64 * h, Z + brow * P_INW + 640 + 64 * h, Z + brow * P_INW + 1024 + 64 * h, Y + qrow * P_D + 256 + 64 * h, 16, 256 + 64 * rsmin, 4 * qb, rsmin, RPB_OFF + h * 465 * 4, (char*)ldsg);
            } else if (item < N_NA + N_CTX) { const int u = item - N_NA; const int b = u / 12, hh = u - b * 12; const size_t brow = (size_t)b * P_RPB;
                int qc, kc, vc, oc;
                if (hh < 6) { qc = 256 + 64 * hh; kc = 640 + 64 * hh; vc = 1024 + 64 * hh; oc = 256 + 64 * hh; }
                else { const int h = hh - 6; qc = 1408 + 64 * h; kc = 1792 + 64 * (h / 3); vc = 1920 + 64 * (h / 3); oc = 640 + 64 * h; }
                attn_body::attn_unit<8, 0>(Z + brow * P_INW + qc, Z + brow * P_INW + kc, Z + brow * P_INW + vc, Y + brow * P_D + oc, 4, 256, 0, 0, RPB_OFF, (char*)ldsg);
            } else { const int tk = item - N_NA - N_CTX; pool_phase(a, l, lds, 4 * tk, 4 * tk + 4, 1, ltid()); }
        }
    }
    MIXSTAMP(44);
}


#if DBG_DIAG
constexpr size_t WS_FLAG = 1 * MiB + 65536;
__device__ __forceinline__ bool vclose(float mine, float ref, float tol) {
    const float d = wave_sum((mine - ref) * (mine - ref)), n = wave_sum(ref * ref); return d <= tol * tol * n + 1e-12f; }
__device__ __forceinline__ float na_ref(const Args& a, const bf16* Z, int b, int h, int pos, int lane) {
    const size_t Rl = (size_t)b * P_RPB + P_CTX + pos; const int gr = pos >> 6, gc = pos & 63; const int rs = min(max(gr - 4, 0), 120), cs = min(max(gc - 8, 0), 48);
    float mx = -1e30f, sc[6];
    for (int i = 0; i < 6; ++i) { const int key = lane + 64 * i; size_t kr_; float bias = 0.f;
        if (key < 128) { const int kr = rs + key / 16, kc = cs + key % 16; kr_ = (size_t)b * P_RPB + P_CTX + kr * 64 + kc; bias = a.na_rpb[(size_t)h * 465 + (kr - gr + 7) * 31 + (kc - gc + 15)] * P_LOG2E; }
        else kr_ = (size_t)b * P_RPB + (key - 128);
        float s = 0.f; for (int d = 0; d < 64; ++d) s += bf2f(Z[Rl * P_INW + 256 + 64 * h + d]) * bf2f(Z[kr_ * P_INW + 640 + 64 * h + d]);
        sc[i] = s + bias; mx = fmaxf(mx, sc[i]); }
    for (int o = 1; o < 64; o <<= 1) mx = fmaxf(mx, __shfl_xor(mx, o));
    float den = 0.f; for (int i = 0; i < 6; ++i) { sc[i] = exp2f(sc[i] - mx); den += sc[i]; } den = wave_sum(den);
    float o_ = 0.f;
    for (int i = 0; i < 6; ++i) for (int l2 = 0; l2 < 64; ++l2) { const int key = l2 + 64 * i; size_t kr_;
        if (key < 128) { const int kr = rs + key / 16, kc = cs + key % 16; kr_ = (size_t)b * P_RPB + P_CTX + kr * 64 + kc; } else kr_ = (size_t)b * P_RPB + (key - 128);
        o_ += __shfl(sc[i], l2) * bf2f(Z[kr_ * P_INW + 1024 + 64 * h + lane]); }
    return o_ / den;
}
__device__ __forceinline__ float att_ref(const bf16* Z, size_t qrow, size_t krow0, int ntile, int qc, int kc, int vc, int lane) {
    float mx = -1e30f;
    for (int i = 0; i < ntile; ++i) { const size_t kr_ = krow0 + lane + 64 * i; float s = 0.f;
        for (int d = 0; d < 64; ++d) s += bf2f(Z[qrow * P_INW + qc + d]) * bf2f(Z[kr_ * P_INW + kc + d]); mx = fmaxf(mx, s); }
    for (int o = 1; o < 64; o <<= 1) mx = fmaxf(mx, __shfl_xor(mx, o));
    float den = 0.f, o_ = 0.f;
    for (int i = 0; i < ntile; ++i) { const size_t kr_ = krow0 + lane + 64 * i; float s = 0.f;
        for (int d = 0; d < 64; ++d) s += bf2f(Z[qrow * P_INW + qc + d]) * bf2f(Z[kr_ * P_INW + kc + d]);
        const float p = exp2f(s - mx); den += p;
        for (int l2 = 0; l2 < 64; ++l2) o_ += __shfl(p, l2) * bf2f(Z[(krow0 + l2 + 64 * i) * P_INW + vc + lane]); }
    return o_ / wave_sum(den);
}
__device__ __forceinline__ float pool_ref(const Args& a, const bf16* Z, size_t R, size_t slo, size_t shi, int g, int lane) {
    const int hw = 1 << g; const size_t lo = (R >= slo + hw) ? R - hw : slo, hi = (R + hw - 1 < shi) ? R + hw - 1 : shi - 1;
    float s = 0.f; for (size_t p = lo; p <= hi; ++p) s += bf2f(Z[p * P_INW + g * 64 + lane]);
    const float pooled = s / (float)(hi - lo + 1) - bf2f(Z[R * P_INW + g * 64 + lane]); float y = 0.f;
    for (int c = 0; c < 64; ++c) y += __shfl(pooled, c) * a.pool_w[(size_t)g * 4096 + c * 64 + lane];
    return y * a.pool_scale[g * 64 + lane];
}
__device__ __forceinline__ void diag_phase(const Args& a, int code, int vcu, int tid, int G) {
    unsigned char* ws = a.ws; unsigned* flag = (unsigned*)(ws + WS_FLAG);
    const bf16* Z = (const bf16*)(ws + WS_Z); const bf16* Y = (const bf16*)(ws + WS_Y);
    const int lane = tid & 63;
    if (code == 199) {
        const unsigned fl = *flag; int first = 0; for (int i = 0; i < 16; ++i) if ((fl >> i) & 1) { first = i + 1; break; }
        for (size_t i = (size_t)vcu * 512 + tid; i < (size_t)P_B * P_SEQ * P_D; i += (size_t)G * 512) a.out[i] = (float)first;
        return;
    }
    if (vcu != 0 || tid >= 64) return;
    if (code == 100) { if (lane == 0) *flag = 0u; return; }
    if (code == 102) {
        const float TOL = 0.006f;
        const int nb[5] = {0, 7, 3, 5, 2}, nh[5] = {0, 5, 2, 3, 1}, npos[5] = {0, 127 * 64 + 63, 60 * 64 + 3, 2 * 64 + 30, 64 * 64 + 31};
        for (int q = 0; q < 5; ++q) { const float r = na_ref(a, Z, nb[q], nh[q], npos[q], lane); const float m = bf2f(Y[((size_t)nb[q] * P_RPB + P_CTX + npos[q]) * P_D + 256 + 64 * nh[q] + lane]);
            if (!vclose(m, r, TOL) && lane == 0) atomicOr(flag, 1u << q); }
        const int gb[2] = {1, 7}, gh[2] = {0, 5}, gpos[2] = {100, 8191};
        for (int q = 0; q < 2; ++q) { const size_t brow = (size_t)gb[q] * P_RPB; const float r = att_ref(Z, brow + P_CTX + gpos[q], brow, 132, 1408 + 64 * gh[q], 1792 + 64 * (gh[q] / 3), 1920 + 64 * (gh[q] / 3), lane);
            const float m = bf2f(Y[(brow + P_CTX + gpos[q]) * P_D + 640 + 64 * gh[q] + lane]); if (!vclose(m, r, TOL) && lane == 0) atomicOr(flag, 1u << (5 + q)); }
        { const size_t brow = (size_t)1 * P_RPB; const float r = att_ref(Z, brow + 200, brow, 4, 256 + 64 * 3, 640 + 64 * 3, 1024 + 64 * 3, lane); const float m = bf2f(Y[(brow + 200) * P_D + 256 + 64 * 3 + lane]);
          if (!vclose(m, r, TOL) && lane == 0) atomicOr(flag, 1u << 7); }
        { const size_t brow = (size_t)6 * P_RPB; const float r = att_ref(Z, brow + 17, brow, 4, 1408 + 64 * 4, 1792 + 64 * 1, 1920 + 64 * 1, lane); const float m = bf2f(Y[(brow + 17) * P_D + 640 + 64 * 4 + lane]);
          if (!vclose(m, r, TOL) && lane == 0) atomicOr(flag, 1u << 8); }
        { const size_t brow = (size_t)4 * P_RPB; const size_t R = brow + P_CTX; const float r = pool_ref(a, Z, R, brow + P_CTX, brow + P_RPB, 0, lane); if (!vclose(bf2f(Y[R * P_D + lane]), r, TOL) && lane == 0) atomicOr(flag, 1u << 9); }
        { const size_t brow = (size_t)7 * P_RPB; const size_t R = brow + P_RPB - 1; const float r = pool_ref(a, Z, R, brow + P_CTX, brow + P_RPB, 3, lane); if (!vclose(bf2f(Y[R * P_D + 192 + lane]), r, TOL) && lane == 0) atomicOr(flag, 1u << 10); }
        { const size_t brow = (size_t)3 * P_RPB; const size_t R = brow + 255; const float r = pool_ref(a, Z, R, brow, brow + P_CTX, 2, lane); if (!vclose(bf2f(Y[R * P_D + 128 + lane]), r, TOL) && lane == 0) atomicOr(flag, 1u << 11); }
    }
}
#endif

__global__ void __launch_bounds__(512, 2) mega(Args a) {
    extern __shared__ __attribute__((aligned(16))) unsigned char ldsraw[];
    LAS unsigned char* lds = (LAS unsigned char*)ldsraw;
    cg::grid_group grid = cg::this_grid();
    const int G = gridDim.x; const int bx = blockIdx.x; const int vcu = (G % 8 == 0) ? (bx % 8) * (G / 8) + bx / 8 : bx;
    const int ph_lo = a.ph_lo, ph_hi = a.ph_hi;
    volatile LAS unsigned* barst = (volatile LAS unsigned*)(lds + BARST_OFF);
    if (threadIdx.x < 2) barst[threadIdx.x] = 0u;
    if (ph_lo == 0 && blockIdx.x == 0) { unsigned* bw = (unsigned*)(a.ws + WS_BAR); for (int i = threadIdx.x; i < XCD_BAR_WORDS; i += 512) bw[i] = 0u;
        if (threadIdx.x < P_DEPTH * 64) ((unsigned*)(a.ws + WS_QUEUE))[threadIdx.x] = 0u; }
    __syncthreads();
    XcdBarrier xbar; xbar.bar = (unsigned*)(a.ws + WS_BAR); xbar.x = 0; xbar.st = barst;
    for (int ph_ = ph_lo; ph_ < ph_hi; ++ph_) {
        const int ph = (ph_ < 2 * DBG_P0REP) ? (ph_ & 1) : ph_ - 2 * DBG_P0REP;
        if (ph >= 2 && ph < 100 && (ph - 2) / PH_PER_L == P_DEPTH - 1 && ((ph - 2) % PH_PER_L == 4 || (ph - 2) % PH_PER_L == 8)) continue;
        if (ph_ > ph_lo) {
            if (ph_ == ph_lo + 1) { grid.sync(); xbar = xcd_barrier_post((unsigned*)(a.ws + WS_BAR), barst); }
            else xcd_barrier(xbar);
        }
        const int tid = ltid(), lane = tid & 63, wave = __builtin_amdgcn_readfirstlane(tid >> 6);
#if DBG_TPROBE >= 0
        if (blockIdx.x == 0 && tid == 0) ((unsigned long long*)(a.ws + WS_TS))[ph] = __builtin_amdgcn_s_memrealtime();
#endif
        Args q;
        ARGF(q, ws); unsigned char* ws = q.ws;
#if DBG_DIAG
        if (ph >= 100) { q = a; diag_phase(q, ph, vcu, tid, G); continue; }
#endif
        if (ph == 0) { ARGF(q, c); ARGF(q, c_ctx); ARGF(q, w_mod); ARGF(q, b_mod); phase0(q, lds, vcu, G, tid, lane, wave); continue; }
        if (ph == 1) { ARGF(q, x); ARGF(q, ctx); ARGF(q, w_in); ARGF(q, w_out); ARGF(q, w_up); ARGF(q, w_down); row_phase<0>(q, 0, 0, 0, bx, vcu, G, wave, lane, lds); phase_weights(q, lds, vcu, G, tid, lane, wave); continue; }
        const int l = (ph - 2) / PH_PER_L, sp = (ph - 2) % PH_PER_L; const bool lastL = (l == P_DEPTH - 1);
        if (sp == 0) {
            ARGF(q, q_norm); ARGF(q, k_norm);
            pg8::Gemm g{(const pg8::bf16_t*)(ws + WS_H), (const pg8::bf16_t*)(ws + WS_WIN) + (size_t)l * P_INW * P_D, P_M, P_INW, P_D};
            pg8::StaticOrder S; S.init(P_M / 256, P_INW / 256, G, bx);
            { LAS float* tab = (LAS float*)(lds + ROPE_OFF); const float* rc = (const float*)(ws + WS_ROPEC); const float* rs = (const float*)(ws + WS_ROPES);
              for (int e2 = tid; e2 < 1024; e2 += 512) { tab[e2] = rc[e2]; tab[1024 + e2] = rs[e2]; }
              if (tid < 64) { tab[2048 + tid] = q.q_norm[l * 64 + tid]; tab[2112 + tid] = q.k_norm[l * 64 + tid]; }
              __syncthreads(); }
            pg8::EpiIn E{(pg8::bf16_t*)(ws + WS_Z), (const float*)(ws + WS_ROPEC), (const float*)(ws + WS_ROPES), (LAS float*)(lds + ROPE_OFF)};
            pg8::gemm_phase<pg8::EpiIn, pg8::StaticOrder, true, true, 0>(lds, g, S, E);
        } else if (sp == 1) {
            ARGF(q, na_rpb); ARGF(q, pool_w); ARGF(q, pool_scale);
            mix_phase(q, l, ldsraw, lds, vcu, G, tid);
        } else if (sp == 5) {
            ARGF(q, conv_w); ARGF(q, conv_b);
            pg8::Gemm g{(const pg8::bf16_t*)(ws + WS_H) - P_D, (const pg8::bf16_t*)(ws + WS_WUP) + (size_t)l * P_UPW * P_D, P_M, P_UPW, P_D};
            pg8::StaticOrder S; S.init((P_M + 247) / 248, P_UPW / 256, G, bx);
            pg8::EpiUp E{(pg8::bf16_t*)(ws + WS_ACT), q.conv_w + (size_t)l * 3 * P_UPW, q.conv_b + (size_t)l * P_UPW, (LAS float*)(lds + PAR_OFF)};
            pg8::gemm_phase<pg8::EpiUp, pg8::StaticOrder, true, true, 1>(lds, g, S, E);
        } else {
            const bool isdown = sp >= 6, ctxpart = (sp == 3 || sp == 7);
            ARGF(q, ln1_g); ARGF(q, ln1_b); ARGF(q, ln2_g); ARGF(q, ln2_b);
            if (sp == 2 || sp == 6 || (ctxpart && !lastL)) {
                ARGF(q, x); ARGF(q, ctx);
                const bool first = (!isdown && l == 0);
                pg8::Gemm g{(const pg8::bf16_t*)(ws + (isdown ? WS_ACT : WS_Y)), isdown ? (const pg8::bf16_t*)(ws + WS_WDN) + (size_t)l * P_D * P_DFF : (const pg8::bf16_t*)(ws + WS_WOUT) + (size_t)l * P_D * P_D, P_M, P_D, isdown ? P_DFF : P_D};
                pg8::StaticOrder S; S.init(P_B * P_SEQ / 256, P_D / 256, G, bx); S.skipctx = 1; S.ctxonly = ctxpart ? 1 : 0;
                pg8::EpiRes E{(_Float16*)(ws + WS_X), (const float*)(ws + WS_MOD) + (size_t)l * 9 * P_MODW + (isdown ? 5 : 2) * P_D, (const float*)(ws + WS_ST),
                              first ? nullptr : (isdown ? q.ln1_g + l * P_D : q.ln2_g + (l - 1) * P_D), first ? nullptr : (isdown ? q.ln1_b + l * P_D : q.ln2_b + (l - 1) * P_D), q.x, q.ctx, (LAS float*)(lds + PAR_OFF)};
                pg8::gemm_phase<pg8::EpiRes, pg8::StaticOrder, true, true, 0>(lds, g, S, E);
            }
            if (sp == 3 || (sp == 4 && !lastL)) row_phase<1>(q, l, sp == 3 ? 1 : 2, lastL ? P_B * P_SEQ : N1_OUT, bx, vcu, G, wave, lane, lds);
            if (sp == 7 || (sp == 8 && !lastL)) { ARGF(q, out); row_phase<2>(q, l, sp == 7 ? 1 : 2, lastL ? P_B * P_SEQ : N1_DOWN, bx, vcu, G, wave, lane, lds); }
        }
    }
}

#ifndef MK_MULTI
#define MK_MULTI 0
#endif
extern "C" void kernel_launch(void* const* d_in, const int* in_sizes, int n_in, void* d_out, int out_size, void* d_ws, size_t ws_size, hipStream_t stream) {
    static int grid = 0;
    if (grid == 0) {
        if (n_in != 21 || ws_size < WS_END) { fprintf(stderr, "kernel_launch: unexpected n_in %d / ws_size %zu\n", n_in, ws_size); grid = -1; return; }
        int dev = 0, cus = 0, per_cu = 0;
        if (hipGetDevice(&dev) != hipSuccess || hipDeviceGetAttribute(&cus, hipDeviceAttributeMultiprocessorCount, dev) != hipSuccess) { grid = -1; return; }
        if (hipFuncSetAttribute((const void*)mega, hipFuncAttributeMaxDynamicSharedMemorySize, LDS_BYTES) != hipSuccess) { fprintf(stderr, "kernel_launch: hipFuncSetAttribute failed\n"); grid = -1; return; }
        if (hipOccupancyMaxActiveBlocksPerMultiprocessor(&per_cu, (const void*)mega, 512, LDS_BYTES) != hipSuccess || per_cu < 1) { fprintf(stderr, "kernel_launch: occupancy query says %d\n", per_cu); per_cu = 1; }
        (void)hipGetLastError();
        grid = cus * 1;
        fprintf(stderr, "kernel_launch: cus %d per_cu %d grid %d\n", cus, per_cu, grid);
    }
    if (grid < 0) return;
    Args a{};
    const float** f = (const float**)&a;
    for (int i = 0; i < 21; ++i) f[i] = (const float*)d_in[i];
    a.out = (float*)d_out; a.ws = (unsigned char*)d_ws;
#if MK_MULTI
#if DBG_DIAG
    { const int seq[] = {0, 1, 100, 2, 3, 102, 199};
      for (int i = 0; i < 7; ++i) { a.ph_lo = seq[i]; a.ph_hi = seq[i] + 1; hipLaunchKernelGGL(mega, dim3(grid), dim3(512), LDS_BYTES, stream, a); } }
#else
    for (int ph = 0; ph < N_PHASES; ++ph) { a.ph_lo = ph; a.ph_hi = ph + 1; hipLaunchKernelGGL(mega, dim3(grid), dim3(512), LDS_BYTES, stream, a); }
#endif
#else
    a.ph_lo = 0; a.ph_hi = N_PHASES;
    void* args[] = {&a};
    hipError_t e = hipLaunchCooperativeKernel((const void*)mega, dim3(grid), dim3(512), args, LDS_BYTES, stream);
    if (e != hipSuccess) fprintf(stderr, "cooperative launch failed: %s (grid %d)\n", hipGetErrorString(e), grid);
#endif
}
```
